# Optimizing an MI355X kernel written in HIP

```python
import math
import jax, jax.numpy as jnp
from jax import lax
import numpy as np

D_MODEL = 1024
BATCH = 32
SEQ = 2048
DEPTH = 4
DEC_BATCH = 8
DEC_SEQ = 64
PAST_LEN = 1024

CHUNK = 64
Q_BLOCK = 128
H_A = 8
HD_A = 64
W_A = H_A * HD_A
H_B = 8
HD_B = 64
W_B = H_B * HD_B
H_IDX = 8
D_IDX = 64
MAX_SELECT = 256
N_BUCKETS = 32
MAX_DISTANCE = 128
LN_EPS = 1e-5
ALPHA = (2 * DEPTH) ** 0.25
BETA = (8 * DEPTH) ** -0.25
SB_SCALE = HD_A ** -0.5
ATT_SCALE = HD_B ** -0.5
SPLIT_SIZES = (W_A, W_A, W_A, W_A, W_B, HD_B, HD_B, W_B, H_IDX * D_IDX, D_IDX, H_IDX, D_MODEL, D_MODEL)
D_IN = 4 * W_A + 2 * W_B + 2 * HD_B + H_IDX * D_IDX + D_IDX + H_IDX + 2 * D_MODEL

kernel_name = 'stickbreak_dsa_hybrid_stream_step'


def layer_norm(x, g, b):
    xf = x.astype(jnp.float32)
    mu = jnp.mean(xf, axis=-1, keepdims=True)
    var = jnp.mean(jnp.square(xf - mu), axis=-1, keepdims=True)
    return ((xf - mu) * lax.rsqrt(var + LN_EPS) * g + b).astype(x.dtype)


def t5_bucket(rel):
    half = N_BUCKETS // 2
    max_exact = half // 2
    n = jnp.abs(rel)
    n_f = jnp.maximum(n, 1).astype(jnp.float32)
    large = max_exact + (jnp.log(n_f / max_exact) / math.log(MAX_DISTANCE / max_exact)
                         * (half - max_exact)).astype(jnp.int32)
    large = jnp.minimum(large, half - 1)
    return jnp.where(rel > 0, half, 0) + jnp.where(n < max_exact, n, large)


def stick_breaking(q, k, v, q_pos, k_pos):
    z = jnp.einsum('bthd,bshd->bhts', q, k).astype(jnp.float32) * SB_SCALE
    before = k_pos[None, :] < q_pos[:, None]
    log_keep = jnp.where(before, jax.nn.log_sigmoid(-z), 0.0)
    later = lax.cumsum(log_keep, axis=3, reverse=True) - log_keep
    a = jnp.where(before, jnp.exp(jax.nn.log_sigmoid(z) + later), 0.0)
    return jnp.einsum('bhts,bshd->bthd', a.astype(v.dtype), v)


def sparse_attention(q, k, v, q_idx, w_idx, k_idx, q_pos, k_pos, rel_bias, n_select):
    admissible = (k_pos[None, :] // CHUNK) <= (q_pos[:, None] // CHUNK)
    head_scores = jax.nn.relu(jnp.einsum('bthi,bsi->bths', q_idx, k_idx).astype(jnp.float32))
    index_score = jnp.einsum('bth,bths->bts', w_idx.astype(jnp.float32), head_scores)
    index_score = jnp.where(admissible[None], index_score, -jnp.inf)
    _, sel = lax.top_k(index_score, n_select)
    sel_pos = k_pos[sel]
    valid = (sel_pos // CHUNK) <= (q_pos[None, :, None] // CHUNK)
    gather = jax.vmap(lambda rows, idx: rows[idx])
    k_sel = gather(k, sel)
    v_sel = gather(v, sel)
    logits = jnp.einsum('bthd,btkd->bhtk', q, k_sel).astype(jnp.float32) * ATT_SCALE
    bias = rel_bias[t5_bucket(sel_pos - q_pos[None, :, None])]
    logits = logits + jnp.moveaxis(bias, 3, 1).astype(jnp.float32)
    logits = jnp.where(valid[:, None], logits, -jnp.inf)
    p = jax.nn.softmax(logits, axis=-1)
    return jnp.einsum('bhtk,btkd->bthd', p.astype(v.dtype), v_sel)


def _to_blocks(a):
    b, t = a.shape[:2]
    return jnp.moveaxis(a.reshape(b, t // Q_BLOCK, Q_BLOCK, *a.shape[2:]), 1, 0)


def _from_blocks(a):
    a = jnp.moveaxis(a, 0, 1)
    return a.reshape(a.shape[0], a.shape[1] * a.shape[2], *a.shape[3:])


def _blockwise(fn, q_arrays, q_pos):
    xs = tuple(_to_blocks(a) for a in q_arrays) + (q_pos.reshape(-1, Q_BLOCK),)
    return _from_blocks(lax.map(lambda args: fn(*args), xs))


def _split_points():
    return [int(c) for c in np.cumsum(SPLIT_SIZES)[:-1]]


def trunk_layer(x, past, q_pos, k_pos, blocked, n_select, w_in, b_in, w_pa, w_pb, w_out, ln_g, ln_b, rel_bias):
    b, t, _ = x.shape
    proj = x @ w_in + b_in
    (q_a, k_a, v_a, g_a, q_b, k_b, v_b, g_b, q_i, k_i, w_i, r_a, r_b) = jnp.split(proj, _split_points(), axis=-1)
    q_a = q_a.reshape(b, t, H_A, HD_A)
    k_a = k_a.reshape(b, t, H_A, HD_A)
    v_a = v_a.reshape(b, t, H_A, HD_A)
    q_b = q_b.reshape(b, t, H_B, HD_B)
    q_i = q_i.reshape(b, t, H_IDX, D_IDX)
    new_rows = (k_a, v_a, k_b, v_b, k_i)
    if past is not None:
        k_a, v_a, k_b, v_b, k_i = (jnp.concatenate([p, n], axis=1) for p, n in zip(past, new_rows))
    if blocked:
        y_a = _blockwise(lambda qa, qp: stick_breaking(qa, k_a, v_a, qp, k_pos), (q_a,), q_pos)
        y_b = _blockwise(lambda qb, qi, wi, qp: sparse_attention(qb, k_b, v_b, qi, wi, k_i, qp, k_pos, rel_bias, n_select),
                         (q_b, q_i, w_i), q_pos)
    else:
        y_a = stick_breaking(q_a, k_a, v_a, q_pos, k_pos)
        y_b = sparse_attention(q_b, k_b, v_b, q_i, w_i, k_i, q_pos, k_pos, rel_bias, n_select)
    y_a = y_a.reshape(b, t, W_A) * jax.nn.silu(g_a)
    y_b = y_b.reshape(b, t, W_B) * jax.nn.silu(g_b)
    merged = jax.nn.sigmoid(r_a) * (y_a @ w_pa) + jax.nn.sigmoid(r_b) * (y_b @ w_pb)
    x = layer_norm(ALPHA * x + merged @ w_out, ln_g, ln_b)
    return x, new_rows


def setup_inputs(seed: int = 0) -> dict:
    key = jax.random.key(seed)
    ks = jax.random.split(key, 18)
    nrm = jax.random.normal
    f32 = jnp.float32
    col_scale = jnp.concatenate([jnp.full((n,), s, f32) for n, s in zip(
        SPLIT_SIZES, (1.0, 1.0, BETA, 1.0, 1.0, 1.0, BETA, 1.0, 1.0, 1.0, 1.0, 1.0, 1.0))])
    return {
        'x_prompt': nrm(ks[0], (BATCH, SEQ, D_MODEL), f32),
        'x_sample': nrm(ks[1], (DEC_BATCH, DEC_SEQ, D_MODEL), f32),
        'cache_sb_k': nrm(ks[2], (DEPTH, DEC_BATCH, PAST_LEN, H_A, HD_A), f32),
        'cache_sb_v': BETA * nrm(ks[3], (DEPTH, DEC_BATCH, PAST_LEN, H_A, HD_A), f32),
        'cache_dsa_k': nrm(ks[4], (DEPTH, DEC_BATCH, PAST_LEN, HD_B), f32),
        'cache_dsa_v': BETA * nrm(ks[5], (DEPTH, DEC_BATCH, PAST_LEN, HD_B), f32),
        'cache_idx_k': nrm(ks[6], (DEPTH, DEC_BATCH, PAST_LEN, D_IDX), f32),
        'ln_in_g': 1.0 + 0.02 * nrm(ks[7], (D_MODEL,), f32),
        'ln_in_b': 0.02 * nrm(ks[8], (D_MODEL,), f32),
        'w_in': nrm(ks[9], (DEPTH, D_MODEL, D_IN), f32) * (D_MODEL ** -0.5) * col_scale,
        'b_in': 0.02 * nrm(ks[10], (DEPTH, D_IN), f32),
        'w_proj_a': nrm(ks[11], (DEPTH, W_A, D_MODEL), f32) * (W_A ** -0.5),
        'w_proj_b': nrm(ks[12], (DEPTH, W_B, D_MODEL), f32) * (W_B ** -0.5),
        'w_out': nrm(ks[13], (DEPTH, D_MODEL, D_MODEL), f32) * (D_MODEL ** -0.5) * BETA,
        'ln_g': 1.0 + 0.02 * nrm(ks[14], (DEPTH, D_MODEL), f32),
        'ln_b': 0.02 * nrm(ks[15], (DEPTH, D_MODEL), f32),
        'rel_bias': 0.2 * nrm(ks[16], (N_BUCKETS, H_B), f32),
    }


def reference(x_prompt, x_sample, cache_sb_k, cache_sb_v, cache_dsa_k, cache_dsa_v, cache_idx_k,
              ln_in_g, ln_in_b, w_in, b_in, w_proj_a, w_proj_b, w_out, ln_g, ln_b, rel_bias):
    seq = x_prompt.shape[1]
    dec_seq = x_sample.shape[1]
    past_len = cache_sb_k.shape[2]
    pos_prompt = jnp.arange(seq, dtype=jnp.int32)
    pos_keys_s = jnp.arange(past_len + dec_seq, dtype=jnp.int32)
    pos_query_s = pos_keys_s[past_len:]
    n_sel_prompt = min(MAX_SELECT, seq // 4)
    n_sel_sample = min(MAX_SELECT, (past_len + dec_seq) // 4)
    hp = layer_norm(x_prompt, ln_in_g, ln_in_b)
    hs = layer_norm(x_sample, ln_in_g, ln_in_b)
    rows_p, rows_s = [], []
    for layer in range(DEPTH):
        weights = (w_in[layer], b_in[layer], w_proj_a[layer], w_proj_b[layer], w_out[layer],
                   ln_g[layer], ln_b[layer], rel_bias)
        hp, new_p = trunk_layer(hp, None, pos_prompt, pos_prompt, True, n_sel_prompt, *weights)
        past = (cache_sb_k[layer], cache_sb_v[layer], cache_dsa_k[layer], cache_dsa_v[layer], cache_idx_k[layer])
        hs, new_s = trunk_layer(hs, past, pos_query_s, pos_keys_s, False, n_sel_sample, *weights)
        rows_p.append(new_p)
        rows_s.append(new_s)
    new_sb_k_p, new_sb_v_p, new_dsa_k_p, new_dsa_v_p, new_idx_k_p = (jnp.stack(r) for r in zip(*rows_p))
    new_sb_k_s, new_sb_v_s, new_dsa_k_s, new_dsa_v_s, new_idx_k_s = (jnp.stack(r) for r in zip(*rows_s))
    return (hp, hs, new_sb_k_p, new_sb_v_p, new_dsa_k_p, new_dsa_v_p, new_idx_k_p,
            new_sb_k_s, new_sb_v_s, new_dsa_k_s, new_dsa_v_s, new_idx_k_s)
```

```cpp
#include <hip/hip_runtime.h>
#include <hip/hip_cooperative_groups.h>
#include <cstdio>
namespace cg = cooperative_groups;

#ifndef USE_COOP
#define USE_COOP 1
#endif

#define DI __device__ __forceinline__
typedef unsigned short bf16_t;
using bf16x8 = __attribute__((ext_vector_type(8))) short;
using bf16x4 = __attribute__((ext_vector_type(4))) short;
using f32x4  = __attribute__((ext_vector_type(4))) float;

constexpr int D_MODEL = 1024, BATCH = 32, SEQ = 2048, DEPTH = 4, DEC_BATCH = 8, DEC_SEQ = 64, PAST = 1024, LS = 1088;
constexpr int MP = BATCH * SEQ;
constexpr int MS = DEC_BATCH * DEC_SEQ;
constexpr int MT = MP + MS;
constexpr int D_IN = 5832, D_INP = 5888;
constexpr float LN_EPS = 1e-5f;
constexpr float ALPHA = 1.681792830507429f;
constexpr float SB_SCALE = 0.125f, ATT_SCALE = 0.125f;
constexpr int LDS_BYTES = 74784;

constexpr size_t O_Y = 0, O_KAP = 67633152, O_VAP = 201850880, O_KBP = 336068608, O_VBP = 352845824, O_KIP = 369623040,
                 O_KAS = 386400256, O_VAS = 387448832, O_KBS = 388497408, O_VBS = 388628480, O_KIS = 388759552;
constexpr int OUT_TOTAL = 388890624;

struct Params {
  const float* x_prompt; const float* x_sample;
  const float* c_sb_k; const float* c_sb_v; const float* c_dsa_k; const float* c_dsa_v; const float* c_idx_k;
  const float* ln_in_g; const float* ln_in_b; const float* w_in; const float* b_in; const float* w_pa; const float* w_pb;
  const float* w_out; const float* ln_g; const float* ln_b; const float* rel_bias;
  float* out;
  bf16_t* Xb; bf16_t* QA; bf16_t* GA; bf16_t* GB; bf16_t* QB; bf16_t* QI;
  bf16_t* KAp; bf16_t* VATp; bf16_t* KAs; bf16_t* VATs;
  bf16_t* KBp; bf16_t* VBTp; bf16_t* KIp; bf16_t* KBs; bf16_t* VBTs; bf16_t* KIs;
  float* WI; bf16_t* RA; bf16_t* RB;
  bf16_t* WinT; bf16_t* WpaT; bf16_t* WpbT; bf16_t* WoutT;
  unsigned char* btab; int* ctr;
};

DI unsigned short f2bf(float x) { unsigned u = __float_as_uint(x); u += 0x7fffu + ((u >> 16) & 1u); return (unsigned short)(u >> 16); }
DI float bf2f(short h) { return __uint_as_float(((unsigned)(unsigned short)h) << 16); }
DI bf16x4 pack4(float a, float b, float c, float d) { bf16x4 r; r[0] = (short)f2bf(a); r[1] = (short)f2bf(b); r[2] = (short)f2bf(c); r[3] = (short)f2bf(d); return r; }
DI bf16x8 ld8(const bf16_t* p) { return *reinterpret_cast<const bf16x8*>(p); }
DI bf16x4 ld4(const bf16_t* p) { return *reinterpret_cast<const bf16x4*>(p); }
DI void st4(bf16_t* p, bf16x4 v) { *reinterpret_cast<bf16x4*>(p) = v; }
DI f32x4 mfma16(bf16x8 a, bf16x8 b, f32x4 c) { return __builtin_amdgcn_mfma_f32_16x16x32_bf16(a, b, c, 0, 0, 0); }
DI int otid() { int t = threadIdx.x; asm volatile("" : "+v"(t)); return t; }
DI float sigmoidf_(float x) { return 1.f / (1.f + __expf(-x)); }
DI float wave_sum(float x) { for (int o = 32; o >= 1; o >>= 1) x += __shfl_xor(x, o); return x; }
DI int hsum32(int x) { x += __shfl_xor(x, 1); x += __shfl_xor(x, 2); x += __shfl_xor(x, 4); x += __shfl_xor(x, 8); x += __shfl_xor(x, 16); return x; }

DI void ln_row_wave(const float* src, const float* g, const float* b, float* d32, bf16_t* db, int lane) {
  float4 v[4]; float s = 0.f;
#pragma unroll
  for (int i = 0; i < 4; ++i) { v[i] = reinterpret_cast<const float4*>(src)[lane + 64 * i]; s += v[i].x + v[i].y + v[i].z + v[i].w; }
  s = wave_sum(s);
  const float mu = s * (1.f / 1024.f);
  float q = 0.f;
#pragma unroll
  for (int i = 0; i < 4; ++i) { float a = v[i].x - mu, bb = v[i].y - mu, c = v[i].z - mu, d = v[i].w - mu; q += a * a + bb * bb + c * c + d * d; }
  q = wave_sum(q);
  const float rstd = rsqrtf(q * (1.f / 1024.f) + LN_EPS);
#pragma unroll
  for (int i = 0; i < 4; ++i) {
    float4 gg = reinterpret_cast<const float4*>(g)[lane + 64 * i], bb = reinterpret_cast<const float4*>(b)[lane + 64 * i];
    float4 o;
    o.x = (v[i].x - mu) * rstd * gg.x + bb.x; o.y = (v[i].y - mu) * rstd * gg.y + bb.y;
    o.z = (v[i].z - mu) * rstd * gg.z + bb.z; o.w = (v[i].w - mu) * rstd * gg.w + bb.w;
    reinterpret_cast<float4*>(d32)[lane + 64 * i] = o;
    st4(db + 4 * (lane + 64 * i), pack4(o.x, o.y, o.z, o.w));
  }
}

DI void tconv_tile(const float* src, int ldsrc, int K, bf16_t* dst, int n0, int k0, bool winmap, float* tile) {
  const int tid = otid();
#pragma unroll
  for (int rr = 0; rr < 16; ++rr) {
    const int kl = rr * 4 + (tid >> 6), nl = tid & 63, np = n0 + nl;
    int n = np; bool ok = true;
    if (winmap) { if (np >= 3840) n = np - 56; else if (np >= 3784) ok = false; }
    tile[kl * 65 + nl] = ok ? src[(size_t)(k0 + kl) * ldsrc + n] : 0.f;
  }
  __syncthreads();
#pragma unroll
  for (int rr = 0; rr < 16; ++rr) {
    const int nl = rr * 4 + (tid >> 6), kl = tid & 63;
    dst[(size_t)(n0 + nl) * K + k0 + kl] = f2bf(tile[kl * 65 + nl]);
  }
  __syncthreads();
}

DI void convert_layer(const Params& p, int l, char* smem) {
  float* tile = reinterpret_cast<float*>(smem);
  const int G = gridDim.x;
  for (int it = blockIdx.x; it < 1984; it += G) {
    if (it < 1472) { int nt = it >> 4, kt = it & 15; tconv_tile(p.w_in + (size_t)l * 1024 * D_IN, D_IN, 1024, p.WinT, nt * 64, kt * 64, true, tile); }
    else if (it < 1600) { int i = it - 1472; int nt = i >> 3, kt = i & 7; tconv_tile(p.w_pa + (size_t)l * 512 * 1024, 1024, 512, p.WpaT, nt * 64, kt * 64, false, tile); }
    else if (it < 1728) { int i = it - 1600; int nt = i >> 3, kt = i & 7; tconv_tile(p.w_pb + (size_t)l * 512 * 1024, 1024, 512, p.WpbT, nt * 64, kt * 64, false, tile); }
    else { int i = it - 1728; int nt = i >> 4, kt = i & 15; tconv_tile(p.w_out + (size_t)l * 1024 * 1024, 1024, 1024, p.WoutT, nt * 64, kt * 64, false, tile); }
  }
  const int gtid = blockIdx.x * 256 + otid(), gn = G * 256;
  for (int idx = gtid; idx < 8 * 1024 * 512; idx += gn) {
    int b = idx >> 19, rem = idx & ((1 << 19) - 1);
    p.KAs[(size_t)b * LS * 512 + rem] = f2bf(p.c_sb_k[(size_t)l * 8 * 1024 * 512 + idx]);
  }
  for (int idx = gtid; idx < 8 * 512 * 1024; idx += gn) {
    int b = idx >> 19, hd = (idx >> 10) & 511, t = idx & 1023;
    p.VATs[((size_t)b * 512 + hd) * LS + t] = f2bf(p.c_sb_v[(((size_t)l * 8 + b) * 1024 + t) * 512 + hd]);
  }
  for (int idx = gtid; idx < 8 * 1024 * 64; idx += gn) {
    int b = idx >> 16, rem = idx & 65535;
    p.KBs[(size_t)b * LS * 64 + rem] = f2bf(p.c_dsa_k[(size_t)l * 8 * 65536 + idx]);
    p.KIs[(size_t)b * LS * 64 + rem] = f2bf(p.c_idx_k[(size_t)l * 8 * 65536 + idx]);
    int d = (idx >> 10) & 63, t = idx & 1023;
    p.VBTs[((size_t)b * 64 + d) * LS + t] = f2bf(p.c_dsa_v[(((size_t)l * 8 + b) * 1024 + t) * 64 + d]);
  }
}

DI void phase_prologue(const Params& p, char* smem) {
  const int tid = otid(), lane = tid & 63;
  if (blockIdx.x == 0 && tid < 16) p.ctr[tid] = 0;
  for (int i = blockIdx.x * 256 + tid; i < 4096; i += gridDim.x * 256) {
    int rel = i - 2047; int n = rel < 0 ? -rel : rel;
    float nf = (float)(n > 1 ? n : 1);
    int large = 8 + (int)(logf(nf / 8.f) / 2.7725887f * 8.f);
    large = large < 15 ? large : 15;
    int bk = (rel > 0 ? 16 : 0) + (n < 8 ? n : large);
    p.btab[i] = (unsigned char)bk;
  }
  for (int row = blockIdx.x * 4 + (tid >> 6); row < MT; row += gridDim.x * 4) {
    const float* src = row < MP ? p.x_prompt + (size_t)row * 1024 : p.x_sample + (size_t)(row - MP) * 1024;
    ln_row_wave(src, p.ln_in_g, p.ln_in_b, p.out + (size_t)row * 1024, p.Xb + (size_t)row * 1024, lane);
  }
  convert_layer(p, 0, smem);
}

DI void gemm_mainloop(const bf16_t* __restrict__ A, int lda, const bf16_t* __restrict__ Bt, int ldb, int K,
                      int brow, int bcol, f32x4 (&acc)[4][4], char* shm) {
  const int tid = otid(), wid = tid >> 6, lane = tid & 63, wr = wid >> 1, wc = wid & 1, fr = lane & 15, fq = lane >> 4;
  char* SA = shm; char* SB = shm + 8192;
  for (int kt = 0; kt < K / 32; ++kt) {
#pragma unroll
    for (int i = 0; i < 2; ++i) {
      const int b = tid * 16 + i * 4096, r = b >> 6, c = (b & 63) >> 1;
      __builtin_amdgcn_global_load_lds((const unsigned*)(A + (size_t)(brow + r) * lda + kt * 32 + c), (__attribute__((address_space(3))) unsigned*)(SA + b), 16, 0, 0);
      __builtin_amdgcn_global_load_lds((const unsigned*)(Bt + (size_t)(bcol + r) * ldb + kt * 32 + c), (__attribute__((address_space(3))) unsigned*)(SB + b), 16, 0, 0);
    }
    asm volatile("s_waitcnt vmcnt(0)" ::: "memory");
    __syncthreads();
    bf16x8 At[4], Bf[4];
#pragma unroll
    for (int m = 0; m < 4; ++m) At[m] = *reinterpret_cast<const bf16x8*>(SA + (wr * 64 + m * 16 + fr) * 64 + fq * 16);
#pragma unroll
    for (int n = 0; n < 4; ++n) Bf[n] = *reinterpret_cast<const bf16x8*>(SB + (wc * 64 + n * 16 + fr) * 64 + fq * 16);
#pragma unroll
    for (int m = 0; m < 4; ++m)
#pragma unroll
      for (int n = 0; n < 4; ++n) acc[m][n] = mfma16(At[m], Bf[n], acc[m][n]);
    __syncthreads();
  }
}

DI void zero_acc(f32x4 (&acc)[4][4]) {
#pragma unroll
  for (int m = 0; m < 4; ++m)
#pragma unroll
    for (int n = 0; n < 4; ++n) acc[m][n] = f32x4{0.f, 0.f, 0.f, 0.f};
}

template <int GRP>
DI void proj_epilogue(const Params& p, int layer, int mt, int nt, f32x4 (&acc)[4][4]) {
  const int tid = otid(), wid = tid >> 6, lane = tid & 63, wr = wid >> 1, wc = wid & 1, fr = lane & 15, fq = lane >> 4;
  const float* bin = p.b_in + (size_t)layer * D_IN;
#pragma unroll
    for (int m = 0; m < 4; ++m) {
      const int r0 = mt * 128 + wr * 64 + m * 16 + fq * 4;
      constexpr int grp = GRP;
      int bb, tt, T;
      if (!GRP) { bb = r0 >> 11; tt = r0 & 2047; T = SEQ; } else { int ms = r0 - MP; bb = ms >> 6; tt = PAST + (ms & 63); T = LS; }
      const size_t orow = grp ? (size_t)layer * MS + (r0 - MP) : (size_t)layer * MP + r0;
#pragma unroll
      for (int n = 0; n < 4; ++n) {
        const int ct = wc * 64 + n * 16 + fr;
        const int np = nt * 128 + ct;
        const float bias = (np < 3784) ? bin[np] : (np < 3840 ? 0.f : bin[np - 56]);
        float v[4];
#pragma unroll
        for (int j = 0; j < 4; ++j) v[j] = acc[m][n][j] + bias;
        if (nt < 4) {
#pragma unroll
          for (int j = 0; j < 4; ++j) p.QA[(size_t)(r0 + j) * 512 + np] = f2bf(v[j]);
        } else if (nt < 8) {
          const int c = np - 512;
          float* o = p.out + (grp ? O_KAS : O_KAP) + orow * 512 + c;
          bf16_t* kd = grp ? p.KAs + ((size_t)bb * LS + tt) * 512 + c : p.KAp + (size_t)r0 * 512 + c;
#pragma unroll
          for (int j = 0; j < 4; ++j) { o[(size_t)j * 512] = v[j]; kd[(size_t)j * 512] = f2bf(v[j]); }
        } else if (nt < 12) {
          const int c = np - 1024;
          float* o = p.out + (grp ? O_VAS : O_VAP) + orow * 512 + c;
#pragma unroll
          for (int j = 0; j < 4; ++j) o[(size_t)j * 512] = v[j];
          bf16_t* vd = (grp ? p.VATs : p.VATp) + ((size_t)bb * 512 + c) * T + tt;
          st4(vd, pack4(v[0], v[1], v[2], v[3]));
        } else if (nt < 16) {
          const int c = np - 1536;
#pragma unroll
          for (int j = 0; j < 4; ++j) p.GA[(size_t)(r0 + j) * 512 + c] = f2bf(v[j] * sigmoidf_(v[j]));
        } else if (nt < 20) {
          const int c = np - 2048;
#pragma unroll
          for (int j = 0; j < 4; ++j) p.QB[(size_t)(r0 + j) * 512 + c] = f2bf(v[j]);
        } else if (nt == 20) {
          if (wc == 0) {
            const int c = ct;
            float* o = p.out + (grp ? O_KBS : O_KBP) + orow * 64 + c;
            bf16_t* kd = (grp ? p.KBs : p.KBp) + ((size_t)bb * T + tt) * 64 + c;
#pragma unroll
            for (int j = 0; j < 4; ++j) { o[(size_t)j * 64] = v[j]; kd[(size_t)j * 64] = f2bf(v[j]); }
          } else {
            const int c = ct - 64;
            float* o = p.out + (grp ? O_VBS : O_VBP) + orow * 64 + c;
#pragma unroll
            for (int j = 0; j < 4; ++j) o[(size_t)j * 64] = v[j];
            bf16_t* vd = (grp ? p.VBTs : p.VBTp) + ((size_t)bb * 64 + c) * T + tt;
            st4(vd, pack4(v[0], v[1], v[2], v[3]));
          }
        } else if (nt < 25) {
          const int c = np - 2688;
#pragma unroll
          for (int j = 0; j < 4; ++j) p.GB[(size_t)(r0 + j) * 512 + c] = f2bf(v[j] * sigmoidf_(v[j]));
        } else if (nt < 29) {
          const int c = np - 3200;
#pragma unroll
          for (int j = 0; j < 4; ++j) p.QI[(size_t)(r0 + j) * 512 + c] = f2bf(v[j]);
        } else if (nt == 29) {
          if (wc == 0) {
            const int c = ct;
            float* o = p.out + (grp ? O_KIS : O_KIP) + orow * 64 + c;
            bf16_t* kd = (grp ? p.KIs : p.KIp) + ((size_t)bb * T + tt) * 64 + c;
#pragma unroll
            for (int j = 0; j < 4; ++j) { o[(size_t)j * 64] = v[j]; kd[(size_t)j * 64] = f2bf(v[j]); }
          } else if (ct < 72) {
#pragma unroll
            for (int j = 0; j < 4; ++j) p.WI[(size_t)(r0 + j) * 8 + (ct - 64)] = v[j];
          }
        } else if (nt < 38) {
          const int c = np - 3840;
#pragma unroll
          for (int j = 0; j < 4; ++j) p.RA[(size_t)(r0 + j) * 1024 + c] = f2bf(sigmoidf_(v[j]));
        } else {
          const int c = np - 4864;
#pragma unroll
          for (int j = 0; j < 4; ++j) p.RB[(size_t)(r0 + j) * 1024 + c] = f2bf(sigmoidf_(v[j]));
        }
      }
    }
}

DI void phase_proj(const Params& p, int layer, char* smem) {
  const int NT = 46, NITEM = (MT / 128) * NT;
  for (int item = blockIdx.x; item < NITEM; item += gridDim.x) {
    const int mt = item / NT, nt = item - mt * NT;
    f32x4 acc[4][4]; zero_acc(acc);
    gemm_mainloop(p.Xb, 1024, p.WinT, 1024, 1024, mt * 128, nt * 128, acc, smem);
    if (mt < MP / 128) proj_epilogue<0>(p, layer, mt, nt, acc); else proj_epilogue<1>(p, layer, mt, nt, acc);
  }
}

template <int grp>
DI void sb_item(const Params& p, int b, int h, int tile64) {
  const int tid = otid(), w = tid >> 6, lane = tid & 63, c = lane & 15, q4 = lane >> 4;
  const int T = grp ? LS : SEQ;
  const int t0 = tile64 * 64 + w * 16;
  const int qpos0 = grp ? PAST + t0 : t0;
  const int m0 = grp ? MP + b * DEC_SEQ + t0 : b * SEQ + t0;
  const bf16_t* Kb = (grp ? p.KAs : p.KAp) + (size_t)b * T * 512 + h * 64;
  const bf16_t* VTb = (grp ? p.VATs : p.VATp) + (size_t)(b * 8 + h) * 64 * T;
  const bf16_t* qp = p.QA + (size_t)(m0 + c) * 512 + h * 64 + q4 * 8;
  const bf16x8 qf0 = ld8(qp), qf1 = ld8(qp + 32);
  const int qpos = qpos0 + c;
  float R = 0.f;
  f32x4 O[4];
#pragma unroll
  for (int dt = 0; dt < 4; ++dt) O[dt] = f32x4{0.f, 0.f, 0.f, 0.f};
  for (int kb = (qpos0 + 14) >> 5; kb >= 0; --kb) {
    const int s0 = kb * 32;
    f32x4 z[2];
#pragma unroll
    for (int kt = 0; kt < 2; ++kt) {
      const bf16_t* kp = Kb + (size_t)(s0 + 16 * kt + c) * 512 + q4 * 8;
      z[kt] = mfma16(ld8(kp), qf0, f32x4{0.f, 0.f, 0.f, 0.f});
      z[kt] = mfma16(ld8(kp + 32), qf1, z[kt]);
    }
    bf16x8 vf[4];
#pragma unroll
    for (int dt = 0; dt < 4; ++dt) {
      const bf16_t* vp = VTb + (size_t)(16 * dt + c) * T + s0 + 4 * q4;
      bf16x4 lo = ld4(vp), hi = ld4(vp + 16);
      vf[dt] = __builtin_shufflevector(lo, hi, 0, 1, 2, 3, 4, 5, 6, 7);
    }
    float lk[2][4], ls[2][4]; bool bf[2][4];
#pragma unroll
    for (int kt = 0; kt < 2; ++kt)
#pragma unroll
      for (int r = 0; r < 4; ++r) {
        const int key = s0 + 16 * kt + 4 * q4 + r;
        const bool before = key < qpos;
        const float zz = z[kt][r] * SB_SCALE;
        const float sp = fmaxf(zz, 0.f) + __logf(1.f + __expf(-fabsf(zz)));
        bf[kt][r] = before; lk[kt][r] = before ? -sp : 0.f; ls[kt][r] = zz - sp;
      }
    const float T1 = (lk[1][0] + lk[1][1]) + (lk[1][2] + lk[1][3]);
    const float T0 = (lk[0][0] + lk[0][1]) + (lk[0][2] + lk[0][3]);
    const float a1 = __shfl_xor(T1, 16), a0 = __shfl_xor(T0, 16);
    const float p1 = T1 + a1, p0 = T0 + a0;
    const float c1 = __shfl_xor(p1, 32), c0 = __shfl_xor(p0, 32);
    const float H1 = ((q4 & 1) ? 0.f : a1) + ((q4 & 2) ? 0.f : c1);
    const float H0 = ((q4 & 1) ? 0.f : a0) + ((q4 & 2) ? 0.f : c0);
    const float TT1 = p1 + c1, TT0 = p0 + c0;
    float a[2][4];
    { float ac = R + H1;
#pragma unroll
      for (int r = 3; r >= 0; --r) { a[1][r] = bf[1][r] ? __expf(ls[1][r] + ac) : 0.f; ac += lk[1][r]; } }
    { float ac = R + TT1 + H0;
#pragma unroll
      for (int r = 3; r >= 0; --r) { a[0][r] = bf[0][r] ? __expf(ls[0][r] + ac) : 0.f; ac += lk[0][r]; } }
    R = R + TT1 + TT0;
    bf16x8 pf;
#pragma unroll
    for (int r = 0; r < 4; ++r) { pf[r] = (short)f2bf(a[0][r]); pf[4 + r] = (short)f2bf(a[1][r]); }
#pragma unroll
    for (int dt = 0; dt < 4; ++dt) O[dt] = mfma16(vf[dt], pf, O[dt]);
    if (__ballot(R > -50.f) == 0ull) break;
  }
#pragma unroll
  for (int dt = 0; dt < 4; ++dt) {
    const size_t off = (size_t)(m0 + c) * 512 + h * 64 + dt * 16 + 4 * q4;
    const bf16x4 g = ld4(p.GA + off);
    st4(p.QA + off, pack4(O[dt][0] * bf2f(g[0]), O[dt][1] * bf2f(g[1]), O[dt][2] * bf2f(g[2]), O[dt][3] * bf2f(g[3])));
  }
}

template <int grp>
DI void dsa_item(const Params& p, int b, int tile16, char* smem) {
  const int tid = otid(), w = tid >> 6, lane = tid & 63, c = lane & 15, q4 = lane >> 4, half = lane >> 5, l32 = lane & 31;
  float* S = reinterpret_cast<float*>(smem) + w * 4096;
  unsigned* bm = reinterpret_cast<unsigned*>(smem + 65536);
  const unsigned char* btab = reinterpret_cast<const unsigned char*>(smem + 69632);
  const float* rb = reinterpret_cast<const float*>(smem + 73728);
  const int T = grp ? LS : SEQ;
  const int t0 = tile16 * 16;
  const int qpos0 = grp ? PAST + t0 : t0;
  const int m0 = grp ? MP + b * DEC_SEQ + t0 : b * SEQ + t0;
  const int n_adm = grp ? LS : ((qpos0 >> 6) + 1) * 64;
  const bf16_t* KIb = (grp ? p.KIs : p.KIp) + (size_t)b * T * 64;
  const bf16_t* KBb = (grp ? p.KBs : p.KBp) + (size_t)b * T * 64;
  const bf16_t* VBTb = (grp ? p.VBTs : p.VBTp) + (size_t)b * 64 * T;

  for (int rnd = 0; rnd < 2; ++rnd) {
    const int qa = 4 * w + 2 * rnd;
    {
      const int tlA = c >> 3, hA = c & 7;
      const bf16_t* qip = p.QI + (size_t)(m0 + qa + tlA) * 512 + hA * 64 + q4 * 8;
      const bf16x8 af0 = ld8(qip), af1 = ld8(qip + 32);
      const int tlC = q4 >> 1;
      const float4 wv = *reinterpret_cast<const float4*>(p.WI + (size_t)(m0 + qa + tlC) * 8 + 4 * (q4 & 1));
      const int nblk = n_adm >> 4;
      for (int blk = 0; blk < nblk; ++blk) {
        const bf16_t* kp = KIb + (size_t)(blk * 16 + c) * 64 + q4 * 8;
        f32x4 C = mfma16(af0, ld8(kp), f32x4{0.f, 0.f, 0.f, 0.f});
        C = mfma16(af1, ld8(kp + 32), C);
        const float part = wv.x * fmaxf(C[0], 0.f) + wv.y * fmaxf(C[1], 0.f) + wv.z * fmaxf(C[2], 0.f) + wv.w * fmaxf(C[3], 0.f);
        const float full = part + __shfl_xor(part, 16);
        if ((q4 & 1) == 0) S[tlC * 2048 + blk * 16 + c] = full;
      }
    }
    __syncthreads();
    {
      unsigned key[64];
      const float* Sh = S + half * 2048;
#pragma unroll
      for (int i = 0; i < 64; ++i) {
        const int s = 32 * i + l32;
        const unsigned u = __float_as_uint(Sh[s]);
        const unsigned k = (u & 0x80000000u) ? ~u : (u | 0x80000000u);
        key[i] = (s < n_adm) ? k : 0u;
      }
      unsigned tau = 0u; int need = 0;
      if (n_adm > 256) {
        for (int bit = 31; bit >= 0; --bit) {
          const unsigned cand = tau | (1u << bit);
          int cnt = 0;
#pragma unroll
          for (int i = 0; i < 64; ++i) cnt += (key[i] >= cand) ? 1 : 0;
          cnt = hsum32(cnt);
          if (cnt >= 256) tau = cand;
        }
        int cgt = 0;
#pragma unroll
        for (int i = 0; i < 64; ++i) cgt += (key[i] > tau) ? 1 : 0;
        cgt = hsum32(cgt);
        need = 256 - cgt;
      }
      int Rk = 0; const unsigned below = (1u << l32) - 1u;
#pragma unroll
      for (int i = 0; i < 64; ++i) {
        const bool eq = key[i] == tau, gt = key[i] > tau;
        const unsigned long long me = __ballot(eq);
        const unsigned hm = (unsigned)(me >> (32 * half));
        const int rank = Rk + __popc(hm & below);
        const bool sel = gt || (eq && rank < need);
        Rk += __popc(hm);
        const unsigned long long msel = __ballot(sel);
        const unsigned wsel = (unsigned)(msel >> (32 * half));
        if (l32 == 0) bm[(qa + half) * 64 + i] = wsel;
      }
    }
    __syncthreads();
  }

  {
    const int tl = c >> 3, h = c & 7;
    bf16x8 qf[2][2]; int qposc[2], qrow[2], qloc[2];
#pragma unroll
    for (int ct = 0; ct < 2; ++ct) {
      qloc[ct] = 4 * w + 2 * ct + tl; qrow[ct] = m0 + qloc[ct]; qposc[ct] = qpos0 + qloc[ct];
      const bf16_t* qp = p.QB + (size_t)qrow[ct] * 512 + h * 64 + q4 * 8;
      qf[ct][0] = ld8(qp); qf[ct][1] = ld8(qp + 32);
    }
    f32x4 O[2][4]; float mrun[2] = {-1e30f, -1e30f}, lrun[2] = {0.f, 0.f};
#pragma unroll
    for (int ct = 0; ct < 2; ++ct)
#pragma unroll
      for (int dt = 0; dt < 4; ++dt) O[ct][dt] = f32x4{0.f, 0.f, 0.f, 0.f};
    const int nkb = n_adm >> 5;
    for (int kb = 0; kb < nkb; ++kb) {
      const int s0 = kb * 32;
      bf16x8 kf[2][2];
#pragma unroll
      for (int kt = 0; kt < 2; ++kt) {
        const bf16_t* kp = KBb + (size_t)(s0 + 16 * kt + c) * 64 + q4 * 8;
        kf[kt][0] = ld8(kp); kf[kt][1] = ld8(kp + 32);
      }
      bf16x8 vf[4];
#pragma unroll
      for (int dt = 0; dt < 4; ++dt) {
        const bf16_t* vp = VBTb + (size_t)(16 * dt + c) * T + s0 + 4 * q4;
        bf16x4 lo = ld4(vp), hi = ld4(vp + 16);
        vf[dt] = __builtin_shufflevector(lo, hi, 0, 1, 2, 3, 4, 5, 6, 7);
      }
#pragma unroll
      for (int ct = 0; ct < 2; ++ct) {
        f32x4 z0 = mfma16(kf[0][0], qf[ct][0], f32x4{0.f, 0.f, 0.f, 0.f}); z0 = mfma16(kf[0][1], qf[ct][1], z0);
        f32x4 z1 = mfma16(kf[1][0], qf[ct][0], f32x4{0.f, 0.f, 0.f, 0.f}); z1 = mfma16(kf[1][1], qf[ct][1], z1);
        const unsigned word = bm[qloc[ct] * 64 + kb];
        float zz[8]; bool bt[8]; float bmx = -1e30f;
#pragma unroll
        for (int e = 0; e < 8; ++e) {
          const int kt = e >> 2, r = e & 3;
          const int off = 16 * kt + 4 * q4 + r;
          const int rel = s0 + off - qposc[ct];
          const int bk = btab[rel + 2047];
          const float bias = rb[bk * 8 + h];
          const float zv = (kt ? z1[r] : z0[r]) * ATT_SCALE + bias;
          bt[e] = (word >> off) & 1u;
          zz[e] = bt[e] ? zv : -1e30f;
          bmx = fmaxf(bmx, zz[e]);
        }
        bmx = fmaxf(bmx, __shfl_xor(bmx, 16));
        bmx = fmaxf(bmx, __shfl_xor(bmx, 32));
        const float mnew = fmaxf(mrun[ct], bmx);
        const float sc = __expf(mrun[ct] - mnew);
        float ps = 0.f; float pe[8];
#pragma unroll
        for (int e = 0; e < 8; ++e) { pe[e] = bt[e] ? __expf(zz[e] - mnew) : 0.f; ps += pe[e]; }
        lrun[ct] = lrun[ct] * sc + ps; mrun[ct] = mnew;
        bf16x8 pf;
#pragma unroll
        for (int e = 0; e < 8; ++e) pf[e] = (short)f2bf(pe[e]);
#pragma unroll
        for (int dt = 0; dt < 4; ++dt) { O[ct][dt] *= sc; O[ct][dt] = mfma16(vf[dt], pf, O[ct][dt]); }
      }
    }
#pragma unroll
    for (int ct = 0; ct < 2; ++ct) {
      float lt = lrun[ct]; lt += __shfl_xor(lt, 16); lt += __shfl_xor(lt, 32);
      const float inv = 1.f / lt;
#pragma unroll
      for (int dt = 0; dt < 4; ++dt) {
        const size_t off = (size_t)qrow[ct] * 512 + h * 64 + dt * 16 + 4 * q4;
        const bf16x4 g = ld4(p.GB + off);
        st4(p.QB + off, pack4(O[ct][dt][0] * inv * bf2f(g[0]), O[ct][dt][1] * inv * bf2f(g[1]), O[ct][dt][2] * inv * bf2f(g[2]), O[ct][dt][3] * inv * bf2f(g[3])));
      }
    }
  }
  __syncthreads();
}

DI void phase_attn(const Params& p, int layer, char* smem) {
  const int tid = otid();
  for (int i = tid; i < 4096; i += 256) smem[69632 + i] = (char)p.btab[i];
  if (tid < 256) reinterpret_cast<float*>(smem + 73728)[tid] = p.rel_bias[tid];
  __syncthreads();
  int* slot = reinterpret_cast<int*>(smem + 74752);
  const int total = 32 + 4096 + 64 + 8192;
  while (true) {
    if (tid == 0) *slot = atomicAdd(&p.ctr[layer], 1);
    __syncthreads();
    const int item = *slot;
    __syncthreads();
    if (item >= total) break;
    if (item < 32) dsa_item<1>(p, item >> 2, item & 3, smem);
    else if (item < 4128) { const int i = item - 32; dsa_item<0>(p, i & 31, 127 - (i >> 5), smem); }
    else if (item < 4192) { const int i = item - 4128; sb_item<1>(p, i >> 3, i & 7, 0); }
    else { const int i = item - 4192; const int tile = 31 - (i >> 8), bh = i & 255; sb_item<0>(p, bh >> 3, bh & 7, tile); }
  }
}

DI void phase_merge(const Params& p, char* smem) {
  const int tid = otid(), wid = tid >> 6, lane = tid & 63, wr = wid >> 1, wc = wid & 1, fr = lane & 15, fq = lane >> 4;
  bf16_t* MERGED = p.GA;
  const int NITEM = (MT / 128) * 8;
  for (int item = blockIdx.x; item < NITEM; item += gridDim.x) {
    const int mt = item >> 3, nt = item & 7;
    f32x4 acc[4][4], acc2[4][4]; zero_acc(acc); zero_acc(acc2);
    gemm_mainloop(p.QA, 512, p.WpaT, 512, 512, mt * 128, nt * 128, acc, smem);
    gemm_mainloop(p.QB, 512, p.WpbT, 512, 512, mt * 128, nt * 128, acc2, smem);
#pragma unroll
    for (int m = 0; m < 4; ++m)
#pragma unroll
      for (int n = 0; n < 4; ++n)
#pragma unroll
        for (int j = 0; j < 4; ++j) {
          const size_t idx = (size_t)(mt * 128 + wr * 64 + m * 16 + fq * 4 + j) * 1024 + nt * 128 + wc * 64 + n * 16 + fr;
          const float sa = bf2f((short)p.RA[idx]), sb = bf2f((short)p.RB[idx]);
          MERGED[idx] = f2bf(sa * acc[m][n][j] + sb * acc2[m][n][j]);
        }
  }
}

DI void phase_out(const Params& p, char* smem) {
  const int tid = otid(), wid = tid >> 6, lane = tid & 63, wr = wid >> 1, wc = wid & 1, fr = lane & 15, fq = lane >> 4;
  const bf16_t* MERGED = p.GA;
  const int NITEM = (MT / 128) * 8;
  for (int item = blockIdx.x; item < NITEM; item += gridDim.x) {
    const int mt = item >> 3, nt = item & 7;
    f32x4 acc[4][4]; zero_acc(acc);
    gemm_mainloop(MERGED, 1024, p.WoutT, 1024, 1024, mt * 128, nt * 128, acc, smem);
#pragma unroll
    for (int m = 0; m < 4; ++m)
#pragma unroll
      for (int n = 0; n < 4; ++n)
#pragma unroll
        for (int j = 0; j < 4; ++j) {
          const size_t idx = (size_t)(mt * 128 + wr * 64 + m * 16 + fq * 4 + j) * 1024 + nt * 128 + wc * 64 + n * 16 + fr;
          p.out[idx] = ALPHA * p.out[idx] + acc[m][n][j];
        }
  }
}

DI void phase_ln(const Params& p, int layer, char* smem) {
  const int tid = otid(), lane = tid & 63;
  for (int row = blockIdx.x * 4 + (tid >> 6); row < MT; row += gridDim.x * 4)
    ln_row_wave(p.out + (size_t)row * 1024, p.ln_g + layer * 1024, p.ln_b + layer * 1024, p.out + (size_t)row * 1024, p.Xb + (size_t)row * 1024, lane);
  if (layer + 1 < DEPTH) convert_layer(p, layer + 1, smem);
}

__global__ void __launch_bounds__(256, 2) mega_kernel(Params p) {
  extern __shared__ __attribute__((aligned(16))) char smem[];
  cg::grid_group grid = cg::this_grid();
  phase_prologue(p, smem);
  grid.sync();
#pragma nounroll
  for (int l = 0; l < DEPTH; ++l) {
    phase_proj(p, l, smem);
    grid.sync();
    phase_attn(p, l, smem);
    grid.sync();
    phase_merge(p, smem);
    grid.sync();
    phase_out(p, smem);
    grid.sync();
    phase_ln(p, l, smem);
    if (l + 1 < DEPTH) grid.sync();
  }
}

__global__ void __launch_bounds__(256, 2) phase_kernel(Params p, int phase, int layer) {
  extern __shared__ __attribute__((aligned(16))) char smem[];
  if (phase == 0) phase_prologue(p, smem);
  else if (phase == 1) phase_proj(p, layer, smem);
  else if (phase == 2) phase_attn(p, layer, smem);
  else if (phase == 3) phase_merge(p, smem);
  else if (phase == 4) phase_out(p, smem);
  else phase_ln(p, layer, smem);
}

extern "C" void kernel_launch(void* const* d_in, const int* in_sizes, int n_in, void* d_out, int out_size, void* d_ws, size_t ws_size, hipStream_t stream) {
  static int grid_blocks = 0;
  if (grid_blocks == 0) {
    if (n_in != 17 || out_size != OUT_TOTAL) { fprintf(stderr, "kernel_launch: unexpected shapes n_in=%d out=%d\n", n_in, out_size); grid_blocks = -1; return; }
    int dev = 0, cus = 0, per_cu = 0;
    hipGetDevice(&dev);
    hipDeviceGetAttribute(&cus, hipDeviceAttributeMultiprocessorCount, dev);
    hipFuncSetAttribute((const void*)mega_kernel, hipFuncAttributeMaxDynamicSharedMemorySize, LDS_BYTES);
    hipFuncSetAttribute((const void*)phase_kernel, hipFuncAttributeMaxDynamicSharedMemorySize, LDS_BYTES);
    hipOccupancyMaxActiveBlocksPerMultiprocessor(&per_cu, (const void*)mega_kernel, 256, LDS_BYTES);
    if (per_cu < 1) per_cu = 1;
    if (per_cu > 2) per_cu = 2;
    grid_blocks = cus * per_cu;
    fprintf(stderr, "kernel_launch: cus=%d per_cu=%d grid=%d ws=%zu\n", cus, per_cu, grid_blocks, ws_size);
  }
  if (grid_blocks < 0) return;
  Params p{};
  p.x_prompt = (const float*)d_in[0]; p.x_sample = (const float*)d_in[1];
  p.c_sb_k = (const float*)d_in[2]; p.c_sb_v = (const float*)d_in[3]; p.c_dsa_k = (const float*)d_in[4]; p.c_dsa_v = (const float*)d_in[5]; p.c_idx_k = (const float*)d_in[6];
  p.ln_in_g = (const float*)d_in[7]; p.ln_in_b = (const float*)d_in[8]; p.w_in = (const float*)d_in[9]; p.b_in = (const float*)d_in[10];
  p.w_pa = (const float*)d_in[11]; p.w_pb = (const float*)d_in[12]; p.w_out = (const float*)d_in[13]; p.ln_g = (const float*)d_in[14]; p.ln_b = (const float*)d_in[15];
  p.rel_bias = (const float*)d_in[16];
  p.out = (float*)d_out;
  char* ws = (char*)d_ws; size_t off = 0;
  auto take = [&](size_t bytes) { char* r = ws + off; off += (bytes + 255) & ~(size_t)255; return r; };
  p.Xb = (bf16_t*)take((size_t)MT * 1024 * 2);
  p.QA = (bf16_t*)take((size_t)MT * 512 * 2);
  p.GA = (bf16_t*)take((size_t)MT * 512 * 2);
  p.GB = (bf16_t*)take((size_t)MT * 512 * 2);
  p.QB = (bf16_t*)take((size_t)MT * 512 * 2);
  p.QI = (bf16_t*)take((size_t)MT * 512 * 2);
  p.KAp = (bf16_t*)take((size_t)MP * 512 * 2);
  p.VATp = (bf16_t*)take((size_t)MP * 512 * 2);
  p.KAs = (bf16_t*)take((size_t)8 * LS * 512 * 2);
  p.VATs = (bf16_t*)take((size_t)8 * LS * 512 * 2);
  p.KBp = (bf16_t*)take((size_t)MP * 64 * 2);
  p.VBTp = (bf16_t*)take((size_t)MP * 64 * 2);
  p.KIp = (bf16_t*)take((size_t)MP * 64 * 2);
  p.KBs = (bf16_t*)take((size_t)8 * LS * 64 * 2);
  p.VBTs = (bf16_t*)take((size_t)8 * LS * 64 * 2);
  p.KIs = (bf16_t*)take((size_t)8 * LS * 64 * 2);
  p.WI = (float*)take((size_t)MT * 8 * 4);
  p.RA = (bf16_t*)take((size_t)MT * 1024 * 2);
  p.RB = (bf16_t*)take((size_t)MT * 1024 * 2);
  p.WinT = (bf16_t*)take((size_t)D_INP * 1024 * 2);
  p.WpaT = (bf16_t*)take((size_t)1024 * 512 * 2);
  p.WpbT = (bf16_t*)take((size_t)1024 * 512 * 2);
  p.WoutT = (bf16_t*)take((size_t)1024 * 1024 * 2);
  p.btab = (unsigned char*)take(4096);
  p.ctr = (int*)take(256);
  if (off > ws_size) { fprintf(stderr, "kernel_launch: workspace too small: need %zu have %zu\n", off, ws_size); return; }
#if USE_COOP
  void* args[] = {&p};
  hipError_t e = hipLaunchCooperativeKernel((const void*)mega_kernel, dim3(grid_blocks), dim3(256), args, LDS_BYTES, stream);
  if (e != hipSuccess) fprintf(stderr, "cooperative launch failed: %s (grid %d)\n", hipGetErrorString(e), grid_blocks);
#else
  hipLaunchKernelGGL(phase_kernel, dim3(grid_blocks), dim3(256), LDS_BYTES, stream, p, 0, 0);
  for (int l = 0; l < DEPTH; ++l)
    for (int ph = 1; ph <= 5; ++ph) hipLaunchKernelGGL(phase_kernel, dim3(grid_blocks), dim3(256), LDS_BYTES, stream, p, ph, l);
#endif
}
```

```cpp
#include <hip/hip_runtime.h>
#include <hip/hip_cooperative_groups.h>
#include <cstdio>
#include <type_traits>
namespace cg = cooperative_groups;

#ifndef USE_COOP
#define USE_COOP 1
#endif

#define DI __device__ __forceinline__
typedef unsigned short bf16_t;
using bf16x8 = __attribute__((ext_vector_type(8))) short;
using bf16x4 = __attribute__((ext_vector_type(4))) short;
using f32x4  = __attribute__((ext_vector_type(4))) float;

constexpr int D_MODEL = 1024, BATCH = 32, SEQ = 2048, DEPTH = 4, DEC_BATCH = 8, DEC_SEQ = 64, PAST = 1024, LS = 1088;
constexpr int MP = BATCH * SEQ;
constexpr int MS = DEC_BATCH * DEC_SEQ;
constexpr int MT = MP + MS;
constexpr int D_IN = 5832, D_INP = 5888;
constexpr float LN_EPS = 1e-5f;
constexpr float ALPHA = 1.681792830507429f;
constexpr float SB_SCALE = 0.125f, ATT_SCALE = 0.125f;
constexpr int NTHREADS = 512, NWAVES = 8;
constexpr int LDS_S = 0, LDS_BM = 131072, LDS_BTAB = 139264, LDS_RB = 143360, LDS_SLOT = 144384, LDS_BYTES = 144448;

constexpr size_t O_Y = 0, O_KAP = 67633152, O_VAP = 201850880, O_KBP = 336068608, O_VBP = 352845824, O_KIP = 369623040,
                 O_KAS = 386400256, O_VAS = 387448832, O_KBS = 388497408, O_VBS = 388628480, O_KIS = 388759552;
constexpr int OUT_TOTAL = 388890624;

struct Params {
  const float* x_prompt; const float* x_sample;
  const float* c_sb_k; const float* c_sb_v; const float* c_dsa_k; const float* c_dsa_v; const float* c_idx_k;
  const float* ln_in_g; const float* ln_in_b; const float* w_in; const float* b_in; const float* w_pa; const float* w_pb;
  const float* w_out; const float* ln_g; const float* ln_b; const float* rel_bias;
  float* out;
  bf16_t* Xb; bf16_t* QA; bf16_t* GA; bf16_t* GB; bf16_t* QB; bf16_t* QI;
  bf16_t* KAp; bf16_t* VATp; bf16_t* KAs; bf16_t* VATs;
  bf16_t* KBp; bf16_t* VBTp; bf16_t* KIp; bf16_t* KBs; bf16_t* VBTs; bf16_t* KIs;
  float* WI; bf16_t* RA; bf16_t* RB;
  bf16_t* WinT; bf16_t* WpaT; bf16_t* WpbT; bf16_t* WoutT;
  unsigned char* btab; int* ctr;
};

DI unsigned short f2bf(float x) { unsigned u = __float_as_uint(x); u += 0x7fffu + ((u >> 16) & 1u); return (unsigned short)(u >> 16); }
DI float bf2f(short h) { return __uint_as_float(((unsigned)(unsigned short)h) << 16); }
typedef __bf16 hbf16x2 __attribute__((ext_vector_type(2)));
typedef float f32x2v __attribute__((ext_vector_type(2)));
typedef unsigned u32x2v __attribute__((ext_vector_type(2)));
typedef unsigned u32x4v __attribute__((ext_vector_type(4)));
DI unsigned pk2(float lo, float hi) { f32x2v v; v.x = lo; v.y = hi; return __builtin_bit_cast(unsigned, __builtin_convertvector(v, hbf16x2)); }
DI bf16x4 pack4(float a, float b, float c, float d) { u32x2v u; u.x = pk2(a, b); u.y = pk2(c, d); return __builtin_bit_cast(bf16x4, u); }
DI bf16x8 pack8(const float (&e)[8]) { u32x4v u; u.x = pk2(e[0], e[1]); u.y = pk2(e[2], e[3]); u.z = pk2(e[4], e[5]); u.w = pk2(e[6], e[7]); return __builtin_bit_cast(bf16x8, u); }
DI bf16x8 ld8(const bf16_t* p) { return *reinterpret_cast<const bf16x8*>(p); }
DI bf16x4 ld4(const bf16_t* p) { return *reinterpret_cast<const bf16x4*>(p); }
DI void st4(bf16_t* p, bf16x4 v) { *reinterpret_cast<bf16x4*>(p) = v; }
DI f32x4 mfma16(bf16x8 a, bf16x8 b, f32x4 c) { return __builtin_amdgcn_mfma_f32_16x16x32_bf16(a, b, c, 0, 0, 0); }
DI int otid() { int t = threadIdx.x; asm volatile("" : "+v"(t)); return t; }
DI float sigmoidf_(float x) { return 1.f / (1.f + __expf(-x)); }
DI float wave_sum(float x) { for (int o = 32; o >= 1; o >>= 1) x += __shfl_xor(x, o); return x; }
DI int hsum32(int x) {
  x += __builtin_amdgcn_update_dpp(0, x, 0xB1, 0xF, 0xF, true);
  x += __builtin_amdgcn_update_dpp(0, x, 0x4E, 0xF, 0xF, true);
  x += __builtin_amdgcn_update_dpp(0, x, 0x141, 0xF, 0xF, true);
  x += __builtin_amdgcn_update_dpp(0, x, 0x140, 0xF, 0xF, true);
  x += __shfl_xor(x, 16);
  return x;
}
DI void gbar(unsigned* ctr, unsigned target) {
  asm volatile("s_waitcnt vmcnt(0)" ::: "memory");
  __syncthreads();
  if (threadIdx.x == 0) {
    __builtin_amdgcn_fence(__ATOMIC_RELEASE, "agent");
    asm volatile("s_waitcnt vmcnt(0)" ::: "memory");
    __hip_atomic_fetch_add(ctr, 1u, __ATOMIC_RELAXED, __HIP_MEMORY_SCOPE_AGENT);
    while (__hip_atomic_load(ctr, __ATOMIC_RELAXED, __HIP_MEMORY_SCOPE_AGENT) < target) __builtin_amdgcn_s_sleep(2);
    __builtin_amdgcn_fence(__ATOMIC_ACQUIRE, "agent");
    asm volatile("s_waitcnt vmcnt(0)" ::: "memory");
  }
  __syncthreads();
}

DI void ln_row_wave(const float* src, const float* g, const float* b, float* d32, bf16_t* db, int lane) {
  float4 v[4]; float s = 0.f;
#pragma unroll
  for (int i = 0; i < 4; ++i) { v[i] = reinterpret_cast<const float4*>(src)[lane + 64 * i]; s += v[i].x + v[i].y + v[i].z + v[i].w; }
  s = wave_sum(s);
  const float mu = s * (1.f / 1024.f);
  float q = 0.f;
#pragma unroll
  for (int i = 0; i < 4; ++i) { float a = v[i].x - mu, bb = v[i].y - mu, c = v[i].z - mu, d = v[i].w - mu; q += a * a + bb * bb + c * c + d * d; }
  q = wave_sum(q);
  const float rstd = rsqrtf(q * (1.f / 1024.f) + LN_EPS);
#pragma unroll
  for (int i = 0; i < 4; ++i) {
    float4 gg = reinterpret_cast<const float4*>(g)[lane + 64 * i], bb = reinterpret_cast<const float4*>(b)[lane + 64 * i];
    float4 o;
    o.x = (v[i].x - mu) * rstd * gg.x + bb.x; o.y = (v[i].y - mu) * rstd * gg.y + bb.y;
    o.z = (v[i].z - mu) * rstd * gg.z + bb.z; o.w = (v[i].w - mu) * rstd * gg.w + bb.w;
    reinterpret_cast<float4*>(d32)[lane + 64 * i] = o;
    st4(db + 4 * (lane + 64 * i), pack4(o.x, o.y, o.z, o.w));
  }
}

DI void tconv_tile(const float* src, int ldsrc, int K, bf16_t* dst, int n0, int k0, bool winmap, float* tile) {
  const int tid = otid();
#pragma unroll
  for (int rr = 0; rr < 8; ++rr) {
    const int kl = rr * 8 + (tid >> 6), nl = tid & 63, np = n0 + nl;
    int n = np; bool ok = true;
    if (winmap) { if (np >= 3840) n = np - 56; else if (np >= 3784) ok = false; }
    tile[kl * 65 + nl] = ok ? src[(size_t)(k0 + kl) * ldsrc + n] : 0.f;
  }
  __syncthreads();
#pragma unroll
  for (int rr = 0; rr < 8; ++rr) {
    const int nl = rr * 8 + (tid >> 6), kl = tid & 63;
    dst[(size_t)(n0 + nl) * K + k0 + kl] = f2bf(tile[kl * 65 + nl]);
  }
  __syncthreads();
}

DI void convert_layer(const Params& p, int l, char* smem) {
  float* tile = reinterpret_cast<float*>(smem);
  const int G = gridDim.x;
  for (int it = blockIdx.x; it < 1984; it += G) {
    if (it < 1472) { int nt = it >> 4, kt = it & 15; tconv_tile(p.w_in + (size_t)l * 1024 * D_IN, D_IN, 1024, p.WinT, nt * 64, kt * 64, true, tile); }
    else if (it < 1600) { int i = it - 1472; int nt = i >> 3, kt = i & 7; tconv_tile(p.w_pa + (size_t)l * 512 * 1024, 1024, 512, p.WpaT, nt * 64, kt * 64, false, tile); }
    else if (it < 1728) { int i = it - 1600; int nt = i >> 3, kt = i & 7; tconv_tile(p.w_pb + (size_t)l * 512 * 1024, 1024, 512, p.WpbT, nt * 64, kt * 64, false, tile); }
    else { int i = it - 1728; int nt = i >> 4, kt = i & 15; tconv_tile(p.w_out + (size_t)l * 1024 * 1024, 1024, 1024, p.WoutT, nt * 64, kt * 64, false, tile); }
  }
  const int gtid = blockIdx.x * NTHREADS + otid(), gn = G * NTHREADS;
  for (int idx = gtid; idx < 8 * 1024 * 512; idx += gn) {
    int b = idx >> 19, rem = idx & ((1 << 19) - 1);
    p.KAs[(size_t)b * LS * 512 + rem] = f2bf(p.c_sb_k[(size_t)l * 8 * 1024 * 512 + idx]);
  }
  for (int idx = gtid; idx < 8 * 512 * 1024; idx += gn) {
    int b = idx >> 19, hd = (idx >> 10) & 511, t = idx & 1023;
    p.VATs[((size_t)b * 512 + hd) * LS + t] = f2bf(p.c_sb_v[(((size_t)l * 8 + b) * 1024 + t) * 512 + hd]);
  }
  for (int idx = gtid; idx < 8 * 1024 * 64; idx += gn) {
    int b = idx >> 16, rem = idx & 65535;
    p.KBs[(size_t)b * LS * 64 + rem] = f2bf(p.c_dsa_k[(size_t)l * 8 * 65536 + idx]);
    p.KIs[(size_t)b * LS * 64 + rem] = f2bf(p.c_idx_k[(size_t)l * 8 * 65536 + idx]);
    int d = (idx >> 10) & 63, t = idx & 1023;
    p.VBTs[((size_t)b * 64 + d) * LS + t] = f2bf(p.c_dsa_v[(((size_t)l * 8 + b) * 1024 + t) * 64 + d]);
  }
}

DI void phase_prologue(const Params& p, char* smem) {
  const int tid = otid(), lane = tid & 63;
  if (blockIdx.x == 0 && tid < 16) p.ctr[tid] = 0;
  for (int i = blockIdx.x * NTHREADS + tid; i < 4096; i += gridDim.x * NTHREADS) {
    int rel = i - 2047; int n = rel < 0 ? -rel : rel;
    float nf = (float)(n > 1 ? n : 1);
    int large = 8 + (int)(logf(nf / 8.f) / 2.7725887f * 8.f);
    large = large < 15 ? large : 15;
    int bk = (rel > 0 ? 16 : 0) + (n < 8 ? n : large);
    p.btab[i] = (unsigned char)bk;
  }
  for (int row = blockIdx.x * NWAVES + (tid >> 6); row < MT; row += gridDim.x * NWAVES) {
    const float* src = row < MP ? p.x_prompt + (size_t)row * 1024 : p.x_sample + (size_t)(row - MP) * 1024;
    ln_row_wave(src, p.ln_in_g, p.ln_in_b, p.out + (size_t)row * 1024, p.Xb + (size_t)row * 1024, lane);
  }
  convert_layer(p, 0, smem);
}


namespace pg8 {
#define PG8_LAS __attribute__((address_space(3)))
constexpr int BM = 256, BK = 64, HALF = 128, HTB = HALF * BK * 2, STAGE_BYTES = 8 * HTB, NXCD = 8, WGM = 8;
DI int lds_byte(int r, int c) { const int st = (r >> 4) * 2 + (c >> 5), rr = r & 15, cc = c & 31, ob = rr * 64 + cc * 2; return st * 1024 + (ob ^ (((ob >> 9) & 1) << 5)); }
DI void stage_rc(int b, int& R, int& C) { const int st = b / 1024, sb = b % 1024, swz = sb ^ (((sb >> 9) & 1) << 5); R = (st >> 1) * 16 + swz / 64; C = (st & 1) * 32 + (swz % 64) / 2; }
DI int perm32(int rho) { const int n = rho >> 4, i = rho & 15; return 8 * (i >> 2) + 4 * n + (i & 3); }
struct Unit { int pm, pn; };
struct Gemm { const bf16_t* A; const bf16_t* Bt; int M, N, K; };
struct StaticOrder {
    int nM, nN, nwg, G, c;
    DI void init(int M, int N, int G_, int c_) { nM = M / BM; nN = N / BM; nwg = nM * nN; G = G_; c = c_; }
    DI bool next(int i, Unit& u) const {
        const long L = (long)i * G + c; if (L >= nwg) return false;
        int wgid = (int)L; { const int q = nwg / NXCD, r = nwg % NXCD, xcd = wgid % NXCD, off = wgid / NXCD; wgid = (xcd < r ? xcd * (q + 1) : r * (q + 1) + (xcd - r) * q) + off; }
        const int nig = WGM * nN, gid = wgid / nig, fm = gid * WGM, gsz = (nM - fm) < WGM ? (nM - fm) : WGM;
        u.pm = fm + ((wgid % nig) % gsz); u.pn = (wgid % nig) / gsz; return true;
    }
    DI void a_ready(const Unit&) const {}
    DI void done(const Unit&) const {}
};
template <class Epi, class Sched>
__device__ __forceinline__ void gemm_phase(PG8_LAS unsigned char* lds, const Gemm g, const Sched& S, const Epi& E) {
    const int tid = otid(), wid = __builtin_amdgcn_readfirstlane(tid >> 6), lane = tid & 63, wr = wid >> 2, wc = wid & 3, fr = lane & 15, fq = lane >> 4;
    const int K = g.K, nt = K / BK;
    unsigned voffA[2], voffB[2];
#pragma unroll
    for (int i = 0; i < 2; ++i) { int R, C; stage_rc(tid * 16 + i * 8192, R, C); const int Rb = Epi::PERM ? ((R & ~31) + perm32(R & 31)) : R;
        voffA[i] = (unsigned)(R * K + C) * 2u; voffB[i] = (unsigned)(Rb * K + C) * 2u; }
    const size_t kstep = (size_t)(BK * 2);
    const size_t hstep = (size_t)HALF * K * 2;
    const size_t tstep = 2 * hstep;
    const unsigned ldsw = (unsigned)wid * 1024u;
    const int aoff = lds_byte(wr * 64 + fr, fq * 8), boff = lds_byte(wc * 32 + fr, fq * 8);
#define PG8_SA(b, h) (((b) * 2 + (h)) * HTB)
#define PG8_SB(b, h) ((4 + (b) * 2 + (h)) * HTB)
#define PG8_STAGE(bufoff, gbase, voff) do { _Pragma("unroll") for (int _i = 0; _i < 2; ++_i) \
        __builtin_amdgcn_global_load_lds((const unsigned*)((const char*)(gbase) + (voff)[_i]), (PG8_LAS unsigned*)(lds + (bufoff) + ldsw + _i * 8192), 16, 0, 0); } while (0)
#define PG8_LDA(dst, b, h) do { _Pragma("unroll") for (int m = 0; m < 4; ++m) _Pragma("unroll") for (int k = 0; k < 2; ++k) dst[m][k] = *(const PG8_LAS bf16x8*)(lds + PG8_SA(b, h) + aoff + m * 2048 + k * 1024); } while (0)
#define PG8_LDB(dst, b, h) do { _Pragma("unroll") for (int n = 0; n < 2; ++n) _Pragma("unroll") for (int k = 0; k < 2; ++k) dst[n][k] = *(const PG8_LAS bf16x8*)(lds + PG8_SB(b, h) + boff + n * 2048 + k * 1024); } while (0)
#define PG8_MMA(ai, bj, At, Bt) do { __builtin_amdgcn_s_setprio(1); _Pragma("unroll") for (int m = 0; m < 4; ++m) _Pragma("unroll") for (int n = 0; n < 2; ++n) _Pragma("unroll") for (int k = 0; k < 2; ++k) \
        acc[ai][bj][m][n] = __builtin_amdgcn_mfma_f32_16x16x32_bf16(Bt[n][k], At[m][k], acc[ai][bj][m][n], 0, 0, 0); __builtin_amdgcn_s_setprio(0); } while (0)
#define PG8_WAIT_V(n) asm volatile("s_waitcnt vmcnt(" #n ")" ::: "memory")
#define PG8_WAIT_L(n) asm volatile("s_waitcnt lgkmcnt(" #n ")" ::: "memory")
#define PG8_BAR __builtin_amdgcn_s_barrier()
#define PG8_SCHED __builtin_amdgcn_sched_barrier(0)
    Unit cur, nxt; int ui = 0;
    if (!S.next(0, cur)) return;
    f32x4 acc[2][2][4][2];
#pragma unroll
    for (int a = 0; a < 2; ++a)
#pragma unroll
        for (int b = 0; b < 2; ++b)
#pragma unroll
            for (int m = 0; m < 4; ++m)
#pragma unroll
                for (int n = 0; n < 2; ++n) acc[a][b][m][n] = (f32x4){0.f, 0.f, 0.f, 0.f};
    bf16x8 At[4][2], B0[2][2], B1[2][2];
    const char* cA = (const char*)g.A + (size_t)cur.pm * tstep; const char* cB = (const char*)g.Bt + (size_t)cur.pn * tstep;
    S.a_ready(cur);
    PG8_STAGE(PG8_SB(0, 0), cB, voffB); PG8_STAGE(PG8_SA(0, 0), cA, voffA); PG8_STAGE(PG8_SB(0, 1), cB + hstep, voffB); PG8_STAGE(PG8_SA(0, 1), cA + hstep, voffA);
    if (wr == 1) PG8_BAR;
    PG8_WAIT_V(4); PG8_BAR;
    PG8_STAGE(PG8_SB(1, 0), cB + kstep, voffB); PG8_STAGE(PG8_SA(1, 0), cA + kstep, voffA); PG8_STAGE(PG8_SB(1, 1), cB + hstep + kstep, voffB);
    PG8_WAIT_V(6); PG8_BAR;
    for (;;) {
        const bool has_next = S.next(ui + 1, nxt);
        const char* nA = has_next ? (const char*)g.A + (size_t)nxt.pm * tstep : cA; const char* nB = has_next ? (const char*)g.Bt + (size_t)nxt.pn * tstep : cB;
        for (int t = 0; t < nt; t += 2) {
            const bool last = (t == nt - 2);
            const char* a1 = cA + (size_t)(t + 1) * kstep;
            const char* a2 = last ? nA : cA + (size_t)(t + 2) * kstep; const char* b2 = last ? nB : cB + (size_t)(t + 2) * kstep;
            const char* a3 = a2 + kstep; const char* b3 = b2 + kstep;
            if (last && has_next) S.a_ready(nxt);
            PG8_LDB(B0, 0, 0); PG8_SCHED; PG8_LDA(At, 0, 0); PG8_STAGE(PG8_SA(1, 1), a1 + hstep, voffA);
            PG8_WAIT_L(8); PG8_BAR; PG8_WAIT_L(0); PG8_MMA(0, 0, At, B0); PG8_BAR; PG8_SCHED;
            PG8_LDB(B1, 0, 1); PG8_STAGE(PG8_SB(0, 0), b2, voffB);
            PG8_BAR; PG8_WAIT_L(0); PG8_MMA(0, 1, At, B1); PG8_BAR;
            PG8_LDA(At, 0, 1); PG8_STAGE(PG8_SA(0, 0), a2, voffA);
            PG8_BAR; PG8_WAIT_L(0); PG8_MMA(1, 0, At, B0); PG8_BAR; PG8_SCHED;
            PG8_STAGE(PG8_SB(0, 1), b2 + hstep, voffB);
            PG8_WAIT_V(6); PG8_BAR; PG8_MMA(1, 1, At, B1); PG8_BAR;
            PG8_LDB(B0, 1, 0); PG8_SCHED; PG8_LDA(At, 1, 0); PG8_STAGE(PG8_SA(0, 1), a2 + hstep, voffA);
            PG8_WAIT_L(8); PG8_BAR; PG8_WAIT_L(0); PG8_MMA(0, 0, At, B0); PG8_BAR; PG8_SCHED;
            PG8_LDB(B1, 1, 1); PG8_STAGE(PG8_SB(1, 0), b3, voffB);
            PG8_BAR; PG8_WAIT_L(0); PG8_MMA(0, 1, At, B1); PG8_BAR;
            PG8_LDA(At, 1, 1); PG8_STAGE(PG8_SA(1, 0), a3, voffA);
            PG8_BAR; PG8_WAIT_L(0); PG8_MMA(1, 0, At, B0); PG8_BAR; PG8_SCHED;
            PG8_STAGE(PG8_SB(1, 1), b3 + hstep, voffB);
            PG8_WAIT_V(6); PG8_BAR; PG8_MMA(1, 1, At, B1); PG8_BAR;
        }
        if constexpr (!Epi::AFTER_DRAIN) { E(acc, cur, wr, wc, fr, fq); S.done(cur); }
        if (!has_next) break;
#pragma unroll
        for (int a = 0; a < 2; ++a)
#pragma unroll
            for (int b = 0; b < 2; ++b)
#pragma unroll
                for (int m = 0; m < 4; ++m)
#pragma unroll
                    for (int n = 0; n < 2; ++n) acc[a][b][m][n] = (f32x4){0.f, 0.f, 0.f, 0.f};
        cur = nxt; cA = nA; cB = nB; ++ui;
    }
    PG8_WAIT_V(0);
    if (wr == 0) PG8_BAR;
    PG8_BAR;
    if constexpr (Epi::AFTER_DRAIN) { E.fused(acc, cur, wr, wc, fr, fq, lds, wid, lane); S.done(cur); }
#undef PG8_SA
#undef PG8_SB
#undef PG8_STAGE
#undef PG8_LDA
#undef PG8_LDB
#undef PG8_MMA
#undef PG8_WAIT_V
#undef PG8_WAIT_L
#undef PG8_BAR
#undef PG8_SCHED
}
}

DI bf16x4 pack4v(const f32x4 v) { return pack4(v[0], v[1], v[2], v[3]); }

constexpr size_t al256(size_t x) { return (x + 255) & ~(size_t)255; }
constexpr size_t OFF_XB = 0;
constexpr size_t OFF_QA = OFF_XB + al256((size_t)MT * 1024 * 2);
constexpr size_t OFF_GA = OFF_QA + al256((size_t)MT * 512 * 2);
constexpr size_t OFF_GB = OFF_GA + al256((size_t)MT * 512 * 2);
constexpr size_t OFF_QB = OFF_GB + al256((size_t)MT * 512 * 2);
constexpr size_t OFF_QI = OFF_QB + al256((size_t)MT * 512 * 2);
constexpr size_t OFF_KAP = OFF_QI + al256((size_t)MT * 512 * 2);
constexpr size_t OFF_VATP = OFF_KAP + al256((size_t)MP * 512 * 2);
constexpr size_t OFF_KAS = OFF_VATP + al256((size_t)MP * 512 * 2);
constexpr size_t OFF_VATS = OFF_KAS + al256((size_t)8 * LS * 512 * 2);
constexpr size_t OFF_KBP = OFF_VATS + al256((size_t)8 * LS * 512 * 2);
constexpr size_t OFF_VBTP = OFF_KBP + al256((size_t)MP * 64 * 2);
constexpr size_t OFF_KIP = OFF_VBTP + al256((size_t)MP * 64 * 2);
constexpr size_t OFF_KBS = OFF_KIP + al256((size_t)MP * 64 * 2);
constexpr size_t OFF_VBTS = OFF_KBS + al256((size_t)8 * LS * 64 * 2);
constexpr size_t OFF_KIS = OFF_VBTS + al256((size_t)8 * LS * 64 * 2);
constexpr size_t OFF_WI = OFF_KIS + al256((size_t)8 * LS * 64 * 2);
constexpr size_t OFF_RA = OFF_WI + al256((size_t)MT * 8 * 4);
constexpr size_t OFF_RB = OFF_RA + al256((size_t)MT * 1024 * 2);

struct EpiProj {
  static constexpr bool PERM = false, AFTER_DRAIN = false;
  const Params& p; int layer;
  template <int GRP>
  DI void run(const f32x4 (&acc)[2][2][4][2], const pg8::Unit& u, int wr, int wc, int fr, int fq) const {
    constexpr int T = GRP ? LS : SEQ;
    const float* bin = p.b_in + (size_t)layer * D_IN;
    char* ws = reinterpret_cast<char*>(p.Xb);
#pragma unroll
    for (int bj = 0; bj < 2; ++bj) {
      const int nt = 2 * u.pn + bj;
      f32x4 bias[2];
#pragma unroll
      for (int n = 0; n < 2; ++n) {
        const int np = nt * 128 + 32 * wc + 16 * n + 4 * fq;
        bias[n] = f32x4{0.f, 0.f, 0.f, 0.f};
        if (np < 3784) bias[n] = *reinterpret_cast<const f32x4*>(bin + np);
        else if (np >= 3840) bias[n] = *reinterpret_cast<const f32x4*>(bin + np - 56);
      }
      const bool simple = (nt < 4) || (nt >= 12 && nt < 20) || (nt >= 21 && nt < 29) || (nt >= 30);
      if (simple) {
        size_t off; int ld, c0, act;
        if (nt < 4) { off = OFF_QA; ld = 512; c0 = nt * 128; act = 0; }
        else if (nt < 16) { off = OFF_GA; ld = 512; c0 = (nt - 12) * 128; act = 1; }
        else if (nt < 20) { off = OFF_QB; ld = 512; c0 = (nt - 16) * 128; act = 0; }
        else if (nt < 25) { off = OFF_GB; ld = 512; c0 = (nt - 21) * 128; act = 1; }
        else if (nt < 29) { off = OFF_QI; ld = 512; c0 = (nt - 25) * 128; act = 0; }
        else if (nt < 38) { off = OFF_RA; ld = 1024; c0 = (nt - 30) * 128; act = 2; }
        else { off = OFF_RB; ld = 1024; c0 = (nt - 38) * 128; act = 2; }
        bf16_t* dst = reinterpret_cast<bf16_t*>(ws + off) + c0 + 32 * wc + 4 * fq;
#pragma unroll
        for (int ai = 0; ai < 2; ++ai)
#pragma unroll
          for (int m = 0; m < 4; ++m) {
            int row = u.pm * 256 + 128 * ai + 64 * wr + 16 * m + fr;
            asm volatile("" : "+v"(row));
            bf16_t* rp = dst + (size_t)row * ld;
#pragma unroll
            for (int n = 0; n < 2; ++n) {
              f32x4 v = acc[ai][bj][m][n] + bias[n];
              if (act != 0) {
#pragma unroll
                for (int j = 0; j < 4; ++j) { const float sg = sigmoidf_(v[j]); v[j] = (act == 1) ? v[j] * sg : sg; }
              }
              st4(rp + 16 * n, pack4v(v));
            }
          }
      } else {
#pragma unroll
        for (int ai = 0; ai < 2; ++ai)
#pragma unroll
          for (int m = 0; m < 4; ++m) {
            int row = u.pm * 256 + 128 * ai + 64 * wr + 16 * m + fr;
            asm volatile("" : "+v"(row));
            int bb, tt;
            if (!GRP) { bb = row >> 11; tt = row & 2047; } else { const int ms = row - MP; bb = ms >> 6; tt = PAST + (ms & 63); }
            const size_t orow = GRP ? (size_t)layer * MS + (row - MP) : (size_t)layer * MP + row;
#pragma unroll
            for (int n = 0; n < 2; ++n) {
              int ct = 32 * wc + 16 * n + 4 * fq;
              asm volatile("" : "+v"(ct));
              const f32x4 v = acc[ai][bj][m][n] + bias[n];
              if (nt < 8) {
                const int c = (nt - 4) * 128 + ct;
                *reinterpret_cast<f32x4*>(p.out + (GRP ? O_KAS : O_KAP) + orow * 512 + c) = v;
                bf16_t* kd = GRP ? p.KAs + ((size_t)bb * LS + tt) * 512 + c : p.KAp + (size_t)row * 512 + c;
                st4(kd, pack4v(v));
              } else if (nt < 12) {
                const int c = (nt - 8) * 128 + ct;
                *reinterpret_cast<f32x4*>(p.out + (GRP ? O_VAS : O_VAP) + orow * 512 + c) = v;
                bf16_t* vd = (GRP ? p.VATs : p.VATp) + ((size_t)bb * 512 + c) * T + tt;
                vd[0] = f2bf(v[0]); vd[T] = f2bf(v[1]); vd[2 * T] = f2bf(v[2]); vd[3 * T] = f2bf(v[3]);
              } else if (nt == 20) {
                if (wc < 2) {
                  *reinterpret_cast<f32x4*>(p.out + (GRP ? O_KBS : O_KBP) + orow * 64 + ct) = v;
                  st4((GRP ? p.KBs : p.KBp) + ((size_t)bb * T + tt) * 64 + ct, pack4v(v));
                } else {
                  const int c = ct - 64;
                  *reinterpret_cast<f32x4*>(p.out + (GRP ? O_VBS : O_VBP) + orow * 64 + c) = v;
                  bf16_t* vd = (GRP ? p.VBTs : p.VBTp) + ((size_t)bb * 64 + c) * T + tt;
                  vd[0] = f2bf(v[0]); vd[T] = f2bf(v[1]); vd[2 * T] = f2bf(v[2]); vd[3 * T] = f2bf(v[3]);
                }
              } else {
                if (wc < 2) {
                  *reinterpret_cast<f32x4*>(p.out + (GRP ? O_KIS : O_KIP) + orow * 64 + ct) = v;
                  st4((GRP ? p.KIs : p.KIp) + ((size_t)bb * T + tt) * 64 + ct, pack4v(v));
                } else if (ct < 72) {
                  *reinterpret_cast<f32x4*>(p.WI + (size_t)row * 8 + (ct - 64)) = v;
                }
              }
            }
          }
      }
    }
  }
  DI void operator()(const f32x4 (&acc)[2][2][4][2], const pg8::Unit& u, int wr, int wc, int fr, int fq) const {
    if (u.pm < MP / 256) run<0>(acc, u, wr, wc, fr, fq); else run<1>(acc, u, wr, wc, fr, fq);
  }
};

template <int MODE>
struct EpiTail {
  static constexpr bool PERM = false, AFTER_DRAIN = false;
  const Params& p;
  DI void operator()(const f32x4 (&acc)[2][2][4][2], const pg8::Unit& u, int wr, int wc, int fr, int fq) const {
    bf16_t* MERGED = p.GA;
#pragma unroll
    for (int ai = 0; ai < 2; ++ai)
#pragma unroll
      for (int m = 0; m < 4; ++m) {
        const int row = u.pm * 256 + 128 * ai + 64 * wr + 16 * m + fr;
#pragma unroll
        for (int bj = 0; bj < 2; ++bj)
#pragma unroll
          for (int n = 0; n < 2; ++n) {
            const size_t idx = (size_t)row * 1024 + u.pn * 256 + 128 * bj + 32 * wc + 16 * n + 4 * fq;
            const f32x4 a = acc[ai][bj][m][n];
            if (MODE == 0) {
              const bf16x4 g = ld4(p.RA + idx);
              st4(MERGED + idx, pack4(bf2f(g[0]) * a[0], bf2f(g[1]) * a[1], bf2f(g[2]) * a[2], bf2f(g[3]) * a[3]));
            } else if (MODE == 1) {
              const bf16x4 g = ld4(p.RB + idx); const bf16x4 o = ld4(MERGED + idx);
              st4(MERGED + idx, pack4(bf2f(o[0]) + bf2f(g[0]) * a[0], bf2f(o[1]) + bf2f(g[1]) * a[1], bf2f(o[2]) + bf2f(g[2]) * a[2], bf2f(o[3]) + bf2f(g[3]) * a[3]));
            } else {
              f32x4 x = *reinterpret_cast<const f32x4*>(p.out + idx);
              x = x * ALPHA + a;
              *reinterpret_cast<f32x4*>(p.out + idx) = x;
            }
          }
      }
  }
};

DI void phase_proj(const Params& p, int layer, char* smem) {
  pg8::Gemm g{p.Xb, p.WinT, MT, D_INP, 1024};
  pg8::StaticOrder S; S.init(MT, D_INP, gridDim.x, blockIdx.x);
  EpiProj E{p, layer};
  pg8::gemm_phase<EpiProj, pg8::StaticOrder>((PG8_LAS unsigned char*)smem, g, S, E);
}
DI void phase_merge_a(const Params& p, char* smem) {
  pg8::Gemm g{p.QA, p.WpaT, MT, 1024, 512};
  pg8::StaticOrder S; S.init(MT, 1024, gridDim.x, blockIdx.x);
  EpiTail<0> E{p};
  pg8::gemm_phase<EpiTail<0>, pg8::StaticOrder>((PG8_LAS unsigned char*)smem, g, S, E);
}
DI void phase_merge_b(const Params& p, char* smem) {
  pg8::Gemm g{p.QB, p.WpbT, MT, 1024, 512};
  pg8::StaticOrder S; S.init(MT, 1024, gridDim.x, blockIdx.x);
  EpiTail<1> E{p};
  pg8::gemm_phase<EpiTail<1>, pg8::StaticOrder>((PG8_LAS unsigned char*)smem, g, S, E);
}
DI void phase_out(const Params& p, char* smem) {
  pg8::Gemm g{p.GA, p.WoutT, MT, 1024, 1024};
  pg8::StaticOrder S; S.init(MT, 1024, gridDim.x, blockIdx.x);
  EpiTail<2> E{p};
  pg8::gemm_phase<EpiTail<2>, pg8::StaticOrder>((PG8_LAS unsigned char*)smem, g, S, E);
}

template <int grp>
DI void sb_item(const Params& p, int b, int h, int t0) {
  const int tid = otid(), w = tid >> 6, lane = tid & 63, c = lane & 15, q4 = lane >> 4;
  const int T = grp ? LS : SEQ;
  const int qpos0 = grp ? PAST + t0 : t0;
  const int m0 = grp ? MP + b * DEC_SEQ + t0 : b * SEQ + t0;
  const bf16_t* Kb = (grp ? p.KAs : p.KAp) + (size_t)b * T * 512 + h * 64;
  const bf16_t* VTb = (grp ? p.VATs : p.VATp) + (size_t)(b * 8 + h) * 64 * T;
  const bf16_t* qp = p.QA + (size_t)(m0 + c) * 512 + h * 64 + q4 * 8;
  const bf16x8 qf0 = ld8(qp), qf1 = ld8(qp + 32);
  const int qpos = qpos0 + c;
  float R = 0.f;
  f32x4 O[4];
#pragma unroll
  for (int dt = 0; dt < 4; ++dt) O[dt] = f32x4{0.f, 0.f, 0.f, 0.f};
  for (int kb = (qpos0 + 14) >> 5; kb >= 0; --kb) {
    const int s0 = kb * 32;
    f32x4 z[2];
#pragma unroll
    for (int kt = 0; kt < 2; ++kt) {
      const bf16_t* kp = Kb + (size_t)(s0 + 16 * kt + c) * 512 + q4 * 8;
      z[kt] = mfma16(ld8(kp), qf0, f32x4{0.f, 0.f, 0.f, 0.f});
      z[kt] = mfma16(ld8(kp + 32), qf1, z[kt]);
    }
    bf16x8 vf[4];
#pragma unroll
    for (int dt = 0; dt < 4; ++dt) {
      const bf16_t* vp = VTb + (size_t)(16 * dt + c) * T + s0 + 4 * q4;
      bf16x4 lo = ld4(vp), hi = ld4(vp + 16);
      vf[dt] = __builtin_shufflevector(lo, hi, 0, 1, 2, 3, 4, 5, 6, 7);
    }
    float lk[2][4], ls[2][4]; bool bf[2][4];
#pragma unroll
    for (int kt = 0; kt < 2; ++kt)
#pragma unroll
      for (int r = 0; r < 4; ++r) {
        const int key = s0 + 16 * kt + 4 * q4 + r;
        const bool before = key < qpos;
        const float zz = z[kt][r] * SB_SCALE;
        const float sp = fmaxf(zz, 0.f) + __logf(1.f + __expf(-fabsf(zz)));
        bf[kt][r] = before; lk[kt][r] = before ? -sp : 0.f; ls[kt][r] = zz - sp;
      }
    const float T1 = (lk[1][0] + lk[1][1]) + (lk[1][2] + lk[1][3]);
    const float T0 = (lk[0][0] + lk[0][1]) + (lk[0][2] + lk[0][3]);
    const float a1 = __shfl_xor(T1, 16), a0 = __shfl_xor(T0, 16);
    const float p1 = T1 + a1, p0 = T0 + a0;
    const float c1 = __shfl_xor(p1, 32), c0 = __shfl_xor(p0, 32);
    const float H1 = ((q4 & 1) ? 0.f : a1) + ((q4 & 2) ? 0.f : c1);
    const float H0 = ((q4 & 1) ? 0.f : a0) + ((q4 & 2) ? 0.f : c0);
    const float TT1 = p1 + c1, TT0 = p0 + c0;
    float a[2][4];
    { float ac = R + H1;
#pragma unroll
      for (int r = 3; r >= 0; --r) { a[1][r] = bf[1][r] ? __expf(ls[1][r] + ac) : 0.f; ac += lk[1][r]; } }
    { float ac = R + TT1 + H0;
#pragma unroll
      for (int r = 3; r >= 0; --r) { a[0][r] = bf[0][r] ? __expf(ls[0][r] + ac) : 0.f; ac += lk[0][r]; } }
    R = R + TT1 + TT0;
    const float ae[8] = {a[0][0], a[0][1], a[0][2], a[0][3], a[1][0], a[1][1], a[1][2], a[1][3]};
    const bf16x8 pf = pack8(ae);
#pragma unroll
    for (int dt = 0; dt < 4; ++dt) O[dt] = mfma16(vf[dt], pf, O[dt]);
    if (__ballot(R > -50.f) == 0ull) break;
  }
#pragma unroll
  for (int dt = 0; dt < 4; ++dt) {
    const size_t off = (size_t)(m0 + c) * 512 + h * 64 + dt * 16 + 4 * q4;
    const bf16x4 g = ld4(p.GA + off);
    st4(p.QA + off, pack4(O[dt][0] * bf2f(g[0]), O[dt][1] * bf2f(g[1]), O[dt][2] * bf2f(g[2]), O[dt][3] * bf2f(g[3])));
  }
}

template <int grp>
DI void dsa_item(const Params& p, int b, int tile32, char* smem) {
  const int tid = otid(), w = tid >> 6, lane = tid & 63, c = lane & 15, q4 = lane >> 4, half = lane >> 5, l32 = lane & 31;
  float* S = reinterpret_cast<float*>(smem) + w * 4096;
  unsigned* bm = reinterpret_cast<unsigned*>(smem + LDS_BM);
  const unsigned char* btab = reinterpret_cast<const unsigned char*>(smem + LDS_BTAB);
  const float* rb = reinterpret_cast<const float*>(smem + LDS_RB);
  const int T = grp ? LS : SEQ;
  const int t0 = tile32 * 32;
  const int qpos0 = grp ? PAST + t0 : t0;
  const int m0 = grp ? MP + b * DEC_SEQ + t0 : b * SEQ + t0;
  const int n_adm = grp ? LS : ((qpos0 >> 6) + 1) * 64;
  const bf16_t* KIb = (grp ? p.KIs : p.KIp) + (size_t)b * T * 64;
  const bf16_t* KBb = (grp ? p.KBs : p.KBp) + (size_t)b * T * 64;
  const bf16_t* VBTb = (grp ? p.VBTs : p.VBTp) + (size_t)b * 64 * T;

  for (int rnd = 0; rnd < 2; ++rnd) {
    const int qa = 4 * w + 2 * rnd;
    {
      const int tlA = c >> 3, hA = c & 7;
      const bf16_t* qip = p.QI + (size_t)(m0 + qa + tlA) * 512 + hA * 64 + q4 * 8;
      const bf16x8 af0 = ld8(qip), af1 = ld8(qip + 32);
      const int tlC = q4 >> 1;
      const float4 wv = *reinterpret_cast<const float4*>(p.WI + (size_t)(m0 + qa + tlC) * 8 + 4 * (q4 & 1));
      const int ngrp = n_adm >> 6;
      bf16x8 kA[4][2], kB[4][2];
      auto loadg = [&](int g, bf16x8 (&d)[4][2]) {
#pragma unroll
        for (int u = 0; u < 4; ++u) { const bf16_t* kp = KIb + (size_t)((g * 4 + u) * 16 + c) * 64 + q4 * 8; d[u][0] = ld8(kp); d[u][1] = ld8(kp + 32); }
      };
      auto compg = [&](int g, const bf16x8 (&d)[4][2]) {
#pragma unroll
        for (int u = 0; u < 4; ++u) {
          f32x4 C = mfma16(af0, d[u][0], f32x4{0.f, 0.f, 0.f, 0.f});
          C = mfma16(af1, d[u][1], C);
          const float part = wv.x * fmaxf(C[0], 0.f) + wv.y * fmaxf(C[1], 0.f) + wv.z * fmaxf(C[2], 0.f) + wv.w * fmaxf(C[3], 0.f);
          const float full = part + __shfl_xor(part, 16);
          if ((q4 & 1) == 0) S[tlC * 2048 + (g * 4 + u) * 16 + c] = full;
        }
      };
      loadg(0, kA);
      for (int g = 0; g < ngrp; g += 2) {
        if (g + 1 < ngrp) loadg(g + 1, kB);
        compg(g, kA);
        if (g + 1 < ngrp) { if (g + 2 < ngrp) loadg(g + 2, kA); compg(g + 1, kB); }
      }
    }
    __syncthreads();
    {
      unsigned key[64];
      const float* Sh = S + half * 2048;
#pragma unroll
      for (int i = 0; i < 64; ++i) {
        const int s = 32 * i + l32;
        const unsigned u = __float_as_uint(Sh[s]);
        const unsigned k = (u & 0x80000000u) ? ~u : (u | 0x80000000u);
        key[i] = (s < n_adm) ? k : 0u;
      }
      unsigned tau = 1u; int need = 0; bool done = true;
      if (n_adm > 256) {
        tau = 0u; done = false;
        for (int bit = 31; bit >= 0; --bit) {
          const unsigned cand = tau | (1u << bit);
          int cnt = 0;
#pragma unroll
          for (int i = 0; i < 64; ++i) cnt += (key[i] >= cand) ? 1 : 0;
          cnt = hsum32(cnt);
          if (!done && cnt >= 256) tau = cand;
          if (cnt == 256) done = true;
          if (__ballot(!done) == 0ull) break;
        }
      }
      unsigned w0 = 0u, w1 = 0u;
      if (__ballot(!done) == 0ull) {
#pragma unroll
        for (int i = 0; i < 64; ++i) {
          const unsigned long long msel = __ballot(key[i] >= tau);
          const unsigned wsel = half ? (unsigned)(msel >> 32) : (unsigned)msel;
          if (i < 32) { if (l32 == i) w0 = wsel; } else { if (l32 == i - 32) w1 = wsel; }
        }
      } else {
        int cgt = 0;
#pragma unroll
        for (int i = 0; i < 64; ++i) cgt += (key[i] > tau) ? 1 : 0;
        cgt = hsum32(cgt);
        need = 256 - cgt;
        int Rk = 0; const unsigned below = (1u << l32) - 1u;
#pragma unroll
        for (int i = 0; i < 64; ++i) {
          const bool eq = key[i] == tau, gt = key[i] > tau;
          const unsigned long long me = __ballot(eq);
          const unsigned hm = half ? (unsigned)(me >> 32) : (unsigned)me;
          const int rank = Rk + __popc(hm & below);
          const bool sel = done ? (key[i] >= tau) : (gt || (eq && rank < need));
          Rk += __popc(hm);
          const unsigned long long msel = __ballot(sel);
          const unsigned wsel = half ? (unsigned)(msel >> 32) : (unsigned)msel;
          if (i < 32) { if (l32 == i) w0 = wsel; } else { if (l32 == i - 32) w1 = wsel; }
        }
      }
      bm[(qa + half) * 64 + l32] = w0;
      bm[(qa + half) * 64 + 32 + l32] = w1;
    }
    __syncthreads();
  }

  {
    const int tl = c >> 3, h = c & 7;
    bf16x8 qf[2][2]; int qposc[2], qrow[2], qloc[2];
#pragma unroll
    for (int ct = 0; ct < 2; ++ct) {
      qloc[ct] = 4 * w + 2 * ct + tl; qrow[ct] = m0 + qloc[ct]; qposc[ct] = qpos0 + qloc[ct];
      const bf16_t* qp = p.QB + (size_t)qrow[ct] * 512 + h * 64 + q4 * 8;
      qf[ct][0] = ld8(qp); qf[ct][1] = ld8(qp + 32);
    }
    f32x4 O[2][4]; float mrun[2] = {-1e30f, -1e30f}, lrun[2] = {0.f, 0.f};
#pragma unroll
    for (int ct = 0; ct < 2; ++ct)
#pragma unroll
      for (int dt = 0; dt < 4; ++dt) O[ct][dt] = f32x4{0.f, 0.f, 0.f, 0.f};
    const int nkb = n_adm >> 5;
    bf16x8 kfA[2][2], vfA[4], kfB[2][2], vfB[4];
    auto loadkv = [&](int kb, bf16x8 (&kf)[2][2], bf16x8 (&vf)[4]) {
      const int s0 = kb * 32;
#pragma unroll
      for (int kt = 0; kt < 2; ++kt) { const bf16_t* kp = KBb + (size_t)(s0 + 16 * kt + c) * 64 + q4 * 8; kf[kt][0] = ld8(kp); kf[kt][1] = ld8(kp + 32); }
#pragma unroll
      for (int dt = 0; dt < 4; ++dt) {
        const bf16_t* vp = VBTb + (size_t)(16 * dt + c) * T + s0 + 4 * q4;
        bf16x4 lo = ld4(vp), hi = ld4(vp + 16);
        vf[dt] = __builtin_shufflevector(lo, hi, 0, 1, 2, 3, 4, 5, 6, 7);
      }
    };
    const float farbias = rb[15 * 8 + h];
    auto compkv = [&](auto FAR, int kb, const bf16x8 (&kf)[2][2], const bf16x8 (&vf)[4]) {
      constexpr bool far = decltype(FAR)::value;
      const int s0 = kb * 32;
#pragma unroll
      for (int ct = 0; ct < 2; ++ct) {
        f32x4 z0 = mfma16(kf[0][0], qf[ct][0], f32x4{0.f, 0.f, 0.f, 0.f}); z0 = mfma16(kf[0][1], qf[ct][1], z0);
        f32x4 z1 = mfma16(kf[1][0], qf[ct][0], f32x4{0.f, 0.f, 0.f, 0.f}); z1 = mfma16(kf[1][1], qf[ct][1], z1);
        const unsigned word = bm[qloc[ct] * 64 + kb];
        float zz[8]; bool bt[8]; float bmx = -1e30f;
#pragma unroll
        for (int e = 0; e < 8; ++e) {
          const int kt = e >> 2, r = e & 3;
          const int off = 16 * kt + 4 * q4 + r;
          float bias = farbias;
          if (!far) { const int rel = s0 + off - qposc[ct]; const int bk = btab[rel + 2047]; bias = rb[bk * 8 + h]; }
          const float zv = (kt ? z1[r] : z0[r]) * ATT_SCALE + bias;
          bt[e] = (word >> off) & 1u;
          zz[e] = bt[e] ? zv : -1e30f;
          bmx = fmaxf(bmx, zz[e]);
        }
        bmx = fmaxf(bmx, __shfl_xor(bmx, 16));
        bmx = fmaxf(bmx, __shfl_xor(bmx, 32));
        const float mnew = fmaxf(mrun[ct], bmx);
        const float sc = __expf(mrun[ct] - mnew);
        float ps = 0.f; float pe[8];
#pragma unroll
        for (int e = 0; e < 8; ++e) { pe[e] = bt[e] ? __expf(zz[e] - mnew) : 0.f; ps += pe[e]; }
        lrun[ct] = lrun[ct] * sc + ps; mrun[ct] = mnew;
        const bf16x8 pf = pack8(pe);
#pragma unroll
        for (int dt = 0; dt < 4; ++dt) { O[ct][dt] *= sc; O[ct][dt] = mfma16(vf[dt], pf, O[ct][dt]); }
      }
    };
    int nfar = (qpos0 - 159) >= 0 ? ((qpos0 - 159) >> 5) + 1 : 0;
    nfar = nfar < nkb ? nfar : nkb; nfar &= ~1;
    loadkv(0, kfA, vfA);
    for (int kb = 0; kb < nfar; kb += 2) {
      loadkv(kb + 1, kfB, vfB);
      compkv(std::true_type{}, kb, kfA, vfA);
      if (kb + 2 < nkb) loadkv(kb + 2, kfA, vfA);
      compkv(std::true_type{}, kb + 1, kfB, vfB);
    }
    for (int kb = nfar; kb < nkb; kb += 2) {
      if (kb + 1 < nkb) loadkv(kb + 1, kfB, vfB);
      compkv(std::false_type{}, kb, kfA, vfA);
      if (kb + 1 < nkb) { if (kb + 2 < nkb) loadkv(kb + 2, kfA, vfA); compkv(std::false_type{}, kb + 1, kfB, vfB); }
    }
#pragma unroll
    for (int ct = 0; ct < 2; ++ct) {
      float lt = lrun[ct]; lt += __shfl_xor(lt, 16); lt += __shfl_xor(lt, 32);
      const float inv = 1.f / lt;
#pragma unroll
      for (int dt = 0; dt < 4; ++dt) {
        const size_t off = (size_t)qrow[ct] * 512 + h * 64 + dt * 16 + 4 * q4;
        const bf16x4 g = ld4(p.GB + off);
        st4(p.QB + off, pack4(O[ct][dt][0] * inv * bf2f(g[0]), O[ct][dt][1] * inv * bf2f(g[1]), O[ct][dt][2] * inv * bf2f(g[2]), O[ct][dt][3] * inv * bf2f(g[3])));
      }
    }
  }
  __syncthreads();
}

DI void phase_attn(const Params& p, int layer, char* smem) {
  const int tid = otid();
  for (int i = tid; i < 4096; i += NTHREADS) smem[LDS_BTAB + i] = (char)p.btab[i];
  if (tid < 256) reinterpret_cast<float*>(smem + LDS_RB)[tid] = p.rel_bias[tid];
  __syncthreads();
  int* slot = reinterpret_cast<int*>(smem + LDS_SLOT);
  const int w = tid >> 6;
  const int total = 16 + 2048 + 32 + 4096;
  while (true) {
    if (tid == 0) *slot = atomicAdd(&p.ctr[layer], 1);
    __syncthreads();
    const int item = *slot;
    __syncthreads();
    if (item >= total) break;
    if (item < 16) dsa_item<1>(p, item >> 1, item & 1, smem);
    else if (item < 2064) { const int i = item - 16; dsa_item<0>(p, i >> 6, 63 - (i & 63), smem); }
    else if (item < 2096) { const int i = item - 2064; sb_item<1>(p, i >> 2, 2 * (i & 3) + (w >> 2), (w & 3) * 16); }
    else { const int i = item - 2096; const int tile = 15 - (i >> 8), bh = i & 255; sb_item<0>(p, bh >> 3, bh & 7, tile * 128 + w * 16); }
  }
}

DI void phase_ln(const Params& p, int layer, char* smem) {
  const int tid = otid(), lane = tid & 63;
  for (int row = blockIdx.x * NWAVES + (tid >> 6); row < MT; row += gridDim.x * NWAVES)
    ln_row_wave(p.out + (size_t)row * 1024, p.ln_g + layer * 1024, p.ln_b + layer * 1024, p.out + (size_t)row * 1024, p.Xb + (size_t)row * 1024, lane);
  if (layer + 1 < DEPTH) convert_layer(p, layer + 1, smem);
}

__global__ void __launch_bounds__(512, 2) mega_kernel(Params p) {
  extern __shared__ __attribute__((aligned(16))) char smem[];
  cg::grid_group grid = cg::this_grid();
  phase_prologue(p, smem);
  grid.sync();
  unsigned* bar = reinterpret_cast<unsigned*>(p.ctr + 8);
  unsigned nb = 0; const unsigned G = gridDim.x;
#pragma nounroll
  for (int l = 0; l < DEPTH; ++l) {
    phase_proj(p, l, smem);
    gbar(bar, ++nb * G);
    phase_attn(p, l, smem);
    gbar(bar, ++nb * G);
    phase_merge_a(p, smem);
    gbar(bar, ++nb * G);
    phase_merge_b(p, smem);
    gbar(bar, ++nb * G);
    phase_out(p, smem);
    gbar(bar, ++nb * G);
    phase_ln(p, l, smem);
    if (l + 1 < DEPTH) gbar(bar, ++nb * G);
  }
}

#if !USE_COOP
__global__ void __launch_bounds__(512, 2) phase_kernel(Params p, int phase, int layer) {
  extern __shared__ __attribute__((aligned(16))) char smem[];
  if (phase == 0) phase_prologue(p, smem);
  else if (phase == 1) phase_proj(p, layer, smem);
  else if (phase == 2) phase_attn(p, layer, smem);
  else if (phase == 3) phase_merge_a(p, smem);
  else if (phase == 4) phase_merge_b(p, smem);
  else if (phase == 5) phase_out(p, smem);
  else phase_ln(p, layer, smem);
}

#endif

extern "C" void kernel_launch(void* const* d_in, const int* in_sizes, int n_in, void* d_out, int out_size, void* d_ws, size_t ws_size, hipStream_t stream) {
  static int grid_blocks = 0;
  if (grid_blocks == 0) {
    if (n_in != 17 || out_size != OUT_TOTAL) { fprintf(stderr, "kernel_launch: unexpected shapes n_in=%d out=%d\n", n_in, out_size); grid_blocks = -1; return; }
    int dev = 0, cus = 0, per_cu = 0;
    hipGetDevice(&dev);
    hipDeviceGetAttribute(&cus, hipDeviceAttributeMultiprocessorCount, dev);
    hipFuncSetAttribute((const void*)mega_kernel, hipFuncAttributeMaxDynamicSharedMemorySize, LDS_BYTES);
#if !USE_COOP
    hipFuncSetAttribute((const void*)phase_kernel, hipFuncAttributeMaxDynamicSharedMemorySize, LDS_BYTES);
#endif
    hipOccupancyMaxActiveBlocksPerMultiprocessor(&per_cu, (const void*)mega_kernel, NTHREADS, LDS_BYTES);
    if (per_cu < 1) per_cu = 1;
    if (per_cu > 1) per_cu = 1;
    grid_blocks = cus * per_cu;
    fprintf(stderr, "kernel_launch: cus=%d per_cu=%d grid=%d ws=%zu\n", cus, per_cu, grid_blocks, ws_size);
  }
  if (grid_blocks < 0) return;
  Params p{};
  p.x_prompt = (const float*)d_in[0]; p.x_sample = (const float*)d_in[1];
  p.c_sb_k = (const float*)d_in[2]; p.c_sb_v = (const float*)d_in[3]; p.c_dsa_k = (const float*)d_in[4]; p.c_dsa_v = (const float*)d_in[5]; p.c_idx_k = (const float*)d_in[6];
  p.ln_in_g = (const float*)d_in[7]; p.ln_in_b = (const float*)d_in[8]; p.w_in = (const float*)d_in[9]; p.b_in = (const float*)d_in[10];
  p.w_pa = (const float*)d_in[11]; p.w_pb = (const float*)d_in[12]; p.w_out = (const float*)d_in[13]; p.ln_g = (const float*)d_in[14]; p.ln_b = (const float*)d_in[15];
  p.rel_bias = (const float*)d_in[16];
  p.out = (float*)d_out;
  char* ws = (char*)d_ws; size_t off = 0;
  auto take = [&](size_t bytes) { char* r = ws + off; off += (bytes + 255) & ~(size_t)255; return r; };
  p.Xb = (bf16_t*)take((size_t)MT * 1024 * 2);
  p.QA = (bf16_t*)take((size_t)MT * 512 * 2);
  p.GA = (bf16_t*)take((size_t)MT * 512 * 2);
  p.GB = (bf16_t*)take((size_t)MT * 512 * 2);
  p.QB = (bf16_t*)take((size_t)MT * 512 * 2);
  p.QI = (bf16_t*)take((size_t)MT * 512 * 2);
  p.KAp = (bf16_t*)take((size_t)MP * 512 * 2);
  p.VATp = (bf16_t*)take((size_t)MP * 512 * 2);
  p.KAs = (bf16_t*)take((size_t)8 * LS * 512 * 2);
  p.VATs = (bf16_t*)take((size_t)8 * LS * 512 * 2);
  p.KBp = (bf16_t*)take((size_t)MP * 64 * 2);
  p.VBTp = (bf16_t*)take((size_t)MP * 64 * 2);
  p.KIp = (bf16_t*)take((size_t)MP * 64 * 2);
  p.KBs = (bf16_t*)take((size_t)8 * LS * 64 * 2);
  p.VBTs = (bf16_t*)take((size_t)8 * LS * 64 * 2);
  p.KIs = (bf16_t*)take((size_t)8 * LS * 64 * 2);
  p.WI = (float*)take((size_t)MT * 8 * 4);
  p.RA = (bf16_t*)take((size_t)MT * 1024 * 2);
  p.RB = (bf16_t*)take((size_t)MT * 1024 * 2);
  p.WinT = (bf16_t*)take((size_t)D_INP * 1024 * 2);
  p.WpaT = (bf16_t*)take((size_t)1024 * 512 * 2);
  p.WpbT = (bf16_t*)take((size_t)1024 * 512 * 2);
  p.WoutT = (bf16_t*)take((size_t)1024 * 1024 * 2);
  p.btab = (unsigned char*)take(4096);
  p.ctr = (int*)take(256);
  if ((size_t)((char*)p.QA - ws) != OFF_QA || (size_t)((char*)p.GA - ws) != OFF_GA || (size_t)((char*)p.GB - ws) != OFF_GB || (size_t)((char*)p.QB - ws) != OFF_QB ||
      (size_t)((char*)p.QI - ws) != OFF_QI || (size_t)((char*)p.RA - ws) != OFF_RA || (size_t)((char*)p.RB - ws) != OFF_RB) { fprintf(stderr, "kernel_launch: workspace offset mismatch\n"); return; }
  if (off > ws_size) { fprintf(stderr, "kernel_launch: workspace too small: need %zu have %zu\n", off, ws_size); return; }
#if USE_COOP
  void* args[] = {&p};
  hipError_t e = hipLaunchCooperativeKernel((const void*)mega_kernel, dim3(grid_blocks), dim3(NTHREADS), args, LDS_BYTES, stream);
  if (e != hipSuccess) fprintf(stderr, "cooperative launch failed: %s (grid %d)\n", hipGetErrorString(e), grid_blocks);
#else
  hipLaunchKernelGGL(phase_kernel, dim3(grid_blocks), dim3(NTHREADS), LDS_BYTES, stream, p, 0, 0);
  for (int l = 0; l < DEPTH; ++l)
    for (int ph = 1; ph <= 6; ++ph) hipLaunchKernelGGL(phase_kernel, dim3(grid_blocks), dim3(NTHREADS), LDS_BYTES, stream, p, ph, l);
#endif
}
```

```cpp
#include <hip/hip_runtime.h>
#include <hip/hip_cooperative_groups.h>
#include <cstdio>
#include <type_traits>
namespace cg = cooperative_groups;

#ifndef USE_COOP
#define USE_COOP 1
#endif

#define DI __device__ __forceinline__
typedef unsigned short bf16_t;
using bf16x8 = __attribute__((ext_vector_type(8))) short;
using bf16x4 = __attribute__((ext_vector_type(4))) short;
using f32x4  = __attribute__((ext_vector_type(4))) float;

constexpr int D_MODEL = 1024, BATCH = 32, SEQ = 2048, DEPTH = 4, DEC_BATCH = 8, DEC_SEQ = 64, PAST = 1024, LS = 1088;
constexpr int MP = BATCH * SEQ;
constexpr int MS = DEC_BATCH * DEC_SEQ;
constexpr int MT = MP + MS;
constexpr int D_IN = 5832, D_INP = 5888;
constexpr float LN_EPS = 1e-5f;
constexpr float ALPHA = 1.681792830507429f;
constexpr float SB_SCALE = 0.125f, ATT_SCALE = 0.125f;
constexpr int NTHREADS = 512, NWAVES = 8;
constexpr int LDS_S = 0, LDS_BM = 131072, LDS_BTAB = 139264, LDS_RB = 143360, LDS_SLOT = 144384, LDS_KI = 144448, LDS_BYTES = 162880;

constexpr size_t O_Y = 0, O_KAP = 67633152, O_VAP = 201850880, O_KBP = 336068608, O_VBP = 352845824, O_KIP = 369623040,
                 O_KAS = 386400256, O_VAS = 387448832, O_KBS = 388497408, O_VBS = 388628480, O_KIS = 388759552;
constexpr int OUT_TOTAL = 388890624;

struct Params {
  const float* x_prompt; const float* x_sample;
  const float* c_sb_k; const float* c_sb_v; const float* c_dsa_k; const float* c_dsa_v; const float* c_idx_k;
  const float* ln_in_g; const float* ln_in_b; const float* w_in; const float* b_in; const float* w_pa; const float* w_pb;
  const float* w_out; const float* ln_g; const float* ln_b; const float* rel_bias;
  float* out;
  bf16_t* Xb; bf16_t* QA; bf16_t* GA; bf16_t* GB; bf16_t* QB; bf16_t* QI;
  bf16_t* KAp; bf16_t* VATp; bf16_t* KAs; bf16_t* VATs;
  bf16_t* KBp; bf16_t* VBTp; bf16_t* KIp; bf16_t* KBs; bf16_t* VBTs; bf16_t* KIs;
  float* WI; bf16_t* RA; bf16_t* RB;
  bf16_t* WinT; bf16_t* WpaT; bf16_t* WpbT; bf16_t* WoutT;
  unsigned char* btab; int* ctr;
};

DI unsigned short f2bf(float x) { unsigned u = __float_as_uint(x); u += 0x7fffu + ((u >> 16) & 1u); return (unsigned short)(u >> 16); }
DI float bf2f(short h) { return __uint_as_float(((unsigned)(unsigned short)h) << 16); }
typedef __bf16 hbf16x2 __attribute__((ext_vector_type(2)));
typedef float f32x2v __attribute__((ext_vector_type(2)));
typedef unsigned u32x2v __attribute__((ext_vector_type(2)));
typedef unsigned u32x4v __attribute__((ext_vector_type(4)));
DI unsigned pk2(float lo, float hi) { f32x2v v; v.x = lo; v.y = hi; return __builtin_bit_cast(unsigned, __builtin_convertvector(v, hbf16x2)); }
DI bf16x4 pack4(float a, float b, float c, float d) { u32x2v u; u.x = pk2(a, b); u.y = pk2(c, d); return __builtin_bit_cast(bf16x4, u); }
DI bf16x8 pack8(const float (&e)[8]) { u32x4v u; u.x = pk2(e[0], e[1]); u.y = pk2(e[2], e[3]); u.z = pk2(e[4], e[5]); u.w = pk2(e[6], e[7]); return __builtin_bit_cast(bf16x8, u); }
DI bf16x8 ld8(const bf16_t* p) { return *reinterpret_cast<const bf16x8*>(p); }
DI bf16x4 ld4(const bf16_t* p) { return *reinterpret_cast<const bf16x4*>(p); }
DI void st4(bf16_t* p, bf16x4 v) { *reinterpret_cast<bf16x4*>(p) = v; }
DI f32x4 mfma16(bf16x8 a, bf16x8 b, f32x4 c) { return __builtin_amdgcn_mfma_f32_16x16x32_bf16(a, b, c, 0, 0, 0); }
DI int otid() { int t = threadIdx.x; asm volatile("" : "+v"(t)); return t; }
DI float sigmoidf_(float x) { return 1.f / (1.f + __expf(-x)); }
struct F2 { float lo, hi; };
DI F2 swap16(float x) { const unsigned u = __float_as_uint(x); auto r = __builtin_amdgcn_permlane16_swap(u, u, false, false); return F2{__uint_as_float(r[0]), __uint_as_float(r[1])}; }
DI F2 swap32(float x) { const unsigned u = __float_as_uint(x); auto r = __builtin_amdgcn_permlane32_swap(u, u, false, false); return F2{__uint_as_float(r[0]), __uint_as_float(r[1])}; }
DI float row_sum16(float x) {
  x += __uint_as_float(__builtin_amdgcn_update_dpp(0, __float_as_uint(x), 0xB1, 0xF, 0xF, true));
  x += __uint_as_float(__builtin_amdgcn_update_dpp(0, __float_as_uint(x), 0x4E, 0xF, 0xF, true));
  x += __uint_as_float(__builtin_amdgcn_update_dpp(0, __float_as_uint(x), 0x141, 0xF, 0xF, true));
  x += __uint_as_float(__builtin_amdgcn_update_dpp(0, __float_as_uint(x), 0x140, 0xF, 0xF, true));
  return x;
}
DI float wave_sum(float x) { x = row_sum16(x); F2 a = swap16(x); x = a.lo + a.hi; F2 b = swap32(x); return b.lo + b.hi; }
DI int hsum32(int x) {
  x += __builtin_amdgcn_update_dpp(0, x, 0xB1, 0xF, 0xF, true);
  x += __builtin_amdgcn_update_dpp(0, x, 0x4E, 0xF, 0xF, true);
  x += __builtin_amdgcn_update_dpp(0, x, 0x141, 0xF, 0xF, true);
  x += __builtin_amdgcn_update_dpp(0, x, 0x140, 0xF, 0xF, true);
  auto r = __builtin_amdgcn_permlane16_swap((unsigned)x, (unsigned)x, false, false);
  return (int)(r[0] + r[1]);
}
DI void gbar(unsigned* ctr, unsigned target) {
  asm volatile("s_waitcnt vmcnt(0)" ::: "memory");
  __syncthreads();
  if (threadIdx.x == 0) {
    __builtin_amdgcn_fence(__ATOMIC_RELEASE, "agent");
    asm volatile("s_waitcnt vmcnt(0)" ::: "memory");
    __hip_atomic_fetch_add(ctr, 1u, __ATOMIC_RELAXED, __HIP_MEMORY_SCOPE_AGENT);
    while (__hip_atomic_load(ctr, __ATOMIC_RELAXED, __HIP_MEMORY_SCOPE_AGENT) < target) __builtin_amdgcn_s_sleep(2);
    __builtin_amdgcn_fence(__ATOMIC_ACQUIRE, "agent");
    asm volatile("s_waitcnt vmcnt(0)" ::: "memory");
  }
  __syncthreads();
}

DI void ln_row_wave(const float* src, const float* g, const float* b, float* d32, bf16_t* db, int lane) {
  float4 v[4]; float s = 0.f;
#pragma unroll
  for (int i = 0; i < 4; ++i) { v[i] = reinterpret_cast<const float4*>(src)[lane + 64 * i]; s += v[i].x + v[i].y + v[i].z + v[i].w; }
  s = wave_sum(s);
  const float mu = s * (1.f / 1024.f);
  float q = 0.f;
#pragma unroll
  for (int i = 0; i < 4; ++i) { float a = v[i].x - mu, bb = v[i].y - mu, c = v[i].z - mu, d = v[i].w - mu; q += a * a + bb * bb + c * c + d * d; }
  q = wave_sum(q);
  const float rstd = rsqrtf(q * (1.f / 1024.f) + LN_EPS);
#pragma unroll
  for (int i = 0; i < 4; ++i) {
    float4 gg = reinterpret_cast<const float4*>(g)[lane + 64 * i], bb = reinterpret_cast<const float4*>(b)[lane + 64 * i];
    float4 o;
    o.x = (v[i].x - mu) * rstd * gg.x + bb.x; o.y = (v[i].y - mu) * rstd * gg.y + bb.y;
    o.z = (v[i].z - mu) * rstd * gg.z + bb.z; o.w = (v[i].w - mu) * rstd * gg.w + bb.w;
    reinterpret_cast<float4*>(d32)[lane + 64 * i] = o;
    st4(db + 4 * (lane + 64 * i), pack4(o.x, o.y, o.z, o.w));
  }
}

DI void tconv_tile(const float* src, int ldsrc, int K, bf16_t* dst, int n0, int k0, bool winmap, float* tile) {
  const int tid = otid();
#pragma unroll
  for (int rr = 0; rr < 8; ++rr) {
    const int kl = rr * 8 + (tid >> 6), nl = tid & 63, np = n0 + nl;
    int n = np; bool ok = true;
    if (winmap) { if (np >= 3840) n = np - 56; else if (np >= 3784) ok = false; }
    tile[kl * 65 + nl] = ok ? src[(size_t)(k0 + kl) * ldsrc + n] : 0.f;
  }
  __syncthreads();
#pragma unroll
  for (int rr = 0; rr < 8; ++rr) {
    const int nl = rr * 8 + (tid >> 6), kl = tid & 63;
    dst[(size_t)(n0 + nl) * K + k0 + kl] = f2bf(tile[kl * 65 + nl]);
  }
  __syncthreads();
}

DI void convert_layer(const Params& p, int l, char* smem) {
  float* tile = reinterpret_cast<float*>(smem);
  const int G = gridDim.x;
  for (int it = blockIdx.x; it < 1984; it += G) {
    if (it < 1472) { int nt = it >> 4, kt = it & 15; tconv_tile(p.w_in + (size_t)l * 1024 * D_IN, D_IN, 1024, p.WinT, nt * 64, kt * 64, true, tile); }
    else if (it < 1600) { int i = it - 1472; int nt = i >> 3, kt = i & 7; tconv_tile(p.w_pa + (size_t)l * 512 * 1024, 1024, 512, p.WpaT, nt * 64, kt * 64, false, tile); }
    else if (it < 1728) { int i = it - 1600; int nt = i >> 3, kt = i & 7; tconv_tile(p.w_pb + (size_t)l * 512 * 1024, 1024, 512, p.WpbT, nt * 64, kt * 64, false, tile); }
    else { int i = it - 1728; int nt = i >> 4, kt = i & 15; tconv_tile(p.w_out + (size_t)l * 1024 * 1024, 1024, 1024, p.WoutT, nt * 64, kt * 64, false, tile); }
  }
  const int gtid = blockIdx.x * NTHREADS + otid(), gn = G * NTHREADS;
#pragma unroll 4
  for (int idx = gtid; idx < 8 * 1024 * 512; idx += gn) {
    int b = idx >> 19, rem = idx & ((1 << 19) - 1);
    p.KAs[(size_t)b * LS * 512 + rem] = f2bf(p.c_sb_k[(size_t)l * 8 * 1024 * 512 + idx]);
  }
#pragma unroll 4
  for (int idx = gtid; idx < 8 * 512 * 1024; idx += gn) {
    int b = idx >> 19, hd = (idx >> 10) & 511, t = idx & 1023;
    p.VATs[((size_t)b * 512 + hd) * LS + t] = f2bf(p.c_sb_v[(((size_t)l * 8 + b) * 1024 + t) * 512 + hd]);
  }
  for (int idx = gtid; idx < 8 * 1024 * 64; idx += gn) {
    int b = idx >> 16, rem = idx & 65535;
    p.KBs[(size_t)b * LS * 64 + rem] = f2bf(p.c_dsa_k[(size_t)l * 8 * 65536 + idx]);
    p.KIs[(size_t)b * LS * 64 + rem] = f2bf(p.c_idx_k[(size_t)l * 8 * 65536 + idx]);
    int d = (idx >> 10) & 63, t = idx & 1023;
    p.VBTs[((size_t)b * 64 + d) * LS + t] = f2bf(p.c_dsa_v[(((size_t)l * 8 + b) * 1024 + t) * 64 + d]);
  }
}

DI void phase_prologue(const Params& p, char* smem) {
  const int tid = otid(), lane = tid & 63;
  if (blockIdx.x == 0 && tid < 16) p.ctr[tid] = 0;
  for (int i = blockIdx.x * NTHREADS + tid; i < 4096; i += gridDim.x * NTHREADS) {
    int rel = i - 2047; int n = rel < 0 ? -rel : rel;
    float nf = (float)(n > 1 ? n : 1);
    int large = 8 + (int)(logf(nf / 8.f) / 2.7725887f * 8.f);
    large = large < 15 ? large : 15;
    int bk = (rel > 0 ? 16 : 0) + (n < 8 ? n : large);
    p.btab[i] = (unsigned char)bk;
  }
  for (int row = blockIdx.x * NWAVES + (tid >> 6); row < MT; row += gridDim.x * NWAVES) {
    const float* src = row < MP ? p.x_prompt + (size_t)row * 1024 : p.x_sample + (size_t)(row - MP) * 1024;
    ln_row_wave(src, p.ln_in_g, p.ln_in_b, p.out + (size_t)row * 1024, p.Xb + (size_t)row * 1024, lane);
  }
  convert_layer(p, 0, smem);
}


namespace pg8 {
#define PG8_LAS __attribute__((address_space(3)))
constexpr int BM = 256, BK = 64, HALF = 128, HTB = HALF * BK * 2, STAGE_BYTES = 8 * HTB, NXCD = 8, WGM = 8;
DI int lds_byte(int r, int c) { const int st = (r >> 4) * 2 + (c >> 5), rr = r & 15, cc = c & 31, ob = rr * 64 + cc * 2; return st * 1024 + (ob ^ (((ob >> 9) & 1) << 5)); }
DI void stage_rc(int b, int& R, int& C) { const int st = b / 1024, sb = b % 1024, swz = sb ^ (((sb >> 9) & 1) << 5); R = (st >> 1) * 16 + swz / 64; C = (st & 1) * 32 + (swz % 64) / 2; }
DI int perm32(int rho) { const int n = rho >> 4, i = rho & 15; return 8 * (i >> 2) + 4 * n + (i & 3); }
struct Unit { int pm, pn; };
struct Gemm { const bf16_t* A; const bf16_t* Bt; int M, N, K; };
struct StaticOrder {
    int nM, nN, nwg, G, c;
    DI void init(int M, int N, int G_, int c_) { nM = M / BM; nN = N / BM; nwg = nM * nN; G = G_; c = c_; }
    DI bool next(int i, Unit& u) const {
        const long L = (long)i * G + c; if (L >= nwg) return false;
        int wgid = (int)L; { const int q = nwg / NXCD, r = nwg % NXCD, xcd = wgid % NXCD, off = wgid / NXCD; wgid = (xcd < r ? xcd * (q + 1) : r * (q + 1) + (xcd - r) * q) + off; }
        const int nig = WGM * nN, gid = wgid / nig, fm = gid * WGM, gsz = (nM - fm) < WGM ? (nM - fm) : WGM;
        u.pm = fm + ((wgid % nig) % gsz); u.pn = (wgid % nig) / gsz; return true;
    }
    DI void a_ready(const Unit&) const {}
    DI void done(const Unit&) const {}
};
template <class Epi, class Sched>
__device__ __forceinline__ void gemm_phase(PG8_LAS unsigned char* lds, const Gemm g, const Sched& S, const Epi& E) {
    const int tid = otid(), wid = __builtin_amdgcn_readfirstlane(tid >> 6), lane = tid & 63, wr = wid >> 2, wc = wid & 3, fr = lane & 15, fq = lane >> 4;
    const int K = g.K, nt = K / BK;
    unsigned voffA[2], voffB[2];
#pragma unroll
    for (int i = 0; i < 2; ++i) { int R, C; stage_rc(tid * 16 + i * 8192, R, C); const int Rb = Epi::PERM ? ((R & ~31) + perm32(R & 31)) : R;
        voffA[i] = (unsigned)(R * K + C) * 2u; voffB[i] = (unsigned)(Rb * K + C) * 2u; }
    const size_t kstep = (size_t)(BK * 2);
    const size_t hstep = (size_t)HALF * K * 2;
    const size_t tstep = 2 * hstep;
    const unsigned ldsw = (unsigned)wid * 1024u;
    const int aoff = lds_byte(wr * 64 + fr, fq * 8), boff = lds_byte(wc * 32 + fr, fq * 8);
#define PG8_SA(b, h) (((b) * 2 + (h)) * HTB)
#define PG8_SB(b, h) ((4 + (b) * 2 + (h)) * HTB)
#define PG8_STAGE(bufoff, gbase, voff) do { _Pragma("unroll") for (int _i = 0; _i < 2; ++_i) \
        __builtin_amdgcn_global_load_lds((const unsigned*)((const char*)(gbase) + (voff)[_i]), (PG8_LAS unsigned*)(lds + (bufoff) + ldsw + _i * 8192), 16, 0, 0); } while (0)
#define PG8_LDA(dst, b, h) do { _Pragma("unroll") for (int m = 0; m < 4; ++m) _Pragma("unroll") for (int k = 0; k < 2; ++k) dst[m][k] = *(const PG8_LAS bf16x8*)(lds + PG8_SA(b, h) + aoff + m * 2048 + k * 1024); } while (0)
#define PG8_LDB(dst, b, h) do { _Pragma("unroll") for (int n = 0; n < 2; ++n) _Pragma("unroll") for (int k = 0; k < 2; ++k) dst[n][k] = *(const PG8_LAS bf16x8*)(lds + PG8_SB(b, h) + boff + n * 2048 + k * 1024); } while (0)
#define PG8_MMA(ai, bj, At, Bt) do { __builtin_amdgcn_s_setprio(1); _Pragma("unroll") for (int m = 0; m < 4; ++m) _Pragma("unroll") for (int n = 0; n < 2; ++n) _Pragma("unroll") for (int k = 0; k < 2; ++k) \
        acc[ai][bj][m][n] = __builtin_amdgcn_mfma_f32_16x16x32_bf16(Bt[n][k], At[m][k], acc[ai][bj][m][n], 0, 0, 0); __builtin_amdgcn_s_setprio(0); } while (0)
#define PG8_WAIT_V(n) asm volatile("s_waitcnt vmcnt(" #n ")" ::: "memory")
#define PG8_WAIT_L(n) asm volatile("s_waitcnt lgkmcnt(" #n ")" ::: "memory")
#define PG8_BAR __builtin_amdgcn_s_barrier()
#define PG8_SCHED __builtin_amdgcn_sched_barrier(0)
    Unit cur, nxt; int ui = 0;
    if (!S.next(0, cur)) return;
    f32x4 acc[2][2][4][2];
#pragma unroll
    for (int a = 0; a < 2; ++a)
#pragma unroll
        for (int b = 0; b < 2; ++b)
#pragma unroll
            for (int m = 0; m < 4; ++m)
#pragma unroll
                for (int n = 0; n < 2; ++n) acc[a][b][m][n] = (f32x4){0.f, 0.f, 0.f, 0.f};
    bf16x8 At[4][2], B0[2][2], B1[2][2];
    const char* cA = (const char*)g.A + (size_t)cur.pm * tstep; const char* cB = (const char*)g.Bt + (size_t)cur.pn * tstep;
    S.a_ready(cur);
    PG8_STAGE(PG8_SB(0, 0), cB, voffB); PG8_STAGE(PG8_SA(0, 0), cA, voffA); PG8_STAGE(PG8_SB(0, 1), cB + hstep, voffB); PG8_STAGE(PG8_SA(0, 1), cA + hstep, voffA);
    if (wr == 1) PG8_BAR;
    PG8_WAIT_V(4); PG8_BAR;
    PG8_STAGE(PG8_SB(1, 0), cB + kstep, voffB); PG8_STAGE(PG8_SA(1, 0), cA + kstep, voffA); PG8_STAGE(PG8_SB(1, 1), cB + hstep + kstep, voffB);
    PG8_WAIT_V(6); PG8_BAR;
    for (;;) {
        const bool has_next = S.next(ui + 1, nxt);
        const char* nA = has_next ? (const char*)g.A + (size_t)nxt.pm * tstep : cA; const char* nB = has_next ? (const char*)g.Bt + (size_t)nxt.pn * tstep : cB;
        for (int t = 0; t < nt; t += 2) {
            const bool last = (t == nt - 2);
            const char* a1 = cA + (size_t)(t + 1) * kstep;
            const char* a2 = last ? nA : cA + (size_t)(t + 2) * kstep; const char* b2 = last ? nB : cB + (size_t)(t + 2) * kstep;
            const char* a3 = a2 + kstep; const char* b3 = b2 + kstep;
            if (last && has_next) S.a_ready(nxt);
            PG8_LDB(B0, 0, 0); PG8_SCHED; PG8_LDA(At, 0, 0); PG8_STAGE(PG8_SA(1, 1), a1 + hstep, voffA);
            PG8_WAIT_L(8); PG8_BAR; PG8_WAIT_L(0); PG8_MMA(0, 0, At, B0); PG8_BAR; PG8_SCHED;
            PG8_LDB(B1, 0, 1); PG8_STAGE(PG8_SB(0, 0), b2, voffB);
            PG8_BAR; PG8_WAIT_L(0); PG8_MMA(0, 1, At, B1); PG8_BAR;
            PG8_LDA(At, 0, 1); PG8_STAGE(PG8_SA(0, 0), a2, voffA);
            PG8_BAR; PG8_WAIT_L(0); PG8_MMA(1, 0, At, B0); PG8_BAR; PG8_SCHED;
            PG8_STAGE(PG8_SB(0, 1), b2 + hstep, voffB);
            PG8_WAIT_V(6); PG8_BAR; PG8_MMA(1, 1, At, B1); PG8_BAR;
            PG8_LDB(B0, 1, 0); PG8_SCHED; PG8_LDA(At, 1, 0); PG8_STAGE(PG8_SA(0, 1), a2 + hstep, voffA);
            PG8_WAIT_L(8); PG8_BAR; PG8_WAIT_L(0); PG8_MMA(0, 0, At, B0); PG8_BAR; PG8_SCHED;
            PG8_LDB(B1, 1, 1); PG8_STAGE(PG8_SB(1, 0), b3, voffB);
            PG8_BAR; PG8_WAIT_L(0); PG8_MMA(0, 1, At, B1); PG8_BAR;
            PG8_LDA(At, 1, 1); PG8_STAGE(PG8_SA(1, 0), a3, voffA);
            PG8_BAR; PG8_WAIT_L(0); PG8_MMA(1, 0, At, B0); PG8_BAR; PG8_SCHED;
            PG8_STAGE(PG8_SB(1, 1), b3 + hstep, voffB);
            PG8_WAIT_V(6); PG8_BAR; PG8_MMA(1, 1, At, B1); PG8_BAR;
        }
        if constexpr (!Epi::AFTER_DRAIN) { E(acc, cur, wr, wc, fr, fq); S.done(cur); }
        if (!has_next) break;
#pragma unroll
        for (int a = 0; a < 2; ++a)
#pragma unroll
            for (int b = 0; b < 2; ++b)
#pragma unroll
                for (int m = 0; m < 4; ++m)
#pragma unroll
                    for (int n = 0; n < 2; ++n) acc[a][b][m][n] = (f32x4){0.f, 0.f, 0.f, 0.f};
        cur = nxt; cA = nA; cB = nB; ++ui;
    }
    PG8_WAIT_V(0);
    if (wr == 0) PG8_BAR;
    PG8_BAR;
    if constexpr (Epi::AFTER_DRAIN) { E.fused(acc, cur, wr, wc, fr, fq, lds, wid, lane); S.done(cur); }
#undef PG8_SA
#undef PG8_SB
#undef PG8_STAGE
#undef PG8_LDA
#undef PG8_LDB
#undef PG8_MMA
#undef PG8_WAIT_V
#undef PG8_WAIT_L
#undef PG8_BAR
#undef PG8_SCHED
}
}

DI bf16x4 pack4v(const f32x4 v) { return pack4(v[0], v[1], v[2], v[3]); }

constexpr size_t al256(size_t x) { return (x + 255) & ~(size_t)255; }
constexpr size_t OFF_XB = 0;
constexpr size_t OFF_QA = OFF_XB + al256((size_t)MT * 1024 * 2);
constexpr size_t OFF_GA = OFF_QA + al256((size_t)MT * 512 * 2);
constexpr size_t OFF_GB = OFF_GA + al256((size_t)MT * 512 * 2);
constexpr size_t OFF_QB = OFF_GB + al256((size_t)MT * 512 * 2);
constexpr size_t OFF_QI = OFF_QB + al256((size_t)MT * 512 * 2);
constexpr size_t OFF_KAP = OFF_QI + al256((size_t)MT * 512 * 2);
constexpr size_t OFF_VATP = OFF_KAP + al256((size_t)MP * 512 * 2);
constexpr size_t OFF_KAS = OFF_VATP + al256((size_t)MP * 512 * 2);
constexpr size_t OFF_VATS = OFF_KAS + al256((size_t)8 * LS * 512 * 2);
constexpr size_t OFF_KBP = OFF_VATS + al256((size_t)8 * LS * 512 * 2);
constexpr size_t OFF_VBTP = OFF_KBP + al256((size_t)MP * 64 * 2);
constexpr size_t OFF_KIP = OFF_VBTP + al256((size_t)MP * 64 * 2);
constexpr size_t OFF_KBS = OFF_KIP + al256((size_t)MP * 64 * 2);
constexpr size_t OFF_VBTS = OFF_KBS + al256((size_t)8 * LS * 64 * 2);
constexpr size_t OFF_KIS = OFF_VBTS + al256((size_t)8 * LS * 64 * 2);
constexpr size_t OFF_WI = OFF_KIS + al256((size_t)8 * LS * 64 * 2);
constexpr size_t OFF_RA = OFF_WI + al256((size_t)MT * 8 * 4);
constexpr size_t OFF_RB = OFF_RA + al256((size_t)MT * 1024 * 2);

struct EpiProj {
  static constexpr bool PERM = false, AFTER_DRAIN = false;
  const Params& p; int layer;
  template <int GRP>
  DI void run(const f32x4 (&acc)[2][2][4][2], const pg8::Unit& u, int wr, int wc, int fr, int fq) const {
    constexpr int T = GRP ? LS : SEQ;
    const float* bin = p.b_in + (size_t)layer * D_IN;
    char* ws = reinterpret_cast<char*>(p.Xb);
#pragma unroll
    for (int bj = 0; bj < 2; ++bj) {
      const int nt = 2 * u.pn + bj;
      f32x4 bias[2];
#pragma unroll
      for (int n = 0; n < 2; ++n) {
        const int np = nt * 128 + 32 * wc + 16 * n + 4 * fq;
        bias[n] = f32x4{0.f, 0.f, 0.f, 0.f};
        if (np < 3784) bias[n] = *reinterpret_cast<const f32x4*>(bin + np);
        else if (np >= 3840) bias[n] = *reinterpret_cast<const f32x4*>(bin + np - 56);
      }
      const bool simple = (nt < 4) || (nt >= 12 && nt < 20) || (nt >= 21 && nt < 29) || (nt >= 30);
      if (simple) {
        size_t off; int ld, c0, act;
        if (nt < 4) { off = OFF_QA; ld = 512; c0 = nt * 128; act = 0; }
        else if (nt < 16) { off = OFF_GA; ld = 512; c0 = (nt - 12) * 128; act = 1; }
        else if (nt < 20) { off = OFF_QB; ld = 512; c0 = (nt - 16) * 128; act = 0; }
        else if (nt < 25) { off = OFF_GB; ld = 512; c0 = (nt - 21) * 128; act = 1; }
        else if (nt < 29) { off = OFF_QI; ld = 512; c0 = (nt - 25) * 128; act = 0; }
        else if (nt < 38) { off = OFF_RA; ld = 1024; c0 = (nt - 30) * 128; act = 2; }
        else { off = OFF_RB; ld = 1024; c0 = (nt - 38) * 128; act = 2; }
        bf16_t* dst = reinterpret_cast<bf16_t*>(ws + off) + c0 + 32 * wc + 4 * fq;
#pragma unroll
        for (int ai = 0; ai < 2; ++ai)
#pragma unroll
          for (int m = 0; m < 4; ++m) {
            int row = u.pm * 256 + 128 * ai + 64 * wr + 16 * m + fr;
            asm volatile("" : "+v"(row));
            bf16_t* rp = dst + (size_t)row * ld;
#pragma unroll
            for (int n = 0; n < 2; ++n) {
              f32x4 v = acc[ai][bj][m][n] + bias[n];
              if (act != 0) {
#pragma unroll
                for (int j = 0; j < 4; ++j) { const float sg = sigmoidf_(v[j]); v[j] = (act == 1) ? v[j] * sg : sg; }
              }
              st4(rp + 16 * n, pack4v(v));
            }
          }
      } else {
#pragma unroll
        for (int ai = 0; ai < 2; ++ai)
#pragma unroll
          for (int m = 0; m < 4; ++m) {
            int row = u.pm * 256 + 128 * ai + 64 * wr + 16 * m + fr;
            asm volatile("" : "+v"(row));
            int bb, tt;
            if (!GRP) { bb = row >> 11; tt = row & 2047; } else { const int ms = row - MP; bb = ms >> 6; tt = PAST + (ms & 63); }
            const size_t orow = GRP ? (size_t)layer * MS + (row - MP) : (size_t)layer * MP + row;
#pragma unroll
            for (int n = 0; n < 2; ++n) {
              int ct = 32 * wc + 16 * n + 4 * fq;
              asm volatile("" : "+v"(ct));
              const f32x4 v = acc[ai][bj][m][n] + bias[n];
              if (nt < 8) {
                const int c = (nt - 4) * 128 + ct;
                *reinterpret_cast<f32x4*>(p.out + (GRP ? O_KAS : O_KAP) + orow * 512 + c) = v;
                bf16_t* kd = GRP ? p.KAs + ((size_t)bb * LS + tt) * 512 + c : p.KAp + (size_t)row * 512 + c;
                st4(kd, pack4v(v));
              } else if (nt < 12) {
                const int c = (nt - 8) * 128 + ct;
                *reinterpret_cast<f32x4*>(p.out + (GRP ? O_VAS : O_VAP) + orow * 512 + c) = v;
                bf16_t* vd = (GRP ? p.VATs : p.VATp) + ((size_t)bb * 512 + c) * T + tt;
                vd[0] = f2bf(v[0]); vd[T] = f2bf(v[1]); vd[2 * T] = f2bf(v[2]); vd[3 * T] = f2bf(v[3]);
              } else if (nt == 20) {
                if (wc < 2) {
                  *reinterpret_cast<f32x4*>(p.out + (GRP ? O_KBS : O_KBP) + orow * 64 + ct) = v;
                  st4((GRP ? p.KBs : p.KBp) + ((size_t)bb * T + tt) * 64 + ct, pack4v(v));
                } else {
                  const int c = ct - 64;
                  *reinterpret_cast<f32x4*>(p.out + (GRP ? O_VBS : O_VBP) + orow * 64 + c) = v;
                  bf16_t* vd = (GRP ? p.VBTs : p.VBTp) + ((size_t)bb * 64 + c) * T + tt;
                  vd[0] = f2bf(v[0]); vd[T] = f2bf(v[1]); vd[2 * T] = f2bf(v[2]); vd[3 * T] = f2bf(v[3]);
                }
              } else {
                if (wc < 2) {
                  *reinterpret_cast<f32x4*>(p.out + (GRP ? O_KIS : O_KIP) + orow * 64 + ct) = v;
                  st4((GRP ? p.KIs : p.KIp) + ((size_t)bb * T + tt) * 64 + ct, pack4v(v));
                } else if (ct < 72) {
                  *reinterpret_cast<f32x4*>(p.WI + (size_t)row * 8 + (ct - 64)) = v;
                }
              }
            }
          }
      }
    }
  }
  DI void operator()(const f32x4 (&acc)[2][2][4][2], const pg8::Unit& u, int wr, int wc, int fr, int fq) const {
    if (u.pm < MP / 256) run<0>(acc, u, wr, wc, fr, fq); else run<1>(acc, u, wr, wc, fr, fq);
  }
};

template <int MODE>
struct EpiTail {
  static constexpr bool PERM = false, AFTER_DRAIN = false;
  const Params& p;
  DI void operator()(const f32x4 (&acc)[2][2][4][2], const pg8::Unit& u, int wr, int wc, int fr, int fq) const {
    bf16_t* MERGED = p.GA;
#pragma unroll
    for (int ai = 0; ai < 2; ++ai)
#pragma unroll
      for (int m = 0; m < 4; ++m) {
        const int row = u.pm * 256 + 128 * ai + 64 * wr + 16 * m + fr;
#pragma unroll
        for (int bj = 0; bj < 2; ++bj)
#pragma unroll
          for (int n = 0; n < 2; ++n) {
            const size_t idx = (size_t)row * 1024 + u.pn * 256 + 128 * bj + 32 * wc + 16 * n + 4 * fq;
            const f32x4 a = acc[ai][bj][m][n];
            if (MODE == 0) {
              const bf16x4 g = ld4(p.RA + idx);
              st4(MERGED + idx, pack4(bf2f(g[0]) * a[0], bf2f(g[1]) * a[1], bf2f(g[2]) * a[2], bf2f(g[3]) * a[3]));
            } else if (MODE == 1) {
              const bf16x4 g = ld4(p.RB + idx); const bf16x4 o = ld4(MERGED + idx);
              st4(MERGED + idx, pack4(bf2f(o[0]) + bf2f(g[0]) * a[0], bf2f(o[1]) + bf2f(g[1]) * a[1], bf2f(o[2]) + bf2f(g[2]) * a[2], bf2f(o[3]) + bf2f(g[3]) * a[3]));
            } else {
              f32x4 x = *reinterpret_cast<const f32x4*>(p.out + idx);
              x = x * ALPHA + a;
              *reinterpret_cast<f32x4*>(p.out + idx) = x;
            }
          }
      }
  }
};

DI void phase_proj(const Params& p, int layer, char* smem) {
  pg8::Gemm g{p.Xb, p.WinT, MT, D_INP, 1024};
  pg8::StaticOrder S; S.init(MT, D_INP, gridDim.x, blockIdx.x);
  EpiProj E{p, layer};
  pg8::gemm_phase<EpiProj, pg8::StaticOrder>((PG8_LAS unsigned char*)smem, g, S, E);
}
DI void phase_merge_a(const Params& p, char* smem) {
  pg8::Gemm g{p.QA, p.WpaT, MT, 1024, 512};
  pg8::StaticOrder S; S.init(MT, 1024, gridDim.x, blockIdx.x);
  EpiTail<0> E{p};
  pg8::gemm_phase<EpiTail<0>, pg8::StaticOrder>((PG8_LAS unsigned char*)smem, g, S, E);
}
DI void phase_merge_b(const Params& p, char* smem) {
  pg8::Gemm g{p.QB, p.WpbT, MT, 1024, 512};
  pg8::StaticOrder S; S.init(MT, 1024, gridDim.x, blockIdx.x);
  EpiTail<1> E{p};
  pg8::gemm_phase<EpiTail<1>, pg8::StaticOrder>((PG8_LAS unsigned char*)smem, g, S, E);
}
DI void phase_out(const Params& p, char* smem) {
  pg8::Gemm g{p.GA, p.WoutT, MT, 1024, 1024};
  pg8::StaticOrder S; S.init(MT, 1024, gridDim.x, blockIdx.x);
  EpiTail<2> E{p};
  pg8::gemm_phase<EpiTail<2>, pg8::StaticOrder>((PG8_LAS unsigned char*)smem, g, S, E);
}

template <int grp>
DI void sb_item(const Params& p, int b, int h, int t0) {
  const int tid = otid(), w = tid >> 6, lane = tid & 63, c = lane & 15, q4 = lane >> 4;
  const int T = grp ? LS : SEQ;
  const int qpos0 = grp ? PAST + t0 : t0;
  const int m0 = grp ? MP + b * DEC_SEQ + t0 : b * SEQ + t0;
  const bf16_t* Kb = (grp ? p.KAs : p.KAp) + (size_t)b * T * 512 + h * 64;
  const bf16_t* VTb = (grp ? p.VATs : p.VATp) + (size_t)(b * 8 + h) * 64 * T;
  const bf16_t* qp = p.QA + (size_t)(m0 + c) * 512 + h * 64 + q4 * 8;
  const bf16x8 qf0 = ld8(qp), qf1 = ld8(qp + 32);
  const int qpos = qpos0 + c;
  float R = 0.f;
  f32x4 O[4];
#pragma unroll
  for (int dt = 0; dt < 4; ++dt) O[dt] = f32x4{0.f, 0.f, 0.f, 0.f};
  bf16x8 kfA[2][2], vfA[4], kfB[2][2], vfB[4];
  auto loadkv = [&](int kb, bf16x8 (&kf)[2][2], bf16x8 (&vf)[4]) {
    const int s0 = kb * 32;
#pragma unroll
    for (int kt = 0; kt < 2; ++kt) { const bf16_t* kp = Kb + (size_t)(s0 + 16 * kt + c) * 512 + q4 * 8; kf[kt][0] = ld8(kp); kf[kt][1] = ld8(kp + 32); }
#pragma unroll
    for (int dt = 0; dt < 4; ++dt) {
      const bf16_t* vp = VTb + (size_t)(16 * dt + c) * T + s0 + 4 * q4;
      bf16x4 lo = ld4(vp), hi = ld4(vp + 16);
      vf[dt] = __builtin_shufflevector(lo, hi, 0, 1, 2, 3, 4, 5, 6, 7);
    }
  };
  auto comp = [&](int kb, const bf16x8 (&kf)[2][2], const bf16x8 (&vf)[4]) -> bool {
    const int s0 = kb * 32;
    f32x4 z[2];
#pragma unroll
    for (int kt = 0; kt < 2; ++kt) {
      z[kt] = mfma16(kf[kt][0], qf0, f32x4{0.f, 0.f, 0.f, 0.f});
      z[kt] = mfma16(kf[kt][1], qf1, z[kt]);
    }
    float lk[2][4], ls[2][4]; bool bf[2][4];
#pragma unroll
    for (int kt = 0; kt < 2; ++kt)
#pragma unroll
      for (int r = 0; r < 4; ++r) {
        const int key = s0 + 16 * kt + 4 * q4 + r;
        const bool before = key < qpos;
        const float zz = z[kt][r] * SB_SCALE;
        const float sp = fmaxf(zz, 0.f) + __logf(1.f + __expf(-fabsf(zz)));
        bf[kt][r] = before; lk[kt][r] = before ? -sp : 0.f; ls[kt][r] = zz - sp;
      }
    const float T1 = (lk[1][0] + lk[1][1]) + (lk[1][2] + lk[1][3]);
    const float T0 = (lk[0][0] + lk[0][1]) + (lk[0][2] + lk[0][3]);
    const F2 x1 = swap16(T1), x0 = swap16(T0);
    const float p1 = x1.lo + x1.hi, p0 = x0.lo + x0.hi;
    const F2 y1 = swap32(p1), y0 = swap32(p0);
    const float H1 = ((q4 & 1) ? 0.f : x1.hi) + ((q4 & 2) ? 0.f : y1.hi);
    const float H0 = ((q4 & 1) ? 0.f : x0.hi) + ((q4 & 2) ? 0.f : y0.hi);
    const float TT1 = y1.lo + y1.hi, TT0 = y0.lo + y0.hi;
    float a[2][4];
    { float ac = R + H1;
#pragma unroll
      for (int r = 3; r >= 0; --r) { a[1][r] = bf[1][r] ? __expf(ls[1][r] + ac) : 0.f; ac += lk[1][r]; } }
    { float ac = R + TT1 + H0;
#pragma unroll
      for (int r = 3; r >= 0; --r) { a[0][r] = bf[0][r] ? __expf(ls[0][r] + ac) : 0.f; ac += lk[0][r]; } }
    R = R + TT1 + TT0;
    const float ae[8] = {a[0][0], a[0][1], a[0][2], a[0][3], a[1][0], a[1][1], a[1][2], a[1][3]};
    const bf16x8 pf = pack8(ae);
#pragma unroll
    for (int dt = 0; dt < 4; ++dt) O[dt] = mfma16(vf[dt], pf, O[dt]);
    return __ballot(R > -50.f) == 0ull;
  };
  {
    int kb = (qpos0 + 14) >> 5;
    loadkv(kb, kfA, vfA);
    while (true) {
      if (kb >= 1) loadkv(kb - 1, kfB, vfB);
      if (comp(kb, kfA, vfA) || kb == 0) break;
      --kb;
      if (kb >= 1) loadkv(kb - 1, kfA, vfA);
      if (comp(kb, kfB, vfB) || kb == 0) break;
      --kb;
    }
  }
#pragma unroll
  for (int dt = 0; dt < 4; ++dt) {
    const size_t off = (size_t)(m0 + c) * 512 + h * 64 + dt * 16 + 4 * q4;
    const bf16x4 g = ld4(p.GA + off);
    st4(p.QA + off, pack4(O[dt][0] * bf2f(g[0]), O[dt][1] * bf2f(g[1]), O[dt][2] * bf2f(g[2]), O[dt][3] * bf2f(g[3])));
  }
}

template <int NK>
DI void topk_round(const float* Sh, int n_adm, int half, int l32, unsigned* bmrow) {
  unsigned key[NK];
#pragma unroll
  for (int i = 0; i < NK; ++i) {
    const int s = 32 * i + l32;
    const unsigned u = __float_as_uint(Sh[s]);
    const unsigned k = (u & 0x80000000u) ? ~u : (u | 0x80000000u);
    key[i] = (s < n_adm) ? k : 0u;
  }
  unsigned tau = 1u; int need = 0; bool done = true;
  if (n_adm > 256) {
    tau = 0u; done = false;
    for (int bit = 31; bit >= 0; --bit) {
      const unsigned cand = tau | (1u << bit);
      int cnt = 0;
#pragma unroll
      for (int i = 0; i < NK; ++i) cnt += (key[i] >= cand) ? 1 : 0;
      cnt = hsum32(cnt);
      if (!done && cnt >= 256) tau = cand;
      if (cnt == 256) done = true;
      if (__ballot(!done) == 0ull) break;
    }
  }
  unsigned w0 = 0u, w1 = 0u;
  if (__ballot(!done) == 0ull) {
#pragma unroll
    for (int i = 0; i < NK; ++i) {
      const unsigned long long msel = __ballot(key[i] >= tau);
      const unsigned wsel = half ? (unsigned)(msel >> 32) : (unsigned)msel;
      if (i < 32) { if (l32 == i) w0 = wsel; } else { if (l32 == i - 32) w1 = wsel; }
    }
  } else {
    int cgt = 0;
#pragma unroll
    for (int i = 0; i < NK; ++i) cgt += (key[i] > tau) ? 1 : 0;
    cgt = hsum32(cgt);
    need = 256 - cgt;
    int Rk = 0; const unsigned below = (1u << l32) - 1u;
#pragma unroll
    for (int i = 0; i < NK; ++i) {
      const bool eq = key[i] == tau, gt = key[i] > tau;
      const unsigned long long me = __ballot(eq);
      const unsigned hm = half ? (unsigned)(me >> 32) : (unsigned)me;
      const int rank = Rk + __popc(hm & below);
      const bool sel = done ? (key[i] >= tau) : (gt || (eq && rank < need));
      Rk += __popc(hm);
      const unsigned long long msel = __ballot(sel);
      const unsigned wsel = half ? (unsigned)(msel >> 32) : (unsigned)msel;
      if (i < 32) { if (l32 == i) w0 = wsel; } else { if (l32 == i - 32) w1 = wsel; }
    }
  }
  bmrow[l32] = w0;
  if (NK > 32) bmrow[32 + l32] = w1;
}

template <int grp>
DI void dsa_item(const Params& p, int b, int tile32, char* smem) {
  const int tid = otid(), w = tid >> 6, lane = tid & 63, c = lane & 15, q4 = lane >> 4, half = lane >> 5, l32 = lane & 31;
  float* S = reinterpret_cast<float*>(smem) + w * 4096;
  unsigned* bm = reinterpret_cast<unsigned*>(smem + LDS_BM);
  const unsigned char* btab = reinterpret_cast<const unsigned char*>(smem + LDS_BTAB);
  const float* rb = reinterpret_cast<const float*>(smem + LDS_RB);
  const int T = grp ? LS : SEQ;
  const int t0 = tile32 * 32;
  const int qpos0 = grp ? PAST + t0 : t0;
  const int m0 = grp ? MP + b * DEC_SEQ + t0 : b * SEQ + t0;
  const int n_adm = grp ? LS : ((qpos0 >> 6) + 1) * 64;
  const bf16_t* KIb = (grp ? p.KIs : p.KIp) + (size_t)b * T * 64;
  const bf16_t* KBb = (grp ? p.KBs : p.KBp) + (size_t)b * T * 64;
  const bf16_t* VBTb = (grp ? p.VBTs : p.VBTp) + (size_t)b * 64 * T;

  for (int rnd = 0; rnd < 2; ++rnd) {
    const int qa = 4 * w + 2 * rnd;
    {
      const int tlA = c >> 3, hA = c & 7;
      const bf16_t* qip = p.QI + (size_t)(m0 + qa + tlA) * 512 + hA * 64 + q4 * 8;
      const bf16x8 af0 = ld8(qip), af1 = ld8(qip + 32);
      const int tlC = q4 >> 1;
      const float4 wv = *reinterpret_cast<const float4*>(p.WI + (size_t)(m0 + qa + tlC) * 8 + 4 * (q4 & 1));
      const int nch = n_adm >> 6;
      char* kis = smem + LDS_KI;
      const int lrow = tid >> 3, lseg = tid & 7;
      bf16x8 pre = ld8(KIb + (size_t)lrow * 64 + lseg * 8);
      *reinterpret_cast<bf16x8*>(kis + lrow * 144 + lseg * 16) = pre;
      __syncthreads();
      for (int ch = 0; ch < nch; ++ch) {
        const bool more = ch + 1 < nch;
        if (more) pre = ld8(KIb + (size_t)((ch + 1) * 64 + lrow) * 64 + lseg * 8);
        const char* cur = kis + (ch & 1) * 9216;
#pragma unroll
        for (int u = 0; u < 4; ++u) {
          const char* rp = cur + (u * 16 + c) * 144 + q4 * 16;
          const bf16x8 b0 = *reinterpret_cast<const bf16x8*>(rp), b1 = *reinterpret_cast<const bf16x8*>(rp + 64);
          f32x4 C = mfma16(af0, b0, f32x4{0.f, 0.f, 0.f, 0.f});
          C = mfma16(af1, b1, C);
          const float part = wv.x * fmaxf(C[0], 0.f) + wv.y * fmaxf(C[1], 0.f) + wv.z * fmaxf(C[2], 0.f) + wv.w * fmaxf(C[3], 0.f);
          const F2 pr = swap16(part); const float full = pr.lo + pr.hi;
          if ((q4 & 1) == 0) S[tlC * 2048 + (ch * 4 + u) * 16 + c] = full;
        }
        if (more) *reinterpret_cast<bf16x8*>(kis + ((ch + 1) & 1) * 9216 + lrow * 144 + lseg * 16) = pre;
        __syncthreads();
      }
    }
    {
      const float* Sh = S + half * 2048;
      unsigned* bmrow = bm + (qa + half) * 64;
      const int nreg = n_adm >> 5;
      if (nreg <= 16) topk_round<16>(Sh, n_adm, half, l32, bmrow);
      else if (nreg <= 32) topk_round<32>(Sh, n_adm, half, l32, bmrow);
      else if (nreg <= 48) topk_round<48>(Sh, n_adm, half, l32, bmrow);
      else topk_round<64>(Sh, n_adm, half, l32, bmrow);
    }
    __syncthreads();
  }

  {
    const int tl = c >> 3, h = c & 7;
    bf16x8 qf[2][2]; int qposc[2], qrow[2], qloc[2];
#pragma unroll
    for (int ct = 0; ct < 2; ++ct) {
      qloc[ct] = 4 * w + 2 * ct + tl; qrow[ct] = m0 + qloc[ct]; qposc[ct] = qpos0 + qloc[ct];
      const bf16_t* qp = p.QB + (size_t)qrow[ct] * 512 + h * 64 + q4 * 8;
      qf[ct][0] = ld8(qp); qf[ct][1] = ld8(qp + 32);
    }
    f32x4 O[2][4]; float mrun[2] = {-1e30f, -1e30f}, lrun[2] = {0.f, 0.f};
#pragma unroll
    for (int ct = 0; ct < 2; ++ct)
#pragma unroll
      for (int dt = 0; dt < 4; ++dt) O[ct][dt] = f32x4{0.f, 0.f, 0.f, 0.f};
    const int nkb = n_adm >> 5;
    const float farbias = rb[15 * 8 + h];
    auto compkv = [&](auto FAR, int kb, const bf16x8 (&kf)[2][2], const bf16x8 (&vf)[4]) {
      constexpr bool far = decltype(FAR)::value;
      const int s0 = kb * 32;
#pragma unroll
      for (int ct = 0; ct < 2; ++ct) {
        f32x4 z0 = mfma16(kf[0][0], qf[ct][0], f32x4{0.f, 0.f, 0.f, 0.f}); z0 = mfma16(kf[0][1], qf[ct][1], z0);
        f32x4 z1 = mfma16(kf[1][0], qf[ct][0], f32x4{0.f, 0.f, 0.f, 0.f}); z1 = mfma16(kf[1][1], qf[ct][1], z1);
        const unsigned word = bm[qloc[ct] * 64 + kb];
        float zz[8]; bool bt[8]; float bmx = -1e30f;
#pragma unroll
        for (int e = 0; e < 8; ++e) {
          const int kt = e >> 2, r = e & 3;
          const int off = 16 * kt + 4 * q4 + r;
          float bias = farbias;
          if (!far) { const int rel = s0 + off - qposc[ct]; const int bk = btab[rel + 2047]; bias = rb[bk * 8 + h]; }
          const float zv = (kt ? z1[r] : z0[r]) * ATT_SCALE + bias;
          bt[e] = (word >> off) & 1u;
          zz[e] = bt[e] ? zv : -1e30f;
          bmx = fmaxf(bmx, zz[e]);
        }
        { const F2 m16 = swap16(bmx); bmx = fmaxf(m16.lo, m16.hi); const F2 m32 = swap32(bmx); bmx = fmaxf(m32.lo, m32.hi); }
        const float mnew = fmaxf(mrun[ct], bmx);
        const float sc = __expf(mrun[ct] - mnew);
        float ps = 0.f; float pe[8];
#pragma unroll
        for (int e = 0; e < 8; ++e) { pe[e] = bt[e] ? __expf(zz[e] - mnew) : 0.f; ps += pe[e]; }
        lrun[ct] = lrun[ct] * sc + ps; mrun[ct] = mnew;
        const bf16x8 pf = pack8(pe);
#pragma unroll
        for (int dt = 0; dt < 4; ++dt) { O[ct][dt] *= sc; O[ct][dt] = mfma16(vf[dt], pf, O[ct][dt]); }
      }
    };
    int nfar = (qpos0 - 159) >= 0 ? ((qpos0 - 159) >> 5) + 1 : 0;
    nfar = nfar < nkb ? nfar : nkb;
    char* kd = smem; char* vd = smem + 9216;
    const bool isK = tid < 256; const int t2 = tid & 255;
    const int krow = t2 >> 3, kseg = t2 & 7, vrow = t2 >> 2, vseg = t2 & 3;
    auto gload = [&](int kb) -> bf16x8 {
      const int s0 = kb * 32;
      return isK ? ld8(KBb + (size_t)(s0 + krow) * 64 + kseg * 8) : ld8(VBTb + (size_t)vrow * T + s0 + vseg * 8);
    };
    auto lstore = [&](int buf, const bf16x8 v) {
      if (isK) *reinterpret_cast<bf16x8*>(kd + buf * 4608 + krow * 144 + kseg * 16) = v;
      else *reinterpret_cast<bf16x8*>(vd + buf * 5120 + vrow * 80 + vseg * 16) = v;
    };
    bf16x8 pre = gload(0);
    lstore(0, pre);
    __syncthreads();
    for (int kb = 0; kb < nkb; ++kb) {
      const bool more = kb + 1 < nkb;
      if (more) pre = gload(kb + 1);
      const char* kc = kd + (kb & 1) * 4608; const char* vc = vd + (kb & 1) * 5120;
      bf16x8 kf[2][2], vf[4];
#pragma unroll
      for (int kt = 0; kt < 2; ++kt)
#pragma unroll
        for (int kk = 0; kk < 2; ++kk) kf[kt][kk] = *reinterpret_cast<const bf16x8*>(kc + (16 * kt + c) * 144 + kk * 64 + q4 * 16);
#pragma unroll
      for (int dt = 0; dt < 4; ++dt) {
        const char* vp = vc + (16 * dt + c) * 80 + q4 * 8;
        const bf16x4 lo = *reinterpret_cast<const bf16x4*>(vp), hi = *reinterpret_cast<const bf16x4*>(vp + 32);
        vf[dt] = __builtin_shufflevector(lo, hi, 0, 1, 2, 3, 4, 5, 6, 7);
      }
      if (kb < nfar) compkv(std::true_type{}, kb, kf, vf); else compkv(std::false_type{}, kb, kf, vf);
      if (more) lstore((kb + 1) & 1, pre);
      __syncthreads();
    }
#pragma unroll
    for (int ct = 0; ct < 2; ++ct) {
      float lt = lrun[ct]; { const F2 a = swap16(lt); lt = a.lo + a.hi; const F2 b = swap32(lt); lt = b.lo + b.hi; }
      const float inv = 1.f / lt;
#pragma unroll
      for (int dt = 0; dt < 4; ++dt) {
        const size_t off = (size_t)qrow[ct] * 512 + h * 64 + dt * 16 + 4 * q4;
        const bf16x4 g = ld4(p.GB + off);
        st4(p.QB + off, pack4(O[ct][dt][0] * inv * bf2f(g[0]), O[ct][dt][1] * inv * bf2f(g[1]), O[ct][dt][2] * inv * bf2f(g[2]), O[ct][dt][3] * inv * bf2f(g[3])));
      }
    }
  }
  __syncthreads();
}

DI void phase_attn(const Params& p, int layer, char* smem) {
  const int tid = otid();
  for (int i = tid; i < 4096; i += NTHREADS) smem[LDS_BTAB + i] = (char)p.btab[i];
  if (tid < 256) reinterpret_cast<float*>(smem + LDS_RB)[tid] = p.rel_bias[tid];
  __syncthreads();
  int* slot = reinterpret_cast<int*>(smem + LDS_SLOT);
  const int w = tid >> 6;
  const int total = 16 + 2048 + 32 + 4096;
  if (tid == 0) *slot = atomicAdd(&p.ctr[layer], 1);
  __syncthreads();
  int item = *slot;
  while (item < total) {
    int nxt = 0;
    if (tid == 0) nxt = atomicAdd(&p.ctr[layer], 1);
    if (item < 16) dsa_item<1>(p, item >> 1, item & 1, smem);
    else if (item < 2064) { const int i = item - 16; dsa_item<0>(p, i >> 6, 63 - (i & 63), smem); }
    else if (item < 2096) { const int i = item - 2064; sb_item<1>(p, i >> 2, 2 * (i & 3) + (w >> 2), (w & 3) * 16); }
    else { const int i = item - 2096; const int tile = 15 - (i >> 8), bh = i & 255; sb_item<0>(p, bh >> 3, bh & 7, tile * 128 + w * 16); }
    __syncthreads();
    if (tid == 0) *slot = nxt;
    __syncthreads();
    item = *slot;
  }
}

DI void phase_ln(const Params& p, int layer, char* smem) {
  const int tid = otid(), lane = tid & 63;
  for (int row = blockIdx.x * NWAVES + (tid >> 6); row < MT; row += gridDim.x * NWAVES)
    ln_row_wave(p.out + (size_t)row * 1024, p.ln_g + layer * 1024, p.ln_b + layer * 1024, p.out + (size_t)row * 1024, p.Xb + (size_t)row * 1024, lane);
  if (layer + 1 < DEPTH) convert_layer(p, layer + 1, smem);
}

__global__ void __launch_bounds__(512, 2) mega_kernel(Params p) {
  extern __shared__ __attribute__((aligned(16))) char smem[];
  cg::grid_group grid = cg::this_grid();
  phase_prologue(p, smem);
  grid.sync();
  unsigned* bar = reinterpret_cast<unsigned*>(p.ctr + 8);
  unsigned nb = 0; const unsigned G = gridDim.x;
#pragma nounroll
  for (int l = 0; l < DEPTH; ++l) {
    phase_proj(p, l, smem);
    gbar(bar, ++nb * G);
    phase_attn(p, l, smem);
    gbar(bar, ++nb * G);
    phase_merge_a(p, smem);
    gbar(bar, ++nb * G);
    phase_merge_b(p, smem);
    gbar(bar, ++nb * G);
    phase_out(p, smem);
    gbar(bar, ++nb * G);
    phase_ln(p, l, smem);
    if (l + 1 < DEPTH) gbar(bar, ++nb * G);
  }
}

#if !USE_COOP
__global__ void __launch_bounds__(512, 2) phase_kernel(Params p, int phase, int layer) {
  extern __shared__ __attribute__((aligned(16))) char smem[];
  if (phase == 0) phase_prologue(p, smem);
  else if (phase == 1) phase_proj(p, layer, smem);
  else if (phase == 2) phase_attn(p, layer, smem);
  else if (phase == 3) phase_merge_a(p, smem);
  else if (phase == 4) phase_merge_b(p, smem);
  else if (phase == 5) phase_out(p, smem);
  else phase_ln(p, layer, smem);
}

#endif

extern "C" void kernel_launch(void* const* d_in, const int* in_sizes, int n_in, void* d_out, int out_size, void* d_ws, size_t ws_size, hipStream_t stream) {
  static int grid_blocks = 0;
  if (grid_blocks == 0) {
    if (n_in != 17 || out_size != OUT_TOTAL) { fprintf(stderr, "kernel_launch: unexpected shapes n_in=%d out=%d\n", n_in, out_size); grid_blocks = -1; return; }
    int dev = 0, cus = 0, per_cu = 0;
    hipGetDevice(&dev);
    hipDeviceGetAttribute(&cus, hipDeviceAttributeMultiprocessorCount, dev);
    hipFuncSetAttribute((const void*)mega_kernel, hipFuncAttributeMaxDynamicSharedMemorySize, LDS_BYTES);
#if !USE_COOP
    hipFuncSetAttribute((const void*)phase_kernel, hipFuncAttributeMaxDynamicSharedMemorySize, LDS_BYTES);
#endif
    hipOccupancyMaxActiveBlocksPerMultiprocessor(&per_cu, (const void*)mega_kernel, NTHREADS, LDS_BYTES);
    if (per_cu < 1) per_cu = 1;
    if (per_cu > 1) per_cu = 1;
    grid_blocks = cus * per_cu;
    fprintf(stderr, "kernel_launch: cus=%d per_cu=%d grid=%d ws=%zu\n", cus, per_cu, grid_blocks, ws_size);
  }
  if (grid_blocks < 0) return;
  Params p{};
  p.x_prompt = (const float*)d_in[0]; p.x_sample = (const float*)d_in[1];
  p.c_sb_k = (const float*)d_in[2]; p.c_sb_v = (const float*)d_in[3]; p.c_dsa_k = (const float*)d_in[4]; p.c_dsa_v = (const float*)d_in[5]; p.c_idx_k = (const float*)d_in[6];
  p.ln_in_g = (const float*)d_in[7]; p.ln_in_b = (const float*)d_in[8]; p.w_in = (const float*)d_in[9]; p.b_in = (const float*)d_in[10];
  p.w_pa = (const float*)d_in[11]; p.w_pb = (const float*)d_in[12]; p.w_out = (const float*)d_in[13]; p.ln_g = (const float*)d_in[14]; p.ln_b = (const float*)d_in[15];
  p.rel_bias = (const float*)d_in[16];
  p.out = (float*)d_out;
  char* ws = (char*)d_ws; size_t off = 0;
  auto take = [&](size_t bytes) { char* r = ws + off; off += (bytes + 255) & ~(size_t)255; return r; };
  p.Xb = (bf16_t*)take((size_t)MT * 1024 * 2);
  p.QA = (bf16_t*)take((size_t)MT * 512 * 2);
  p.GA = (bf16_t*)take((size_t)MT * 512 * 2);
  p.GB = (bf16_t*)take((size_t)MT * 512 * 2);
  p.QB = (bf16_t*)take((size_t)MT * 512 * 2);
  p.QI = (bf16_t*)take((size_t)MT * 512 * 2);
  p.KAp = (bf16_t*)take((size_t)MP * 512 * 2);
  p.VATp = (bf16_t*)take((size_t)MP * 512 * 2);
  p.KAs = (bf16_t*)take((size_t)8 * LS * 512 * 2);
  p.VATs = (bf16_t*)take((size_t)8 * LS * 512 * 2);
  p.KBp = (bf16_t*)take((size_t)MP * 64 * 2);
  p.VBTp = (bf16_t*)take((size_t)MP * 64 * 2);
  p.KIp = (bf16_t*)take((size_t)MP * 64 * 2);
  p.KBs = (bf16_t*)take((size_t)8 * LS * 64 * 2);
  p.VBTs = (bf16_t*)take((size_t)8 * LS * 64 * 2);
  p.KIs = (bf16_t*)take((size_t)8 * LS * 64 * 2);
  p.WI = (float*)take((size_t)MT * 8 * 4);
  p.RA = (bf16_t*)take((size_t)MT * 1024 * 2);
  p.RB = (bf16_t*)take((size_t)MT * 1024 * 2);
  p.WinT = (bf16_t*)take((size_t)D_INP * 1024 * 2);
  p.WpaT = (bf16_t*)take((size_t)1024 * 512 * 2);
  p.WpbT = (bf16_t*)take((size_t)1024 * 512 * 2);
  p.WoutT = (bf16_t*)take((size_t)1024 * 1024 * 2);
  p.btab = (unsigned char*)take(4096);
  p.ctr = (int*)take(256);
  if ((size_t)((char*)p.QA - ws) != OFF_QA || (size_t)((char*)p.GA - ws) != OFF_GA || (size_t)((char*)p.GB - ws) != OFF_GB || (size_t)((char*)p.QB - ws) != OFF_QB ||
      (size_t)((char*)p.QI - ws) != OFF_QI || (size_t)((char*)p.RA - ws) != OFF_RA || (size_t)((char*)p.RB - ws) != OFF_RB) { fprintf(stderr, "kernel_launch: workspace offset mismatch\n"); return; }
  if (off > ws_size) { fprintf(stderr, "kernel_launch: workspace too small: need %zu have %zu\n", off, ws_size); return; }
#if USE_COOP
  void* args[] = {&p};
  hipError_t e = hipLaunchCooperativeKernel((const void*)mega_kernel, dim3(grid_blocks), dim3(NTHREADS), args, LDS_BYTES, stream);
  if (e != hipSuccess) fprintf(stderr, "cooperative launch failed: %s (grid %d)\n", hipGetErrorString(e), grid_blocks);
#else
  hipLaunchKernelGGL(phase_kernel, dim3(grid_blocks), dim3(NTHREADS), LDS_BYTES, stream, p, 0, 0);
  for (int l = 0; l < DEPTH; ++l)
    for (int ph = 1; ph <= 6; ++ph) hipLaunchKernelGGL(phase_kernel, dim3(grid_blocks), dim3(NTHREADS), LDS_BYTES, stream, p, ph, l);
#endif
}
```

```cpp
#include <hip/hip_runtime.h>
#include <hip/hip_cooperative_groups.h>
#include <cstdio>
#include <type_traits>
namespace cg = cooperative_groups;

#ifndef USE_COOP
#define USE_COOP 1
#endif

#define DI __device__ __forceinline__
typedef unsigned short bf16_t;
using bf16x8 = __attribute__((ext_vector_type(8))) short;
using bf16x4 = __attribute__((ext_vector_type(4))) short;
using f32x4  = __attribute__((ext_vector_type(4))) float;

constexpr int D_MODEL = 1024, BATCH = 32, SEQ = 2048, DEPTH = 4, DEC_BATCH = 8, DEC_SEQ = 64, PAST = 1024, LS = 1088;
constexpr int MP = BATCH * SEQ;
constexpr int MS = DEC_BATCH * DEC_SEQ;
constexpr int MT = MP + MS;
constexpr int D_IN = 5832, D_INP = 5888;
constexpr float LN_EPS = 1e-5f;
constexpr float ALPHA = 1.681792830507429f;
constexpr float SB_SCALE = 0.125f, ATT_SCALE = 0.125f;
constexpr int NTHREADS = 512, NWAVES = 8;
constexpr int LDS_S = 0, LDS_BM = 131072, LDS_BTAB = 139264, LDS_RB = 143360, LDS_SLOT = 144384, LDS_KI = 144448, LDS_BYTES = 162880;

constexpr size_t O_Y = 0, O_KAP = 67633152, O_VAP = 201850880, O_KBP = 336068608, O_VBP = 352845824, O_KIP = 369623040,
                 O_KAS = 386400256, O_VAS = 387448832, O_KBS = 388497408, O_VBS = 388628480, O_KIS = 388759552;
constexpr int OUT_TOTAL = 388890624;

constexpr size_t al256(size_t x) { return (x + 255) & ~(size_t)255; }
constexpr size_t OFF_XB = 0;
constexpr size_t OFF_QA = OFF_XB + al256((size_t)MT * 1024 * 2);
constexpr size_t OFF_GA = OFF_QA + al256((size_t)MT * 512 * 2);
constexpr size_t OFF_GB = OFF_GA + al256((size_t)MT * 512 * 2);
constexpr size_t OFF_QB = OFF_GB + al256((size_t)MT * 512 * 2);
constexpr size_t OFF_QI = OFF_QB + al256((size_t)MT * 512 * 2);
constexpr size_t OFF_KAP = OFF_QI + al256((size_t)MT * 512 * 2);
constexpr size_t OFF_VATP = OFF_KAP + al256((size_t)MP * 512 * 2);
constexpr size_t OFF_KAS = OFF_VATP + al256((size_t)MP * 512 * 2);
constexpr size_t OFF_VATS = OFF_KAS + al256((size_t)8 * LS * 512 * 2);
constexpr size_t OFF_KBP = OFF_VATS + al256((size_t)8 * LS * 512 * 2);
constexpr size_t OFF_VBTP = OFF_KBP + al256((size_t)MP * 64 * 2);
constexpr size_t OFF_KIP = OFF_VBTP + al256((size_t)MP * 64 * 2);
constexpr size_t OFF_KBS = OFF_KIP + al256((size_t)MP * 64 * 2);
constexpr size_t OFF_VBTS = OFF_KBS + al256((size_t)8 * LS * 64 * 2);
constexpr size_t OFF_KIS = OFF_VBTS + al256((size_t)8 * LS * 64 * 2);
constexpr size_t OFF_WI = OFF_KIS + al256((size_t)8 * LS * 64 * 2);
constexpr size_t OFF_RA = OFF_WI + al256((size_t)MT * 8 * 4);
constexpr size_t OFF_RB = OFF_RA + al256((size_t)MT * 1024 * 2);
constexpr size_t OFF_WINT = OFF_RB + al256((size_t)MT * 1024 * 2);
constexpr size_t OFF_WPAT = OFF_WINT + al256((size_t)D_INP * 1024 * 2);
constexpr size_t OFF_WPBT = OFF_WPAT + al256((size_t)1024 * 512 * 2);
constexpr size_t OFF_WOUTT = OFF_WPBT + al256((size_t)1024 * 512 * 2);
constexpr size_t OFF_BTAB = OFF_WOUTT + al256((size_t)1024 * 1024 * 2);
constexpr size_t OFF_CTR = OFF_BTAB + 4096;
constexpr size_t OFF_END = OFF_CTR + 256;

struct Params {
  const float* x_prompt; const float* x_sample;
  const float* c_sb_k; const float* c_sb_v; const float* c_dsa_k; const float* c_dsa_v; const float* c_idx_k;
  const float* ln_in_g; const float* ln_in_b; const float* w_in; const float* b_in; const float* w_pa; const float* w_pb;
  const float* w_out; const float* ln_g; const float* ln_b; const float* rel_bias;
  float* out; char* ws;
};

DI unsigned short f2bf(float x) { unsigned u = __float_as_uint(x); u += 0x7fffu + ((u >> 16) & 1u); return (unsigned short)(u >> 16); }
DI float bf2f(short h) { return __uint_as_float(((unsigned)(unsigned short)h) << 16); }
typedef __bf16 hbf16x2 __attribute__((ext_vector_type(2)));
typedef float f32x2v __attribute__((ext_vector_type(2)));
typedef unsigned u32x2v __attribute__((ext_vector_type(2)));
typedef unsigned u32x4v __attribute__((ext_vector_type(4)));
DI unsigned pk2(float lo, float hi) { f32x2v v; v.x = lo; v.y = hi; return __builtin_bit_cast(unsigned, __builtin_convertvector(v, hbf16x2)); }
DI bf16x4 pack4(float a, float b, float c, float d) { u32x2v u; u.x = pk2(a, b); u.y = pk2(c, d); return __builtin_bit_cast(bf16x4, u); }
DI bf16x8 pack8(const float (&e)[8]) { u32x4v u; u.x = pk2(e[0], e[1]); u.y = pk2(e[2], e[3]); u.z = pk2(e[4], e[5]); u.w = pk2(e[6], e[7]); return __builtin_bit_cast(bf16x8, u); }
DI bf16x8 ld8(const bf16_t* p) { return *reinterpret_cast<const bf16x8*>(p); }
DI bf16x4 ld4(const bf16_t* p) { return *reinterpret_cast<const bf16x4*>(p); }
DI void st4(bf16_t* p, bf16x4 v) { *reinterpret_cast<bf16x4*>(p) = v; }
DI f32x4 mfma16(bf16x8 a, bf16x8 b, f32x4 c) { return __builtin_amdgcn_mfma_f32_16x16x32_bf16(a, b, c, 0, 0, 0); }
DI int otid() { int t = threadIdx.x; asm volatile("" : "+v"(t)); return t; }
DI int osg(int v) { asm volatile("" : "+s"(v)); return v; }
DI float sigmoidf_(float x) { return __builtin_amdgcn_rcpf(1.f + __expf(-x)); }
struct F2 { float lo, hi; };
DI F2 swap16(float x) { const unsigned u = __float_as_uint(x); auto r = __builtin_amdgcn_permlane16_swap(u, u, false, false); return F2{__uint_as_float(r[0]), __uint_as_float(r[1])}; }
DI F2 swap32(float x) { const unsigned u = __float_as_uint(x); auto r = __builtin_amdgcn_permlane32_swap(u, u, false, false); return F2{__uint_as_float(r[0]), __uint_as_float(r[1])}; }
DI float row_sum16(float x) {
  x += __uint_as_float(__builtin_amdgcn_update_dpp(0, __float_as_uint(x), 0xB1, 0xF, 0xF, true));
  x += __uint_as_float(__builtin_amdgcn_update_dpp(0, __float_as_uint(x), 0x4E, 0xF, 0xF, true));
  x += __uint_as_float(__builtin_amdgcn_update_dpp(0, __float_as_uint(x), 0x141, 0xF, 0xF, true));
  x += __uint_as_float(__builtin_amdgcn_update_dpp(0, __float_as_uint(x), 0x140, 0xF, 0xF, true));
  return x;
}
DI float wave_sum(float x) { x = row_sum16(x); F2 a = swap16(x); x = a.lo + a.hi; F2 b = swap32(x); return b.lo + b.hi; }
DI int hsum32(int x) {
  x += __builtin_amdgcn_update_dpp(0, x, 0xB1, 0xF, 0xF, true);
  x += __builtin_amdgcn_update_dpp(0, x, 0x4E, 0xF, 0xF, true);
  x += __builtin_amdgcn_update_dpp(0, x, 0x141, 0xF, 0xF, true);
  x += __builtin_amdgcn_update_dpp(0, x, 0x140, 0xF, 0xF, true);
  auto r = __builtin_amdgcn_permlane16_swap((unsigned)x, (unsigned)x, false, false);
  return (int)(r[0] + r[1]);
}
DI void gbar(unsigned* ctr, unsigned target) {
  asm volatile("s_waitcnt vmcnt(0)" ::: "memory");
  __syncthreads();
  if (otid() == 0) {
    __builtin_amdgcn_fence(__ATOMIC_RELEASE, "agent");
    asm volatile("s_waitcnt vmcnt(0)" ::: "memory");
    __hip_atomic_fetch_add(ctr, 1u, __ATOMIC_RELAXED, __HIP_MEMORY_SCOPE_AGENT);
    while (__hip_atomic_load(ctr, __ATOMIC_RELAXED, __HIP_MEMORY_SCOPE_AGENT) < target) __builtin_amdgcn_s_sleep(2);
    __builtin_amdgcn_fence(__ATOMIC_ACQUIRE, "agent");
    asm volatile("s_waitcnt vmcnt(0)" ::: "memory");
  }
  __syncthreads();
}

DI void ln_row_wave(const float* src, const float* g, const float* b, float* d32, bf16_t* db, int lane) {
  float4 v[4]; float s = 0.f;
#pragma unroll
  for (int i = 0; i < 4; ++i) { v[i] = reinterpret_cast<const float4*>(src)[lane + 64 * i]; s += v[i].x + v[i].y + v[i].z + v[i].w; }
  s = wave_sum(s);
  const float mu = s * (1.f / 1024.f);
  float q = 0.f;
#pragma unroll
  for (int i = 0; i < 4; ++i) { float a = v[i].x - mu, bb = v[i].y - mu, c = v[i].z - mu, d = v[i].w - mu; q += a * a + bb * bb + c * c + d * d; }
  q = wave_sum(q);
  const float rstd = rsqrtf(q * (1.f / 1024.f) + LN_EPS);
#pragma unroll
  for (int i = 0; i < 4; ++i) {
    float4 gg = reinterpret_cast<const float4*>(g)[lane + 64 * i], bb = reinterpret_cast<const float4*>(b)[lane + 64 * i];
    float4 o;
    o.x = (v[i].x - mu) * rstd * gg.x + bb.x; o.y = (v[i].y - mu) * rstd * gg.y + bb.y;
    o.z = (v[i].z - mu) * rstd * gg.z + bb.z; o.w = (v[i].w - mu) * rstd * gg.w + bb.w;
    reinterpret_cast<float4*>(d32)[lane + 64 * i] = o;
    st4(db + 4 * (lane + 64 * i), pack4(o.x, o.y, o.z, o.w));
  }
}

DI void ln_rows2(const float* s0, const float* s1, const float* g, const float* b, float* d0, bf16_t* db0, float* d1, bf16_t* db1, int lane) {
  float4 v0[4], v1[4]; float a0 = 0.f, a1 = 0.f;
#pragma unroll
  for (int i = 0; i < 4; ++i) { v0[i] = reinterpret_cast<const float4*>(s0)[lane + 64 * i]; v1[i] = reinterpret_cast<const float4*>(s1)[lane + 64 * i]; }
#pragma unroll
  for (int i = 0; i < 4; ++i) { a0 += v0[i].x + v0[i].y + v0[i].z + v0[i].w; a1 += v1[i].x + v1[i].y + v1[i].z + v1[i].w; }
  a0 = wave_sum(a0); a1 = wave_sum(a1);
  const float mu0 = a0 * (1.f / 1024.f), mu1 = a1 * (1.f / 1024.f);
  float q0 = 0.f, q1 = 0.f;
#pragma unroll
  for (int i = 0; i < 4; ++i) {
    { float a = v0[i].x - mu0, bb = v0[i].y - mu0, c = v0[i].z - mu0, d = v0[i].w - mu0; q0 += a * a + bb * bb + c * c + d * d; }
    { float a = v1[i].x - mu1, bb = v1[i].y - mu1, c = v1[i].z - mu1, d = v1[i].w - mu1; q1 += a * a + bb * bb + c * c + d * d; }
  }
  q0 = wave_sum(q0); q1 = wave_sum(q1);
  const float r0 = rsqrtf(q0 * (1.f / 1024.f) + LN_EPS), r1 = rsqrtf(q1 * (1.f / 1024.f) + LN_EPS);
#pragma unroll
  for (int i = 0; i < 4; ++i) {
    const float4 gg = reinterpret_cast<const float4*>(g)[lane + 64 * i], bb = reinterpret_cast<const float4*>(b)[lane + 64 * i];
    float4 o;
    o.x = (v0[i].x - mu0) * r0 * gg.x + bb.x; o.y = (v0[i].y - mu0) * r0 * gg.y + bb.y; o.z = (v0[i].z - mu0) * r0 * gg.z + bb.z; o.w = (v0[i].w - mu0) * r0 * gg.w + bb.w;
    reinterpret_cast<float4*>(d0)[lane + 64 * i] = o; st4(db0 + 4 * (lane + 64 * i), pack4(o.x, o.y, o.z, o.w));
    o.x = (v1[i].x - mu1) * r1 * gg.x + bb.x; o.y = (v1[i].y - mu1) * r1 * gg.y + bb.y; o.z = (v1[i].z - mu1) * r1 * gg.z + bb.z; o.w = (v1[i].w - mu1) * r1 * gg.w + bb.w;
    reinterpret_cast<float4*>(d1)[lane + 64 * i] = o; st4(db1 + 4 * (lane + 64 * i), pack4(o.x, o.y, o.z, o.w));
  }
}

DI void tconv_tile(const float* src, int ldsrc, int K, bf16_t* dst, int n0, int k0, bool winmap, float* tile) {
  const int tid = otid();
#pragma unroll
  for (int rr = 0; rr < 8; ++rr) {
    const int kl = rr * 8 + (tid >> 6), nl = tid & 63, np = n0 + nl;
    int n = np; bool ok = true;
    if (winmap) { if (np >= 3840) n = np - 56; else if (np >= 3784) ok = false; }
    tile[kl * 65 + nl] = ok ? src[(size_t)(k0 + kl) * ldsrc + n] : 0.f;
  }
  __syncthreads();
#pragma unroll
  for (int rr = 0; rr < 8; ++rr) {
    const int nl = rr * 8 + (tid >> 6), kl = tid & 63;
    dst[(size_t)(n0 + nl) * K + k0 + kl] = f2bf(tile[kl * 65 + nl]);
  }
  __syncthreads();
}

DI void convert_layer(const Params& p, int l, char* smem) {
  float* tile = reinterpret_cast<float*>(smem);
  const int G = gridDim.x;
  for (int it = blockIdx.x; it < 1984; it += G) {
    if (it < 1472) { int nt = it >> 4, kt = it & 15; tconv_tile(p.w_in + (size_t)l * 1024 * D_IN, D_IN, 1024, (reinterpret_cast<bf16_t*>(p.ws + OFF_WINT)), nt * 64, kt * 64, true, tile); }
    else if (it < 1600) { int i = it - 1472; int nt = i >> 3, kt = i & 7; tconv_tile(p.w_pa + (size_t)l * 512 * 1024, 1024, 512, (reinterpret_cast<bf16_t*>(p.ws + OFF_WPAT)), nt * 64, kt * 64, false, tile); }
    else if (it < 1728) { int i = it - 1600; int nt = i >> 3, kt = i & 7; tconv_tile(p.w_pb + (size_t)l * 512 * 1024, 1024, 512, (reinterpret_cast<bf16_t*>(p.ws + OFF_WPBT)), nt * 64, kt * 64, false, tile); }
    else { int i = it - 1728; int nt = i >> 4, kt = i & 15; tconv_tile(p.w_out + (size_t)l * 1024 * 1024, 1024, 1024, (reinterpret_cast<bf16_t*>(p.ws + OFF_WOUTT)), nt * 64, kt * 64, false, tile); }
  }
  const int gtid = blockIdx.x * NTHREADS + otid(), gn = G * NTHREADS;
#pragma unroll 4
  for (int idx = gtid; idx < 8 * 1024 * 512; idx += gn) {
    int b = idx >> 19, rem = idx & ((1 << 19) - 1);
    (reinterpret_cast<bf16_t*>(p.ws + OFF_KAS))[(size_t)b * LS * 512 + rem] = f2bf(p.c_sb_k[(size_t)l * 8 * 1024 * 512 + idx]);
  }
#pragma unroll 4
  for (int idx = gtid; idx < 8 * 512 * 1024; idx += gn) {
    int b = idx >> 19, hd = (idx >> 10) & 511, t = idx & 1023;
    (reinterpret_cast<bf16_t*>(p.ws + OFF_VATS))[((size_t)b * 512 + hd) * LS + t] = f2bf(p.c_sb_v[(((size_t)l * 8 + b) * 1024 + t) * 512 + hd]);
  }
  for (int idx = gtid; idx < 8 * 1024 * 64; idx += gn) {
    int b = idx >> 16, rem = idx & 65535;
    (reinterpret_cast<bf16_t*>(p.ws + OFF_KBS))[(size_t)b * LS * 64 + rem] = f2bf(p.c_dsa_k[(size_t)l * 8 * 65536 + idx]);
    (reinterpret_cast<bf16_t*>(p.ws + OFF_KIS))[(size_t)b * LS * 64 + rem] = f2bf(p.c_idx_k[(size_t)l * 8 * 65536 + idx]);
    int d = (idx >> 10) & 63, t = idx & 1023;
    (reinterpret_cast<bf16_t*>(p.ws + OFF_VBTS))[((size_t)b * 64 + d) * LS + t] = f2bf(p.c_dsa_v[(((size_t)l * 8 + b) * 1024 + t) * 64 + d]);
  }
}

DI void phase_prologue(const Params& p, char* smem) {
  const int tid = otid(), lane = tid & 63;
  if (blockIdx.x == 0 && tid < 16) (reinterpret_cast<int*>(p.ws + OFF_CTR))[tid] = 0;
  for (int i = blockIdx.x * NTHREADS + tid; i < 4096; i += gridDim.x * NTHREADS) {
    int rel = i - 2047; int n = rel < 0 ? -rel : rel;
    float nf = (float)(n > 1 ? n : 1);
    int large = 8 + (int)(logf(nf / 8.f) / 2.7725887f * 8.f);
    large = large < 15 ? large : 15;
    int bk = (rel > 0 ? 16 : 0) + (n < 8 ? n : large);
    (reinterpret_cast<unsigned char*>(p.ws + OFF_BTAB))[i] = (unsigned char)bk;
  }
  {
    const int stride = gridDim.x * NWAVES;
    for (int row = blockIdx.x * NWAVES + (tid >> 6); row < MT; row += 2 * stride) {
      const int row2 = row + stride;
      const float* src = row < MP ? p.x_prompt + (size_t)row * 1024 : p.x_sample + (size_t)(row - MP) * 1024;
      if (row2 < MT) {
        const float* src2 = row2 < MP ? p.x_prompt + (size_t)row2 * 1024 : p.x_sample + (size_t)(row2 - MP) * 1024;
        ln_rows2(src, src2, p.ln_in_g, p.ln_in_b, p.out + (size_t)row * 1024, (reinterpret_cast<bf16_t*>(p.ws + OFF_XB)) + (size_t)row * 1024, p.out + (size_t)row2 * 1024, (reinterpret_cast<bf16_t*>(p.ws + OFF_XB)) + (size_t)row2 * 1024, lane);
      } else ln_row_wave(src, p.ln_in_g, p.ln_in_b, p.out + (size_t)row * 1024, (reinterpret_cast<bf16_t*>(p.ws + OFF_XB)) + (size_t)row * 1024, lane);
    }
  }
  convert_layer(p, 0, smem);
}


namespace pg8 {
#define PG8_LAS __attribute__((address_space(3)))
constexpr int BM = 256, BK = 64, HALF = 128, HTB = HALF * BK * 2, STAGE_BYTES = 8 * HTB, NXCD = 8, WGM = 8;
DI int lds_byte(int r, int c) { const int st = (r >> 4) * 2 + (c >> 5), rr = r & 15, cc = c & 31, ob = rr * 64 + cc * 2; return st * 1024 + (ob ^ (((ob >> 9) & 1) << 5)); }
DI void stage_rc(int b, int& R, int& C) { const int st = b / 1024, sb = b % 1024, swz = sb ^ (((sb >> 9) & 1) << 5); R = (st >> 1) * 16 + swz / 64; C = (st & 1) * 32 + (swz % 64) / 2; }
DI int perm32(int rho) { const int n = rho >> 4, i = rho & 15; return 8 * (i >> 2) + 4 * n + (i & 3); }
struct Unit { int pm, pn; };
struct Gemm { const bf16_t* A; const bf16_t* Bt; int M, N, K; };
struct StaticOrder {
    int nM, nN, nwg, G, c;
    DI void init(int M, int N, int G_, int c_) { nM = M / BM; nN = N / BM; nwg = nM * nN; G = G_; c = c_; }
    DI bool next(int i, Unit& u) const {
        const long L = (long)i * G + c; if (L >= nwg) return false;
        int wgid = (int)L; { const int q = nwg / NXCD, r = nwg % NXCD, xcd = wgid % NXCD, off = wgid / NXCD; wgid = (xcd < r ? xcd * (q + 1) : r * (q + 1) + (xcd - r) * q) + off; }
        const int nig = WGM * nN, gid = wgid / nig, fm = gid * WGM, gsz = (nM - fm) < WGM ? (nM - fm) : WGM;
        u.pm = fm + ((wgid % nig) % gsz); u.pn = (wgid % nig) / gsz; return true;
    }
    DI void a_ready(const Unit&) const {}
    DI void done(const Unit&) const {}
};
template <class Epi, class Sched>
__device__ __forceinline__ void gemm_phase(PG8_LAS unsigned char* lds, const Gemm g, const Sched& S, const Epi& E) {
    const int tid = otid(), wid = __builtin_amdgcn_readfirstlane(tid >> 6), lane = tid & 63, wr = wid >> 2, wc = wid & 3, fr = lane & 15, fq = lane >> 4;
    const int K = g.K, nt = K / BK;
    unsigned voffA[2], voffB[2];
#pragma unroll
    for (int i = 0; i < 2; ++i) { int R, C; stage_rc(tid * 16 + i * 8192, R, C); const int Rb = Epi::PERM ? ((R & ~31) + perm32(R & 31)) : R;
        voffA[i] = (unsigned)(R * K + C) * 2u; voffB[i] = (unsigned)(Rb * K + C) * 2u; }
    const size_t kstep = (size_t)(BK * 2);
    const size_t hstep = (size_t)HALF * K * 2;
    const size_t tstep = 2 * hstep;
    const unsigned ldsw = (unsigned)wid * 1024u;
    const int aoff = lds_byte(wr * 64 + fr, fq * 8), boff = lds_byte(wc * 32 + fr, fq * 8);
#define PG8_SA(b, h) (((b) * 2 + (h)) * HTB)
#define PG8_SB(b, h) ((4 + (b) * 2 + (h)) * HTB)
#define PG8_STAGE(bufoff, gbase, voff) do { _Pragma("unroll") for (int _i = 0; _i < 2; ++_i) \
        __builtin_amdgcn_global_load_lds((const unsigned*)((const char*)(gbase) + (voff)[_i]), (PG8_LAS unsigned*)(lds + (bufoff) + ldsw + _i * 8192), 16, 0, 0); } while (0)
#define PG8_LDA(dst, b, h) do { _Pragma("unroll") for (int m = 0; m < 4; ++m) _Pragma("unroll") for (int k = 0; k < 2; ++k) dst[m][k] = *(const PG8_LAS bf16x8*)(lds + PG8_SA(b, h) + aoff + m * 2048 + k * 1024); } while (0)
#define PG8_LDB(dst, b, h) do { _Pragma("unroll") for (int n = 0; n < 2; ++n) _Pragma("unroll") for (int k = 0; k < 2; ++k) dst[n][k] = *(const PG8_LAS bf16x8*)(lds + PG8_SB(b, h) + boff + n * 2048 + k * 1024); } while (0)
#define PG8_MMA(ai, bj, At, Bt) do { __builtin_amdgcn_s_setprio(1); _Pragma("unroll") for (int m = 0; m < 4; ++m) _Pragma("unroll") for (int n = 0; n < 2; ++n) _Pragma("unroll") for (int k = 0; k < 2; ++k) \
        acc[ai][bj][m][n] = __builtin_amdgcn_mfma_f32_16x16x32_bf16(Bt[n][k], At[m][k], acc[ai][bj][m][n], 0, 0, 0); __builtin_amdgcn_s_setprio(0); } while (0)
#define PG8_WAIT_V(n) asm volatile("s_waitcnt vmcnt(" #n ")" ::: "memory")
#define PG8_WAIT_L(n) asm volatile("s_waitcnt lgkmcnt(" #n ")" ::: "memory")
#define PG8_BAR __builtin_amdgcn_s_barrier()
#define PG8_SCHED __builtin_amdgcn_sched_barrier(0)
    Unit cur, nxt; int ui = 0;
    if (!S.next(0, cur)) return;
    f32x4 acc[2][2][4][2];
#pragma unroll
    for (int a = 0; a < 2; ++a)
#pragma unroll
        for (int b = 0; b < 2; ++b)
#pragma unroll
            for (int m = 0; m < 4; ++m)
#pragma unroll
                for (int n = 0; n < 2; ++n) acc[a][b][m][n] = (f32x4){0.f, 0.f, 0.f, 0.f};
    bf16x8 At[4][2], B0[2][2], B1[2][2];
    const char* cA = (const char*)g.A + (size_t)cur.pm * tstep; const char* cB = (const char*)g.Bt + (size_t)cur.pn * tstep;
    S.a_ready(cur);
    PG8_STAGE(PG8_SB(0, 0), cB, voffB); PG8_STAGE(PG8_SA(0, 0), cA, voffA); PG8_STAGE(PG8_SB(0, 1), cB + hstep, voffB); PG8_STAGE(PG8_SA(0, 1), cA + hstep, voffA);
    if (wr == 1) PG8_BAR;
    PG8_WAIT_V(4); PG8_BAR;
    PG8_STAGE(PG8_SB(1, 0), cB + kstep, voffB); PG8_STAGE(PG8_SA(1, 0), cA + kstep, voffA); PG8_STAGE(PG8_SB(1, 1), cB + hstep + kstep, voffB);
    PG8_WAIT_V(6); PG8_BAR;
    for (;;) {
        const bool has_next = S.next(ui + 1, nxt);
        const char* nA = has_next ? (const char*)g.A + (size_t)nxt.pm * tstep : cA; const char* nB = has_next ? (const char*)g.Bt + (size_t)nxt.pn * tstep : cB;
        for (int t = 0; t < nt; t += 2) {
            const bool last = (t == nt - 2);
            const char* a1 = cA + (size_t)(t + 1) * kstep;
            const char* a2 = last ? nA : cA + (size_t)(t + 2) * kstep; const char* b2 = last ? nB : cB + (size_t)(t + 2) * kstep;
            const char* a3 = a2 + kstep; const char* b3 = b2 + kstep;
            if (last && has_next) S.a_ready(nxt);
            PG8_LDB(B0, 0, 0); PG8_SCHED; PG8_LDA(At, 0, 0); PG8_STAGE(PG8_SA(1, 1), a1 + hstep, voffA);
            PG8_WAIT_L(8); PG8_BAR; PG8_WAIT_L(0); PG8_MMA(0, 0, At, B0); PG8_BAR; PG8_SCHED;
            PG8_LDB(B1, 0, 1); PG8_STAGE(PG8_SB(0, 0), b2, voffB);
            PG8_BAR; PG8_WAIT_L(0); PG8_MMA(0, 1, At, B1); PG8_BAR;
            PG8_LDA(At, 0, 1); PG8_STAGE(PG8_SA(0, 0), a2, voffA);
            PG8_BAR; PG8_WAIT_L(0); PG8_MMA(1, 0, At, B0); PG8_BAR; PG8_SCHED;
            PG8_STAGE(PG8_SB(0, 1), b2 + hstep, voffB);
            PG8_WAIT_V(6); PG8_BAR; PG8_MMA(1, 1, At, B1); PG8_BAR;
            PG8_LDB(B0, 1, 0); PG8_SCHED; PG8_LDA(At, 1, 0); PG8_STAGE(PG8_SA(0, 1), a2 + hstep, voffA);
            PG8_WAIT_L(8); PG8_BAR; PG8_WAIT_L(0); PG8_MMA(0, 0, At, B0); PG8_BAR; PG8_SCHED;
            PG8_LDB(B1, 1, 1); PG8_STAGE(PG8_SB(1, 0), b3, voffB);
            PG8_BAR; PG8_WAIT_L(0); PG8_MMA(0, 1, At, B1); PG8_BAR;
            PG8_LDA(At, 1, 1); PG8_STAGE(PG8_SA(1, 0), a3, voffA);
            PG8_BAR; PG8_WAIT_L(0); PG8_MMA(1, 0, At, B0); PG8_BAR; PG8_SCHED;
            PG8_STAGE(PG8_SB(1, 1), b3 + hstep, voffB);
            PG8_WAIT_V(6); PG8_BAR; PG8_MMA(1, 1, At, B1); PG8_BAR;
        }
        if constexpr (!Epi::AFTER_DRAIN) { E(acc, cur, wr, wc, fr, fq); S.done(cur); }
        if (!has_next) break;
#pragma unroll
        for (int a = 0; a < 2; ++a)
#pragma unroll
            for (int b = 0; b < 2; ++b)
#pragma unroll
                for (int m = 0; m < 4; ++m)
#pragma unroll
                    for (int n = 0; n < 2; ++n) acc[a][b][m][n] = (f32x4){0.f, 0.f, 0.f, 0.f};
        cur = nxt; cA = nA; cB = nB; ++ui;
    }
    PG8_WAIT_V(0);
    if (wr == 0) PG8_BAR;
    PG8_BAR;
    if constexpr (Epi::AFTER_DRAIN) { E.fused(acc, cur, wr, wc, fr, fq, lds, wid, lane); S.done(cur); }
#undef PG8_SA
#undef PG8_SB
#undef PG8_STAGE
#undef PG8_LDA
#undef PG8_LDB
#undef PG8_MMA
#undef PG8_WAIT_V
#undef PG8_WAIT_L
#undef PG8_BAR
#undef PG8_SCHED
}
}

DI bf16x4 pack4v(const f32x4 v) { return pack4(v[0], v[1], v[2], v[3]); }

struct EpiProj {
  static constexpr bool PERM = true, AFTER_DRAIN = false;
  const Params& p; int layer; const __attribute__((address_space(3))) float* biasl;
  template <int GRP>
  DI void run(const f32x4 (&acc)[2][2][4][2], const pg8::Unit& u, int wr, int wc, int fr, int fq) const {
    constexpr int T = GRP ? LS : SEQ;
    char* ws = p.ws;
#pragma unroll
    for (int bj = 0; bj < 2; ++bj) {
      const int nt = 2 * u.pn + bj;
      const __attribute__((address_space(3))) f32x4* bp = reinterpret_cast<const __attribute__((address_space(3))) f32x4*>(biasl + nt * 128 + 32 * wc + 8 * fq);
      const bool simple = (nt < 4) || (nt >= 12 && nt < 20) || (nt >= 21 && nt < 29) || (nt >= 30);
      if (simple) {
        size_t off; int ld, c0, act;
        if (nt < 4) { off = OFF_QA; ld = 512; c0 = nt * 128; act = 0; }
        else if (nt < 16) { off = OFF_GA; ld = 512; c0 = (nt - 12) * 128; act = 1; }
        else if (nt < 20) { off = OFF_QB; ld = 512; c0 = (nt - 16) * 128; act = 0; }
        else if (nt < 25) { off = OFF_GB; ld = 512; c0 = (nt - 21) * 128; act = 1; }
        else if (nt < 29) { off = OFF_QI; ld = 512; c0 = (nt - 25) * 128; act = 0; }
        else if (nt < 38) { off = OFF_RA; ld = 1024; c0 = (nt - 30) * 128; act = 2; }
        else { off = OFF_RB; ld = 1024; c0 = (nt - 38) * 128; act = 2; }
        bf16_t* dst = reinterpret_cast<bf16_t*>(ws + off) + c0 + 32 * wc + 8 * fq;
#pragma unroll
        for (int ai = 0; ai < 2; ++ai)
#pragma unroll
          for (int m = 0; m < 4; ++m) {
            int row = u.pm * 256 + 128 * ai + 64 * wr + 16 * m + fr;
            asm volatile("" : "+v"(row));
            u32x4v pk;
#pragma unroll
            for (int n = 0; n < 2; ++n) {
              f32x4 v = acc[ai][bj][m][n] + bp[n];
              if (act != 0) {
#pragma unroll
                for (int j = 0; j < 4; ++j) { const float sg = sigmoidf_(v[j]); v[j] = (act == 1) ? v[j] * sg : sg; }
              }
              if (n == 0) { pk.x = pk2(v[0], v[1]); pk.y = pk2(v[2], v[3]); } else { pk.z = pk2(v[0], v[1]); pk.w = pk2(v[2], v[3]); }
            }
            *reinterpret_cast<u32x4v*>(dst + (size_t)row * ld) = pk;
          }
      } else {
#pragma unroll
        for (int ai = 0; ai < 2; ++ai)
#pragma unroll
          for (int m = 0; m < 4; ++m) {
            int row = u.pm * 256 + 128 * ai + 64 * wr + 16 * m + fr;
            asm volatile("" : "+v"(row));
            int bb, tt;
            if (!GRP) { bb = row >> 11; tt = row & 2047; } else { const int ms = row - MP; bb = ms >> 6; tt = PAST + (ms & 63); }
            const size_t orow = GRP ? (size_t)layer * MS + (row - MP) : (size_t)layer * MP + row;
#pragma unroll
            for (int n = 0; n < 2; ++n) {
              int ct = 32 * wc + 8 * fq + 4 * n;
              asm volatile("" : "+v"(ct));
              const f32x4 v = acc[ai][bj][m][n] + bp[n];
              if (nt < 8) {
                const int c = (nt - 4) * 128 + ct;
                *reinterpret_cast<f32x4*>(p.out + (GRP ? O_KAS : O_KAP) + orow * 512 + c) = v;
                bf16_t* kd = GRP ? (reinterpret_cast<bf16_t*>(p.ws + OFF_KAS)) + ((size_t)bb * LS + tt) * 512 + c : (reinterpret_cast<bf16_t*>(p.ws + OFF_KAP)) + (size_t)row * 512 + c;
                st4(kd, pack4v(v));
              } else if (nt < 12) {
                const int c = (nt - 8) * 128 + ct;
                *reinterpret_cast<f32x4*>(p.out + (GRP ? O_VAS : O_VAP) + orow * 512 + c) = v;
                bf16_t* vd = (GRP ? (reinterpret_cast<bf16_t*>(p.ws + OFF_VATS)) : (reinterpret_cast<bf16_t*>(p.ws + OFF_VATP))) + ((size_t)bb * 512 + c) * T + tt;
                vd[0] = f2bf(v[0]); vd[T] = f2bf(v[1]); vd[2 * T] = f2bf(v[2]); vd[3 * T] = f2bf(v[3]);
              } else if (nt == 20) {
                if (wc < 2) {
                  *reinterpret_cast<f32x4*>(p.out + (GRP ? O_KBS : O_KBP) + orow * 64 + ct) = v;
                  st4((GRP ? (reinterpret_cast<bf16_t*>(p.ws + OFF_KBS)) : (reinterpret_cast<bf16_t*>(p.ws + OFF_KBP))) + ((size_t)bb * T + tt) * 64 + ct, pack4v(v));
                } else {
                  const int c = ct - 64;
                  *reinterpret_cast<f32x4*>(p.out + (GRP ? O_VBS : O_VBP) + orow * 64 + c) = v;
                  bf16_t* vd = (GRP ? (reinterpret_cast<bf16_t*>(p.ws + OFF_VBTS)) : (reinterpret_cast<bf16_t*>(p.ws + OFF_VBTP))) + ((size_t)bb * 64 + c) * T + tt;
                  vd[0] = f2bf(v[0]); vd[T] = f2bf(v[1]); vd[2 * T] = f2bf(v[2]); vd[3 * T] = f2bf(v[3]);
                }
              } else {
                if (wc < 2) {
                  *reinterpret_cast<f32x4*>(p.out + (GRP ? O_KIS : O_KIP) + orow * 64 + ct) = v;
                  st4((GRP ? (reinterpret_cast<bf16_t*>(p.ws + OFF_KIS)) : (reinterpret_cast<bf16_t*>(p.ws + OFF_KIP))) + ((size_t)bb * T + tt) * 64 + ct, pack4v(v));
                } else if (ct < 72) {
                  *reinterpret_cast<f32x4*>((reinterpret_cast<float*>(p.ws + OFF_WI)) + (size_t)row * 8 + (ct - 64)) = v;
                }
              }
            }
          }
      }
    }
  }
  DI void operator()(const f32x4 (&acc)[2][2][4][2], const pg8::Unit& u, int wr, int wc, int fr, int fq) const {
    if (u.pm < MP / 256) run<0>(acc, u, wr, wc, fr, fq); else run<1>(acc, u, wr, wc, fr, fq);
  }
};

template <int MODE>
struct EpiTail {
  static constexpr bool PERM = false, AFTER_DRAIN = false;
  const Params& p;
  DI void operator()(const f32x4 (&acc)[2][2][4][2], const pg8::Unit& u, int wr, int wc, int fr, int fq) const {
    bf16_t* MERGED = (reinterpret_cast<bf16_t*>(p.ws + OFF_GA));
#pragma unroll
    for (int ai = 0; ai < 2; ++ai)
#pragma unroll
      for (int m = 0; m < 4; ++m) {
        const int row = u.pm * 256 + 128 * ai + 64 * wr + 16 * m + fr;
#pragma unroll
        for (int bj = 0; bj < 2; ++bj)
#pragma unroll
          for (int n = 0; n < 2; ++n) {
            const size_t idx = (size_t)row * 1024 + u.pn * 256 + 128 * bj + 32 * wc + 16 * n + 4 * fq;
            const f32x4 a = acc[ai][bj][m][n];
            if (MODE == 0) {
              const bf16x4 g = ld4((reinterpret_cast<bf16_t*>(p.ws + OFF_RA)) + idx);
              st4(MERGED + idx, pack4(bf2f(g[0]) * a[0], bf2f(g[1]) * a[1], bf2f(g[2]) * a[2], bf2f(g[3]) * a[3]));
            } else if (MODE == 1) {
              const bf16x4 g = ld4((reinterpret_cast<bf16_t*>(p.ws + OFF_RB)) + idx); const bf16x4 o = ld4(MERGED + idx);
              st4(MERGED + idx, pack4(bf2f(o[0]) + bf2f(g[0]) * a[0], bf2f(o[1]) + bf2f(g[1]) * a[1], bf2f(o[2]) + bf2f(g[2]) * a[2], bf2f(o[3]) + bf2f(g[3]) * a[3]));
            } else {
              f32x4 x = *reinterpret_cast<const f32x4*>(p.out + idx);
              x = x * ALPHA + a;
              *reinterpret_cast<f32x4*>(p.out + idx) = x;
            }
          }
      }
  }
};

DI void phase_proj(const Params& p, int layer, char* smem) {
  {
    const float* bin = p.b_in + (size_t)layer * D_IN;
    float* bl = reinterpret_cast<float*>(smem + 131072);
    for (int i = otid(); i < D_INP; i += NTHREADS) bl[i] = (i < 3784) ? bin[i] : (i < 3840 ? 0.f : bin[i - 56]);
    __syncthreads();
  }
  pg8::Gemm g{(reinterpret_cast<bf16_t*>(p.ws + OFF_XB)), (reinterpret_cast<bf16_t*>(p.ws + OFF_WINT)), MT, D_INP, 1024};
  pg8::StaticOrder S; S.init(MT, D_INP, osg(gridDim.x), osg(blockIdx.x));
  EpiProj E{p, layer, (const __attribute__((address_space(3))) float*)(smem + 131072)};
  pg8::gemm_phase<EpiProj, pg8::StaticOrder>((PG8_LAS unsigned char*)smem, g, S, E);
}
DI void phase_merge_a(const Params& p, char* smem) {
  pg8::Gemm g{(reinterpret_cast<bf16_t*>(p.ws + OFF_QA)), (reinterpret_cast<bf16_t*>(p.ws + OFF_WPAT)), MT, 1024, 512};
  pg8::StaticOrder S; S.init(MT, 1024, osg(gridDim.x), osg(blockIdx.x));
  EpiTail<0> E{p};
  pg8::gemm_phase<EpiTail<0>, pg8::StaticOrder>((PG8_LAS unsigned char*)smem, g, S, E);
}
DI void phase_merge_b(const Params& p, char* smem) {
  pg8::Gemm g{(reinterpret_cast<bf16_t*>(p.ws + OFF_QB)), (reinterpret_cast<bf16_t*>(p.ws + OFF_WPBT)), MT, 1024, 512};
  pg8::StaticOrder S; S.init(MT, 1024, osg(gridDim.x), osg(blockIdx.x));
  EpiTail<1> E{p};
  pg8::gemm_phase<EpiTail<1>, pg8::StaticOrder>((PG8_LAS unsigned char*)smem, g, S, E);
}
DI void phase_out(const Params& p, char* smem) {
  pg8::Gemm g{(reinterpret_cast<bf16_t*>(p.ws + OFF_GA)), (reinterpret_cast<bf16_t*>(p.ws + OFF_WOUTT)), MT, 1024, 1024};
  pg8::StaticOrder S; S.init(MT, 1024, osg(gridDim.x), osg(blockIdx.x));
  EpiTail<2> E{p};
  pg8::gemm_phase<EpiTail<2>, pg8::StaticOrder>((PG8_LAS unsigned char*)smem, g, S, E);
}

template <int grp>
DI void sb_item(const Params& p, int b, int h, int t0) {
  const int tid = otid(), w = tid >> 6, lane = tid & 63, c = lane & 15, q4 = lane >> 4;
  const int T = grp ? LS : SEQ;
  const int qpos0 = grp ? PAST + t0 : t0;
  const int m0 = grp ? MP + b * DEC_SEQ + t0 : b * SEQ + t0;
  const bf16_t* Kb = (grp ? (reinterpret_cast<bf16_t*>(p.ws + OFF_KAS)) : (reinterpret_cast<bf16_t*>(p.ws + OFF_KAP))) + (size_t)b * T * 512 + h * 64;
  const bf16_t* VTb = (grp ? (reinterpret_cast<bf16_t*>(p.ws + OFF_VATS)) : (reinterpret_cast<bf16_t*>(p.ws + OFF_VATP))) + (size_t)(b * 8 + h) * 64 * T;
  const bf16_t* qp = (reinterpret_cast<bf16_t*>(p.ws + OFF_QA)) + (size_t)(m0 + c) * 512 + h * 64 + q4 * 8;
  const bf16x8 qf0 = ld8(qp), qf1 = ld8(qp + 32);
  const int qpos = qpos0 + c;
  float R = 0.f;
  f32x4 O[4];
#pragma unroll
  for (int dt = 0; dt < 4; ++dt) O[dt] = f32x4{0.f, 0.f, 0.f, 0.f};
  bf16x8 kfA[2][2], vfA[4], kfB[2][2], vfB[4];
  auto loadkv = [&](int kb, bf16x8 (&kf)[2][2], bf16x8 (&vf)[4]) {
    const int s0 = kb * 32;
#pragma unroll
    for (int kt = 0; kt < 2; ++kt) { const bf16_t* kp = Kb + (size_t)(s0 + 16 * kt + c) * 512 + q4 * 8; kf[kt][0] = ld8(kp); kf[kt][1] = ld8(kp + 32); }
#pragma unroll
    for (int dt = 0; dt < 4; ++dt) {
      const bf16_t* vp = VTb + (size_t)(16 * dt + c) * T + s0 + 4 * q4;
      bf16x4 lo = ld4(vp), hi = ld4(vp + 16);
      vf[dt] = __builtin_shufflevector(lo, hi, 0, 1, 2, 3, 4, 5, 6, 7);
    }
  };
  auto comp = [&](int kb, const bf16x8 (&kf)[2][2], const bf16x8 (&vf)[4]) -> bool {
    const int s0 = kb * 32;
    f32x4 z[2];
#pragma unroll
    for (int kt = 0; kt < 2; ++kt) {
      z[kt] = mfma16(kf[kt][0], qf0, f32x4{0.f, 0.f, 0.f, 0.f});
      z[kt] = mfma16(kf[kt][1], qf1, z[kt]);
    }
    float lk[2][4], ls[2][4]; bool bf[2][4];
#pragma unroll
    for (int kt = 0; kt < 2; ++kt)
#pragma unroll
      for (int r = 0; r < 4; ++r) {
        const int key = s0 + 16 * kt + 4 * q4 + r;
        const bool before = key < qpos;
        const float zz = z[kt][r] * SB_SCALE;
        const float sp = fmaxf(zz, 0.f) + __logf(1.f + __expf(-fabsf(zz)));
        bf[kt][r] = before; lk[kt][r] = before ? -sp : 0.f; ls[kt][r] = zz - sp;
      }
    const float T1 = (lk[1][0] + lk[1][1]) + (lk[1][2] + lk[1][3]);
    const float T0 = (lk[0][0] + lk[0][1]) + (lk[0][2] + lk[0][3]);
    const F2 x1 = swap16(T1), x0 = swap16(T0);
    const float p1 = x1.lo + x1.hi, p0 = x0.lo + x0.hi;
    const F2 y1 = swap32(p1), y0 = swap32(p0);
    const float H1 = ((q4 & 1) ? 0.f : x1.hi) + ((q4 & 2) ? 0.f : y1.hi);
    const float H0 = ((q4 & 1) ? 0.f : x0.hi) + ((q4 & 2) ? 0.f : y0.hi);
    const float TT1 = y1.lo + y1.hi, TT0 = y0.lo + y0.hi;
    float a[2][4];
    { float ac = R + H1;
#pragma unroll
      for (int r = 3; r >= 0; --r) { a[1][r] = bf[1][r] ? __expf(ls[1][r] + ac) : 0.f; ac += lk[1][r]; } }
    { float ac = R + TT1 + H0;
#pragma unroll
      for (int r = 3; r >= 0; --r) { a[0][r] = bf[0][r] ? __expf(ls[0][r] + ac) : 0.f; ac += lk[0][r]; } }
    R = R + TT1 + TT0;
    const float ae[8] = {a[0][0], a[0][1], a[0][2], a[0][3], a[1][0], a[1][1], a[1][2], a[1][3]};
    const bf16x8 pf = pack8(ae);
#pragma unroll
    for (int dt = 0; dt < 4; ++dt) O[dt] = mfma16(vf[dt], pf, O[dt]);
    return __ballot(R > -50.f) == 0ull;
  };
  {
    int kb = (qpos0 + 14) >> 5;
    loadkv(kb, kfA, vfA);
    while (true) {
      if (kb >= 1) loadkv(kb - 1, kfB, vfB);
      if (comp(kb, kfA, vfA) || kb == 0) break;
      --kb;
      if (kb >= 1) loadkv(kb - 1, kfA, vfA);
      if (comp(kb, kfB, vfB) || kb == 0) break;
      --kb;
    }
  }
#pragma unroll
  for (int dt = 0; dt < 4; ++dt) {
    const size_t off = (size_t)(m0 + c) * 512 + h * 64 + dt * 16 + 4 * q4;
    const bf16x4 g = ld4((reinterpret_cast<bf16_t*>(p.ws + OFF_GA)) + off);
    st4((reinterpret_cast<bf16_t*>(p.ws + OFF_QA)) + off, pack4(O[dt][0] * bf2f(g[0]), O[dt][1] * bf2f(g[1]), O[dt][2] * bf2f(g[2]), O[dt][3] * bf2f(g[3])));
  }
}

template <int NK>
DI void topk_round(const unsigned short* Sh, int n_adm, int half, int l32, unsigned* bmrow) {
  unsigned key[NK];
#pragma unroll
  for (int i = 0; i < NK; ++i) {
    const int s = 32 * i + l32;
    const unsigned k = Sh[s];
    key[i] = (s < n_adm) ? k : 0u;
  }
  unsigned tau = 1u; int need = 0; bool done = true;
  if (n_adm > 256) {
    tau = 0u; done = false;
    for (int bit = 15; bit >= 0; --bit) {
      const unsigned cand = tau | (1u << bit);
      int cnt = 0;
#pragma unroll
      for (int i = 0; i < NK; ++i) cnt += (key[i] >= cand) ? 1 : 0;
      cnt = hsum32(cnt);
      if (!done && cnt >= 256) tau = cand;
      if (cnt == 256) done = true;
      if (__ballot(!done) == 0ull) break;
    }
  }
  unsigned w0 = 0u, w1 = 0u;
  if (__ballot(!done) == 0ull) {
#pragma unroll
    for (int i = 0; i < NK; ++i) {
      const unsigned long long msel = __ballot(key[i] >= tau);
      const unsigned wsel = half ? (unsigned)(msel >> 32) : (unsigned)msel;
      if (i < 32) { if (l32 == i) w0 = wsel; } else { if (l32 == i - 32) w1 = wsel; }
    }
  } else {
    int cgt = 0;
#pragma unroll
    for (int i = 0; i < NK; ++i) cgt += (key[i] > tau) ? 1 : 0;
    cgt = hsum32(cgt);
    need = 256 - cgt;
    int Rk = 0; const unsigned below = (1u << l32) - 1u;
#pragma unroll
    for (int i = 0; i < NK; ++i) {
      const bool eq = key[i] == tau, gt = key[i] > tau;
      const unsigned long long me = __ballot(eq);
      const unsigned hm = half ? (unsigned)(me >> 32) : (unsigned)me;
      const int rank = Rk + __popc(hm & below);
      const bool sel = done ? (key[i] >= tau) : (gt || (eq && rank < need));
      Rk += __popc(hm);
      const unsigned long long msel = __ballot(sel);
      const unsigned wsel = half ? (unsigned)(msel >> 32) : (unsigned)msel;
      if (i < 32) { if (l32 == i) w0 = wsel; } else { if (l32 == i - 32) w1 = wsel; }
    }
  }
  bmrow[l32] = w0;
  if (NK > 32) bmrow[32 + l32] = w1;
}

template <int grp>
DI void dsa_item(const Params& p, int b, int tile32, char* smem) {
  const int tid = otid(), w = tid >> 6, lane = tid & 63, c = lane & 15, q4 = lane >> 4, half = lane >> 5, l32 = lane & 31;
  unsigned* bm = reinterpret_cast<unsigned*>(smem + LDS_BM);
  const unsigned char* btab = reinterpret_cast<const unsigned char*>(smem + LDS_BTAB);
  const float* rb = reinterpret_cast<const float*>(smem + LDS_RB);
  const int T = grp ? LS : SEQ;
  const int t0 = tile32 * 32;
  const int qpos0 = grp ? PAST + t0 : t0;
  const int m0 = grp ? MP + b * DEC_SEQ + t0 : b * SEQ + t0;
  const int n_adm = grp ? LS : ((qpos0 >> 6) + 1) * 64;
  const bf16_t* KIb = (grp ? (reinterpret_cast<bf16_t*>(p.ws + OFF_KIS)) : (reinterpret_cast<bf16_t*>(p.ws + OFF_KIP))) + (size_t)b * T * 64;
  const bf16_t* KBb = (grp ? (reinterpret_cast<bf16_t*>(p.ws + OFF_KBS)) : (reinterpret_cast<bf16_t*>(p.ws + OFF_KBP))) + (size_t)b * T * 64;
  const bf16_t* VBTb = (grp ? (reinterpret_cast<bf16_t*>(p.ws + OFF_VBTS)) : (reinterpret_cast<bf16_t*>(p.ws + OFF_VBTP))) + (size_t)b * 64 * T;

  unsigned short* S16 = reinterpret_cast<unsigned short*>(smem) + w * 8192;
  {
    const int tlA = c >> 3, hA = c & 7, tlC = q4 >> 1;
    bf16x8 af[2][2]; float4 wv[2];
#pragma unroll
    for (int pr = 0; pr < 2; ++pr) {
      const bf16_t* qip = (reinterpret_cast<bf16_t*>(p.ws + OFF_QI)) + (size_t)(m0 + 4 * w + 2 * pr + tlA) * 512 + hA * 64 + q4 * 8;
      af[pr][0] = ld8(qip); af[pr][1] = ld8(qip + 32);
      wv[pr] = *reinterpret_cast<const float4*>((reinterpret_cast<float*>(p.ws + OFF_WI)) + (size_t)(m0 + 4 * w + 2 * pr + tlC) * 8 + 4 * (q4 & 1));
    }
    const int nch = n_adm >> 6;
    char* kis = smem + LDS_KI;
    const int lrow = tid >> 3, lseg = tid & 7;
    bf16x8 pre = ld8(KIb + (size_t)lrow * 64 + lseg * 8);
    *reinterpret_cast<bf16x8*>(kis + lrow * 144 + lseg * 16) = pre;
    __syncthreads();
    for (int ch = 0; ch < nch; ++ch) {
      const bool more = ch + 1 < nch;
      if (more) pre = ld8(KIb + (size_t)((ch + 1) * 64 + lrow) * 64 + lseg * 8);
      const char* cur = kis + (ch & 1) * 9216;
#pragma unroll
      for (int u = 0; u < 4; ++u) {
        const char* rp = cur + (u * 16 + c) * 144 + q4 * 16;
        const bf16x8 b0 = *reinterpret_cast<const bf16x8*>(rp), b1 = *reinterpret_cast<const bf16x8*>(rp + 64);
#pragma unroll
        for (int pr = 0; pr < 2; ++pr) {
          f32x4 C = mfma16(af[pr][0], b0, f32x4{0.f, 0.f, 0.f, 0.f});
          C = mfma16(af[pr][1], b1, C);
          const float part = wv[pr].x * fmaxf(C[0], 0.f) + wv[pr].y * fmaxf(C[1], 0.f) + wv[pr].z * fmaxf(C[2], 0.f) + wv[pr].w * fmaxf(C[3], 0.f);
          const F2 ps = swap16(part); const float full = ps.lo + ps.hi;
          const unsigned hu = (unsigned)__builtin_bit_cast(unsigned short, (_Float16)full);
          const unsigned hk = (hu & 0x8000u) ? (~hu & 0xFFFFu) : (hu | 0x8000u);
          if ((q4 & 1) == 0) S16[(2 * pr + tlC) * 2048 + (ch * 4 + u) * 16 + c] = (unsigned short)hk;
        }
      }
      if (more) *reinterpret_cast<bf16x8*>(kis + ((ch + 1) & 1) * 9216 + lrow * 144 + lseg * 16) = pre;
      __syncthreads();
    }
  }
  for (int rnd = 0; rnd < 2; ++rnd) {
    const unsigned short* Sh = S16 + (2 * rnd + half) * 2048;
    unsigned* bmrow = bm + (4 * w + 2 * rnd + half) * 64;
    const int nreg = n_adm >> 5;
    if (nreg <= 16) topk_round<16>(Sh, n_adm, half, l32, bmrow);
    else if (nreg <= 32) topk_round<32>(Sh, n_adm, half, l32, bmrow);
    else if (nreg <= 48) topk_round<48>(Sh, n_adm, half, l32, bmrow);
    else topk_round<64>(Sh, n_adm, half, l32, bmrow);
  }
  __syncthreads();

  {
    const int tl = c >> 3, h = c & 7;
    bf16x8 qf[2][2]; int qposc[2], qrow[2], qloc[2];
#pragma unroll
    for (int ct = 0; ct < 2; ++ct) {
      qloc[ct] = 4 * w + 2 * ct + tl; qrow[ct] = m0 + qloc[ct]; qposc[ct] = qpos0 + qloc[ct];
      const bf16_t* qp = (reinterpret_cast<bf16_t*>(p.ws + OFF_QB)) + (size_t)qrow[ct] * 512 + h * 64 + q4 * 8;
      qf[ct][0] = ld8(qp); qf[ct][1] = ld8(qp + 32);
    }
    f32x4 O[2][4]; float mrun[2] = {-1e30f, -1e30f}, lrun[2] = {0.f, 0.f};
#pragma unroll
    for (int ct = 0; ct < 2; ++ct)
#pragma unroll
      for (int dt = 0; dt < 4; ++dt) O[ct][dt] = f32x4{0.f, 0.f, 0.f, 0.f};
    const int nkb = n_adm >> 5;
    const float farbias = rb[15 * 8 + h];
    auto compkv = [&](auto FAR, int kb, const bf16x8 (&kf)[2][2], const bf16x8 (&vf)[4]) {
      constexpr bool far = decltype(FAR)::value;
      const int s0 = kb * 32;
#pragma unroll
      for (int ct = 0; ct < 2; ++ct) {
        f32x4 z0 = mfma16(kf[0][0], qf[ct][0], f32x4{0.f, 0.f, 0.f, 0.f}); z0 = mfma16(kf[0][1], qf[ct][1], z0);
        f32x4 z1 = mfma16(kf[1][0], qf[ct][0], f32x4{0.f, 0.f, 0.f, 0.f}); z1 = mfma16(kf[1][1], qf[ct][1], z1);
        const unsigned word = bm[qloc[ct] * 64 + kb];
        float zz[8]; bool bt[8]; float bmx = -1e30f;
#pragma unroll
        for (int e = 0; e < 8; ++e) {
          const int kt = e >> 2, r = e & 3;
          const int off = 16 * kt + 4 * q4 + r;
          float bias = farbias;
          if (!far) { const int rel = s0 + off - qposc[ct]; const int bk = btab[rel + 2047]; bias = rb[bk * 8 + h]; }
          const float zv = (kt ? z1[r] : z0[r]) * ATT_SCALE + bias;
          bt[e] = (word >> off) & 1u;
          zz[e] = bt[e] ? zv : -1e30f;
          bmx = fmaxf(bmx, zz[e]);
        }
        { const F2 m16 = swap16(bmx); bmx = fmaxf(m16.lo, m16.hi); const F2 m32 = swap32(bmx); bmx = fmaxf(m32.lo, m32.hi); }
        const float mnew = fmaxf(mrun[ct], bmx);
        const float sc = __expf(mrun[ct] - mnew);
        float ps = 0.f; float pe[8];
#pragma unroll
        for (int e = 0; e < 8; ++e) { pe[e] = bt[e] ? __expf(zz[e] - mnew) : 0.f; ps += pe[e]; }
        lrun[ct] = lrun[ct] * sc + ps; mrun[ct] = mnew;
        const bf16x8 pf = pack8(pe);
#pragma unroll
        for (int dt = 0; dt < 4; ++dt) { O[ct][dt] *= sc; O[ct][dt] = mfma16(vf[dt], pf, O[ct][dt]); }
      }
    };
    int nfar = (qpos0 - 159) >= 0 ? ((qpos0 - 159) >> 5) + 1 : 0;
    nfar = nfar < nkb ? nfar : nkb;
    char* kd = smem; char* vd = smem + 9216;
    const bool isK = tid < 256; const int t2 = tid & 255;
    const int krow = t2 >> 3, kseg = t2 & 7, vrow = t2 >> 2, vseg = t2 & 3;
    auto gload = [&](int kb) -> bf16x8 {
      const int s0 = kb * 32;
      return isK ? ld8(KBb + (size_t)(s0 + krow) * 64 + kseg * 8) : ld8(VBTb + (size_t)vrow * T + s0 + vseg * 8);
    };
    auto lstore = [&](int buf, const bf16x8 v) {
      if (isK) *reinterpret_cast<bf16x8*>(kd + buf * 4608 + krow * 144 + kseg * 16) = v;
      else *reinterpret_cast<bf16x8*>(vd + buf * 5120 + vrow * 80 + vseg * 16) = v;
    };
    bf16x8 pre = gload(0);
    lstore(0, pre);
    __syncthreads();
    for (int kb = 0; kb < nkb; ++kb) {
      const bool more = kb + 1 < nkb;
      if (more) pre = gload(kb + 1);
      const char* kc = kd + (kb & 1) * 4608; const char* vc = vd + (kb & 1) * 5120;
      bf16x8 kf[2][2], vf[4];
#pragma unroll
      for (int kt = 0; kt < 2; ++kt)
#pragma unroll
        for (int kk = 0; kk < 2; ++kk) kf[kt][kk] = *reinterpret_cast<const bf16x8*>(kc + (16 * kt + c) * 144 + kk * 64 + q4 * 16);
#pragma unroll
      for (int dt = 0; dt < 4; ++dt) {
        const char* vp = vc + (16 * dt + c) * 80 + q4 * 8;
        const bf16x4 lo = *reinterpret_cast<const bf16x4*>(vp), hi = *reinterpret_cast<const bf16x4*>(vp + 32);
        vf[dt] = __builtin_shufflevector(lo, hi, 0, 1, 2, 3, 4, 5, 6, 7);
      }
      if (kb < nfar) compkv(std::true_type{}, kb, kf, vf); else compkv(std::false_type{}, kb, kf, vf);
      if (more) lstore((kb + 1) & 1, pre);
      __syncthreads();
    }
#pragma unroll
    for (int ct = 0; ct < 2; ++ct) {
      float lt = lrun[ct]; { const F2 a = swap16(lt); lt = a.lo + a.hi; const F2 b = swap32(lt); lt = b.lo + b.hi; }
      const float inv = 1.f / lt;
#pragma unroll
      for (int dt = 0; dt < 4; ++dt) {
        const size_t off = (size_t)qrow[ct] * 512 + h * 64 + dt * 16 + 4 * q4;
        const bf16x4 g = ld4((reinterpret_cast<bf16_t*>(p.ws + OFF_GB)) + off);
        st4((reinterpret_cast<bf16_t*>(p.ws + OFF_QB)) + off, pack4(O[ct][dt][0] * inv * bf2f(g[0]), O[ct][dt][1] * inv * bf2f(g[1]), O[ct][dt][2] * inv * bf2f(g[2]), O[ct][dt][3] * inv * bf2f(g[3])));
      }
    }
  }
  __syncthreads();
}

DI void phase_attn(const Params& p, int layer, char* smem) {
  const int tid = otid();
  for (int i = tid; i < 4096; i += NTHREADS) smem[LDS_BTAB + i] = (char)(reinterpret_cast<unsigned char*>(p.ws + OFF_BTAB))[i];
  if (tid < 256) reinterpret_cast<float*>(smem + LDS_RB)[tid] = p.rel_bias[tid];
  __syncthreads();
  int* slot = reinterpret_cast<int*>(smem + LDS_SLOT);
  const int w = tid >> 6;
  const int total = 16 + 2048 + 32 + 4096;
  if (tid == 0) *slot = atomicAdd(&(reinterpret_cast<int*>(p.ws + OFF_CTR))[layer], 1);
  __syncthreads();
  int item = *slot;
  while (item < total) {
    int nxt = 0;
    if (tid == 0) nxt = atomicAdd(&(reinterpret_cast<int*>(p.ws + OFF_CTR))[layer], 1);
    if (item < 16) dsa_item<1>(p, item >> 1, item & 1, smem);
    else if (item < 2064) { const int i = item - 16; dsa_item<0>(p, i >> 6, 63 - (i & 63), smem); }
    else if (item < 2096) { const int i = item - 2064; sb_item<1>(p, i >> 2, 2 * (i & 3) + (w >> 2), (w & 3) * 16); }
    else { const int i = item - 2096; const int tile = 15 - (i >> 8), bh = i & 255; sb_item<0>(p, bh >> 3, bh & 7, tile * 128 + w * 16); }
    __syncthreads();
    if (tid == 0) *slot = nxt;
    __syncthreads();
    item = *slot;
  }
}

DI void phase_ln(const Params& p, int layer, char* smem) {
  const int tid = otid(), lane = tid & 63;
  {
    const int stride = gridDim.x * NWAVES;
    const float* g = p.ln_g + layer * 1024; const float* b = p.ln_b + layer * 1024;
    for (int row = blockIdx.x * NWAVES + (tid >> 6); row < MT; row += 2 * stride) {
      const int row2 = row + stride;
      if (row2 < MT) ln_rows2(p.out + (size_t)row * 1024, p.out + (size_t)row2 * 1024, g, b, p.out + (size_t)row * 1024, (reinterpret_cast<bf16_t*>(p.ws + OFF_XB)) + (size_t)row * 1024, p.out + (size_t)row2 * 1024, (reinterpret_cast<bf16_t*>(p.ws + OFF_XB)) + (size_t)row2 * 1024, lane);
      else ln_row_wave(p.out + (size_t)row * 1024, g, b, p.out + (size_t)row * 1024, (reinterpret_cast<bf16_t*>(p.ws + OFF_XB)) + (size_t)row * 1024, lane);
    }
  }
  if (layer + 1 < DEPTH) convert_layer(p, layer + 1, smem);
}

__global__ void __launch_bounds__(512, 2) mega_kernel(Params p) {
  extern __shared__ __attribute__((aligned(16))) char smem[];
  cg::grid_group grid = cg::this_grid();
  phase_prologue(p, smem);
  grid.sync();
  unsigned* bar = reinterpret_cast<unsigned*>((reinterpret_cast<int*>(p.ws + OFF_CTR)) + 8);
  unsigned nb = 0; const unsigned G = gridDim.x;
#pragma nounroll
  for (int l = 0; l < DEPTH; ++l) {
    phase_proj(p, l, smem);
    gbar(bar, ++nb * G);
    phase_attn(p, l, smem);
    gbar(bar, ++nb * G);
    phase_merge_a(p, smem);
    phase_merge_b(p, smem);
    gbar(bar, ++nb * G);
    phase_out(p, smem);
    gbar(bar, ++nb * G);
    phase_ln(p, l, smem);
    if (l + 1 < DEPTH) gbar(bar, ++nb * G);
  }
}

#if !USE_COOP
__global__ void __launch_bounds__(512, 2) phase_kernel(Params p, int phase, int layer) {
  extern __shared__ __attribute__((aligned(16))) char smem[];
  if (phase == 0) phase_prologue(p, smem);
  else if (phase == 1) phase_proj(p, layer, smem);
  else if (phase == 2) phase_attn(p, layer, smem);
  else if (phase == 3) phase_merge_a(p, smem);
  else if (phase == 4) phase_merge_b(p, smem);
  else if (phase == 5) phase_out(p, smem);
  else phase_ln(p, layer, smem);
}

#endif

extern "C" void kernel_launch(void* const* d_in, const int* in_sizes, int n_in, void* d_out, int out_size, void* d_ws, size_t ws_size, hipStream_t stream) {
  static int grid_blocks = 0;
  if (grid_blocks == 0) {
    if (n_in != 17 || out_size != OUT_TOTAL) { fprintf(stderr, "kernel_launch: unexpected shapes n_in=%d out=%d\n", n_in, out_size); grid_blocks = -1; return; }
    int dev = 0, cus = 0, per_cu = 0;
    hipGetDevice(&dev);
    hipDeviceGetAttribute(&cus, hipDeviceAttributeMultiprocessorCount, dev);
    hipFuncSetAttribute((const void*)mega_kernel, hipFuncAttributeMaxDynamicSharedMemorySize, LDS_BYTES);
#if !USE_COOP
    hipFuncSetAttribute((const void*)phase_kernel, hipFuncAttributeMaxDynamicSharedMemorySize, LDS_BYTES);
#endif
    hipOccupancyMaxActiveBlocksPerMultiprocessor(&per_cu, (const void*)mega_kernel, NTHREADS, LDS_BYTES);
    if (per_cu < 1) per_cu = 1;
    if (per_cu > 1) per_cu = 1;
    grid_blocks = cus * per_cu;
    fprintf(stderr, "kernel_launch: cus=%d per_cu=%d grid=%d ws=%zu\n", cus, per_cu, grid_blocks, ws_size);
  }
  if (grid_blocks < 0) return;
  Params p{};
  p.x_prompt = (const float*)d_in[0]; p.x_sample = (const float*)d_in[1];
  p.c_sb_k = (const float*)d_in[2]; p.c_sb_v = (const float*)d_in[3]; p.c_dsa_k = (const float*)d_in[4]; p.c_dsa_v = (const float*)d_in[5]; p.c_idx_k = (const float*)d_in[6];
  p.ln_in_g = (const float*)d_in[7]; p.ln_in_b = (const float*)d_in[8]; p.w_in = (const float*)d_in[9]; p.b_in = (const float*)d_in[10];
  p.w_pa = (const float*)d_in[11]; p.w_pb = (const float*)d_in[12]; p.w_out = (const float*)d_in[13]; p.ln_g = (const float*)d_in[14]; p.ln_b = (const float*)d_in[15];
  p.rel_bias = (const float*)d_in[16];
  p.out = (float*)d_out;
  p.ws = (char*)d_ws;
  if (OFF_END > ws_size) { fprintf(stderr, "kernel_launch: workspace too small: need %zu have %zu\n", (size_t)OFF_END, ws_size); return; }
#if USE_COOP
  void* args[] = {&p};
  hipError_t e = hipLaunchCooperativeKernel((const void*)mega_kernel, dim3(grid_blocks), dim3(NTHREADS), args, LDS_BYTES, stream);
  if (e != hipSuccess) fprintf(stderr, "cooperative launch failed: %s (grid %d)\n", hipGetErrorString(e), grid_blocks);
#else
  hipLaunchKernelGGL(phase_kernel, dim3(grid_blocks), dim3(NTHREADS), LDS_BYTES, stream, p, 0, 0);
  for (int l = 0; l < DEPTH; ++l)
    for (int ph = 1; ph <= 6; ++ph) hipLaunchKernelGGL(phase_kernel, dim3(grid_blocks), dim3(NTHREADS), LDS_BYTES, stream, p, ph, l);
#endif
}
```

```cpp
#include <hip/hip_runtime.h>
#include <hip/hip_cooperative_groups.h>
#include <cstdio>
#include <type_traits>
namespace cg = cooperative_groups;

#ifndef USE_COOP
#define USE_COOP 1
#endif

#define DI __device__ __forceinline__
typedef unsigned short bf16_t;
using bf16x8 = __attribute__((ext_vector_type(8))) short;
using bf16x4 = __attribute__((ext_vector_type(4))) short;
using f32x4  = __attribute__((ext_vector_type(4))) float;

constexpr int D_MODEL = 1024, BATCH = 32, SEQ = 2048, DEPTH = 4, DEC_BATCH = 8, DEC_SEQ = 64, PAST = 1024, LS = 1088;
constexpr int MP = BATCH * SEQ;
constexpr int MS = DEC_BATCH * DEC_SEQ;
constexpr int MT = MP + MS;
constexpr int D_IN = 5832, D_INP = 5888;
constexpr float LN_EPS = 1e-5f;
constexpr float ALPHA = 1.681792830507429f;
constexpr float SB_SCALE = 0.125f, ATT_SCALE = 0.125f;
constexpr int NTHREADS = 512, NWAVES = 8;
constexpr int LDS_S = 0, LDS_BM = 131072, LDS_BTAB = 139264, LDS_RB = 143360, LDS_SLOT = 144384, LDS_KI = 144448, LDS_BYTES = 162880;

constexpr size_t O_Y = 0, O_KAP = 67633152, O_VAP = 201850880, O_KBP = 336068608, O_VBP = 352845824, O_KIP = 369623040,
                 O_KAS = 386400256, O_VAS = 387448832, O_KBS = 388497408, O_VBS = 388628480, O_KIS = 388759552;
constexpr int OUT_TOTAL = 388890624;

constexpr size_t al256(size_t x) { return (x + 255) & ~(size_t)255; }
constexpr size_t OFF_XB = 0;
constexpr size_t OFF_QA = OFF_XB + al256((size_t)MT * 1024 * 2);
constexpr size_t OFF_GA = OFF_QA + al256((size_t)MT * 512 * 2);
constexpr size_t OFF_GB = OFF_GA + al256((size_t)MT * 512 * 2);
constexpr size_t OFF_QB = OFF_GB + al256((size_t)MT * 512 * 2);
constexpr size_t OFF_QI = OFF_QB + al256((size_t)MT * 512 * 2);
constexpr size_t OFF_KAP = OFF_QI + al256((size_t)MT * 512 * 2);
constexpr size_t OFF_VATP = OFF_KAP + al256((size_t)MP * 512 * 2);
constexpr size_t OFF_KAS = OFF_VATP + al256((size_t)MP * 512 * 2);
constexpr size_t OFF_VATS = OFF_KAS + al256((size_t)8 * LS * 512 * 2);
constexpr size_t OFF_KBP = OFF_VATS + al256((size_t)8 * LS * 512 * 2);
constexpr size_t OFF_VBTP = OFF_KBP + al256((size_t)MP * 64 * 2);
constexpr size_t OFF_KIP = OFF_VBTP + al256((size_t)MP * 64 * 2);
constexpr size_t OFF_KBS = OFF_KIP + al256((size_t)MP * 64 * 2);
constexpr size_t OFF_VBTS = OFF_KBS + al256((size_t)8 * LS * 64 * 2);
constexpr size_t OFF_KIS = OFF_VBTS + al256((size_t)8 * LS * 64 * 2);
constexpr size_t OFF_WI = OFF_KIS + al256((size_t)8 * LS * 64 * 2);
constexpr size_t OFF_RA = OFF_WI + al256((size_t)MT * 8 * 4);
constexpr size_t OFF_RB = OFF_RA + al256((size_t)MT * 1024 * 2);
constexpr size_t OFF_WINT = OFF_RB + al256((size_t)MT * 1024 * 2);
constexpr size_t OFF_WPAT = OFF_WINT + al256((size_t)D_INP * 1024 * 2);
constexpr size_t OFF_WPBT = OFF_WPAT + al256((size_t)1024 * 512 * 2);
constexpr size_t OFF_WOUTT = OFF_WPBT + al256((size_t)1024 * 512 * 2);
constexpr size_t OFF_BTAB = OFF_WOUTT + al256((size_t)1024 * 1024 * 2);
constexpr size_t OFF_CTR = OFF_BTAB + 4096;
constexpr size_t OFF_END = OFF_CTR + 256;

struct Params {
  const float* x_prompt; const float* x_sample;
  const float* c_sb_k; const float* c_sb_v; const float* c_dsa_k; const float* c_dsa_v; const float* c_idx_k;
  const float* ln_in_g; const float* ln_in_b; const float* w_in; const float* b_in; const float* w_pa; const float* w_pb;
  const float* w_out; const float* ln_g; const float* ln_b; const float* rel_bias;
  float* out; char* ws;
};

DI unsigned short f2bf(float x) { unsigned u = __float_as_uint(x); u += 0x7fffu + ((u >> 16) & 1u); return (unsigned short)(u >> 16); }
DI float bf2f(short h) { return __uint_as_float(((unsigned)(unsigned short)h) << 16); }
typedef __bf16 hbf16x2 __attribute__((ext_vector_type(2)));
typedef float f32x2v __attribute__((ext_vector_type(2)));
typedef unsigned u32x2v __attribute__((ext_vector_type(2)));
typedef unsigned u32x4v __attribute__((ext_vector_type(4)));
DI unsigned pk2(float lo, float hi) { f32x2v v; v.x = lo; v.y = hi; return __builtin_bit_cast(unsigned, __builtin_convertvector(v, hbf16x2)); }
DI bf16x4 pack4(float a, float b, float c, float d) { u32x2v u; u.x = pk2(a, b); u.y = pk2(c, d); return __builtin_bit_cast(bf16x4, u); }
DI bf16x8 pack8(const float (&e)[8]) { u32x4v u; u.x = pk2(e[0], e[1]); u.y = pk2(e[2], e[3]); u.z = pk2(e[4], e[5]); u.w = pk2(e[6], e[7]); return __builtin_bit_cast(bf16x8, u); }
DI bf16x8 ld8(const bf16_t* p) { return *reinterpret_cast<const bf16x8*>(p); }
DI bf16x4 ld4(const bf16_t* p) { return *reinterpret_cast<const bf16x4*>(p); }
DI void st4(bf16_t* p, bf16x4 v) { *reinterpret_cast<bf16x4*>(p) = v; }
DI f32x4 mfma16(bf16x8 a, bf16x8 b, f32x4 c) { return __builtin_amdgcn_mfma_f32_16x16x32_bf16(a, b, c, 0, 0, 0); }
DI int otid() { int t = threadIdx.x; asm volatile("" : "+v"(t)); return t; }
DI int osg(int v) { asm volatile("" : "+s"(v)); return v; }
DI float sigmoidf_(float x) { return __builtin_amdgcn_rcpf(1.f + __expf(-x)); }
struct F2 { float lo, hi; };
DI F2 swap16(float x) { const unsigned u = __float_as_uint(x); auto r = __builtin_amdgcn_permlane16_swap(u, u, false, false); return F2{__uint_as_float(r[0]), __uint_as_float(r[1])}; }
DI F2 swap32(float x) { const unsigned u = __float_as_uint(x); auto r = __builtin_amdgcn_permlane32_swap(u, u, false, false); return F2{__uint_as_float(r[0]), __uint_as_float(r[1])}; }
DI float row_sum16(float x) {
  x += __uint_as_float(__builtin_amdgcn_update_dpp(0, __float_as_uint(x), 0xB1, 0xF, 0xF, true));
  x += __uint_as_float(__builtin_amdgcn_update_dpp(0, __float_as_uint(x), 0x4E, 0xF, 0xF, true));
  x += __uint_as_float(__builtin_amdgcn_update_dpp(0, __float_as_uint(x), 0x141, 0xF, 0xF, true));
  x += __uint_as_float(__builtin_amdgcn_update_dpp(0, __float_as_uint(x), 0x140, 0xF, 0xF, true));
  return x;
}
DI float wave_sum(float x) { x = row_sum16(x); F2 a = swap16(x); x = a.lo + a.hi; F2 b = swap32(x); return b.lo + b.hi; }
DI int hsum32(int x) {
  x += __builtin_amdgcn_update_dpp(0, x, 0xB1, 0xF, 0xF, true);
  x += __builtin_amdgcn_update_dpp(0, x, 0x4E, 0xF, 0xF, true);
  x += __builtin_amdgcn_update_dpp(0, x, 0x141, 0xF, 0xF, true);
  x += __builtin_amdgcn_update_dpp(0, x, 0x140, 0xF, 0xF, true);
  auto r = __builtin_amdgcn_permlane16_swap((unsigned)x, (unsigned)x, false, false);
  return (int)(r[0] + r[1]);
}
DI void gbar(unsigned* ctr, unsigned target) {
  asm volatile("s_waitcnt vmcnt(0)" ::: "memory");
  __syncthreads();
  if (otid() == 0) {
    __builtin_amdgcn_fence(__ATOMIC_RELEASE, "agent");
    asm volatile("s_waitcnt vmcnt(0)" ::: "memory");
    __hip_atomic_fetch_add(ctr, 1u, __ATOMIC_RELAXED, __HIP_MEMORY_SCOPE_AGENT);
    while (__hip_atomic_load(ctr, __ATOMIC_RELAXED, __HIP_MEMORY_SCOPE_AGENT) < target) __builtin_amdgcn_s_sleep(2);
    __builtin_amdgcn_fence(__ATOMIC_ACQUIRE, "agent");
    asm volatile("s_waitcnt vmcnt(0)" ::: "memory");
  }
  __syncthreads();
}

DI void ln_row_wave(const float* src, const float* g, const float* b, float* d32, bf16_t* db, int lane) {
  float4 v[4]; float s = 0.f;
#pragma unroll
  for (int i = 0; i < 4; ++i) { v[i] = reinterpret_cast<const float4*>(src)[lane + 64 * i]; s += v[i].x + v[i].y + v[i].z + v[i].w; }
  s = wave_sum(s);
  const float mu = s * (1.f / 1024.f);
  float q = 0.f;
#pragma unroll
  for (int i = 0; i < 4; ++i) { float a = v[i].x - mu, bb = v[i].y - mu, c = v[i].z - mu, d = v[i].w - mu; q += a * a + bb * bb + c * c + d * d; }
  q = wave_sum(q);
  const float rstd = rsqrtf(q * (1.f / 1024.f) + LN_EPS);
#pragma unroll
  for (int i = 0; i < 4; ++i) {
    float4 gg = reinterpret_cast<const float4*>(g)[lane + 64 * i], bb = reinterpret_cast<const float4*>(b)[lane + 64 * i];
    float4 o;
    o.x = (v[i].x - mu) * rstd * gg.x + bb.x; o.y = (v[i].y - mu) * rstd * gg.y + bb.y;
    o.z = (v[i].z - mu) * rstd * gg.z + bb.z; o.w = (v[i].w - mu) * rstd * gg.w + bb.w;
    reinterpret_cast<float4*>(d32)[lane + 64 * i] = o;
    st4(db + 4 * (lane + 64 * i), pack4(o.x, o.y, o.z, o.w));
  }
}

DI void ln_rows2(const float* s0, const float* s1, const float* g, const float* b, float* d0, bf16_t* db0, float* d1, bf16_t* db1, int lane) {
  float4 v0[4], v1[4]; float a0 = 0.f, a1 = 0.f;
#pragma unroll
  for (int i = 0; i < 4; ++i) { v0[i] = reinterpret_cast<const float4*>(s0)[lane + 64 * i]; v1[i] = reinterpret_cast<const float4*>(s1)[lane + 64 * i]; }
#pragma unroll
  for (int i = 0; i < 4; ++i) { a0 += v0[i].x + v0[i].y + v0[i].z + v0[i].w; a1 += v1[i].x + v1[i].y + v1[i].z + v1[i].w; }
  a0 = wave_sum(a0); a1 = wave_sum(a1);
  const float mu0 = a0 * (1.f / 1024.f), mu1 = a1 * (1.f / 1024.f);
  float q0 = 0.f, q1 = 0.f;
#pragma unroll
  for (int i = 0; i < 4; ++i) {
    { float a = v0[i].x - mu0, bb = v0[i].y - mu0, c = v0[i].z - mu0, d = v0[i].w - mu0; q0 += a * a + bb * bb + c * c + d * d; }
    { float a = v1[i].x - mu1, bb = v1[i].y - mu1, c = v1[i].z - mu1, d = v1[i].w - mu1; q1 += a * a + bb * bb + c * c + d * d; }
  }
  q0 = wave_sum(q0); q1 = wave_sum(q1);
  const float r0 = rsqrtf(q0 * (1.f / 1024.f) + LN_EPS), r1 = rsqrtf(q1 * (1.f / 1024.f) + LN_EPS);
#pragma unroll
  for (int i = 0; i < 4; ++i) {
    const float4 gg = reinterpret_cast<const float4*>(g)[lane + 64 * i], bb = reinterpret_cast<const float4*>(b)[lane + 64 * i];
    float4 o;
    o.x = (v0[i].x - mu0) * r0 * gg.x + bb.x; o.y = (v0[i].y - mu0) * r0 * gg.y + bb.y; o.z = (v0[i].z - mu0) * r0 * gg.z + bb.z; o.w = (v0[i].w - mu0) * r0 * gg.w + bb.w;
    reinterpret_cast<float4*>(d0)[lane + 64 * i] = o; st4(db0 + 4 * (lane + 64 * i), pack4(o.x, o.y, o.z, o.w));
    o.x = (v1[i].x - mu1) * r1 * gg.x + bb.x; o.y = (v1[i].y - mu1) * r1 * gg.y + bb.y; o.z = (v1[i].z - mu1) * r1 * gg.z + bb.z; o.w = (v1[i].w - mu1) * r1 * gg.w + bb.w;
    reinterpret_cast<float4*>(d1)[lane + 64 * i] = o; st4(db1 + 4 * (lane + 64 * i), pack4(o.x, o.y, o.z, o.w));
  }
}

DI void tconv_tile(const float* src, int ldsrc, int K, bf16_t* dst, int n0, int k0, bool winmap, float* tile) {
  const int tid = otid();
#pragma unroll
  for (int rr = 0; rr < 8; ++rr) {
    const int kl = rr * 8 + (tid >> 6), nl = tid & 63, np = n0 + nl;
    int n = np; bool ok = true;
    if (winmap) { if (np >= 3840) n = np - 56; else if (np >= 3784) ok = false; }
    tile[kl * 65 + nl] = ok ? src[(size_t)(k0 + kl) * ldsrc + n] : 0.f;
  }
  __syncthreads();
#pragma unroll
  for (int rr = 0; rr < 8; ++rr) {
    const int nl = rr * 8 + (tid >> 6), kl = tid & 63;
    dst[(size_t)(n0 + nl) * K + k0 + kl] = f2bf(tile[kl * 65 + nl]);
  }
  __syncthreads();
}

DI void convert_layer(const Params& p, int l, char* smem) {
  float* tile = reinterpret_cast<float*>(smem);
  const int G = gridDim.x;
  for (int it = blockIdx.x; it < 1984; it += G) {
    if (it < 1472) { int nt = it >> 4, kt = it & 15; tconv_tile(p.w_in + (size_t)l * 1024 * D_IN, D_IN, 1024, (reinterpret_cast<bf16_t*>(p.ws + OFF_WINT)), nt * 64, kt * 64, true, tile); }
    else if (it < 1600) { int i = it - 1472; int nt = i >> 3, kt = i & 7; tconv_tile(p.w_pa + (size_t)l * 512 * 1024, 1024, 512, (reinterpret_cast<bf16_t*>(p.ws + OFF_WPAT)), nt * 64, kt * 64, false, tile); }
    else if (it < 1728) { int i = it - 1600; int nt = i >> 3, kt = i & 7; tconv_tile(p.w_pb + (size_t)l * 512 * 1024, 1024, 512, (reinterpret_cast<bf16_t*>(p.ws + OFF_WPBT)), nt * 64, kt * 64, false, tile); }
    else { int i = it - 1728; int nt = i >> 4, kt = i & 15; tconv_tile(p.w_out + (size_t)l * 1024 * 1024, 1024, 1024, (reinterpret_cast<bf16_t*>(p.ws + OFF_WOUTT)), nt * 64, kt * 64, false, tile); }
  }
  const int gtid = blockIdx.x * NTHREADS + otid(), gn = G * NTHREADS;
#pragma unroll 4
  for (int idx = gtid; idx < 8 * 1024 * 512; idx += gn) {
    int b = idx >> 19, rem = idx & ((1 << 19) - 1);
    (reinterpret_cast<bf16_t*>(p.ws + OFF_KAS))[(size_t)b * LS * 512 + rem] = f2bf(p.c_sb_k[(size_t)l * 8 * 1024 * 512 + idx]);
  }
#pragma unroll 4
  for (int idx = gtid; idx < 8 * 512 * 1024; idx += gn) {
    int b = idx >> 19, hd = (idx >> 10) & 511, t = idx & 1023;
    (reinterpret_cast<bf16_t*>(p.ws + OFF_VATS))[((size_t)b * 512 + hd) * LS + t] = f2bf(p.c_sb_v[(((size_t)l * 8 + b) * 1024 + t) * 512 + hd]);
  }
  for (int idx = gtid; idx < 8 * 1024 * 64; idx += gn) {
    int b = idx >> 16, rem = idx & 65535;
    (reinterpret_cast<bf16_t*>(p.ws + OFF_KBS))[(size_t)b * LS * 64 + rem] = f2bf(p.c_dsa_k[(size_t)l * 8 * 65536 + idx]);
    (reinterpret_cast<bf16_t*>(p.ws + OFF_KIS))[(size_t)b * LS * 64 + rem] = f2bf(p.c_idx_k[(size_t)l * 8 * 65536 + idx]);
    int d = (idx >> 10) & 63, t = idx & 1023;
    (reinterpret_cast<bf16_t*>(p.ws + OFF_VBTS))[((size_t)b * 64 + d) * LS + t] = f2bf(p.c_dsa_v[(((size_t)l * 8 + b) * 1024 + t) * 64 + d]);
  }
}

DI void phase_prologue(const Params& p, char* smem) {
  const int tid = otid(), lane = tid & 63;
  if (blockIdx.x == 0 && tid < 16) (reinterpret_cast<int*>(p.ws + OFF_CTR))[tid] = 0;
  for (int i = blockIdx.x * NTHREADS + tid; i < 4096; i += gridDim.x * NTHREADS) {
    int rel = i - 2047; int n = rel < 0 ? -rel : rel;
    float nf = (float)(n > 1 ? n : 1);
    int large = 8 + (int)(logf(nf / 8.f) / 2.7725887f * 8.f);
    large = large < 15 ? large : 15;
    int bk = (rel > 0 ? 16 : 0) + (n < 8 ? n : large);
    (reinterpret_cast<unsigned char*>(p.ws + OFF_BTAB))[i] = (unsigned char)bk;
  }
  {
    const int stride = gridDim.x * NWAVES;
    for (int row = blockIdx.x * NWAVES + (tid >> 6); row < MT; row += 2 * stride) {
      const int row2 = row + stride;
      const float* src = row < MP ? p.x_prompt + (size_t)row * 1024 : p.x_sample + (size_t)(row - MP) * 1024;
      if (row2 < MT) {
        const float* src2 = row2 < MP ? p.x_prompt + (size_t)row2 * 1024 : p.x_sample + (size_t)(row2 - MP) * 1024;
        ln_rows2(src, src2, p.ln_in_g, p.ln_in_b, p.out + (size_t)row * 1024, (reinterpret_cast<bf16_t*>(p.ws + OFF_XB)) + (size_t)row * 1024, p.out + (size_t)row2 * 1024, (reinterpret_cast<bf16_t*>(p.ws + OFF_XB)) + (size_t)row2 * 1024, lane);
      } else ln_row_wave(src, p.ln_in_g, p.ln_in_b, p.out + (size_t)row * 1024, (reinterpret_cast<bf16_t*>(p.ws + OFF_XB)) + (size_t)row * 1024, lane);
    }
  }
  convert_layer(p, 0, smem);
}


namespace pg8 {
#define PG8_LAS __attribute__((address_space(3)))
constexpr int BM = 256, BK = 64, HALF = 128, HTB = HALF * BK * 2, STAGE_BYTES = 8 * HTB, NXCD = 8, WGM = 8;
DI int lds_byte(int r, int c) { const int st = (r >> 4) * 2 + (c >> 5), rr = r & 15, cc = c & 31, ob = rr * 64 + cc * 2; return st * 1024 + (ob ^ (((ob >> 9) & 1) << 5)); }
DI void stage_rc(int b, int& R, int& C) { const int st = b / 1024, sb = b % 1024, swz = sb ^ (((sb >> 9) & 1) << 5); R = (st >> 1) * 16 + swz / 64; C = (st & 1) * 32 + (swz % 64) / 2; }
DI int perm32(int rho) { const int n = rho >> 4, i = rho & 15; return 8 * (i >> 2) + 4 * n + (i & 3); }
struct Unit { int pm, pn; };
struct Gemm { const bf16_t* A; const bf16_t* Bt; int M, N, K; };
struct StaticOrder {
    int nM, nN, nwg, G, c;
    DI void init(int M, int N, int G_, int c_) { nM = M / BM; nN = N / BM; nwg = nM * nN; G = G_; c = c_; }
    DI bool next(int i, Unit& u) const {
        const long L = (long)i * G + c; if (L >= nwg) return false;
        int wgid = (int)L; { const int q = nwg / NXCD, r = nwg % NXCD, xcd = wgid % NXCD, off = wgid / NXCD; wgid = (xcd < r ? xcd * (q + 1) : r * (q + 1) + (xcd - r) * q) + off; }
        const int nig = WGM * nN, gid = wgid / nig, fm = gid * WGM, gsz = (nM - fm) < WGM ? (nM - fm) : WGM;
        u.pm = fm + ((wgid % nig) % gsz); u.pn = (wgid % nig) / gsz; return true;
    }
    DI void a_ready(const Unit&) const {}
    DI void done(const Unit&) const {}
};
template <class Epi, class Sched>
__device__ __forceinline__ void gemm_phase(PG8_LAS unsigned char* lds, const Gemm g, const Sched& S, const Epi& E) {
    const int tid = otid(), wid = __builtin_amdgcn_readfirstlane(tid >> 6), lane = tid & 63, wr = wid >> 2, wc = wid & 3, fr = lane & 15, fq = lane >> 4;
    const int K = g.K, nt = K / BK;
    unsigned voffA[2], voffB[2];
#pragma unroll
    for (int i = 0; i < 2; ++i) { int R, C; stage_rc(tid * 16 + i * 8192, R, C); const int Rb = Epi::PERM ? ((R & ~31) + perm32(R & 31)) : R;
        voffA[i] = (unsigned)(R * K + C) * 2u; voffB[i] = (unsigned)(Rb * K + C) * 2u; }
    const size_t kstep = (size_t)(BK * 2);
    const size_t hstep = (size_t)HALF * K * 2;
    const size_t tstep = 2 * hstep;
    const unsigned ldsw = (unsigned)wid * 1024u;
    const int aoff = lds_byte(wr * 64 + fr, fq * 8), boff = lds_byte(wc * 32 + fr, fq * 8);
#define PG8_SA(b, h) (((b) * 2 + (h)) * HTB)
#define PG8_SB(b, h) ((4 + (b) * 2 + (h)) * HTB)
#define PG8_STAGE(bufoff, gbase, voff) do { _Pragma("unroll") for (int _i = 0; _i < 2; ++_i) \
        __builtin_amdgcn_global_load_lds((const unsigned*)((const char*)(gbase) + (voff)[_i]), (PG8_LAS unsigned*)(lds + (bufoff) + ldsw + _i * 8192), 16, 0, 0); } while (0)
#define PG8_LDA(dst, b, h) do { _Pragma("unroll") for (int m = 0; m < 4; ++m) _Pragma("unroll") for (int k = 0; k < 2; ++k) dst[m][k] = *(const PG8_LAS bf16x8*)(lds + PG8_SA(b, h) + aoff + m * 2048 + k * 1024); } while (0)
#define PG8_LDB(dst, b, h) do { _Pragma("unroll") for (int n = 0; n < 2; ++n) _Pragma("unroll") for (int k = 0; k < 2; ++k) dst[n][k] = *(const PG8_LAS bf16x8*)(lds + PG8_SB(b, h) + boff + n * 2048 + k * 1024); } while (0)
#define PG8_MMA(ai, bj, At, Bt) do { __builtin_amdgcn_s_setprio(1); _Pragma("unroll") for (int m = 0; m < 4; ++m) _Pragma("unroll") for (int n = 0; n < 2; ++n) _Pragma("unroll") for (int k = 0; k < 2; ++k) \
        acc[ai][bj][m][n] = __builtin_amdgcn_mfma_f32_16x16x32_bf16(Bt[n][k], At[m][k], acc[ai][bj][m][n], 0, 0, 0); __builtin_amdgcn_s_setprio(0); } while (0)
#define PG8_WAIT_V(n) asm volatile("s_waitcnt vmcnt(" #n ")" ::: "memory")
#define PG8_WAIT_L(n) asm volatile("s_waitcnt lgkmcnt(" #n ")" ::: "memory")
#define PG8_BAR __builtin_amdgcn_s_barrier()
#define PG8_SCHED __builtin_amdgcn_sched_barrier(0)
    Unit cur, nxt; int ui = 0;
    if (!S.next(0, cur)) return;
    f32x4 acc[2][2][4][2];
#pragma unroll
    for (int a = 0; a < 2; ++a)
#pragma unroll
        for (int b = 0; b < 2; ++b)
#pragma unroll
            for (int m = 0; m < 4; ++m)
#pragma unroll
                for (int n = 0; n < 2; ++n) acc[a][b][m][n] = (f32x4){0.f, 0.f, 0.f, 0.f};
    bf16x8 At[4][2], B0[2][2], B1[2][2];
    const char* cA = (const char*)g.A + (size_t)cur.pm * tstep; const char* cB = (const char*)g.Bt + (size_t)cur.pn * tstep;
    S.a_ready(cur);
    PG8_STAGE(PG8_SB(0, 0), cB, voffB); PG8_STAGE(PG8_SA(0, 0), cA, voffA); PG8_STAGE(PG8_SB(0, 1), cB + hstep, voffB); PG8_STAGE(PG8_SA(0, 1), cA + hstep, voffA);
    if (wr == 1) PG8_BAR;
    PG8_WAIT_V(4); PG8_BAR;
    PG8_STAGE(PG8_SB(1, 0), cB + kstep, voffB); PG8_STAGE(PG8_SA(1, 0), cA + kstep, voffA); PG8_STAGE(PG8_SB(1, 1), cB + hstep + kstep, voffB);
    PG8_WAIT_V(6); PG8_BAR;
    for (;;) {
        const bool has_next = S.next(ui + 1, nxt);
        const char* nA = has_next ? (const char*)g.A + (size_t)nxt.pm * tstep : cA; const char* nB = has_next ? (const char*)g.Bt + (size_t)nxt.pn * tstep : cB;
        for (int t = 0; t < nt; t += 2) {
            const bool last = (t == nt - 2);
            const char* a1 = cA + (size_t)(t + 1) * kstep;
            const char* a2 = last ? nA : cA + (size_t)(t + 2) * kstep; const char* b2 = last ? nB : cB + (size_t)(t + 2) * kstep;
            const char* a3 = a2 + kstep; const char* b3 = b2 + kstep;
            if (last && has_next) S.a_ready(nxt);
            PG8_LDB(B0, 0, 0); PG8_SCHED; PG8_LDA(At, 0, 0); PG8_STAGE(PG8_SA(1, 1), a1 + hstep, voffA);
            PG8_WAIT_L(8); PG8_BAR; PG8_WAIT_L(0); PG8_MMA(0, 0, At, B0); PG8_BAR; PG8_SCHED;
            PG8_LDB(B1, 0, 1); PG8_STAGE(PG8_SB(0, 0), b2, voffB);
            PG8_BAR; PG8_WAIT_L(0); PG8_MMA(0, 1, At, B1); PG8_BAR;
            PG8_LDA(At, 0, 1); PG8_STAGE(PG8_SA(0, 0), a2, voffA);
            PG8_BAR; PG8_WAIT_L(0); PG8_MMA(1, 0, At, B0); PG8_BAR; PG8_SCHED;
            PG8_STAGE(PG8_SB(0, 1), b2 + hstep, voffB);
            PG8_WAIT_V(6); PG8_BAR; PG8_MMA(1, 1, At, B1); PG8_BAR;
            PG8_LDB(B0, 1, 0); PG8_SCHED; PG8_LDA(At, 1, 0); PG8_STAGE(PG8_SA(0, 1), a2 + hstep, voffA);
            PG8_WAIT_L(8); PG8_BAR; PG8_WAIT_L(0); PG8_MMA(0, 0, At, B0); PG8_BAR; PG8_SCHED;
            PG8_LDB(B1, 1, 1); PG8_STAGE(PG8_SB(1, 0), b3, voffB);
            PG8_BAR; PG8_WAIT_L(0); PG8_MMA(0, 1, At, B1); PG8_BAR;
            PG8_LDA(At, 1, 1); PG8_STAGE(PG8_SA(1, 0), a3, voffA);
            PG8_BAR; PG8_WAIT_L(0); PG8_MMA(1, 0, At, B0); PG8_BAR; PG8_SCHED;
            PG8_STAGE(PG8_SB(1, 1), b3 + hstep, voffB);
            PG8_WAIT_V(6); PG8_BAR; PG8_MMA(1, 1, At, B1); PG8_BAR;
        }
        if constexpr (!Epi::AFTER_DRAIN) { E(acc, cur, wr, wc, fr, fq); S.done(cur); }
        if (!has_next) break;
#pragma unroll
        for (int a = 0; a < 2; ++a)
#pragma unroll
            for (int b = 0; b < 2; ++b)
#pragma unroll
                for (int m = 0; m < 4; ++m)
#pragma unroll
                    for (int n = 0; n < 2; ++n) acc[a][b][m][n] = (f32x4){0.f, 0.f, 0.f, 0.f};
        cur = nxt; cA = nA; cB = nB; ++ui;
    }
    PG8_WAIT_V(0);
    if (wr == 0) PG8_BAR;
    PG8_BAR;
    if constexpr (Epi::AFTER_DRAIN) { E.fused(acc, cur, wr, wc, fr, fq, lds, wid, lane); S.done(cur); }
#undef PG8_SA
#undef PG8_SB
#undef PG8_STAGE
#undef PG8_LDA
#undef PG8_LDB
#undef PG8_MMA
#undef PG8_WAIT_V
#undef PG8_WAIT_L
#undef PG8_BAR
#undef PG8_SCHED
}
}

DI bf16x4 pack4v(const f32x4 v) { return pack4(v[0], v[1], v[2], v[3]); }

struct EpiProj {
  static constexpr bool PERM = true, AFTER_DRAIN = false;
  const Params& p; int layer; const __attribute__((address_space(3))) float* biasl;
  template <int GRP>
  DI void run(const f32x4 (&acc)[2][2][4][2], const pg8::Unit& u, int wr, int wc, int fr, int fq) const {
    constexpr int T = GRP ? LS : SEQ;
    char* ws = p.ws;
#pragma unroll
    for (int bj = 0; bj < 2; ++bj) {
      const int nt = 2 * u.pn + bj;
      const __attribute__((address_space(3))) f32x4* bp = reinterpret_cast<const __attribute__((address_space(3))) f32x4*>(biasl + nt * 128 + 32 * wc + 8 * fq);
      const bool simple = (nt < 4) || (nt >= 12 && nt < 20) || (nt >= 21 && nt < 29) || (nt >= 30);
      if (simple) {
        size_t off; int ld, c0, act;
        if (nt < 4) { off = OFF_QA; ld = 512; c0 = nt * 128; act = 0; }
        else if (nt < 16) { off = OFF_GA; ld = 512; c0 = (nt - 12) * 128; act = 1; }
        else if (nt < 20) { off = OFF_QB; ld = 512; c0 = (nt - 16) * 128; act = 0; }
        else if (nt < 25) { off = OFF_GB; ld = 512; c0 = (nt - 21) * 128; act = 1; }
        else if (nt < 29) { off = OFF_QI; ld = 512; c0 = (nt - 25) * 128; act = 0; }
        else if (nt < 38) { off = OFF_RA; ld = 1024; c0 = (nt - 30) * 128; act = 2; }
        else { off = OFF_RB; ld = 1024; c0 = (nt - 38) * 128; act = 2; }
        bf16_t* dst = reinterpret_cast<bf16_t*>(ws + off) + c0 + 32 * wc + 8 * fq;
#pragma unroll
        for (int ai = 0; ai < 2; ++ai)
#pragma unroll
          for (int m = 0; m < 4; ++m) {
            int row = u.pm * 256 + 128 * ai + 64 * wr + 16 * m + fr;
            asm volatile("" : "+v"(row));
            u32x4v pk;
#pragma unroll
            for (int n = 0; n < 2; ++n) {
              f32x4 v = acc[ai][bj][m][n] + bp[n];
              if (act != 0) {
#pragma unroll
                for (int j = 0; j < 4; ++j) { const float sg = sigmoidf_(v[j]); v[j] = (act == 1) ? v[j] * sg : sg; }
              }
              if (n == 0) { pk.x = pk2(v[0], v[1]); pk.y = pk2(v[2], v[3]); } else { pk.z = pk2(v[0], v[1]); pk.w = pk2(v[2], v[3]); }
            }
            *reinterpret_cast<u32x4v*>(dst + (size_t)row * ld) = pk;
          }
      } else {
#pragma unroll
        for (int ai = 0; ai < 2; ++ai)
#pragma unroll
          for (int m = 0; m < 4; ++m) {
            int row = u.pm * 256 + 128 * ai + 64 * wr + 16 * m + fr;
            asm volatile("" : "+v"(row));
            int bb, tt;
            if (!GRP) { bb = row >> 11; tt = row & 2047; } else { const int ms = row - MP; bb = ms >> 6; tt = PAST + (ms & 63); }
            const size_t orow = GRP ? (size_t)layer * MS + (row - MP) : (size_t)layer * MP + row;
#pragma unroll
            for (int n = 0; n < 2; ++n) {
              int ct = 32 * wc + 8 * fq + 4 * n;
              asm volatile("" : "+v"(ct));
              const f32x4 v = acc[ai][bj][m][n] + bp[n];
              if (nt < 8) {
                const int c = (nt - 4) * 128 + ct;
                *reinterpret_cast<f32x4*>(p.out + (GRP ? O_KAS : O_KAP) + orow * 512 + c) = v;
                bf16_t* kd = GRP ? (reinterpret_cast<bf16_t*>(p.ws + OFF_KAS)) + ((size_t)bb * LS + tt) * 512 + c : (reinterpret_cast<bf16_t*>(p.ws + OFF_KAP)) + (size_t)row * 512 + c;
                st4(kd, pack4v(v));
              } else if (nt < 12) {
                const int c = (nt - 8) * 128 + ct;
                *reinterpret_cast<f32x4*>(p.out + (GRP ? O_VAS : O_VAP) + orow * 512 + c) = v;
                bf16_t* vd = (GRP ? (reinterpret_cast<bf16_t*>(p.ws + OFF_VATS)) : (reinterpret_cast<bf16_t*>(p.ws + OFF_VATP))) + ((size_t)bb * 512 + c) * T + tt;
                vd[0] = f2bf(v[0]); vd[T] = f2bf(v[1]); vd[2 * T] = f2bf(v[2]); vd[3 * T] = f2bf(v[3]);
              } else if (nt == 20) {
                if (wc < 2) {
                  *reinterpret_cast<f32x4*>(p.out + (GRP ? O_KBS : O_KBP) + orow * 64 + ct) = v;
                  st4((GRP ? (reinterpret_cast<bf16_t*>(p.ws + OFF_KBS)) : (reinterpret_cast<bf16_t*>(p.ws + OFF_KBP))) + ((size_t)bb * T + tt) * 64 + ct, pack4v(v));
                } else {
                  const int c = ct - 64;
                  *reinterpret_cast<f32x4*>(p.out + (GRP ? O_VBS : O_VBP) + orow * 64 + c) = v;
                  bf16_t* vd = (GRP ? (reinterpret_cast<bf16_t*>(p.ws + OFF_VBTS)) : (reinterpret_cast<bf16_t*>(p.ws + OFF_VBTP))) + ((size_t)bb * 64 + c) * T + tt;
                  vd[0] = f2bf(v[0]); vd[T] = f2bf(v[1]); vd[2 * T] = f2bf(v[2]); vd[3 * T] = f2bf(v[3]);
                }
              } else {
                if (wc < 2) {
                  *reinterpret_cast<f32x4*>(p.out + (GRP ? O_KIS : O_KIP) + orow * 64 + ct) = v;
                  st4((GRP ? (reinterpret_cast<bf16_t*>(p.ws + OFF_KIS)) : (reinterpret_cast<bf16_t*>(p.ws + OFF_KIP))) + ((size_t)bb * T + tt) * 64 + ct, pack4v(v));
                } else if (ct < 72) {
                  *reinterpret_cast<f32x4*>((reinterpret_cast<float*>(p.ws + OFF_WI)) + (size_t)row * 8 + (ct - 64)) = v;
                }
              }
            }
          }
      }
    }
  }
  DI void operator()(const f32x4 (&acc)[2][2][4][2], const pg8::Unit& u, int wr, int wc, int fr, int fq) const {
    if (u.pm < MP / 256) run<0>(acc, u, wr, wc, fr, fq); else run<1>(acc, u, wr, wc, fr, fq);
  }
};

template <int MODE>
struct EpiTail {
  static constexpr bool PERM = false, AFTER_DRAIN = false;
  const Params& p;
  DI void operator()(const f32x4 (&acc)[2][2][4][2], const pg8::Unit& u, int wr, int wc, int fr, int fq) const {
    bf16_t* MERGED = (reinterpret_cast<bf16_t*>(p.ws + OFF_GA));
#pragma unroll
    for (int ai = 0; ai < 2; ++ai)
#pragma unroll
      for (int m = 0; m < 4; ++m) {
        const int row = u.pm * 256 + 128 * ai + 64 * wr + 16 * m + fr;
#pragma unroll
        for (int bj = 0; bj < 2; ++bj)
#pragma unroll
          for (int n = 0; n < 2; ++n) {
            const size_t idx = (size_t)row * 1024 + u.pn * 256 + 128 * bj + 32 * wc + 16 * n + 4 * fq;
            const f32x4 a = acc[ai][bj][m][n];
            if (MODE == 0) {
              const bf16x4 g = ld4((reinterpret_cast<bf16_t*>(p.ws + OFF_RA)) + idx);
              st4(MERGED + idx, pack4(bf2f(g[0]) * a[0], bf2f(g[1]) * a[1], bf2f(g[2]) * a[2], bf2f(g[3]) * a[3]));
            } else if (MODE == 1) {
              const bf16x4 g = ld4((reinterpret_cast<bf16_t*>(p.ws + OFF_RB)) + idx); const bf16x4 o = ld4(MERGED + idx);
              st4(MERGED + idx, pack4(bf2f(o[0]) + bf2f(g[0]) * a[0], bf2f(o[1]) + bf2f(g[1]) * a[1], bf2f(o[2]) + bf2f(g[2]) * a[2], bf2f(o[3]) + bf2f(g[3]) * a[3]));
            } else {
              f32x4 x = *reinterpret_cast<const f32x4*>(p.out + idx);
              x = x * ALPHA + a;
              *reinterpret_cast<f32x4*>(p.out + idx) = x;
            }
          }
      }
  }
};

DI void phase_proj(const Params& p, int layer, char* smem) {
  {
    const float* bin = p.b_in + (size_t)layer * D_IN;
    float* bl = reinterpret_cast<float*>(smem + 131072);
    for (int i = otid(); i < D_INP; i += NTHREADS) bl[i] = (i < 3784) ? bin[i] : (i < 3840 ? 0.f : bin[i - 56]);
    __syncthreads();
  }
  pg8::Gemm g{(reinterpret_cast<bf16_t*>(p.ws + OFF_XB)), (reinterpret_cast<bf16_t*>(p.ws + OFF_WINT)), MT, D_INP, 1024};
  pg8::StaticOrder S; S.init(MT, D_INP, osg(gridDim.x), osg(blockIdx.x));
  EpiProj E{p, layer, (const __attribute__((address_space(3))) float*)(smem + 131072)};
  pg8::gemm_phase<EpiProj, pg8::StaticOrder>((PG8_LAS unsigned char*)smem, g, S, E);
}
DI void phase_merge_a(const Params& p, char* smem) {
  pg8::Gemm g{(reinterpret_cast<bf16_t*>(p.ws + OFF_QA)), (reinterpret_cast<bf16_t*>(p.ws + OFF_WPAT)), MT, 1024, 512};
  pg8::StaticOrder S; S.init(MT, 1024, osg(gridDim.x), osg(blockIdx.x));
  EpiTail<0> E{p};
  pg8::gemm_phase<EpiTail<0>, pg8::StaticOrder>((PG8_LAS unsigned char*)smem, g, S, E);
}
DI void phase_merge_b(const Params& p, char* smem) {
  pg8::Gemm g{(reinterpret_cast<bf16_t*>(p.ws + OFF_QB)), (reinterpret_cast<bf16_t*>(p.ws + OFF_WPBT)), MT, 1024, 512};
  pg8::StaticOrder S; S.init(MT, 1024, osg(gridDim.x), osg(blockIdx.x));
  EpiTail<1> E{p};
  pg8::gemm_phase<EpiTail<1>, pg8::StaticOrder>((PG8_LAS unsigned char*)smem, g, S, E);
}
DI void phase_out(const Params& p, char* smem) {
  pg8::Gemm g{(reinterpret_cast<bf16_t*>(p.ws + OFF_GA)), (reinterpret_cast<bf16_t*>(p.ws + OFF_WOUTT)), MT, 1024, 1024};
  pg8::StaticOrder S; S.init(MT, 1024, osg(gridDim.x), osg(blockIdx.x));
  EpiTail<2> E{p};
  pg8::gemm_phase<EpiTail<2>, pg8::StaticOrder>((PG8_LAS unsigned char*)smem, g, S, E);
}

template <int grp>
DI void sb_item(const Params& p, int b, int h, int t0) {
  const int tid = otid(), w = tid >> 6, lane = tid & 63, c = lane & 15, q4 = lane >> 4;
  const int T = grp ? LS : SEQ;
  const int qpos0 = grp ? PAST + t0 : t0;
  const int m0 = grp ? MP + b * DEC_SEQ + t0 : b * SEQ + t0;
  const bf16_t* Kb = (grp ? (reinterpret_cast<bf16_t*>(p.ws + OFF_KAS)) : (reinterpret_cast<bf16_t*>(p.ws + OFF_KAP))) + (size_t)b * T * 512 + h * 64;
  const bf16_t* VTb = (grp ? (reinterpret_cast<bf16_t*>(p.ws + OFF_VATS)) : (reinterpret_cast<bf16_t*>(p.ws + OFF_VATP))) + (size_t)(b * 8 + h) * 64 * T;
  const bf16_t* qp = (reinterpret_cast<bf16_t*>(p.ws + OFF_QA)) + (size_t)(m0 + c) * 512 + h * 64 + q4 * 8;
  const bf16x8 qf0 = ld8(qp), qf1 = ld8(qp + 32);
  const int qpos = qpos0 + c;
  float R = 0.f;
  f32x4 O[4];
#pragma unroll
  for (int dt = 0; dt < 4; ++dt) O[dt] = f32x4{0.f, 0.f, 0.f, 0.f};
  bf16x8 kfA[2][2], vfA[4], kfB[2][2], vfB[4];
  auto loadkv = [&](int kb, bf16x8 (&kf)[2][2], bf16x8 (&vf)[4]) {
    const int s0 = kb * 32;
#pragma unroll
    for (int kt = 0; kt < 2; ++kt) { const bf16_t* kp = Kb + (size_t)(s0 + 16 * kt + c) * 512 + q4 * 8; kf[kt][0] = ld8(kp); kf[kt][1] = ld8(kp + 32); }
#pragma unroll
    for (int dt = 0; dt < 4; ++dt) {
      const bf16_t* vp = VTb + (size_t)(16 * dt + c) * T + s0 + 4 * q4;
      bf16x4 lo = ld4(vp), hi = ld4(vp + 16);
      vf[dt] = __builtin_shufflevector(lo, hi, 0, 1, 2, 3, 4, 5, 6, 7);
    }
  };
  auto comp = [&](int kb, const bf16x8 (&kf)[2][2], const bf16x8 (&vf)[4]) -> bool {
    const int s0 = kb * 32;
    f32x4 z[2];
#pragma unroll
    for (int kt = 0; kt < 2; ++kt) {
      z[kt] = mfma16(kf[kt][0], qf0, f32x4{0.f, 0.f, 0.f, 0.f});
      z[kt] = mfma16(kf[kt][1], qf1, z[kt]);
    }
    float lk[2][4], ls[2][4]; bool bf[2][4];
#pragma unroll
    for (int kt = 0; kt < 2; ++kt)
#pragma unroll
      for (int r = 0; r < 4; ++r) {
        const int key = s0 + 16 * kt + 4 * q4 + r;
        const bool before = key < qpos;
        const float zz = z[kt][r] * SB_SCALE;
        const float sp = fmaxf(zz, 0.f) + __logf(1.f + __expf(-fabsf(zz)));
        bf[kt][r] = before; lk[kt][r] = before ? -sp : 0.f; ls[kt][r] = zz - sp;
      }
    const float T1 = (lk[1][0] + lk[1][1]) + (lk[1][2] + lk[1][3]);
    const float T0 = (lk[0][0] + lk[0][1]) + (lk[0][2] + lk[0][3]);
    const F2 x1 = swap16(T1), x0 = swap16(T0);
    const float p1 = x1.lo + x1.hi, p0 = x0.lo + x0.hi;
    const F2 y1 = swap32(p1), y0 = swap32(p0);
    const float H1 = ((q4 & 1) ? 0.f : x1.hi) + ((q4 & 2) ? 0.f : y1.hi);
    const float H0 = ((q4 & 1) ? 0.f : x0.hi) + ((q4 & 2) ? 0.f : y0.hi);
    const float TT1 = y1.lo + y1.hi, TT0 = y0.lo + y0.hi;
    float a[2][4];
    { float ac = R + H1;
#pragma unroll
      for (int r = 3; r >= 0; --r) { a[1][r] = bf[1][r] ? __expf(ls[1][r] + ac) : 0.f; ac += lk[1][r]; } }
    { float ac = R + TT1 + H0;
#pragma unroll
      for (int r = 3; r >= 0; --r) { a[0][r] = bf[0][r] ? __expf(ls[0][r] + ac) : 0.f; ac += lk[0][r]; } }
    R = R + TT1 + TT0;
    const float ae[8] = {a[0][0], a[0][1], a[0][2], a[0][3], a[1][0], a[1][1], a[1][2], a[1][3]};
    const bf16x8 pf = pack8(ae);
#pragma unroll
    for (int dt = 0; dt < 4; ++dt) O[dt] = mfma16(vf[dt], pf, O[dt]);
    return __ballot(R > -50.f) == 0ull;
  };
  {
    int kb = (qpos0 + 14) >> 5;
    loadkv(kb, kfA, vfA);
    while (true) {
      if (kb >= 1) loadkv(kb - 1, kfB, vfB);
      if (comp(kb, kfA, vfA) || kb == 0) break;
      --kb;
      if (kb >= 1) loadkv(kb - 1, kfA, vfA);
      if (comp(kb, kfB, vfB) || kb == 0) break;
      --kb;
    }
  }
#pragma unroll
  for (int dt = 0; dt < 4; ++dt) {
    const size_t off = (size_t)(m0 + c) * 512 + h * 64 + dt * 16 + 4 * q4;
    const bf16x4 g = ld4((reinterpret_cast<bf16_t*>(p.ws + OFF_GA)) + off);
    st4((reinterpret_cast<bf16_t*>(p.ws + OFF_QA)) + off, pack4(O[dt][0] * bf2f(g[0]), O[dt][1] * bf2f(g[1]), O[dt][2] * bf2f(g[2]), O[dt][3] * bf2f(g[3])));
  }
}

template <int NK>
DI void topk_round(const unsigned short* Sh, int n_adm, int half, int l32, unsigned* bmrow) {
  unsigned key[NK];
#pragma unroll
  for (int i = 0; i < NK; ++i) {
    const int s = 32 * i + l32;
    const unsigned k = Sh[s];
    key[i] = (s < n_adm) ? k : 0u;
  }
  unsigned tau = 1u; int need = 0; bool done = true;
  if (n_adm > 256) {
    tau = 0u; done = false;
    for (int bit = 15; bit >= 0; --bit) {
      const unsigned cand = tau | (1u << bit);
      int cnt = 0;
#pragma unroll
      for (int i = 0; i < NK; ++i) cnt += (key[i] >= cand) ? 1 : 0;
      cnt = hsum32(cnt);
      if (!done && cnt >= 256) tau = cand;
      if (cnt == 256) done = true;
      if (__ballot(!done) == 0ull) break;
    }
  }
  unsigned w0 = 0u, w1 = 0u;
  if (__ballot(!done) == 0ull) {
#pragma unroll
    for (int i = 0; i < NK; ++i) {
      const unsigned long long msel = __ballot(key[i] >= tau);
      const unsigned wsel = half ? (unsigned)(msel >> 32) : (unsigned)msel;
      if (i < 32) { if (l32 == i) w0 = wsel; } else { if (l32 == i - 32) w1 = wsel; }
    }
  } else {
    int cgt = 0;
#pragma unroll
    for (int i = 0; i < NK; ++i) cgt += (key[i] > tau) ? 1 : 0;
    cgt = hsum32(cgt);
    need = 256 - cgt;
    int Rk = 0; const unsigned below = (1u << l32) - 1u;
#pragma unroll
    for (int i = 0; i < NK; ++i) {
      const bool eq = key[i] == tau, gt = key[i] > tau;
      const unsigned long long me = __ballot(eq);
      const unsigned hm = half ? (unsigned)(me >> 32) : (unsigned)me;
      const int rank = Rk + __popc(hm & below);
      const bool sel = done ? (key[i] >= tau) : (gt || (eq && rank < need));
      Rk += __popc(hm);
      const unsigned long long msel = __ballot(sel);
      const unsigned wsel = half ? (unsigned)(msel >> 32) : (unsigned)msel;
      if (i < 32) { if (l32 == i) w0 = wsel; } else { if (l32 == i - 32) w1 = wsel; }
    }
  }
  bmrow[l32] = w0;
  if (NK > 32) bmrow[32 + l32] = w1;
}

template <int grp>
DI void dsa_item(const Params& p, int b, int tile32, char* smem) {
  const int tid = otid(), w = tid >> 6, lane = tid & 63, c = lane & 15, q4 = lane >> 4, half = lane >> 5, l32 = lane & 31;
  unsigned* bm = reinterpret_cast<unsigned*>(smem + LDS_BM);
  const unsigned char* btab = reinterpret_cast<const unsigned char*>(smem + LDS_BTAB);
  const float* rb = reinterpret_cast<const float*>(smem + LDS_RB);
  const int T = grp ? LS : SEQ;
  const int t0 = tile32 * 32;
  const int qpos0 = grp ? PAST + t0 : t0;
  const int m0 = grp ? MP + b * DEC_SEQ + t0 : b * SEQ + t0;
  const int n_adm = grp ? LS : ((qpos0 >> 6) + 1) * 64;
  const bf16_t* KIb = (grp ? (reinterpret_cast<bf16_t*>(p.ws + OFF_KIS)) : (reinterpret_cast<bf16_t*>(p.ws + OFF_KIP))) + (size_t)b * T * 64;
  const bf16_t* KBb = (grp ? (reinterpret_cast<bf16_t*>(p.ws + OFF_KBS)) : (reinterpret_cast<bf16_t*>(p.ws + OFF_KBP))) + (size_t)b * T * 64;
  const bf16_t* VBTb = (grp ? (reinterpret_cast<bf16_t*>(p.ws + OFF_VBTS)) : (reinterpret_cast<bf16_t*>(p.ws + OFF_VBTP))) + (size_t)b * 64 * T;

  unsigned short* S16 = reinterpret_cast<unsigned short*>(smem) + w * 8192;
  {
    const int tlA = c >> 3, hA = c & 7, tlC = q4 >> 1;
    bf16x8 af[2][2]; float4 wv[2];
#pragma unroll
    for (int pr = 0; pr < 2; ++pr) {
      const bf16_t* qip = (reinterpret_cast<bf16_t*>(p.ws + OFF_QI)) + (size_t)(m0 + 4 * w + 2 * pr + tlA) * 512 + hA * 64 + q4 * 8;
      af[pr][0] = ld8(qip); af[pr][1] = ld8(qip + 32);
      wv[pr] = *reinterpret_cast<const float4*>((reinterpret_cast<float*>(p.ws + OFF_WI)) + (size_t)(m0 + 4 * w + 2 * pr + tlC) * 8 + 4 * (q4 & 1));
    }
    const int nch = n_adm >> 6;
    char* kis = smem + LDS_KI;
    const int lrow = tid >> 3, lseg = tid & 7;
    bf16x8 pre = ld8(KIb + (size_t)lrow * 64 + lseg * 8);
    *reinterpret_cast<bf16x8*>(kis + lrow * 144 + lseg * 16) = pre;
    __syncthreads();
    for (int ch = 0; ch < nch; ++ch) {
      const bool more = ch + 1 < nch;
      if (more) pre = ld8(KIb + (size_t)((ch + 1) * 64 + lrow) * 64 + lseg * 8);
      const char* cur = kis + (ch & 1) * 9216;
#pragma unroll
      for (int u = 0; u < 4; ++u) {
        const char* rp = cur + (u * 16 + c) * 144 + q4 * 16;
        const bf16x8 b0 = *reinterpret_cast<const bf16x8*>(rp), b1 = *reinterpret_cast<const bf16x8*>(rp + 64);
#pragma unroll
        for (int pr = 0; pr < 2; ++pr) {
          f32x4 C = mfma16(af[pr][0], b0, f32x4{0.f, 0.f, 0.f, 0.f});
          C = mfma16(af[pr][1], b1, C);
          const float part = wv[pr].x * fmaxf(C[0], 0.f) + wv[pr].y * fmaxf(C[1], 0.f) + wv[pr].z * fmaxf(C[2], 0.f) + wv[pr].w * fmaxf(C[3], 0.f);
          const F2 ps = swap16(part); const float full = ps.lo + ps.hi;
          const unsigned hu = (unsigned)__builtin_bit_cast(unsigned short, (_Float16)full);
          const unsigned hk = (hu & 0x8000u) ? (~hu & 0xFFFFu) : (hu | 0x8000u);
          if ((q4 & 1) == 0) S16[(2 * pr + tlC) * 2048 + (ch * 4 + u) * 16 + c] = (unsigned short)hk;
        }
      }
      if (more) *reinterpret_cast<bf16x8*>(kis + ((ch + 1) & 1) * 9216 + lrow * 144 + lseg * 16) = pre;
      __syncthreads();
    }
  }
  for (int rnd = 0; rnd < 2; ++rnd) {
    const unsigned short* Sh = S16 + (2 * rnd + half) * 2048;
    unsigned* bmrow = bm + (4 * w + 2 * rnd + half) * 64;
    const int nreg = n_adm >> 5;
    if (nreg <= 16) topk_round<16>(Sh, n_adm, half, l32, bmrow);
    else if (nreg <= 32) topk_round<32>(Sh, n_adm, half, l32, bmrow);
    else if (nreg <= 48) topk_round<48>(Sh, n_adm, half, l32, bmrow);
    else topk_round<64>(Sh, n_adm, half, l32, bmrow);
  }
  __syncthreads();

  {
    const int tl = c >> 3, h = c & 7;
    bf16x8 qf[2][2]; int qposc[2], qrow[2], qloc[2];
#pragma unroll
    for (int ct = 0; ct < 2; ++ct) {
      qloc[ct] = 4 * w + 2 * ct + tl; qrow[ct] = m0 + qloc[ct]; qposc[ct] = qpos0 + qloc[ct];
      const bf16_t* qp = (reinterpret_cast<bf16_t*>(p.ws + OFF_QB)) + (size_t)qrow[ct] * 512 + h * 64 + q4 * 8;
      qf[ct][0] = ld8(qp); qf[ct][1] = ld8(qp + 32);
    }
    f32x4 O[2][4]; float mrun[2] = {-1e30f, -1e30f}, lrun[2] = {0.f, 0.f};
#pragma unroll
    for (int ct = 0; ct < 2; ++ct)
#pragma unroll
      for (int dt = 0; dt < 4; ++dt) O[ct][dt] = f32x4{0.f, 0.f, 0.f, 0.f};
    const int nkb = n_adm >> 5;
    const float farbias = rb[15 * 8 + h];
    auto compkv = [&](auto FAR, int kb, const bf16x8 (&kf)[2][2], const bf16x8 (&vf)[4]) {
      constexpr bool far = decltype(FAR)::value;
      const int s0 = kb * 32;
#pragma unroll
      for (int ct = 0; ct < 2; ++ct) {
        f32x4 z0 = mfma16(kf[0][0], qf[ct][0], f32x4{0.f, 0.f, 0.f, 0.f}); z0 = mfma16(kf[0][1], qf[ct][1], z0);
        f32x4 z1 = mfma16(kf[1][0], qf[ct][0], f32x4{0.f, 0.f, 0.f, 0.f}); z1 = mfma16(kf[1][1], qf[ct][1], z1);
        const unsigned word = bm[qloc[ct] * 64 + kb];
        float zz[8]; bool bt[8]; float bmx = -1e30f;
#pragma unroll
        for (int e = 0; e < 8; ++e) {
          const int kt = e >> 2, r = e & 3;
          const int off = 16 * kt + 4 * q4 + r;
          float bias = farbias;
          if (!far) { const int rel = s0 + off - qposc[ct]; const int bk = btab[rel + 2047]; bias = rb[bk * 8 + h]; }
          const float zv = (kt ? z1[r] : z0[r]) * ATT_SCALE + bias;
          bt[e] = (word >> off) & 1u;
          zz[e] = bt[e] ? zv : -1e30f;
          bmx = fmaxf(bmx, zz[e]);
        }
        { const F2 m16 = swap16(bmx); bmx = fmaxf(m16.lo, m16.hi); const F2 m32 = swap32(bmx); bmx = fmaxf(m32.lo, m32.hi); }
        const float mnew = fmaxf(mrun[ct], bmx);
        const float sc = __expf(mrun[ct] - mnew);
        float ps = 0.f; float pe[8];
#pragma unroll
        for (int e = 0; e < 8; ++e) { pe[e] = bt[e] ? __expf(zz[e] - mnew) : 0.f; ps += pe[e]; }
        lrun[ct] = lrun[ct] * sc + ps; mrun[ct] = mnew;
        const bf16x8 pf = pack8(pe);
#pragma unroll
        for (int dt = 0; dt < 4; ++dt) { O[ct][dt] *= sc; O[ct][dt] = mfma16(vf[dt], pf, O[ct][dt]); }
      }
    };
    int nfar = (qpos0 - 159) >= 0 ? ((qpos0 - 159) >> 5) + 1 : 0;
    nfar = nfar < nkb ? nfar : nkb;
    char* kd = smem; char* vd = smem + 18432;
    const int srow = tid >> 3, sseg = tid & 7;
    bf16x8 preK = ld8(KBb + (size_t)srow * 64 + sseg * 8);
    bf16x8 preV = ld8(VBTb + (size_t)srow * T + sseg * 8);
    *reinterpret_cast<bf16x8*>(kd + srow * 144 + sseg * 16) = preK;
    *reinterpret_cast<bf16x8*>(vd + srow * 144 + sseg * 16) = preV;
    __syncthreads();
    const int nkb2 = n_adm >> 6;
    for (int kb2 = 0; kb2 < nkb2; ++kb2) {
      const bool more = kb2 + 1 < nkb2;
      if (more) {
        preK = ld8(KBb + (size_t)((kb2 + 1) * 64 + srow) * 64 + sseg * 8);
        preV = ld8(VBTb + (size_t)srow * T + (kb2 + 1) * 64 + sseg * 8);
      }
      const char* kc = kd + (kb2 & 1) * 9216; const char* vc = vd + (kb2 & 1) * 9216;
#pragma unroll
      for (int sub = 0; sub < 2; ++sub) {
        const int kb = 2 * kb2 + sub;
        bf16x8 kf[2][2], vf[4];
#pragma unroll
        for (int kt = 0; kt < 2; ++kt)
#pragma unroll
          for (int kk = 0; kk < 2; ++kk) kf[kt][kk] = *reinterpret_cast<const bf16x8*>(kc + (32 * sub + 16 * kt + c) * 144 + kk * 64 + q4 * 16);
#pragma unroll
        for (int dt = 0; dt < 4; ++dt) {
          const char* vp = vc + (16 * dt + c) * 144 + sub * 64 + q4 * 8;
          const bf16x4 lo = *reinterpret_cast<const bf16x4*>(vp), hi = *reinterpret_cast<const bf16x4*>(vp + 32);
          vf[dt] = __builtin_shufflevector(lo, hi, 0, 1, 2, 3, 4, 5, 6, 7);
        }
        if (kb < nfar) compkv(std::true_type{}, kb, kf, vf); else compkv(std::false_type{}, kb, kf, vf);
      }
      if (more) {
        *reinterpret_cast<bf16x8*>(kd + ((kb2 + 1) & 1) * 9216 + srow * 144 + sseg * 16) = preK;
        *reinterpret_cast<bf16x8*>(vd + ((kb2 + 1) & 1) * 9216 + srow * 144 + sseg * 16) = preV;
      }
      __syncthreads();
    }
#pragma unroll
    for (int ct = 0; ct < 2; ++ct) {
      float lt = lrun[ct]; { const F2 a = swap16(lt); lt = a.lo + a.hi; const F2 b = swap32(lt); lt = b.lo + b.hi; }
      const float inv = 1.f / lt;
#pragma unroll
      for (int dt = 0; dt < 4; ++dt) {
        const size_t off = (size_t)qrow[ct] * 512 + h * 64 + dt * 16 + 4 * q4;
        const bf16x4 g = ld4((reinterpret_cast<bf16_t*>(p.ws + OFF_GB)) + off);
        st4((reinterpret_cast<bf16_t*>(p.ws + OFF_QB)) + off, pack4(O[ct][dt][0] * inv * bf2f(g[0]), O[ct][dt][1] * inv * bf2f(g[1]), O[ct][dt][2] * inv * bf2f(g[2]), O[ct][dt][3] * inv * bf2f(g[3])));
      }
    }
  }
  __syncthreads();
}

DI void phase_attn(const Params& p, int layer, char* smem) {
  const int tid = otid();
  for (int i = tid; i < 4096; i += NTHREADS) smem[LDS_BTAB + i] = (char)(reinterpret_cast<unsigned char*>(p.ws + OFF_BTAB))[i];
  if (tid < 256) reinterpret_cast<float*>(smem + LDS_RB)[tid] = p.rel_bias[tid];
  __syncthreads();
  int* slot = reinterpret_cast<int*>(smem + LDS_SLOT);
  const int w = tid >> 6;
  const int total = 16 + 2048 + 32 + 4096;
  if (tid == 0) *slot = atomicAdd(&(reinterpret_cast<int*>(p.ws + OFF_CTR))[layer], 1);
  __syncthreads();
  int item = *slot;
  while (item < total) {
    int nxt = 0;
    if (tid == 0) nxt = atomicAdd(&(reinterpret_cast<int*>(p.ws + OFF_CTR))[layer], 1);
    if (item < 16) dsa_item<1>(p, item >> 1, item & 1, smem);
    else if (item < 2064) { const int i = item - 16; dsa_item<0>(p, i >> 6, 63 - (i & 63), smem); }
    else if (item < 2096) { const int i = item - 2064; sb_item<1>(p, i >> 2, 2 * (i & 3) + (w >> 2), (w & 3) * 16); }
    else { const int i = item - 2096; const int tile = 15 - (i >> 8), bh = i & 255; sb_item<0>(p, bh >> 3, bh & 7, tile * 128 + w * 16); }
    __syncthreads();
    if (tid == 0) *slot = nxt;
    __syncthreads();
    item = *slot;
  }
}

DI void phase_ln(const Params& p, int layer, char* smem) {
  const int tid = otid(), lane = tid & 63;
  {
    const int stride = gridDim.x * NWAVES;
    const float* g = p.ln_g + layer * 1024; const float* b = p.ln_b + layer * 1024;
    for (int row = blockIdx.x * NWAVES + (tid >> 6); row < MT; row += 2 * stride) {
      const int row2 = row + stride;
      if (row2 < MT) ln_rows2(p.out + (size_t)row * 1024, p.out + (size_t)row2 * 1024, g, b, p.out + (size_t)row * 1024, (reinterpret_cast<bf16_t*>(p.ws + OFF_XB)) + (size_t)row * 1024, p.out + (size_t)row2 * 1024, (reinterpret_cast<bf16_t*>(p.ws + OFF_XB)) + (size_t)row2 * 1024, lane);
      else ln_row_wave(p.out + (size_t)row * 1024, g, b, p.out + (size_t)row * 1024, (reinterpret_cast<bf16_t*>(p.ws + OFF_XB)) + (size_t)row * 1024, lane);
    }
  }
  if (layer + 1 < DEPTH) convert_layer(p, layer + 1, smem);
}

__global__ void __launch_bounds__(512, 2) mega_kernel(Params p) {
  extern __shared__ __attribute__((aligned(16))) char smem[];
  cg::grid_group grid = cg::this_grid();
  phase_prologue(p, smem);
  grid.sync();
  unsigned* bar = reinterpret_cast<unsigned*>((reinterpret_cast<int*>(p.ws + OFF_CTR)) + 8);
  unsigned nb = 0; const unsigned G = gridDim.x;
#pragma nounroll
  for (int l = 0; l < DEPTH; ++l) {
    phase_proj(p, l, smem);
    gbar(bar, ++nb * G);
    phase_attn(p, l, smem);
    gbar(bar, ++nb * G);
    phase_merge_a(p, smem);
    phase_merge_b(p, smem);
    gbar(bar, ++nb * G);
    phase_out(p, smem);
    gbar(bar, ++nb * G);
    phase_ln(p, l, smem);
    if (l + 1 < DEPTH) gbar(bar, ++nb * G);
  }
}

#if !USE_COOP
__global__ void __launch_bounds__(512, 2) phase_kernel(Params p, int phase, int layer) {
  extern __shared__ __attribute__((aligned(16))) char smem[];
  if (phase == 0) phase_prologue(p, smem);
  else if (phase == 1) phase_proj(p, layer, smem);
  else if (phase == 2) phase_attn(p, layer, smem);
  else if (phase == 3) phase_merge_a(p, smem);
  else if (phase == 4) phase_merge_b(p, smem);
  else if (phase == 5) phase_out(p, smem);
  else phase_ln(p, layer, smem);
}

#endif

extern "C" void kernel_launch(void* const* d_in, const int* in_sizes, int n_in, void* d_out, int out_size, void* d_ws, size_t ws_size, hipStream_t stream) {
  static int grid_blocks = 0;
  if (grid_blocks == 0) {
    if (n_in != 17 || out_size != OUT_TOTAL) { fprintf(stderr, "kernel_launch: unexpected shapes n_in=%d out=%d\n", n_in, out_size); grid_blocks = -1; return; }
    int dev = 0, cus = 0, per_cu = 0;
    hipGetDevice(&dev);
    hipDeviceGetAttribute(&cus, hipDeviceAttributeMultiprocessorCount, dev);
    hipFuncSetAttribute((const void*)mega_kernel, hipFuncAttributeMaxDynamicSharedMemorySize, LDS_BYTES);
#if !USE_COOP
    hipFuncSetAttribute((const void*)phase_kernel, hipFuncAttributeMaxDynamicSharedMemorySize, LDS_BYTES);
#endif
    hipOccupancyMaxActiveBlocksPerMultiprocessor(&per_cu, (const void*)mega_kernel, NTHREADS, LDS_BYTES);
    if (per_cu < 1) per_cu = 1;
    if (per_cu > 1) per_cu = 1;
    grid_blocks = cus * per_cu;
    fprintf(stderr, "kernel_launch: cus=%d per_cu=%d grid=%d ws=%zu\n", cus, per_cu, grid_blocks, ws_size);
  }
  if (grid_blocks < 0) return;
  Params p{};
  p.x_prompt = (const float*)d_in[0]; p.x_sample = (const float*)d_in[1];
  p.c_sb_k = (const float*)d_in[2]; p.c_sb_v = (const float*)d_in[3]; p.c_dsa_k = (const float*)d_in[4]; p.c_dsa_v = (const float*)d_in[5]; p.c_idx_k = (const float*)d_in[6];
  p.ln_in_g = (const float*)d_in[7]; p.ln_in_b = (const float*)d_in[8]; p.w_in = (const float*)d_in[9]; p.b_in = (const float*)d_in[10];
  p.w_pa = (const float*)d_in[11]; p.w_pb = (const float*)d_in[12]; p.w_out = (const float*)d_in[13]; p.ln_g = (const float*)d_in[14]; p.ln_b = (const float*)d_in[15];
  p.rel_bias = (const float*)d_in[16];
  p.out = (float*)d_out;
  p.ws = (char*)d_ws;
  if (OFF_END > ws_size) { fprintf(stderr, "kernel_launch: workspace too small: need %zu have %zu\n", (size_t)OFF_END, ws_size); return; }
#if USE_COOP
  void* args[] = {&p};
  hipError_t e = hipLaunchCooperativeKernel((const void*)mega_kernel, dim3(grid_blocks), dim3(NTHREADS), args, LDS_BYTES, stream);
  if (e != hipSuccess) fprintf(stderr, "cooperative launch failed: %s (grid %d)\n", hipGetErrorString(e), grid_blocks);
#else
  hipLaunchKernelGGL(phase_kernel, dim3(grid_blocks), dim3(NTHREADS), LDS_BYTES, stream, p, 0, 0);
  for (int l = 0; l < DEPTH; ++l)
    for (int ph = 1; ph <= 6; ++ph) hipLaunchKernelGGL(phase_kernel, dim3(grid_blocks), dim3(NTHREADS), LDS_BYTES, stream, p, ph, l);
#endif
}
```

```cpp
#include <hip/hip_runtime.h>
#include <hip/hip_cooperative_groups.h>
#include <cstdio>
#include <type_traits>
namespace cg = cooperative_groups;

#ifndef USE_COOP
#define USE_COOP 1
#endif

#define DI __device__ __forceinline__
typedef unsigned short bf16_t;
using bf16x8 = __attribute__((ext_vector_type(8))) short;
using bf16x4 = __attribute__((ext_vector_type(4))) short;
using f32x4  = __attribute__((ext_vector_type(4))) float;

constexpr int D_MODEL = 1024, BATCH = 32, SEQ = 2048, DEPTH = 4, DEC_BATCH = 8, DEC_SEQ = 64, PAST = 1024, LS = 1088;
constexpr int MP = BATCH * SEQ;
constexpr int MS = DEC_BATCH * DEC_SEQ;
constexpr int MT = MP + MS;
constexpr int D_IN = 5832, D_INP = 5888;
constexpr float LN_EPS = 1e-5f;
constexpr float ALPHA = 1.681792830507429f;
constexpr float SB_SCALE = 0.125f, ATT_SCALE = 0.125f;
constexpr int NTHREADS = 512, NWAVES = 8;
constexpr int LDS_S = 0, LDS_BM = 131072, LDS_BTAB = 139264, LDS_RB = 143360, LDS_SLOT = 144384, LDS_KI = 144448, LDS_BYTES = 162880;

constexpr size_t O_Y = 0, O_KAP = 67633152, O_VAP = 201850880, O_KBP = 336068608, O_VBP = 352845824, O_KIP = 369623040,
                 O_KAS = 386400256, O_VAS = 387448832, O_KBS = 388497408, O_VBS = 388628480, O_KIS = 388759552;
constexpr int OUT_TOTAL = 388890624;

constexpr size_t al256(size_t x) { return (x + 255) & ~(size_t)255; }
constexpr size_t OFF_XB = 0;
constexpr size_t OFF_QAB = OFF_XB + al256((size_t)MT * 1024 * 2);
constexpr size_t OFF_GA = OFF_QAB + al256((size_t)MT * 1024 * 2);
constexpr size_t OFF_GB = OFF_GA + al256((size_t)MT * 512 * 2);
constexpr size_t OFF_QI = OFF_GB + al256((size_t)MT * 512 * 2);
constexpr size_t OFF_KAP = OFF_QI + al256((size_t)MT * 512 * 2);
constexpr size_t OFF_VATP = OFF_KAP + al256((size_t)MP * 512 * 2);
constexpr size_t OFF_KAS = OFF_VATP + al256((size_t)MP * 512 * 2);
constexpr size_t OFF_VATS = OFF_KAS + al256((size_t)8 * LS * 512 * 2);
constexpr size_t OFF_KBP = OFF_VATS + al256((size_t)8 * LS * 512 * 2);
constexpr size_t OFF_VBTP = OFF_KBP + al256((size_t)MP * 64 * 2);
constexpr size_t OFF_KIP = OFF_VBTP + al256((size_t)MP * 64 * 2);
constexpr size_t OFF_KBS = OFF_KIP + al256((size_t)MP * 64 * 2);
constexpr size_t OFF_VBTS = OFF_KBS + al256((size_t)8 * LS * 64 * 2);
constexpr size_t OFF_KIS = OFF_VBTS + al256((size_t)8 * LS * 64 * 2);
constexpr size_t OFF_WI = OFF_KIS + al256((size_t)8 * LS * 64 * 2);
constexpr size_t OFF_RA = OFF_WI + al256((size_t)MT * 8 * 4);
constexpr size_t OFF_RB = OFF_RA + al256((size_t)MT * 1024 * 2);
constexpr size_t OFF_WINT = OFF_RB + al256((size_t)MT * 1024 * 2);
constexpr size_t OFF_WPAT = OFF_WINT + al256((size_t)D_INP * 1024 * 2);
constexpr size_t OFF_WPBT = OFF_WPAT + al256((size_t)1024 * 512 * 2);
constexpr size_t OFF_WOUTT = OFF_WPBT + al256((size_t)1024 * 512 * 2);
constexpr size_t OFF_BTAB = OFF_WOUTT + al256((size_t)1024 * 1024 * 2);
constexpr size_t OFF_CTR = OFF_BTAB + 4096;
constexpr size_t OFF_END = OFF_CTR + 256;

struct Params {
  const float* x_prompt; const float* x_sample;
  const float* c_sb_k; const float* c_sb_v; const float* c_dsa_k; const float* c_dsa_v; const float* c_idx_k;
  const float* ln_in_g; const float* ln_in_b; const float* w_in; const float* b_in; const float* w_pa; const float* w_pb;
  const float* w_out; const float* ln_g; const float* ln_b; const float* rel_bias;
  float* out; char* ws;
};

DI unsigned short f2bf(float x) { unsigned u = __float_as_uint(x); u += 0x7fffu + ((u >> 16) & 1u); return (unsigned short)(u >> 16); }
DI float bf2f(short h) { return __uint_as_float(((unsigned)(unsigned short)h) << 16); }
typedef __bf16 hbf16x2 __attribute__((ext_vector_type(2)));
typedef float f32x2v __attribute__((ext_vector_type(2)));
typedef unsigned u32x2v __attribute__((ext_vector_type(2)));
typedef unsigned u32x4v __attribute__((ext_vector_type(4)));
DI unsigned pk2(float lo, float hi) { f32x2v v; v.x = lo; v.y = hi; return __builtin_bit_cast(unsigned, __builtin_convertvector(v, hbf16x2)); }
DI bf16x4 pack4(float a, float b, float c, float d) { u32x2v u; u.x = pk2(a, b); u.y = pk2(c, d); return __builtin_bit_cast(bf16x4, u); }
DI bf16x8 pack8(const float (&e)[8]) { u32x4v u; u.x = pk2(e[0], e[1]); u.y = pk2(e[2], e[3]); u.z = pk2(e[4], e[5]); u.w = pk2(e[6], e[7]); return __builtin_bit_cast(bf16x8, u); }
DI bf16x8 ld8(const bf16_t* p) { return *reinterpret_cast<const bf16x8*>(p); }
DI bf16x4 ld4(const bf16_t* p) { return *reinterpret_cast<const bf16x4*>(p); }
DI void st4(bf16_t* p, bf16x4 v) { *reinterpret_cast<bf16x4*>(p) = v; }
DI f32x4 mfma16(bf16x8 a, bf16x8 b, f32x4 c) { return __builtin_amdgcn_mfma_f32_16x16x32_bf16(a, b, c, 0, 0, 0); }
DI int otid() { int t = threadIdx.x; asm volatile("" : "+v"(t)); return t; }
DI int osg(int v) { asm volatile("" : "+s"(v)); return v; }
DI float sigmoidf_(float x) { return __builtin_amdgcn_rcpf(1.f + __expf(-x)); }
struct F2 { float lo, hi; };
DI F2 swap16(float x) { const unsigned u = __float_as_uint(x); auto r = __builtin_amdgcn_permlane16_swap(u, u, false, false); return F2{__uint_as_float(r[0]), __uint_as_float(r[1])}; }
DI F2 swap32(float x) { const unsigned u = __float_as_uint(x); auto r = __builtin_amdgcn_permlane32_swap(u, u, false, false); return F2{__uint_as_float(r[0]), __uint_as_float(r[1])}; }
DI float row_sum16(float x) {
  x += __uint_as_float(__builtin_amdgcn_update_dpp(0, __float_as_uint(x), 0xB1, 0xF, 0xF, true));
  x += __uint_as_float(__builtin_amdgcn_update_dpp(0, __float_as_uint(x), 0x4E, 0xF, 0xF, true));
  x += __uint_as_float(__builtin_amdgcn_update_dpp(0, __float_as_uint(x), 0x141, 0xF, 0xF, true));
  x += __uint_as_float(__builtin_amdgcn_update_dpp(0, __float_as_uint(x), 0x140, 0xF, 0xF, true));
  return x;
}
DI float wave_sum(float x) { x = row_sum16(x); F2 a = swap16(x); x = a.lo + a.hi; F2 b = swap32(x); return b.lo + b.hi; }
DI int hsum32(int x) {
  x += __builtin_amdgcn_update_dpp(0, x, 0xB1, 0xF, 0xF, true);
  x += __builtin_amdgcn_update_dpp(0, x, 0x4E, 0xF, 0xF, true);
  x += __builtin_amdgcn_update_dpp(0, x, 0x141, 0xF, 0xF, true);
  x += __builtin_amdgcn_update_dpp(0, x, 0x140, 0xF, 0xF, true);
  auto r = __builtin_amdgcn_permlane16_swap((unsigned)x, (unsigned)x, false, false);
  return (int)(r[0] + r[1]);
}
DI void gbar(unsigned* ctr, unsigned target) {
  asm volatile("s_waitcnt vmcnt(0)" ::: "memory");
  __syncthreads();
  if (otid() == 0) {
    __builtin_amdgcn_fence(__ATOMIC_RELEASE, "agent");
    asm volatile("s_waitcnt vmcnt(0)" ::: "memory");
    __hip_atomic_fetch_add(ctr, 1u, __ATOMIC_RELAXED, __HIP_MEMORY_SCOPE_AGENT);
    while (__hip_atomic_load(ctr, __ATOMIC_RELAXED, __HIP_MEMORY_SCOPE_AGENT) < target) __builtin_amdgcn_s_sleep(2);
    __builtin_amdgcn_fence(__ATOMIC_ACQUIRE, "agent");
    asm volatile("s_waitcnt vmcnt(0)" ::: "memory");
  }
  __syncthreads();
}

DI void ln_row_wave(const float* src, const float* g, const float* b, float* d32, bf16_t* db, int lane) {
  float4 v[4]; float s = 0.f;
#pragma unroll
  for (int i = 0; i < 4; ++i) { v[i] = reinterpret_cast<const float4*>(src)[lane + 64 * i]; s += v[i].x + v[i].y + v[i].z + v[i].w; }
  s = wave_sum(s);
  const float mu = s * (1.f / 1024.f);
  float q = 0.f;
#pragma unroll
  for (int i = 0; i < 4; ++i) { float a = v[i].x - mu, bb = v[i].y - mu, c = v[i].z - mu, d = v[i].w - mu; q += a * a + bb * bb + c * c + d * d; }
  q = wave_sum(q);
  const float rstd = rsqrtf(q * (1.f / 1024.f) + LN_EPS);
#pragma unroll
  for (int i = 0; i < 4; ++i) {
    float4 gg = reinterpret_cast<const float4*>(g)[lane + 64 * i], bb = reinterpret_cast<const float4*>(b)[lane + 64 * i];
    float4 o;
    o.x = (v[i].x - mu) * rstd * gg.x + bb.x; o.y = (v[i].y - mu) * rstd * gg.y + bb.y;
    o.z = (v[i].z - mu) * rstd * gg.z + bb.z; o.w = (v[i].w - mu) * rstd * gg.w + bb.w;
    reinterpret_cast<float4*>(d32)[lane + 64 * i] = o;
    st4(db + 4 * (lane + 64 * i), pack4(o.x, o.y, o.z, o.w));
  }
}

DI void ln_rows2(const float* s0, const float* s1, const float* g, const float* b, float* d0, bf16_t* db0, float* d1, bf16_t* db1, int lane) {
  float4 v0[4], v1[4]; float a0 = 0.f, a1 = 0.f;
#pragma unroll
  for (int i = 0; i < 4; ++i) { v0[i] = reinterpret_cast<const float4*>(s0)[lane + 64 * i]; v1[i] = reinterpret_cast<const float4*>(s1)[lane + 64 * i]; }
#pragma unroll
  for (int i = 0; i < 4; ++i) { a0 += v0[i].x + v0[i].y + v0[i].z + v0[i].w; a1 += v1[i].x + v1[i].y + v1[i].z + v1[i].w; }
  a0 = wave_sum(a0); a1 = wave_sum(a1);
  const float mu0 = a0 * (1.f / 1024.f), mu1 = a1 * (1.f / 1024.f);
  float q0 = 0.f, q1 = 0.f;
#pragma unroll
  for (int i = 0; i < 4; ++i) {
    { float a = v0[i].x - mu0, bb = v0[i].y - mu0, c = v0[i].z - mu0, d = v0[i].w - mu0; q0 += a * a + bb * bb + c * c + d * d; }
    { float a = v1[i].x - mu1, bb = v1[i].y - mu1, c = v1[i].z - mu1, d = v1[i].w - mu1; q1 += a * a + bb * bb + c * c + d * d; }
  }
  q0 = wave_sum(q0); q1 = wave_sum(q1);
  const float r0 = rsqrtf(q0 * (1.f / 1024.f) + LN_EPS), r1 = rsqrtf(q1 * (1.f / 1024.f) + LN_EPS);
#pragma unroll
  for (int i = 0; i < 4; ++i) {
    const float4 gg = reinterpret_cast<const float4*>(g)[lane + 64 * i], bb = reinterpret_cast<const float4*>(b)[lane + 64 * i];
    float4 o;
    o.x = (v0[i].x - mu0) * r0 * gg.x + bb.x; o.y = (v0[i].y - mu0) * r0 * gg.y + bb.y; o.z = (v0[i].z - mu0) * r0 * gg.z + bb.z; o.w = (v0[i].w - mu0) * r0 * gg.w + bb.w;
    reinterpret_cast<float4*>(d0)[lane + 64 * i] = o; st4(db0 + 4 * (lane + 64 * i), pack4(o.x, o.y, o.z, o.w));
    o.x = (v1[i].x - mu1) * r1 * gg.x + bb.x; o.y = (v1[i].y - mu1) * r1 * gg.y + bb.y; o.z = (v1[i].z - mu1) * r1 * gg.z + bb.z; o.w = (v1[i].w - mu1) * r1 * gg.w + bb.w;
    reinterpret_cast<float4*>(d1)[lane + 64 * i] = o; st4(db1 + 4 * (lane + 64 * i), pack4(o.x, o.y, o.z, o.w));
  }
}

DI void tconv_tile(const float* src, int ldsrc, int K, bf16_t* dst, int n0, int k0, bool winmap, float* tile, int dk = 0) {
  const int tid = otid();
#pragma unroll
  for (int rr = 0; rr < 8; ++rr) {
    const int kl = rr * 8 + (tid >> 6), nl = tid & 63, np = n0 + nl;
    int n = np; bool ok = true;
    if (winmap) { if (np >= 3840) n = np - 56; else if (np >= 3784) ok = false; }
    tile[kl * 65 + nl] = ok ? src[(size_t)(k0 + kl) * ldsrc + n] : 0.f;
  }
  __syncthreads();
#pragma unroll
  for (int rr = 0; rr < 8; ++rr) {
    const int nl = rr * 8 + (tid >> 6), kl = tid & 63;
    dst[(size_t)(n0 + nl) * K + dk + k0 + kl] = f2bf(tile[kl * 65 + nl]);
  }
  __syncthreads();
}

DI void convert_layer(const Params& p, int l, char* smem) {
  float* tile = reinterpret_cast<float*>(smem);
  const int G = gridDim.x;
  for (int it = blockIdx.x; it < 1984; it += G) {
    if (it < 1472) { int nt = it >> 4, kt = it & 15; tconv_tile(p.w_in + (size_t)l * 1024 * D_IN, D_IN, 1024, (reinterpret_cast<bf16_t*>(p.ws + OFF_WINT)), nt * 64, kt * 64, true, tile); }
    else if (it < 1600) { int i = it - 1472; int nt = i >> 3, kt = i & 7; tconv_tile(p.w_pa + (size_t)l * 512 * 1024, 1024, 1024, (reinterpret_cast<bf16_t*>(p.ws + OFF_WPAT)), nt * 64, kt * 64, false, tile); }
    else if (it < 1728) { int i = it - 1600; int nt = i >> 3, kt = i & 7; tconv_tile(p.w_pb + (size_t)l * 512 * 1024, 1024, 1024, (reinterpret_cast<bf16_t*>(p.ws + OFF_WPAT)), nt * 64, kt * 64, false, tile, 512); }
    else { int i = it - 1728; int nt = i >> 4, kt = i & 15; tconv_tile(p.w_out + (size_t)l * 1024 * 1024, 1024, 1024, (reinterpret_cast<bf16_t*>(p.ws + OFF_WOUTT)), nt * 64, kt * 64, false, tile); }
  }
  const int gtid = blockIdx.x * NTHREADS + otid(), gn = G * NTHREADS;
#pragma unroll 4
  for (int idx = gtid; idx < 8 * 1024 * 512; idx += gn) {
    int b = idx >> 19, rem = idx & ((1 << 19) - 1);
    (reinterpret_cast<bf16_t*>(p.ws + OFF_KAS))[(size_t)b * LS * 512 + rem] = f2bf(p.c_sb_k[(size_t)l * 8 * 1024 * 512 + idx]);
  }
#pragma unroll 4
  for (int idx = gtid; idx < 8 * 512 * 1024; idx += gn) {
    int b = idx >> 19, hd = (idx >> 10) & 511, t = idx & 1023;
    (reinterpret_cast<bf16_t*>(p.ws + OFF_VATS))[((size_t)b * 512 + hd) * LS + t] = f2bf(p.c_sb_v[(((size_t)l * 8 + b) * 1024 + t) * 512 + hd]);
  }
  for (int idx = gtid; idx < 8 * 1024 * 64; idx += gn) {
    int b = idx >> 16, rem = idx & 65535;
    (reinterpret_cast<bf16_t*>(p.ws + OFF_KBS))[(size_t)b * LS * 64 + rem] = f2bf(p.c_dsa_k[(size_t)l * 8 * 65536 + idx]);
    (reinterpret_cast<bf16_t*>(p.ws + OFF_KIS))[(size_t)b * LS * 64 + rem] = f2bf(p.c_idx_k[(size_t)l * 8 * 65536 + idx]);
    int d = (idx >> 10) & 63, t = idx & 1023;
    (reinterpret_cast<bf16_t*>(p.ws + OFF_VBTS))[((size_t)b * 64 + d) * LS + t] = f2bf(p.c_dsa_v[(((size_t)l * 8 + b) * 1024 + t) * 64 + d]);
  }
}

DI void phase_prologue(const Params& p, char* smem) {
  const int tid = otid(), lane = tid & 63;
  if (blockIdx.x == 0 && tid < 16) (reinterpret_cast<int*>(p.ws + OFF_CTR))[tid] = 0;
  for (int i = blockIdx.x * NTHREADS + tid; i < 4096; i += gridDim.x * NTHREADS) {
    int rel = i - 2047; int n = rel < 0 ? -rel : rel;
    float nf = (float)(n > 1 ? n : 1);
    int large = 8 + (int)(logf(nf / 8.f) / 2.7725887f * 8.f);
    large = large < 15 ? large : 15;
    int bk = (rel > 0 ? 16 : 0) + (n < 8 ? n : large);
    (reinterpret_cast<unsigned char*>(p.ws + OFF_BTAB))[i] = (unsigned char)bk;
  }
  {
    const int stride = gridDim.x * NWAVES;
    for (int row = blockIdx.x * NWAVES + (tid >> 6); row < MT; row += 2 * stride) {
      const int row2 = row + stride;
      const float* src = row < MP ? p.x_prompt + (size_t)row * 1024 : p.x_sample + (size_t)(row - MP) * 1024;
      if (row2 < MT) {
        const float* src2 = row2 < MP ? p.x_prompt + (size_t)row2 * 1024 : p.x_sample + (size_t)(row2 - MP) * 1024;
        ln_rows2(src, src2, p.ln_in_g, p.ln_in_b, p.out + (size_t)row * 1024, (reinterpret_cast<bf16_t*>(p.ws + OFF_XB)) + (size_t)row * 1024, p.out + (size_t)row2 * 1024, (reinterpret_cast<bf16_t*>(p.ws + OFF_XB)) + (size_t)row2 * 1024, lane);
      } else ln_row_wave(src, p.ln_in_g, p.ln_in_b, p.out + (size_t)row * 1024, (reinterpret_cast<bf16_t*>(p.ws + OFF_XB)) + (size_t)row * 1024, lane);
    }
  }
  convert_layer(p, 0, smem);
}


namespace pg8 {
#define PG8_LAS __attribute__((address_space(3)))
constexpr int BM = 256, BK = 64, HALF = 128, HTB = HALF * BK * 2, STAGE_BYTES = 8 * HTB, NXCD = 8, WGM = 8;
DI int lds_byte(int r, int c) { const int st = (r >> 4) * 2 + (c >> 5), rr = r & 15, cc = c & 31, ob = rr * 64 + cc * 2; return st * 1024 + (ob ^ (((ob >> 9) & 1) << 5)); }
DI void stage_rc(int b, int& R, int& C) { const int st = b / 1024, sb = b % 1024, swz = sb ^ (((sb >> 9) & 1) << 5); R = (st >> 1) * 16 + swz / 64; C = (st & 1) * 32 + (swz % 64) / 2; }
DI int perm32(int rho) { const int n = rho >> 4, i = rho & 15; return 8 * (i >> 2) + 4 * n + (i & 3); }
struct Unit { int pm, pn; };
struct Gemm { const bf16_t* A; const bf16_t* Bt; int M, N, K; };
struct StaticOrder {
    int nM, nN, nwg, G, c;
    DI void init(int M, int N, int G_, int c_) { nM = M / BM; nN = N / BM; nwg = nM * nN; G = G_; c = c_; }
    DI bool next(int i, Unit& u) const {
        const long L = (long)i * G + c; if (L >= nwg) return false;
        int wgid = (int)L; { const int q = nwg / NXCD, r = nwg % NXCD, xcd = wgid % NXCD, off = wgid / NXCD; wgid = (xcd < r ? xcd * (q + 1) : r * (q + 1) + (xcd - r) * q) + off; }
        const int nig = WGM * nN, gid = wgid / nig, fm = gid * WGM, gsz = (nM - fm) < WGM ? (nM - fm) : WGM;
        u.pm = fm + ((wgid % nig) % gsz); u.pn = (wgid % nig) / gsz; return true;
    }
    DI void a_ready(const Unit&) const {}
    DI void done(const Unit&) const {}
};
template <class Epi, class Sched>
__device__ __forceinline__ void gemm_phase(PG8_LAS unsigned char* lds, const Gemm g, const Sched& S, const Epi& E) {
    const int tid = otid(), wid = __builtin_amdgcn_readfirstlane(tid >> 6), lane = tid & 63, wr = wid >> 2, wc = wid & 3, fr = lane & 15, fq = lane >> 4;
    const int K = g.K, nt = K / BK;
    unsigned voffA[2], voffB[2];
#pragma unroll
    for (int i = 0; i < 2; ++i) { int R, C; stage_rc(tid * 16 + i * 8192, R, C); const int Rb = Epi::PERM ? ((R & ~31) + perm32(R & 31)) : R;
        voffA[i] = (unsigned)(R * K + C) * 2u; voffB[i] = (unsigned)(Rb * K + C) * 2u; }
    const size_t kstep = (size_t)(BK * 2);
    const size_t hstep = (size_t)HALF * K * 2;
    const size_t tstep = 2 * hstep;
    const unsigned ldsw = (unsigned)wid * 1024u;
    const int aoff = lds_byte(wr * 64 + fr, fq * 8), boff = lds_byte(wc * 32 + fr, fq * 8);
#define PG8_SA(b, h) (((b) * 2 + (h)) * HTB)
#define PG8_SB(b, h) ((4 + (b) * 2 + (h)) * HTB)
#define PG8_STAGE(bufoff, gbase, voff) do { _Pragma("unroll") for (int _i = 0; _i < 2; ++_i) \
        __builtin_amdgcn_global_load_lds((const unsigned*)((const char*)(gbase) + (voff)[_i]), (PG8_LAS unsigned*)(lds + (bufoff) + ldsw + _i * 8192), 16, 0, 0); } while (0)
#define PG8_LDA(dst, b, h) do { _Pragma("unroll") for (int m = 0; m < 4; ++m) _Pragma("unroll") for (int k = 0; k < 2; ++k) dst[m][k] = *(const PG8_LAS bf16x8*)(lds + PG8_SA(b, h) + aoff + m * 2048 + k * 1024); } while (0)
#define PG8_LDB(dst, b, h) do { _Pragma("unroll") for (int n = 0; n < 2; ++n) _Pragma("unroll") for (int k = 0; k < 2; ++k) dst[n][k] = *(const PG8_LAS bf16x8*)(lds + PG8_SB(b, h) + boff + n * 2048 + k * 1024); } while (0)
#define PG8_MMA(ai, bj, At, Bt) do { __builtin_amdgcn_s_setprio(1); _Pragma("unroll") for (int m = 0; m < 4; ++m) _Pragma("unroll") for (int n = 0; n < 2; ++n) _Pragma("unroll") for (int k = 0; k < 2; ++k) \
        acc[ai][bj][m][n] = __builtin_amdgcn_mfma_f32_16x16x32_bf16(Bt[n][k], At[m][k], acc[ai][bj][m][n], 0, 0, 0); __builtin_amdgcn_s_setprio(0); } while (0)
#define PG8_WAIT_V(n) asm volatile("s_waitcnt vmcnt(" #n ")" ::: "memory")
#define PG8_WAIT_L(n) asm volatile("s_waitcnt lgkmcnt(" #n ")" ::: "memory")
#define PG8_BAR __builtin_amdgcn_s_barrier()
#define PG8_SCHED __builtin_amdgcn_sched_barrier(0)
    Unit cur, nxt; int ui = 0;
    if (!S.next(0, cur)) return;
    f32x4 acc[2][2][4][2];
#pragma unroll
    for (int a = 0; a < 2; ++a)
#pragma unroll
        for (int b = 0; b < 2; ++b)
#pragma unroll
            for (int m = 0; m < 4; ++m)
#pragma unroll
                for (int n = 0; n < 2; ++n) acc[a][b][m][n] = (f32x4){0.f, 0.f, 0.f, 0.f};
    bf16x8 At[4][2], B0[2][2], B1[2][2];
    const char* cA = (const char*)g.A + (size_t)cur.pm * tstep; const char* cB = (const char*)g.Bt + (size_t)cur.pn * tstep;
    S.a_ready(cur);
    PG8_STAGE(PG8_SB(0, 0), cB, voffB); PG8_STAGE(PG8_SA(0, 0), cA, voffA); PG8_STAGE(PG8_SB(0, 1), cB + hstep, voffB); PG8_STAGE(PG8_SA(0, 1), cA + hstep, voffA);
    if (wr == 1) PG8_BAR;
    PG8_WAIT_V(4); PG8_BAR;
    PG8_STAGE(PG8_SB(1, 0), cB + kstep, voffB); PG8_STAGE(PG8_SA(1, 0), cA + kstep, voffA); PG8_STAGE(PG8_SB(1, 1), cB + hstep + kstep, voffB);
    PG8_WAIT_V(6); PG8_BAR;
    for (;;) {
        const bool has_next = S.next(ui + 1, nxt);
        const char* nA = has_next ? (const char*)g.A + (size_t)nxt.pm * tstep : cA; const char* nB = has_next ? (const char*)g.Bt + (size_t)nxt.pn * tstep : cB;
        for (int t = 0; t < nt; t += 2) {
            const bool last = (t == nt - 2);
            const char* a1 = cA + (size_t)(t + 1) * kstep;
            const char* a2 = last ? nA : cA + (size_t)(t + 2) * kstep; const char* b2 = last ? nB : cB + (size_t)(t + 2) * kstep;
            const char* a3 = a2 + kstep; const char* b3 = b2 + kstep;
            if (last && has_next) S.a_ready(nxt);
            if constexpr (Epi::MIDK) { if (t == nt / 2) E.mid(acc, cur, wr, wc, fr, fq); }
            PG8_LDB(B0, 0, 0); PG8_SCHED; PG8_LDA(At, 0, 0); PG8_STAGE(PG8_SA(1, 1), a1 + hstep, voffA);
            PG8_WAIT_L(8); PG8_BAR; PG8_WAIT_L(0); PG8_MMA(0, 0, At, B0); PG8_BAR; PG8_SCHED;
            PG8_LDB(B1, 0, 1); PG8_STAGE(PG8_SB(0, 0), b2, voffB);
            PG8_BAR; PG8_WAIT_L(0); PG8_MMA(0, 1, At, B1); PG8_BAR;
            PG8_LDA(At, 0, 1); PG8_STAGE(PG8_SA(0, 0), a2, voffA);
            PG8_BAR; PG8_WAIT_L(0); PG8_MMA(1, 0, At, B0); PG8_BAR; PG8_SCHED;
            PG8_STAGE(PG8_SB(0, 1), b2 + hstep, voffB);
            PG8_WAIT_V(6); PG8_BAR; PG8_MMA(1, 1, At, B1); PG8_BAR;
            PG8_LDB(B0, 1, 0); PG8_SCHED; PG8_LDA(At, 1, 0); PG8_STAGE(PG8_SA(0, 1), a2 + hstep, voffA);
            PG8_WAIT_L(8); PG8_BAR; PG8_WAIT_L(0); PG8_MMA(0, 0, At, B0); PG8_BAR; PG8_SCHED;
            PG8_LDB(B1, 1, 1); PG8_STAGE(PG8_SB(1, 0), b3, voffB);
            PG8_BAR; PG8_WAIT_L(0); PG8_MMA(0, 1, At, B1); PG8_BAR;
            PG8_LDA(At, 1, 1); PG8_STAGE(PG8_SA(1, 0), a3, voffA);
            PG8_BAR; PG8_WAIT_L(0); PG8_MMA(1, 0, At, B0); PG8_BAR; PG8_SCHED;
            PG8_STAGE(PG8_SB(1, 1), b3 + hstep, voffB);
            PG8_WAIT_V(6); PG8_BAR; PG8_MMA(1, 1, At, B1); PG8_BAR;
        }
        if constexpr (!Epi::AFTER_DRAIN) { E(acc, cur, wr, wc, fr, fq); S.done(cur); }
        if (!has_next) break;
#pragma unroll
        for (int a = 0; a < 2; ++a)
#pragma unroll
            for (int b = 0; b < 2; ++b)
#pragma unroll
                for (int m = 0; m < 4; ++m)
#pragma unroll
                    for (int n = 0; n < 2; ++n) acc[a][b][m][n] = (f32x4){0.f, 0.f, 0.f, 0.f};
        cur = nxt; cA = nA; cB = nB; ++ui;
    }
    PG8_WAIT_V(0);
    if (wr == 0) PG8_BAR;
    PG8_BAR;
    if constexpr (Epi::AFTER_DRAIN) { E.fused(acc, cur, wr, wc, fr, fq, lds, wid, lane); S.done(cur); }
#undef PG8_SA
#undef PG8_SB
#undef PG8_STAGE
#undef PG8_LDA
#undef PG8_LDB
#undef PG8_MMA
#undef PG8_WAIT_V
#undef PG8_WAIT_L
#undef PG8_BAR
#undef PG8_SCHED
}
}

DI bf16x4 pack4v(const f32x4 v) { return pack4(v[0], v[1], v[2], v[3]); }

struct EpiProj {
  static constexpr bool PERM = true, AFTER_DRAIN = false, MIDK = false;
  const Params& p; int layer; const __attribute__((address_space(3))) float* biasl;
  template <int GRP>
  DI void run(const f32x4 (&acc)[2][2][4][2], const pg8::Unit& u, int wr, int wc, int fr, int fq) const {
    constexpr int T = GRP ? LS : SEQ;
    char* ws = p.ws;
#pragma unroll
    for (int bj = 0; bj < 2; ++bj) {
      const int nt = 2 * u.pn + bj;
      const __attribute__((address_space(3))) f32x4* bp = reinterpret_cast<const __attribute__((address_space(3))) f32x4*>(biasl + nt * 128 + 32 * wc + 8 * fq);
      const bool simple = (nt < 4) || (nt >= 12 && nt < 20) || (nt >= 21 && nt < 29) || (nt >= 30);
      if (simple) {
        size_t off; int ld, c0, act;
        if (nt < 4) { off = OFF_QAB; ld = 1024; c0 = nt * 128; act = 0; }
        else if (nt < 16) { off = OFF_GA; ld = 512; c0 = (nt - 12) * 128; act = 1; }
        else if (nt < 20) { off = OFF_QAB; ld = 1024; c0 = 512 + (nt - 16) * 128; act = 0; }
        else if (nt < 25) { off = OFF_GB; ld = 512; c0 = (nt - 21) * 128; act = 1; }
        else if (nt < 29) { off = OFF_QI; ld = 512; c0 = (nt - 25) * 128; act = 0; }
        else if (nt < 38) { off = OFF_RA; ld = 1024; c0 = (nt - 30) * 128; act = 2; }
        else { off = OFF_RB; ld = 1024; c0 = (nt - 38) * 128; act = 2; }
        bf16_t* dst = reinterpret_cast<bf16_t*>(ws + off) + c0 + 32 * wc + 8 * fq;
#pragma unroll
        for (int ai = 0; ai < 2; ++ai)
#pragma unroll
          for (int m = 0; m < 4; ++m) {
            int row = u.pm * 256 + 128 * ai + 64 * wr + 16 * m + fr;
            asm volatile("" : "+v"(row));
            if (act == 2) {
              u32x2v g8;
#pragma unroll
              for (int n = 0; n < 2; ++n) {
                const f32x4 v = acc[ai][bj][m][n] + bp[n];
                unsigned q = 0u;
#pragma unroll
                for (int j = 0; j < 4; ++j) q |= ((unsigned)(sigmoidf_(v[j]) * 255.f + 0.5f)) << (8 * j);
                if (n == 0) g8.x = q; else g8.y = q;
              }
              *reinterpret_cast<u32x2v*>(reinterpret_cast<unsigned char*>(ws + off) + (size_t)row * 1024 + c0 + 32 * wc + 8 * fq) = g8;
              continue;
            }
            u32x4v pk;
#pragma unroll
            for (int n = 0; n < 2; ++n) {
              f32x4 v = acc[ai][bj][m][n] + bp[n];
              if (act != 0) {
#pragma unroll
                for (int j = 0; j < 4; ++j) { const float sg = sigmoidf_(v[j]); v[j] = (act == 1) ? v[j] * sg : sg; }
              }
              if (n == 0) { pk.x = pk2(v[0], v[1]); pk.y = pk2(v[2], v[3]); } else { pk.z = pk2(v[0], v[1]); pk.w = pk2(v[2], v[3]); }
            }
            *reinterpret_cast<u32x4v*>(dst + (size_t)row * ld) = pk;
          }
      } else {
#pragma unroll
        for (int ai = 0; ai < 2; ++ai)
#pragma unroll
          for (int m = 0; m < 4; ++m) {
            int row = u.pm * 256 + 128 * ai + 64 * wr + 16 * m + fr;
            asm volatile("" : "+v"(row));
            int bb, tt;
            if (!GRP) { bb = row >> 11; tt = row & 2047; } else { const int ms = row - MP; bb = ms >> 6; tt = PAST + (ms & 63); }
            const size_t orow = GRP ? (size_t)layer * MS + (row - MP) : (size_t)layer * MP + row;
#pragma unroll
            for (int n = 0; n < 2; ++n) {
              int ct = 32 * wc + 8 * fq + 4 * n;
              asm volatile("" : "+v"(ct));
              const f32x4 v = acc[ai][bj][m][n] + bp[n];
              if (nt < 8) {
                const int c = (nt - 4) * 128 + ct;
                *reinterpret_cast<f32x4*>(p.out + (GRP ? O_KAS : O_KAP) + orow * 512 + c) = v;
                bf16_t* kd = GRP ? (reinterpret_cast<bf16_t*>(p.ws + OFF_KAS)) + ((size_t)bb * LS + tt) * 512 + c : (reinterpret_cast<bf16_t*>(p.ws + OFF_KAP)) + (size_t)row * 512 + c;
                st4(kd, pack4v(v));
              } else if (nt < 12) {
                const int c = (nt - 8) * 128 + ct;
                *reinterpret_cast<f32x4*>(p.out + (GRP ? O_VAS : O_VAP) + orow * 512 + c) = v;
                bf16_t* vd = (GRP ? (reinterpret_cast<bf16_t*>(p.ws + OFF_VATS)) : (reinterpret_cast<bf16_t*>(p.ws + OFF_VATP))) + ((size_t)bb * 512 + c) * T + tt;
                vd[0] = f2bf(v[0]); vd[T] = f2bf(v[1]); vd[2 * T] = f2bf(v[2]); vd[3 * T] = f2bf(v[3]);
              } else if (nt == 20) {
                if (wc < 2) {
                  *reinterpret_cast<f32x4*>(p.out + (GRP ? O_KBS : O_KBP) + orow * 64 + ct) = v;
                  st4((GRP ? (reinterpret_cast<bf16_t*>(p.ws + OFF_KBS)) : (reinterpret_cast<bf16_t*>(p.ws + OFF_KBP))) + ((size_t)bb * T + tt) * 64 + ct, pack4v(v));
                } else {
                  const int c = ct - 64;
                  *reinterpret_cast<f32x4*>(p.out + (GRP ? O_VBS : O_VBP) + orow * 64 + c) = v;
                  bf16_t* vd = (GRP ? (reinterpret_cast<bf16_t*>(p.ws + OFF_VBTS)) : (reinterpret_cast<bf16_t*>(p.ws + OFF_VBTP))) + ((size_t)bb * 64 + c) * T + tt;
                  vd[0] = f2bf(v[0]); vd[T] = f2bf(v[1]); vd[2 * T] = f2bf(v[2]); vd[3 * T] = f2bf(v[3]);
                }
              } else {
                if (wc < 2) {
                  *reinterpret_cast<f32x4*>(p.out + (GRP ? O_KIS : O_KIP) + orow * 64 + ct) = v;
                  st4((GRP ? (reinterpret_cast<bf16_t*>(p.ws + OFF_KIS)) : (reinterpret_cast<bf16_t*>(p.ws + OFF_KIP))) + ((size_t)bb * T + tt) * 64 + ct, pack4v(v));
                } else if (ct < 72) {
                  *reinterpret_cast<f32x4*>((reinterpret_cast<float*>(p.ws + OFF_WI)) + (size_t)row * 8 + (ct - 64)) = v;
                }
              }
            }
          }
      }
    }
  }
  DI void operator()(const f32x4 (&acc)[2][2][4][2], const pg8::Unit& u, int wr, int wc, int fr, int fq) const {
    if (u.pm < MP / 256) run<0>(acc, u, wr, wc, fr, fq); else run<1>(acc, u, wr, wc, fr, fq);
  }
};

template <int MODE>
struct EpiTail {
  static constexpr bool PERM = false, AFTER_DRAIN = false, MIDK = (MODE == 0);
  const Params& p;
  DI void mid(f32x4 (&acc)[2][2][4][2], const pg8::Unit& u, int wr, int wc, int fr, int fq) const {
#pragma unroll
    for (int ai = 0; ai < 2; ++ai)
#pragma unroll
      for (int m = 0; m < 4; ++m) {
        int row = u.pm * 256 + 128 * ai + 64 * wr + 16 * m + fr;
        asm volatile("" : "+v"(row));
#pragma unroll
        for (int bj = 0; bj < 2; ++bj)
#pragma unroll
          for (int n = 0; n < 2; ++n) {
            const size_t idx = (size_t)row * 1024 + u.pn * 256 + 128 * bj + 32 * wc + 16 * n + 4 * fq;
            const unsigned ga = *reinterpret_cast<const unsigned*>(reinterpret_cast<const unsigned char*>(p.ws + OFF_RA) + idx);
            const unsigned gb = *reinterpret_cast<const unsigned*>(reinterpret_cast<const unsigned char*>(p.ws + OFF_RB) + idx);
#pragma unroll
            for (int j = 0; j < 4; ++j) {
              const unsigned a8 = (ga >> (8 * j)) & 255u, b8 = (gb >> (8 * j)) & 255u;
              acc[ai][bj][m][n][j] *= (float)a8 * __builtin_amdgcn_rcpf((float)(b8 > 1u ? b8 : 1u));
            }
          }
        asm volatile("" ::: "memory");
      }
  }
  DI void operator()(const f32x4 (&acc)[2][2][4][2], const pg8::Unit& u, int wr, int wc, int fr, int fq) const {
    bf16_t* MERGED = (reinterpret_cast<bf16_t*>(p.ws + OFF_GA));
#pragma unroll
    for (int ai = 0; ai < 2; ++ai)
#pragma unroll
      for (int m = 0; m < 4; ++m) {
        const int row = u.pm * 256 + 128 * ai + 64 * wr + 16 * m + fr;
#pragma unroll
        for (int bj = 0; bj < 2; ++bj)
#pragma unroll
          for (int n = 0; n < 2; ++n) {
            const size_t idx = (size_t)row * 1024 + u.pn * 256 + 128 * bj + 32 * wc + 16 * n + 4 * fq;
            const f32x4 a = acc[ai][bj][m][n];
            if (MODE == 0) {
              const unsigned g = *reinterpret_cast<const unsigned*>(reinterpret_cast<const unsigned char*>(p.ws + OFF_RB) + idx);
              const float k = 1.f / 255.f;
              st4(MERGED + idx, pack4((float)(g & 255u) * k * a[0], (float)((g >> 8) & 255u) * k * a[1], (float)((g >> 16) & 255u) * k * a[2], (float)(g >> 24) * k * a[3]));
            } else {
              f32x4 x = *reinterpret_cast<const f32x4*>(p.out + idx);
              x = x * ALPHA + a;
              *reinterpret_cast<f32x4*>(p.out + idx) = x;
            }
          }
      }
  }
};

DI void phase_proj(const Params& p, int layer, char* smem) {
  {
    const float* bin = p.b_in + (size_t)layer * D_IN;
    float* bl = reinterpret_cast<float*>(smem + 131072);
    for (int i = otid(); i < D_INP; i += NTHREADS) bl[i] = (i < 3784) ? bin[i] : (i < 3840 ? 0.f : bin[i - 56]);
    __syncthreads();
  }
  pg8::Gemm g{(reinterpret_cast<bf16_t*>(p.ws + OFF_XB)), (reinterpret_cast<bf16_t*>(p.ws + OFF_WINT)), MT, D_INP, 1024};
  pg8::StaticOrder S; S.init(MT, D_INP, osg(gridDim.x), osg(blockIdx.x));
  EpiProj E{p, layer, (const __attribute__((address_space(3))) float*)(smem + 131072)};
  pg8::gemm_phase<EpiProj, pg8::StaticOrder>((PG8_LAS unsigned char*)smem, g, S, E);
}
DI void phase_merge(const Params& p, char* smem) {
  pg8::Gemm g{(reinterpret_cast<bf16_t*>(p.ws + OFF_QAB)), (reinterpret_cast<bf16_t*>(p.ws + OFF_WPAT)), MT, 1024, 1024};
  pg8::StaticOrder S; S.init(MT, 1024, osg(gridDim.x), osg(blockIdx.x));
  EpiTail<0> E{p};
  pg8::gemm_phase<EpiTail<0>, pg8::StaticOrder>((PG8_LAS unsigned char*)smem, g, S, E);
}
DI void phase_out(const Params& p, char* smem) {
  pg8::Gemm g{(reinterpret_cast<bf16_t*>(p.ws + OFF_GA)), (reinterpret_cast<bf16_t*>(p.ws + OFF_WOUTT)), MT, 1024, 1024};
  pg8::StaticOrder S; S.init(MT, 1024, osg(gridDim.x), osg(blockIdx.x));
  EpiTail<2> E{p};
  pg8::gemm_phase<EpiTail<2>, pg8::StaticOrder>((PG8_LAS unsigned char*)smem, g, S, E);
}

template <int grp>
DI void sb_item(const Params& p, int b, int h, int t0) {
  const int tid = otid(), w = tid >> 6, lane = tid & 63, c = lane & 15, q4 = lane >> 4;
  const int T = grp ? LS : SEQ;
  const int qpos0 = grp ? PAST + t0 : t0;
  const int m0 = grp ? MP + b * DEC_SEQ + t0 : b * SEQ + t0;
  const bf16_t* Kb = (grp ? (reinterpret_cast<bf16_t*>(p.ws + OFF_KAS)) : (reinterpret_cast<bf16_t*>(p.ws + OFF_KAP))) + (size_t)b * T * 512 + h * 64;
  const bf16_t* VTb = (grp ? (reinterpret_cast<bf16_t*>(p.ws + OFF_VATS)) : (reinterpret_cast<bf16_t*>(p.ws + OFF_VATP))) + (size_t)(b * 8 + h) * 64 * T;
  const bf16_t* qp = (reinterpret_cast<bf16_t*>(p.ws + OFF_QAB)) + (size_t)(m0 + c) * 1024 + h * 64 + q4 * 8;
  const bf16x8 qf0 = ld8(qp), qf1 = ld8(qp + 32);
  const int qpos = qpos0 + c;
  float R = 0.f;
  f32x4 O[4];
#pragma unroll
  for (int dt = 0; dt < 4; ++dt) O[dt] = f32x4{0.f, 0.f, 0.f, 0.f};
  bf16x8 kfA[2][2], vfA[4], kfB[2][2], vfB[4];
  auto loadkv = [&](int kb, bf16x8 (&kf)[2][2], bf16x8 (&vf)[4]) {
    const int s0 = kb * 32;
#pragma unroll
    for (int kt = 0; kt < 2; ++kt) { const bf16_t* kp = Kb + (size_t)(s0 + 16 * kt + c) * 512 + q4 * 8; kf[kt][0] = ld8(kp); kf[kt][1] = ld8(kp + 32); }
#pragma unroll
    for (int dt = 0; dt < 4; ++dt) {
      const bf16_t* vp = VTb + (size_t)(16 * dt + c) * T + s0 + 4 * q4;
      bf16x4 lo = ld4(vp), hi = ld4(vp + 16);
      vf[dt] = __builtin_shufflevector(lo, hi, 0, 1, 2, 3, 4, 5, 6, 7);
    }
  };
  auto comp = [&](int kb, const bf16x8 (&kf)[2][2], const bf16x8 (&vf)[4]) -> bool {
    const int s0 = kb * 32;
    f32x4 z[2];
#pragma unroll
    for (int kt = 0; kt < 2; ++kt) {
      z[kt] = mfma16(kf[kt][0], qf0, f32x4{0.f, 0.f, 0.f, 0.f});
      z[kt] = mfma16(kf[kt][1], qf1, z[kt]);
    }
    float lk[2][4], ls[2][4]; bool bf[2][4];
#pragma unroll
    for (int kt = 0; kt < 2; ++kt)
#pragma unroll
      for (int r = 0; r < 4; ++r) {
        const int key = s0 + 16 * kt + 4 * q4 + r;
        const bool before = key < qpos;
        const float zz = z[kt][r] * SB_SCALE;
        const float sp = fmaxf(zz, 0.f) + __logf(1.f + __expf(-fabsf(zz)));
        bf[kt][r] = before; lk[kt][r] = before ? -sp : 0.f; ls[kt][r] = zz - sp;
      }
    const float T1 = (lk[1][0] + lk[1][1]) + (lk[1][2] + lk[1][3]);
    const float T0 = (lk[0][0] + lk[0][1]) + (lk[0][2] + lk[0][3]);
    const F2 x1 = swap16(T1), x0 = swap16(T0);
    const float p1 = x1.lo + x1.hi, p0 = x0.lo + x0.hi;
    const F2 y1 = swap32(p1), y0 = swap32(p0);
    const float H1 = ((q4 & 1) ? 0.f : x1.hi) + ((q4 & 2) ? 0.f : y1.hi);
    const float H0 = ((q4 & 1) ? 0.f : x0.hi) + ((q4 & 2) ? 0.f : y0.hi);
    const float TT1 = y1.lo + y1.hi, TT0 = y0.lo + y0.hi;
    float a[2][4];
    { float ac = R + H1;
#pragma unroll
      for (int r = 3; r >= 0; --r) { a[1][r] = bf[1][r] ? __expf(ls[1][r] + ac) : 0.f; ac += lk[1][r]; } }
    { float ac = R + TT1 + H0;
#pragma unroll
      for (int r = 3; r >= 0; --r) { a[0][r] = bf[0][r] ? __expf(ls[0][r] + ac) : 0.f; ac += lk[0][r]; } }
    R = R + TT1 + TT0;
    const float ae[8] = {a[0][0], a[0][1], a[0][2], a[0][3], a[1][0], a[1][1], a[1][2], a[1][3]};
    const bf16x8 pf = pack8(ae);
#pragma unroll
    for (int dt = 0; dt < 4; ++dt) O[dt] = mfma16(vf[dt], pf, O[dt]);
    return __ballot(R > -50.f) == 0ull;
  };
  {
    int kb = (qpos0 + 14) >> 5;
    loadkv(kb, kfA, vfA);
    while (true) {
      if (kb >= 1) loadkv(kb - 1, kfB, vfB);
      if (comp(kb, kfA, vfA) || kb == 0) break;
      --kb;
      if (kb >= 1) loadkv(kb - 1, kfA, vfA);
      if (comp(kb, kfB, vfB) || kb == 0) break;
      --kb;
    }
  }
#pragma unroll
  for (int dt = 0; dt < 4; ++dt) {
    const size_t off = (size_t)(m0 + c) * 512 + h * 64 + dt * 16 + 4 * q4;
    const size_t offq = (size_t)(m0 + c) * 1024 + h * 64 + dt * 16 + 4 * q4;
    const bf16x4 g = ld4((reinterpret_cast<bf16_t*>(p.ws + OFF_GA)) + off);
    st4((reinterpret_cast<bf16_t*>(p.ws + OFF_QAB)) + offq, pack4(O[dt][0] * bf2f(g[0]), O[dt][1] * bf2f(g[1]), O[dt][2] * bf2f(g[2]), O[dt][3] * bf2f(g[3])));
  }
}

template <int NK>
DI void topk_round(const unsigned short* Sh, int n_adm, int half, int l32, unsigned* bmrow) {
  unsigned key[NK];
#pragma unroll
  for (int i = 0; i < NK; ++i) {
    const int s = 32 * i + l32;
    const unsigned k = Sh[s];
    key[i] = (s < n_adm) ? k : 0u;
  }
  unsigned tau = 1u; int need = 0; bool done = true;
  if (n_adm > 256) {
    tau = 0u; done = false;
    for (int bit = 15; bit >= 0; --bit) {
      const unsigned cand = tau | (1u << bit);
      int cnt = 0;
#pragma unroll
      for (int i = 0; i < NK; ++i) cnt += (key[i] >= cand) ? 1 : 0;
      cnt = hsum32(cnt);
      if (!done && cnt >= 256) tau = cand;
      if (cnt == 256) done = true;
      if (__ballot(!done) == 0ull) break;
    }
  }
  unsigned w0 = 0u, w1 = 0u;
  if (__ballot(!done) == 0ull) {
#pragma unroll
    for (int i = 0; i < NK; ++i) {
      const unsigned long long msel = __ballot(key[i] >= tau);
      const unsigned wsel = half ? (unsigned)(msel >> 32) : (unsigned)msel;
      if (i < 32) { if (l32 == i) w0 = wsel; } else { if (l32 == i - 32) w1 = wsel; }
    }
  } else {
    int cgt = 0;
#pragma unroll
    for (int i = 0; i < NK; ++i) cgt += (key[i] > tau) ? 1 : 0;
    cgt = hsum32(cgt);
    need = 256 - cgt;
    int Rk = 0; const unsigned below = (1u << l32) - 1u;
#pragma unroll
    for (int i = 0; i < NK; ++i) {
      const bool eq = key[i] == tau, gt = key[i] > tau;
      const unsigned long long me = __ballot(eq);
      const unsigned hm = half ? (unsigned)(me >> 32) : (unsigned)me;
      const int rank = Rk + __popc(hm & below);
      const bool sel = done ? (key[i] >= tau) : (gt || (eq && rank < need));
      Rk += __popc(hm);
      const unsigned long long msel = __ballot(sel);
      const unsigned wsel = half ? (unsigned)(msel >> 32) : (unsigned)msel;
      if (i < 32) { if (l32 == i) w0 = wsel; } else { if (l32 == i - 32) w1 = wsel; }
    }
  }
  bmrow[l32] = w0;
  if (NK > 32) bmrow[32 + l32] = w1;
}

template <int grp>
DI void dsa_item(const Params& p, int b, int tile32, char* smem) {
  const int tid = otid(), w = tid >> 6, lane = tid & 63, c = lane & 15, q4 = lane >> 4, half = lane >> 5, l32 = lane & 31;
  unsigned* bm = reinterpret_cast<unsigned*>(smem + LDS_BM);
  const unsigned char* btab = reinterpret_cast<const unsigned char*>(smem + LDS_BTAB);
  const float* rb = reinterpret_cast<const float*>(smem + LDS_RB);
  const int T = grp ? LS : SEQ;
  const int t0 = tile32 * 32;
  const int qpos0 = grp ? PAST + t0 : t0;
  const int m0 = grp ? MP + b * DEC_SEQ + t0 : b * SEQ + t0;
  const int n_adm = grp ? LS : ((qpos0 >> 6) + 1) * 64;
  const bf16_t* KIb = (grp ? (reinterpret_cast<bf16_t*>(p.ws + OFF_KIS)) : (reinterpret_cast<bf16_t*>(p.ws + OFF_KIP))) + (size_t)b * T * 64;
  const bf16_t* KBb = (grp ? (reinterpret_cast<bf16_t*>(p.ws + OFF_KBS)) : (reinterpret_cast<bf16_t*>(p.ws + OFF_KBP))) + (size_t)b * T * 64;
  const bf16_t* VBTb = (grp ? (reinterpret_cast<bf16_t*>(p.ws + OFF_VBTS)) : (reinterpret_cast<bf16_t*>(p.ws + OFF_VBTP))) + (size_t)b * 64 * T;

  unsigned short* S16 = reinterpret_cast<unsigned short*>(smem) + w * 8192;
  {
    const int tlA = c >> 3, hA = c & 7, tlC = q4 >> 1;
    bf16x8 af[2][2]; float4 wv[2];
#pragma unroll
    for (int pr = 0; pr < 2; ++pr) {
      const bf16_t* qip = (reinterpret_cast<bf16_t*>(p.ws + OFF_QI)) + (size_t)(m0 + 4 * w + 2 * pr + tlA) * 512 + hA * 64 + q4 * 8;
      af[pr][0] = ld8(qip); af[pr][1] = ld8(qip + 32);
      wv[pr] = *reinterpret_cast<const float4*>((reinterpret_cast<float*>(p.ws + OFF_WI)) + (size_t)(m0 + 4 * w + 2 * pr + tlC) * 8 + 4 * (q4 & 1));
    }
    const int nch = n_adm >> 6;
    char* kis = smem + LDS_KI;
    const int lrow = tid >> 3, lseg = tid & 7;
    bf16x8 pre = ld8(KIb + (size_t)lrow * 64 + lseg * 8);
    *reinterpret_cast<bf16x8*>(kis + lrow * 144 + lseg * 16) = pre;
    __syncthreads();
    for (int ch = 0; ch < nch; ++ch) {
      const bool more = ch + 1 < nch;
      if (more) pre = ld8(KIb + (size_t)((ch + 1) * 64 + lrow) * 64 + lseg * 8);
      const char* cur = kis + (ch & 1) * 9216;
#pragma unroll
      for (int u = 0; u < 4; ++u) {
        const char* rp = cur + (u * 16 + c) * 144 + q4 * 16;
        const bf16x8 b0 = *reinterpret_cast<const bf16x8*>(rp), b1 = *reinterpret_cast<const bf16x8*>(rp + 64);
#pragma unroll
        for (int pr = 0; pr < 2; ++pr) {
          f32x4 C = mfma16(af[pr][0], b0, f32x4{0.f, 0.f, 0.f, 0.f});
          C = mfma16(af[pr][1], b1, C);
          const float part = wv[pr].x * fmaxf(C[0], 0.f) + wv[pr].y * fmaxf(C[1], 0.f) + wv[pr].z * fmaxf(C[2], 0.f) + wv[pr].w * fmaxf(C[3], 0.f);
          const F2 ps = swap16(part); const float full = ps.lo + ps.hi;
          const unsigned hu = (unsigned)__builtin_bit_cast(unsigned short, (_Float16)full);
          const unsigned hk = (hu & 0x8000u) ? (~hu & 0xFFFFu) : (hu | 0x8000u);
          if ((q4 & 1) == 0) S16[(2 * pr + tlC) * 2048 + (ch * 4 + u) * 16 + c] = (unsigned short)hk;
        }
      }
      if (more) *reinterpret_cast<bf16x8*>(kis + ((ch + 1) & 1) * 9216 + lrow * 144 + lseg * 16) = pre;
      __syncthreads();
    }
  }
  for (int rnd = 0; rnd < 2; ++rnd) {
    const unsigned short* Sh = S16 + (2 * rnd + half) * 2048;
    unsigned* bmrow = bm + (4 * w + 2 * rnd + half) * 64;
    const int nreg = n_adm >> 5;
    if (nreg <= 16) topk_round<16>(Sh, n_adm, half, l32, bmrow);
    else if (nreg <= 32) topk_round<32>(Sh, n_adm, half, l32, bmrow);
    else if (nreg <= 48) topk_round<48>(Sh, n_adm, half, l32, bmrow);
    else topk_round<64>(Sh, n_adm, half, l32, bmrow);
  }
  __syncthreads();

  {
    const int tl = c >> 3, h = c & 7;
    bf16x8 qf[2][2]; int qposc[2], qrow[2], qloc[2];
#pragma unroll
    for (int ct = 0; ct < 2; ++ct) {
      qloc[ct] = 4 * w + 2 * ct + tl; qrow[ct] = m0 + qloc[ct]; qposc[ct] = qpos0 + qloc[ct];
      const bf16_t* qp = (reinterpret_cast<bf16_t*>(p.ws + OFF_QAB)) + (size_t)qrow[ct] * 1024 + 512 + h * 64 + q4 * 8;
      qf[ct][0] = ld8(qp); qf[ct][1] = ld8(qp + 32);
    }
    f32x4 O[2][4]; float mrun[2] = {-1e30f, -1e30f}, lrun[2] = {0.f, 0.f};
#pragma unroll
    for (int ct = 0; ct < 2; ++ct)
#pragma unroll
      for (int dt = 0; dt < 4; ++dt) O[ct][dt] = f32x4{0.f, 0.f, 0.f, 0.f};
    const int nkb = n_adm >> 5;
    const float farbias = rb[15 * 8 + h];
    auto compkv = [&](auto FAR, int kb, const bf16x8 (&kf)[2][2], const bf16x8 (&vf)[4]) {
      constexpr bool far = decltype(FAR)::value;
      const int s0 = kb * 32;
#pragma unroll
      for (int ct = 0; ct < 2; ++ct) {
        f32x4 z0 = mfma16(kf[0][0], qf[ct][0], f32x4{0.f, 0.f, 0.f, 0.f}); z0 = mfma16(kf[0][1], qf[ct][1], z0);
        f32x4 z1 = mfma16(kf[1][0], qf[ct][0], f32x4{0.f, 0.f, 0.f, 0.f}); z1 = mfma16(kf[1][1], qf[ct][1], z1);
        const unsigned word = bm[qloc[ct] * 64 + kb];
        float zz[8]; bool bt[8]; float bmx = -1e30f;
#pragma unroll
        for (int e = 0; e < 8; ++e) {
          const int kt = e >> 2, r = e & 3;
          const int off = 16 * kt + 4 * q4 + r;
          float bias = farbias;
          if (!far) { const int rel = s0 + off - qposc[ct]; const int bk = btab[rel + 2047]; bias = rb[bk * 8 + h]; }
          const float zv = (kt ? z1[r] : z0[r]) * ATT_SCALE + bias;
          bt[e] = (word >> off) & 1u;
          zz[e] = bt[e] ? zv : -1e30f;
          bmx = fmaxf(bmx, zz[e]);
        }
        { const F2 m16 = swap16(bmx); bmx = fmaxf(m16.lo, m16.hi); const F2 m32 = swap32(bmx); bmx = fmaxf(m32.lo, m32.hi); }
        const float mnew = fmaxf(mrun[ct], bmx);
        const float sc = __expf(mrun[ct] - mnew);
        float ps = 0.f; float pe[8];
#pragma unroll
        for (int e = 0; e < 8; ++e) { pe[e] = bt[e] ? __expf(zz[e] - mnew) : 0.f; ps += pe[e]; }
        lrun[ct] = lrun[ct] * sc + ps; mrun[ct] = mnew;
        const bf16x8 pf = pack8(pe);
#pragma unroll
        for (int dt = 0; dt < 4; ++dt) { O[ct][dt] *= sc; O[ct][dt] = mfma16(vf[dt], pf, O[ct][dt]); }
      }
    };
    int nfar = (qpos0 - 159) >= 0 ? ((qpos0 - 159) >> 5) + 1 : 0;
    nfar = nfar < nkb ? nfar : nkb;
    char* kd = smem; char* vd = smem + 18432;
    const int srow = tid >> 3, sseg = tid & 7;
    bf16x8 preK = ld8(KBb + (size_t)srow * 64 + sseg * 8);
    bf16x8 preV = ld8(VBTb + (size_t)srow * T + sseg * 8);
    *reinterpret_cast<bf16x8*>(kd + srow * 144 + sseg * 16) = preK;
    *reinterpret_cast<bf16x8*>(vd + srow * 144 + sseg * 16) = preV;
    __syncthreads();
    const int nkb2 = n_adm >> 6;
    for (int kb2 = 0; kb2 < nkb2; ++kb2) {
      const bool more = kb2 + 1 < nkb2;
      if (more) {
        preK = ld8(KBb + (size_t)((kb2 + 1) * 64 + srow) * 64 + sseg * 8);
        preV = ld8(VBTb + (size_t)srow * T + (kb2 + 1) * 64 + sseg * 8);
      }
      const char* kc = kd + (kb2 & 1) * 9216; const char* vc = vd + (kb2 & 1) * 9216;
#pragma unroll
      for (int sub = 0; sub < 2; ++sub) {
        const int kb = 2 * kb2 + sub;
        bf16x8 kf[2][2], vf[4];
#pragma unroll
        for (int kt = 0; kt < 2; ++kt)
#pragma unroll
          for (int kk = 0; kk < 2; ++kk) kf[kt][kk] = *reinterpret_cast<const bf16x8*>(kc + (32 * sub + 16 * kt + c) * 144 + kk * 64 + q4 * 16);
#pragma unroll
        for (int dt = 0; dt < 4; ++dt) {
          const char* vp = vc + (16 * dt + c) * 144 + sub * 64 + q4 * 8;
          const bf16x4 lo = *reinterpret_cast<const bf16x4*>(vp), hi = *reinterpret_cast<const bf16x4*>(vp + 32);
          vf[dt] = __builtin_shufflevector(lo, hi, 0, 1, 2, 3, 4, 5, 6, 7);
        }
        if (kb < nfar) compkv(std::true_type{}, kb, kf, vf); else compkv(std::false_type{}, kb, kf, vf);
      }
      if (more) {
        *reinterpret_cast<bf16x8*>(kd + ((kb2 + 1) & 1) * 9216 + srow * 144 + sseg * 16) = preK;
        *reinterpret_cast<bf16x8*>(vd + ((kb2 + 1) & 1) * 9216 + srow * 144 + sseg * 16) = preV;
      }
      __syncthreads();
    }
#pragma unroll
    for (int ct = 0; ct < 2; ++ct) {
      float lt = lrun[ct]; { const F2 a = swap16(lt); lt = a.lo + a.hi; const F2 b = swap32(lt); lt = b.lo + b.hi; }
      const float inv = 1.f / lt;
#pragma unroll
      for (int dt = 0; dt < 4; ++dt) {
        const size_t off = (size_t)qrow[ct] * 512 + h * 64 + dt * 16 + 4 * q4;
        const size_t offq = (size_t)qrow[ct] * 1024 + 512 + h * 64 + dt * 16 + 4 * q4;
        const bf16x4 g = ld4((reinterpret_cast<bf16_t*>(p.ws + OFF_GB)) + off);
        st4((reinterpret_cast<bf16_t*>(p.ws + OFF_QAB)) + offq, pack4(O[ct][dt][0] * inv * bf2f(g[0]), O[ct][dt][1] * inv * bf2f(g[1]), O[ct][dt][2] * inv * bf2f(g[2]), O[ct][dt][3] * inv * bf2f(g[3])));
      }
    }
  }
  __syncthreads();
}

DI void phase_attn(const Params& p, int layer, char* smem) {
  const int tid = otid();
  for (int i = tid; i < 4096; i += NTHREADS) smem[LDS_BTAB + i] = (char)(reinterpret_cast<unsigned char*>(p.ws + OFF_BTAB))[i];
  if (tid < 256) reinterpret_cast<float*>(smem + LDS_RB)[tid] = p.rel_bias[tid];
  __syncthreads();
  int* slot = reinterpret_cast<int*>(smem + LDS_SLOT);
  const int w = tid >> 6;
  const int total = 16 + 2048 + 32 + 4096;
  if (tid == 0) *slot = atomicAdd(&(reinterpret_cast<int*>(p.ws + OFF_CTR))[layer], 1);
  __syncthreads();
  int item = *slot;
  while (item < total) {
    int nxt = 0;
    if (tid == 0) nxt = atomicAdd(&(reinterpret_cast<int*>(p.ws + OFF_CTR))[layer], 1);
    if (item < 16) dsa_item<1>(p, item >> 1, item & 1, smem);
    else if (item < 2064) { const int i = item - 16; dsa_item<0>(p, i >> 6, 63 - (i & 63), smem); }
    else if (item < 2096) { const int i = item - 2064; sb_item<1>(p, i >> 2, 2 * (i & 3) + (w >> 2), (w & 3) * 16); }
    else { const int i = item - 2096; const int tile = 15 - (i >> 8), bh = i & 255; sb_item<0>(p, bh >> 3, bh & 7, tile * 128 + w * 16); }
    __syncthreads();
    if (tid == 0) *slot = nxt;
    __syncthreads();
    item = *slot;
  }
}

DI void phase_ln(const Params& p, int layer, char* smem) {
  const int tid = otid(), lane = tid & 63;
  {
    const int stride = gridDim.x * NWAVES;
    const float* g = p.ln_g + layer * 1024; const float* b = p.ln_b + layer * 1024;
    for (int row = blockIdx.x * NWAVES + (tid >> 6); row < MT; row += 2 * stride) {
      const int row2 = row + stride;
      if (row2 < MT) ln_rows2(p.out + (size_t)row * 1024, p.out + (size_t)row2 * 1024, g, b, p.out + (size_t)row * 1024, (reinterpret_cast<bf16_t*>(p.ws + OFF_XB)) + (size_t)row * 1024, p.out + (size_t)row2 * 1024, (reinterpret_cast<bf16_t*>(p.ws + OFF_XB)) + (size_t)row2 * 1024, lane);
      else ln_row_wave(p.out + (size_t)row * 1024, g, b, p.out + (size_t)row * 1024, (reinterpret_cast<bf16_t*>(p.ws + OFF_XB)) + (size_t)row * 1024, lane);
    }
  }
  if (layer + 1 < DEPTH) convert_layer(p, layer + 1, smem);
}

__global__ void __launch_bounds__(512, 2) mega_kernel(Params p) {
  extern __shared__ __attribute__((aligned(16))) char smem[];
  cg::grid_group grid = cg::this_grid();
  phase_prologue(p, smem);
  grid.sync();
  unsigned* bar = reinterpret_cast<unsigned*>((reinterpret_cast<int*>(p.ws + OFF_CTR)) + 8);
  unsigned nb = 0; const unsigned G = gridDim.x;
#pragma nounroll
  for (int l = 0; l < DEPTH; ++l) {
    phase_proj(p, l, smem);
    gbar(bar, ++nb * G);
    phase_attn(p, l, smem);
    gbar(bar, ++nb * G);
    phase_merge(p, smem);
    gbar(bar, ++nb * G);
    phase_out(p, smem);
    gbar(bar, ++nb * G);
    phase_ln(p, l, smem);
    if (l + 1 < DEPTH) gbar(bar, ++nb * G);
  }
}

#if !USE_COOP
__global__ void __launch_bounds__(512, 2) phase_kernel(Params p, int phase, int layer) {
  extern __shared__ __attribute__((aligned(16))) char smem[];
  if (phase == 0) phase_prologue(p, smem);
  else if (phase == 1) phase_proj(p, layer, smem);
  else if (phase == 2) phase_attn(p, layer, smem);
  else if (phase == 3) phase_merge(p, smem);
  else if (phase == 4) { }
  else if (phase == 5) phase_out(p, smem);
  else phase_ln(p, layer, smem);
}

#endif

extern "C" void kernel_launch(void* const* d_in, const int* in_sizes, int n_in, void* d_out, int out_size, void* d_ws, size_t ws_size, hipStream_t stream) {
  static int grid_blocks = 0;
  if (grid_blocks == 0) {
    if (n_in != 17 || out_size != OUT_TOTAL) { fprintf(stderr, "kernel_launch: unexpected shapes n_in=%d out=%d\n", n_in, out_size); grid_blocks = -1; return; }
    int dev = 0, cus = 0, per_cu = 0;
    hipGetDevice(&dev);
    hipDeviceGetAttribute(&cus, hipDeviceAttributeMultiprocessorCount, dev);
    hipFuncSetAttribute((const void*)mega_kernel, hipFuncAttributeMaxDynamicSharedMemorySize, LDS_BYTES);
#if !USE_COOP
    hipFuncSetAttribute((const void*)phase_kernel, hipFuncAttributeMaxDynamicSharedMemorySize, LDS_BYTES);
#endif
    hipOccupancyMaxActiveBlocksPerMultiprocessor(&per_cu, (const void*)mega_kernel, NTHREADS, LDS_BYTES);
    if (per_cu < 1) per_cu = 1;
    if (per_cu > 1) per_cu = 1;
    grid_blocks = cus * per_cu;
    fprintf(stderr, "kernel_launch: cus=%d per_cu=%d grid=%d ws=%zu\n", cus, per_cu, grid_blocks, ws_size);
  }
  if (grid_blocks < 0) return;
  Params p{};
  p.x_prompt = (const float*)d_in[0]; p.x_sample = (const float*)d_in[1];
  p.c_sb_k = (const float*)d_in[2]; p.c_sb_v = (const float*)d_in[3]; p.c_dsa_k = (const float*)d_in[4]; p.c_dsa_v = (const float*)d_in[5]; p.c_idx_k = (const float*)d_in[6];
  p.ln_in_g = (const float*)d_in[7]; p.ln_in_b = (const float*)d_in[8]; p.w_in = (const float*)d_in[9]; p.b_in = (const float*)d_in[10];
  p.w_pa = (const float*)d_in[11]; p.w_pb = (const float*)d_in[12]; p.w_out = (const float*)d_in[13]; p.ln_g = (const float*)d_in[14]; p.ln_b = (const float*)d_in[15];
  p.rel_bias = (const float*)d_in[16];
  p.out = (float*)d_out;
  p.ws = (char*)d_ws;
  if (OFF_END > ws_size) { fprintf(stderr, "kernel_launch: workspace too small: need %zu have %zu\n", (size_t)OFF_END, ws_size); return; }
#if USE_COOP
  void* args[] = {&p};
  hipError_t e = hipLaunchCooperativeKernel((const void*)mega_kernel, dim3(grid_blocks), dim3(NTHREADS), args, LDS_BYTES, stream);
  if (e != hipSuccess) fprintf(stderr, "cooperative launch failed: %s (grid %d)\n", hipGetErrorString(e), grid_blocks);
#else
  hipLaunchKernelGGL(phase_kernel, dim3(grid_blocks), dim3(NTHREADS), LDS_BYTES, stream, p, 0, 0);
  for (int l = 0; l < DEPTH; ++l)
    for (int ph = 1; ph <= 6; ++ph) hipLaunchKernelGGL(phase_kernel, dim3(grid_blocks), dim3(NTHREADS), LDS_BYTES, stream, p, ph, l);
#endif
}
```

```cpp
#include <hip/hip_runtime.h>
#include <hip/hip_cooperative_groups.h>
#include <cstdio>
#include <type_traits>
namespace cg = cooperative_groups;

#ifndef USE_COOP
#define USE_COOP 1
#endif

#define DI __device__ __forceinline__
typedef unsigned short bf16_t;
using bf16x8 = __attribute__((ext_vector_type(8))) short;
using bf16x4 = __attribute__((ext_vector_type(4))) short;
using f32x4  = __attribute__((ext_vector_type(4))) float;

constexpr int D_MODEL = 1024, BATCH = 32, SEQ = 2048, DEPTH = 4, DEC_BATCH = 8, DEC_SEQ = 64, PAST = 1024, LS = 1088;
constexpr int MP = BATCH * SEQ;
constexpr int MS = DEC_BATCH * DEC_SEQ;
constexpr int MT = MP + MS;
constexpr int D_IN = 5832, D_INP = 5888;
constexpr float LN_EPS = 1e-5f;
constexpr float ALPHA = 1.681792830507429f;
constexpr float SB_SCALE = 0.125f, ATT_SCALE = 0.125f;
constexpr int NTHREADS = 512, NWAVES = 8;
constexpr int LDS_S = 0, LDS_BM = 131072, LDS_BTAB = 139264, LDS_RB = 143360, LDS_SLOT = 144384, LDS_KI = 144448, LDS_BYTES = 162880;

constexpr size_t O_Y = 0, O_KAP = 67633152, O_VAP = 201850880, O_KBP = 336068608, O_VBP = 352845824, O_KIP = 369623040,
                 O_KAS = 386400256, O_VAS = 387448832, O_KBS = 388497408, O_VBS = 388628480, O_KIS = 388759552;
constexpr int OUT_TOTAL = 388890624;

constexpr size_t al256(size_t x) { return (x + 255) & ~(size_t)255; }
constexpr size_t OFF_XB = 0;
constexpr size_t OFF_QAB = OFF_XB + al256((size_t)MT * 1024 * 2);
constexpr size_t OFF_GA = OFF_QAB + al256((size_t)MT * 1024 * 2);
constexpr size_t OFF_GB = OFF_GA + al256((size_t)MT * 512 * 2);
constexpr size_t OFF_QI = OFF_GB + al256((size_t)MT * 512 * 2);
constexpr size_t OFF_KAP = OFF_QI + al256((size_t)MT * 512 * 2);
constexpr size_t OFF_VATP = OFF_KAP + al256((size_t)MP * 512 * 2);
constexpr size_t OFF_KAS = OFF_VATP + al256((size_t)MP * 512 * 2);
constexpr size_t OFF_VATS = OFF_KAS + al256((size_t)8 * LS * 512 * 2);
constexpr size_t OFF_KBP = OFF_VATS + al256((size_t)8 * LS * 512 * 2);
constexpr size_t OFF_VBTP = OFF_KBP + al256((size_t)MP * 64 * 2);
constexpr size_t OFF_KIP = OFF_VBTP + al256((size_t)MP * 64 * 2);
constexpr size_t OFF_KBS = OFF_KIP + al256((size_t)MP * 64 * 2);
constexpr size_t OFF_VBTS = OFF_KBS + al256((size_t)8 * LS * 64 * 2);
constexpr size_t OFF_KIS = OFF_VBTS + al256((size_t)8 * LS * 64 * 2);
constexpr size_t OFF_WI = OFF_KIS + al256((size_t)8 * LS * 64 * 2);
constexpr size_t OFF_RA = OFF_WI + al256((size_t)MT * 8 * 4);
constexpr size_t OFF_RB = OFF_RA + al256((size_t)MT * 1024 * 2);
constexpr size_t OFF_WINT = OFF_RB + al256((size_t)MT * 1024 * 2);
constexpr size_t OFF_WPAT = OFF_WINT + al256((size_t)D_INP * 1024 * 2);
constexpr size_t OFF_WPBT = OFF_WPAT + al256((size_t)1024 * 512 * 2);
constexpr size_t OFF_WOUTT = OFF_WPBT + al256((size_t)1024 * 512 * 2);
constexpr size_t OFF_BTAB = OFF_WOUTT + al256((size_t)1024 * 1024 * 2);
constexpr size_t OFF_CTR = OFF_BTAB + 4096;
constexpr size_t OFF_END = OFF_CTR + 256;

struct Params {
  const float* x_prompt; const float* x_sample;
  const float* c_sb_k; const float* c_sb_v; const float* c_dsa_k; const float* c_dsa_v; const float* c_idx_k;
  const float* ln_in_g; const float* ln_in_b; const float* w_in; const float* b_in; const float* w_pa; const float* w_pb;
  const float* w_out; const float* ln_g; const float* ln_b; const float* rel_bias;
  float* out; char* ws;
};

DI unsigned short f2bf(float x) { unsigned u = __float_as_uint(x); u += 0x7fffu + ((u >> 16) & 1u); return (unsigned short)(u >> 16); }
DI float bf2f(short h) { return __uint_as_float(((unsigned)(unsigned short)h) << 16); }
typedef __bf16 hbf16x2 __attribute__((ext_vector_type(2)));
typedef float f32x2v __attribute__((ext_vector_type(2)));
typedef unsigned u32x2v __attribute__((ext_vector_type(2)));
typedef unsigned u32x4v __attribute__((ext_vector_type(4)));
DI unsigned pk2(float lo, float hi) { f32x2v v; v.x = lo; v.y = hi; return __builtin_bit_cast(unsigned, __builtin_convertvector(v, hbf16x2)); }
DI bf16x4 pack4(float a, float b, float c, float d) { u32x2v u; u.x = pk2(a, b); u.y = pk2(c, d); return __builtin_bit_cast(bf16x4, u); }
DI bf16x8 pack8(const float (&e)[8]) { u32x4v u; u.x = pk2(e[0], e[1]); u.y = pk2(e[2], e[3]); u.z = pk2(e[4], e[5]); u.w = pk2(e[6], e[7]); return __builtin_bit_cast(bf16x8, u); }
DI bf16x8 ld8(const bf16_t* p) { return *reinterpret_cast<const bf16x8*>(p); }
DI bf16x4 ld4(const bf16_t* p) { return *reinterpret_cast<const bf16x4*>(p); }
DI void st4(bf16_t* p, bf16x4 v) { *reinterpret_cast<bf16x4*>(p) = v; }
DI f32x4 mfma16(bf16x8 a, bf16x8 b, f32x4 c) { return __builtin_amdgcn_mfma_f32_16x16x32_bf16(a, b, c, 0, 0, 0); }
DI int otid() { int t = threadIdx.x; asm volatile("" : "+v"(t)); return t; }
DI int osg(int v) { asm volatile("" : "+s"(v)); return v; }
DI float sigmoidf_(float x) { return __builtin_amdgcn_rcpf(1.f + __expf(-x)); }
struct F2 { float lo, hi; };
DI F2 swap16(float x) { const unsigned u = __float_as_uint(x); auto r = __builtin_amdgcn_permlane16_swap(u, u, false, false); return F2{__uint_as_float(r[0]), __uint_as_float(r[1])}; }
DI F2 swap32(float x) { const unsigned u = __float_as_uint(x); auto r = __builtin_amdgcn_permlane32_swap(u, u, false, false); return F2{__uint_as_float(r[0]), __uint_as_float(r[1])}; }
DI float row_sum16(float x) {
  x += __uint_as_float(__builtin_amdgcn_update_dpp(0, __float_as_uint(x), 0xB1, 0xF, 0xF, true));
  x += __uint_as_float(__builtin_amdgcn_update_dpp(0, __float_as_uint(x), 0x4E, 0xF, 0xF, true));
  x += __uint_as_float(__builtin_amdgcn_update_dpp(0, __float_as_uint(x), 0x141, 0xF, 0xF, true));
  x += __uint_as_float(__builtin_amdgcn_update_dpp(0, __float_as_uint(x), 0x140, 0xF, 0xF, true));
  return x;
}
DI float wave_sum(float x) { x = row_sum16(x); F2 a = swap16(x); x = a.lo + a.hi; F2 b = swap32(x); return b.lo + b.hi; }
DI int hsum32(int x) {
  x += __builtin_amdgcn_update_dpp(0, x, 0xB1, 0xF, 0xF, true);
  x += __builtin_amdgcn_update_dpp(0, x, 0x4E, 0xF, 0xF, true);
  x += __builtin_amdgcn_update_dpp(0, x, 0x141, 0xF, 0xF, true);
  x += __builtin_amdgcn_update_dpp(0, x, 0x140, 0xF, 0xF, true);
  auto r = __builtin_amdgcn_permlane16_swap((unsigned)x, (unsigned)x, false, false);
  return (int)(r[0] + r[1]);
}
DI void gbar(unsigned* ctr, unsigned target) {
  asm volatile("s_waitcnt vmcnt(0)" ::: "memory");
  __syncthreads();
  if (otid() == 0) {
    __builtin_amdgcn_fence(__ATOMIC_RELEASE, "agent");
    asm volatile("s_waitcnt vmcnt(0)" ::: "memory");
    __hip_atomic_fetch_add(ctr, 1u, __ATOMIC_RELAXED, __HIP_MEMORY_SCOPE_AGENT);
    while (__hip_atomic_load(ctr, __ATOMIC_RELAXED, __HIP_MEMORY_SCOPE_AGENT) < target) __builtin_amdgcn_s_sleep(2);
    __builtin_amdgcn_fence(__ATOMIC_ACQUIRE, "agent");
    asm volatile("s_waitcnt vmcnt(0)" ::: "memory");
  }
  __syncthreads();
}

DI void ln_row_wave(const float* src, const float* g, const float* b, float* d32, bf16_t* db, int lane) {
  float4 v[4]; float s = 0.f;
#pragma unroll
  for (int i = 0; i < 4; ++i) { v[i] = reinterpret_cast<const float4*>(src)[lane + 64 * i]; s += v[i].x + v[i].y + v[i].z + v[i].w; }
  s = wave_sum(s);
  const float mu = s * (1.f / 1024.f);
  float q = 0.f;
#pragma unroll
  for (int i = 0; i < 4; ++i) { float a = v[i].x - mu, bb = v[i].y - mu, c = v[i].z - mu, d = v[i].w - mu; q += a * a + bb * bb + c * c + d * d; }
  q = wave_sum(q);
  const float rstd = rsqrtf(q * (1.f / 1024.f) + LN_EPS);
#pragma unroll
  for (int i = 0; i < 4; ++i) {
    float4 gg = reinterpret_cast<const float4*>(g)[lane + 64 * i], bb = reinterpret_cast<const float4*>(b)[lane + 64 * i];
    float4 o;
    o.x = (v[i].x - mu) * rstd * gg.x + bb.x; o.y = (v[i].y - mu) * rstd * gg.y + bb.y;
    o.z = (v[i].z - mu) * rstd * gg.z + bb.z; o.w = (v[i].w - mu) * rstd * gg.w + bb.w;
    reinterpret_cast<float4*>(d32)[lane + 64 * i] = o;
    st4(db + 4 * (lane + 64 * i), pack4(o.x, o.y, o.z, o.w));
  }
}

DI void ln_rows2(const float* s0, const float* s1, const float* g, const float* b, float* d0, bf16_t* db0, float* d1, bf16_t* db1, int lane) {
  float4 v0[4], v1[4]; float a0 = 0.f, a1 = 0.f;
#pragma unroll
  for (int i = 0; i < 4; ++i) { v0[i] = reinterpret_cast<const float4*>(s0)[lane + 64 * i]; v1[i] = reinterpret_cast<const float4*>(s1)[lane + 64 * i]; }
#pragma unroll
  for (int i = 0; i < 4; ++i) { a0 += v0[i].x + v0[i].y + v0[i].z + v0[i].w; a1 += v1[i].x + v1[i].y + v1[i].z + v1[i].w; }
  a0 = wave_sum(a0); a1 = wave_sum(a1);
  const float mu0 = a0 * (1.f / 1024.f), mu1 = a1 * (1.f / 1024.f);
  float q0 = 0.f, q1 = 0.f;
#pragma unroll
  for (int i = 0; i < 4; ++i) {
    { float a = v0[i].x - mu0, bb = v0[i].y - mu0, c = v0[i].z - mu0, d = v0[i].w - mu0; q0 += a * a + bb * bb + c * c + d * d; }
    { float a = v1[i].x - mu1, bb = v1[i].y - mu1, c = v1[i].z - mu1, d = v1[i].w - mu1; q1 += a * a + bb * bb + c * c + d * d; }
  }
  q0 = wave_sum(q0); q1 = wave_sum(q1);
  const float r0 = rsqrtf(q0 * (1.f / 1024.f) + LN_EPS), r1 = rsqrtf(q1 * (1.f / 1024.f) + LN_EPS);
#pragma unroll
  for (int i = 0; i < 4; ++i) {
    const float4 gg = reinterpret_cast<const float4*>(g)[lane + 64 * i], bb = reinterpret_cast<const float4*>(b)[lane + 64 * i];
    float4 o;
    o.x = (v0[i].x - mu0) * r0 * gg.x + bb.x; o.y = (v0[i].y - mu0) * r0 * gg.y + bb.y; o.z = (v0[i].z - mu0) * r0 * gg.z + bb.z; o.w = (v0[i].w - mu0) * r0 * gg.w + bb.w;
    reinterpret_cast<float4*>(d0)[lane + 64 * i] = o; st4(db0 + 4 * (lane + 64 * i), pack4(o.x, o.y, o.z, o.w));
    o.x = (v1[i].x - mu1) * r1 * gg.x + bb.x; o.y = (v1[i].y - mu1) * r1 * gg.y + bb.y; o.z = (v1[i].z - mu1) * r1 * gg.z + bb.z; o.w = (v1[i].w - mu1) * r1 * gg.w + bb.w;
    reinterpret_cast<float4*>(d1)[lane + 64 * i] = o; st4(db1 + 4 * (lane + 64 * i), pack4(o.x, o.y, o.z, o.w));
  }
}

DI void tconv_tile(const float* src, int ldsrc, int K, bf16_t* dst, int n0, int k0, bool winmap, float* tile, int dk = 0) {
  const int tid = otid();
#pragma unroll
  for (int rr = 0; rr < 8; ++rr) {
    const int kl = rr * 8 + (tid >> 6), nl = tid & 63, np = n0 + nl;
    int n = np; bool ok = true;
    if (winmap) { if (np >= 3840) n = np - 56; else if (np >= 3784) ok = false; }
    tile[kl * 65 + nl] = ok ? src[(size_t)(k0 + kl) * ldsrc + n] : 0.f;
  }
  __syncthreads();
#pragma unroll
  for (int rr = 0; rr < 8; ++rr) {
    const int nl = rr * 8 + (tid >> 6), kl = tid & 63;
    dst[(size_t)(n0 + nl) * K + dk + k0 + kl] = f2bf(tile[kl * 65 + nl]);
  }
  __syncthreads();
}

DI void convert_layer(const Params& p, int l, char* smem) {
  float* tile = reinterpret_cast<float*>(smem);
  const int G = gridDim.x;
  for (int it = blockIdx.x; it < 1984; it += G) {
    if (it < 1472) { int nt = it >> 4, kt = it & 15; tconv_tile(p.w_in + (size_t)l * 1024 * D_IN, D_IN, 1024, (reinterpret_cast<bf16_t*>(p.ws + OFF_WINT)), nt * 64, kt * 64, true, tile); }
    else if (it < 1600) { int i = it - 1472; int nt = i >> 3, kt = i & 7; tconv_tile(p.w_pa + (size_t)l * 512 * 1024, 1024, 1024, (reinterpret_cast<bf16_t*>(p.ws + OFF_WPAT)), nt * 64, kt * 64, false, tile); }
    else if (it < 1728) { int i = it - 1600; int nt = i >> 3, kt = i & 7; tconv_tile(p.w_pb + (size_t)l * 512 * 1024, 1024, 1024, (reinterpret_cast<bf16_t*>(p.ws + OFF_WPAT)), nt * 64, kt * 64, false, tile, 512); }
    else { int i = it - 1728; int nt = i >> 4, kt = i & 15; tconv_tile(p.w_out + (size_t)l * 1024 * 1024, 1024, 1024, (reinterpret_cast<bf16_t*>(p.ws + OFF_WOUTT)), nt * 64, kt * 64, false, tile); }
  }
  const int gtid = blockIdx.x * NTHREADS + otid(), gn = G * NTHREADS;
#pragma unroll 4
  for (int idx = gtid; idx < 8 * 1024 * 512; idx += gn) {
    int b = idx >> 19, rem = idx & ((1 << 19) - 1);
    (reinterpret_cast<bf16_t*>(p.ws + OFF_KAS))[(size_t)b * LS * 512 + rem] = f2bf(p.c_sb_k[(size_t)l * 8 * 1024 * 512 + idx]);
  }
#pragma unroll 4
  for (int idx = gtid; idx < 8 * 512 * 1024; idx += gn) {
    int b = idx >> 19, hd = (idx >> 10) & 511, t = idx & 1023;
    (reinterpret_cast<bf16_t*>(p.ws + OFF_VATS))[((size_t)b * 512 + hd) * LS + t] = f2bf(p.c_sb_v[(((size_t)l * 8 + b) * 1024 + t) * 512 + hd]);
  }
  for (int idx = gtid; idx < 8 * 1024 * 64; idx += gn) {
    int b = idx >> 16, rem = idx & 65535;
    (reinterpret_cast<bf16_t*>(p.ws + OFF_KBS))[(size_t)b * LS * 64 + rem] = f2bf(p.c_dsa_k[(size_t)l * 8 * 65536 + idx]);
    (reinterpret_cast<bf16_t*>(p.ws + OFF_KIS))[(size_t)b * LS * 64 + rem] = f2bf(p.c_idx_k[(size_t)l * 8 * 65536 + idx]);
    int d = (idx >> 10) & 63, t = idx & 1023;
    (reinterpret_cast<bf16_t*>(p.ws + OFF_VBTS))[((size_t)b * 64 + d) * LS + t] = f2bf(p.c_dsa_v[(((size_t)l * 8 + b) * 1024 + t) * 64 + d]);
  }
}

DI void phase_prologue(const Params& p, char* smem) {
  const int tid = otid(), lane = tid & 63;
  if (blockIdx.x == 0 && tid < 16) (reinterpret_cast<int*>(p.ws + OFF_CTR))[tid] = 0;
  for (int i = blockIdx.x * NTHREADS + tid; i < 4096; i += gridDim.x * NTHREADS) {
    int rel = i - 2047; int n = rel < 0 ? -rel : rel;
    float nf = (float)(n > 1 ? n : 1);
    int large = 8 + (int)(logf(nf / 8.f) / 2.7725887f * 8.f);
    large = large < 15 ? large : 15;
    int bk = (rel > 0 ? 16 : 0) + (n < 8 ? n : large);
    (reinterpret_cast<unsigned char*>(p.ws + OFF_BTAB))[i] = (unsigned char)bk;
  }
  {
    const int stride = gridDim.x * NWAVES;
    for (int row = blockIdx.x * NWAVES + (tid >> 6); row < MT; row += 2 * stride) {
      const int row2 = row + stride;
      const float* src = row < MP ? p.x_prompt + (size_t)row * 1024 : p.x_sample + (size_t)(row - MP) * 1024;
      if (row2 < MT) {
        const float* src2 = row2 < MP ? p.x_prompt + (size_t)row2 * 1024 : p.x_sample + (size_t)(row2 - MP) * 1024;
        ln_rows2(src, src2, p.ln_in_g, p.ln_in_b, p.out + (size_t)row * 1024, (reinterpret_cast<bf16_t*>(p.ws + OFF_XB)) + (size_t)row * 1024, p.out + (size_t)row2 * 1024, (reinterpret_cast<bf16_t*>(p.ws + OFF_XB)) + (size_t)row2 * 1024, lane);
      } else ln_row_wave(src, p.ln_in_g, p.ln_in_b, p.out + (size_t)row * 1024, (reinterpret_cast<bf16_t*>(p.ws + OFF_XB)) + (size_t)row * 1024, lane);
    }
  }
  convert_layer(p, 0, smem);
}


namespace pg8 {
#define PG8_LAS __attribute__((address_space(3)))
constexpr int BM = 256, BK = 64, HALF = 128, HTB = HALF * BK * 2, STAGE_BYTES = 8 * HTB, NXCD = 8, WGM = 8;
DI int lds_byte(int r, int c) { const int st = (r >> 4) * 2 + (c >> 5), rr = r & 15, cc = c & 31, ob = rr * 64 + cc * 2; return st * 1024 + (ob ^ (((ob >> 9) & 1) << 5)); }
DI void stage_rc(int b, int& R, int& C) { const int st = b / 1024, sb = b % 1024, swz = sb ^ (((sb >> 9) & 1) << 5); R = (st >> 1) * 16 + swz / 64; C = (st & 1) * 32 + (swz % 64) / 2; }
DI int perm32(int rho) { const int n = rho >> 4, i = rho & 15; return 8 * (i >> 2) + 4 * n + (i & 3); }
struct Unit { int pm, pn; };
struct Gemm { const bf16_t* A; const bf16_t* Bt; int M, N, K; };
struct StaticOrder {
    int nM, nN, nwg, G, c;
    DI void init(int M, int N, int G_, int c_) { nM = M / BM; nN = N / BM; nwg = nM * nN; G = G_; c = c_; }
    DI bool next(int i, Unit& u) const {
        const long L = (long)i * G + c; if (L >= nwg) return false;
        int wgid = (int)L; { const int q = nwg / NXCD, r = nwg % NXCD, xcd = wgid % NXCD, off = wgid / NXCD; wgid = (xcd < r ? xcd * (q + 1) : r * (q + 1) + (xcd - r) * q) + off; }
        const int nig = WGM * nN, gid = wgid / nig, fm = gid * WGM, gsz = (nM - fm) < WGM ? (nM - fm) : WGM;
        u.pm = fm + ((wgid % nig) % gsz); u.pn = (wgid % nig) / gsz; return true;
    }
    DI void a_ready(const Unit&) const {}
    DI void done(const Unit&) const {}
};
template <class Epi, class Sched>
__device__ __forceinline__ void gemm_phase(PG8_LAS unsigned char* lds, const Gemm g, const Sched& S, const Epi& E) {
    const int tid = otid(), wid = __builtin_amdgcn_readfirstlane(tid >> 6), lane = tid & 63, wr = wid >> 2, wc = wid & 3, fr = lane & 15, fq = lane >> 4;
    const int K = g.K, nt = K / BK;
    unsigned voffA[2], voffB[2];
#pragma unroll
    for (int i = 0; i < 2; ++i) { int R, C; stage_rc(tid * 16 + i * 8192, R, C); const int Rb = Epi::PERM ? ((R & ~31) + perm32(R & 31)) : R;
        voffA[i] = (unsigned)(R * K + C) * 2u; voffB[i] = (unsigned)(Rb * K + C) * 2u; }
    const size_t kstep = (size_t)(BK * 2);
    const size_t hstep = (size_t)HALF * K * 2;
    const size_t tstep = 2 * hstep;
    const unsigned ldsw = (unsigned)wid * 1024u;
    const int aoff = lds_byte(wr * 64 + fr, fq * 8), boff = lds_byte(wc * 32 + fr, fq * 8);
#define PG8_SA(b, h) (((b) * 2 + (h)) * HTB)
#define PG8_SB(b, h) ((4 + (b) * 2 + (h)) * HTB)
#define PG8_STAGE(bufoff, gbase, voff) do { _Pragma("unroll") for (int _i = 0; _i < 2; ++_i) \
        __builtin_amdgcn_global_load_lds((const unsigned*)((const char*)(gbase) + (voff)[_i]), (PG8_LAS unsigned*)(lds + (bufoff) + ldsw + _i * 8192), 16, 0, 0); } while (0)
#define PG8_LDA(dst, b, h) do { _Pragma("unroll") for (int m = 0; m < 4; ++m) _Pragma("unroll") for (int k = 0; k < 2; ++k) dst[m][k] = *(const PG8_LAS bf16x8*)(lds + PG8_SA(b, h) + aoff + m * 2048 + k * 1024); } while (0)
#define PG8_LDB(dst, b, h) do { _Pragma("unroll") for (int n = 0; n < 2; ++n) _Pragma("unroll") for (int k = 0; k < 2; ++k) dst[n][k] = *(const PG8_LAS bf16x8*)(lds + PG8_SB(b, h) + boff + n * 2048 + k * 1024); } while (0)
#define PG8_MMA(ai, bj, At, Bt) do { __builtin_amdgcn_s_setprio(1); _Pragma("unroll") for (int m = 0; m < 4; ++m) _Pragma("unroll") for (int n = 0; n < 2; ++n) _Pragma("unroll") for (int k = 0; k < 2; ++k) \
        acc[ai][bj][m][n] = __builtin_amdgcn_mfma_f32_16x16x32_bf16(Bt[n][k], At[m][k], acc[ai][bj][m][n], 0, 0, 0); __builtin_amdgcn_s_setprio(0); } while (0)
#define PG8_WAIT_V(n) asm volatile("s_waitcnt vmcnt(" #n ")" ::: "memory")
#define PG8_WAIT_L(n) asm volatile("s_waitcnt lgkmcnt(" #n ")" ::: "memory")
#define PG8_BAR __builtin_amdgcn_s_barrier()
#define PG8_SCHED __builtin_amdgcn_sched_barrier(0)
    Unit cur, nxt; int ui = 0;
    if (!S.next(0, cur)) return;
    f32x4 acc[2][2][4][2];
#pragma unroll
    for (int a = 0; a < 2; ++a)
#pragma unroll
        for (int b = 0; b < 2; ++b)
#pragma unroll
            for (int m = 0; m < 4; ++m)
#pragma unroll
                for (int n = 0; n < 2; ++n) acc[a][b][m][n] = (f32x4){0.f, 0.f, 0.f, 0.f};
    bf16x8 At[4][2], B0[2][2], B1[2][2];
    const char* cA = (const char*)g.A + (size_t)cur.pm * tstep; const char* cB = (const char*)g.Bt + (size_t)cur.pn * tstep;
    S.a_ready(cur);
    PG8_STAGE(PG8_SB(0, 0), cB, voffB); PG8_STAGE(PG8_SA(0, 0), cA, voffA); PG8_STAGE(PG8_SB(0, 1), cB + hstep, voffB); PG8_STAGE(PG8_SA(0, 1), cA + hstep, voffA);
    if (wr == 1) PG8_BAR;
    PG8_WAIT_V(4); PG8_BAR;
    PG8_STAGE(PG8_SB(1, 0), cB + kstep, voffB); PG8_STAGE(PG8_SA(1, 0), cA + kstep, voffA); PG8_STAGE(PG8_SB(1, 1), cB + hstep + kstep, voffB);
    PG8_WAIT_V(6); PG8_BAR;
    for (;;) {
        const bool has_next = S.next(ui + 1, nxt);
        const char* nA = has_next ? (const char*)g.A + (size_t)nxt.pm * tstep : cA; const char* nB = has_next ? (const char*)g.Bt + (size_t)nxt.pn * tstep : cB;
        for (int t = 0; t < nt; t += 2) {
            const bool last = (t == nt - 2);
            const char* a1 = cA + (size_t)(t + 1) * kstep;
            const char* a2 = last ? nA : cA + (size_t)(t + 2) * kstep; const char* b2 = last ? nB : cB + (size_t)(t + 2) * kstep;
            const char* a3 = a2 + kstep; const char* b3 = b2 + kstep;
            if (last && has_next) S.a_ready(nxt);
            if constexpr (Epi::MIDK) { if (t == nt / 2) E.mid(acc, cur, wr, wc, fr, fq); }
            PG8_LDB(B0, 0, 0); PG8_SCHED; PG8_LDA(At, 0, 0); PG8_STAGE(PG8_SA(1, 1), a1 + hstep, voffA);
            PG8_WAIT_L(8); PG8_BAR; PG8_WAIT_L(0); PG8_MMA(0, 0, At, B0); PG8_BAR; PG8_SCHED;
            PG8_LDB(B1, 0, 1); PG8_STAGE(PG8_SB(0, 0), b2, voffB);
            PG8_BAR; PG8_WAIT_L(0); PG8_MMA(0, 1, At, B1); PG8_BAR;
            PG8_LDA(At, 0, 1); PG8_STAGE(PG8_SA(0, 0), a2, voffA);
            PG8_BAR; PG8_WAIT_L(0); PG8_MMA(1, 0, At, B0); PG8_BAR; PG8_SCHED;
            PG8_STAGE(PG8_SB(0, 1), b2 + hstep, voffB);
            PG8_WAIT_V(6); PG8_BAR; PG8_MMA(1, 1, At, B1); PG8_BAR;
            PG8_LDB(B0, 1, 0); PG8_SCHED; PG8_LDA(At, 1, 0); PG8_STAGE(PG8_SA(0, 1), a2 + hstep, voffA);
            PG8_WAIT_L(8); PG8_BAR; PG8_WAIT_L(0); PG8_MMA(0, 0, At, B0); PG8_BAR; PG8_SCHED;
            PG8_LDB(B1, 1, 1); PG8_STAGE(PG8_SB(1, 0), b3, voffB);
            PG8_BAR; PG8_WAIT_L(0); PG8_MMA(0, 1, At, B1); PG8_BAR;
            PG8_LDA(At, 1, 1); PG8_STAGE(PG8_SA(1, 0), a3, voffA);
            PG8_BAR; PG8_WAIT_L(0); PG8_MMA(1, 0, At, B0); PG8_BAR; PG8_SCHED;
            PG8_STAGE(PG8_SB(1, 1), b3 + hstep, voffB);
            PG8_WAIT_V(6); PG8_BAR; PG8_MMA(1, 1, At, B1); PG8_BAR;
        }
        if constexpr (!Epi::AFTER_DRAIN) { E(acc, cur, wr, wc, fr, fq); S.done(cur); }
        if (!has_next) break;
#pragma unroll
        for (int a = 0; a < 2; ++a)
#pragma unroll
            for (int b = 0; b < 2; ++b)
#pragma unroll
                for (int m = 0; m < 4; ++m)
#pragma unroll
                    for (int n = 0; n < 2; ++n) acc[a][b][m][n] = (f32x4){0.f, 0.f, 0.f, 0.f};
        cur = nxt; cA = nA; cB = nB; ++ui;
    }
    PG8_WAIT_V(0);
    if (wr == 0) PG8_BAR;
    PG8_BAR;
    if constexpr (Epi::AFTER_DRAIN) { E.fused(acc, cur, wr, wc, fr, fq, lds, wid, lane); S.done(cur); }
#undef PG8_SA
#undef PG8_SB
#undef PG8_STAGE
#undef PG8_LDA
#undef PG8_LDB
#undef PG8_MMA
#undef PG8_WAIT_V
#undef PG8_WAIT_L
#undef PG8_BAR
#undef PG8_SCHED
}
}

DI bf16x4 pack4v(const f32x4 v) { return pack4(v[0], v[1], v[2], v[3]); }

struct EpiProj {
  static constexpr bool PERM = true, AFTER_DRAIN = false, MIDK = false;
  const Params& p; int layer; const __attribute__((address_space(3))) float* biasl;
  template <int GRP>
  DI void run(const f32x4 (&acc)[2][2][4][2], const pg8::Unit& u, int wr, int wc, int fr, int fq) const {
    constexpr int T = GRP ? LS : SEQ;
    char* ws = p.ws;
#pragma unroll
    for (int bj = 0; bj < 2; ++bj) {
      const int nt = 2 * u.pn + bj;
      const __attribute__((address_space(3))) f32x4* bp = reinterpret_cast<const __attribute__((address_space(3))) f32x4*>(biasl + nt * 128 + 32 * wc + 8 * fq);
      const bool simple = (nt < 4) || (nt >= 12 && nt < 20) || (nt >= 21 && nt < 29) || (nt >= 30);
      if (simple) {
        size_t off; int ld, c0, act;
        if (nt < 4) { off = OFF_QAB; ld = 1024; c0 = nt * 128; act = 0; }
        else if (nt < 16) { off = OFF_GA; ld = 512; c0 = (nt - 12) * 128; act = 1; }
        else if (nt < 20) { off = OFF_QAB; ld = 1024; c0 = 512 + (nt - 16) * 128; act = 0; }
        else if (nt < 25) { off = OFF_GB; ld = 512; c0 = (nt - 21) * 128; act = 1; }
        else if (nt < 29) { off = OFF_QI; ld = 512; c0 = (nt - 25) * 128; act = 0; }
        else if (nt < 38) { off = OFF_RA; ld = 1024; c0 = (nt - 30) * 128; act = 2; }
        else { off = OFF_RB; ld = 1024; c0 = (nt - 38) * 128; act = 2; }
        bf16_t* dst = reinterpret_cast<bf16_t*>(ws + off) + c0 + 32 * wc + 8 * fq;
#pragma unroll
        for (int ai = 0; ai < 2; ++ai)
#pragma unroll
          for (int m = 0; m < 4; ++m) {
            int row = u.pm * 256 + 128 * ai + 64 * wr + 16 * m + fr;
            asm volatile("" : "+v"(row));
            if (act == 2) {
              u32x2v g8;
#pragma unroll
              for (int n = 0; n < 2; ++n) {
                const f32x4 v = acc[ai][bj][m][n] + bp[n];
                unsigned q = 0u;
#pragma unroll
                for (int j = 0; j < 4; ++j) q |= ((unsigned)(sigmoidf_(v[j]) * 255.f + 0.5f)) << (8 * j);
                if (n == 0) g8.x = q; else g8.y = q;
              }
              *reinterpret_cast<u32x2v*>(reinterpret_cast<unsigned char*>(ws + off) + (size_t)row * 1024 + c0 + 32 * wc + 8 * fq) = g8;
              continue;
            }
            u32x4v pk;
#pragma unroll
            for (int n = 0; n < 2; ++n) {
              f32x4 v = acc[ai][bj][m][n] + bp[n];
              if (act != 0) {
#pragma unroll
                for (int j = 0; j < 4; ++j) { const float sg = sigmoidf_(v[j]); v[j] = (act == 1) ? v[j] * sg : sg; }
              }
              if (n == 0) { pk.x = pk2(v[0], v[1]); pk.y = pk2(v[2], v[3]); } else { pk.z = pk2(v[0], v[1]); pk.w = pk2(v[2], v[3]); }
            }
            *reinterpret_cast<u32x4v*>(dst + (size_t)row * ld) = pk;
          }
      } else {
#pragma unroll
        for (int ai = 0; ai < 2; ++ai)
#pragma unroll
          for (int m = 0; m < 4; ++m) {
            int row = u.pm * 256 + 128 * ai + 64 * wr + 16 * m + fr;
            asm volatile("" : "+v"(row));
            int bb, tt;
            if (!GRP) { bb = row >> 11; tt = row & 2047; } else { const int ms = row - MP; bb = ms >> 6; tt = PAST + (ms & 63); }
            const size_t orow = GRP ? (size_t)layer * MS + (row - MP) : (size_t)layer * MP + row;
#pragma unroll
            for (int n = 0; n < 2; ++n) {
              int ct = 32 * wc + 8 * fq + 4 * n;
              asm volatile("" : "+v"(ct));
              const f32x4 v = acc[ai][bj][m][n] + bp[n];
              if (nt < 8) {
                const int c = (nt - 4) * 128 + ct;
                *reinterpret_cast<f32x4*>(p.out + (GRP ? O_KAS : O_KAP) + orow * 512 + c) = v;
                bf16_t* kd = GRP ? (reinterpret_cast<bf16_t*>(p.ws + OFF_KAS)) + ((size_t)bb * LS + tt) * 512 + c : (reinterpret_cast<bf16_t*>(p.ws + OFF_KAP)) + (size_t)row * 512 + c;
                st4(kd, pack4v(v));
              } else if (nt < 12) {
                const int c = (nt - 8) * 128 + ct;
                *reinterpret_cast<f32x4*>(p.out + (GRP ? O_VAS : O_VAP) + orow * 512 + c) = v;
                bf16_t* vd = (GRP ? (reinterpret_cast<bf16_t*>(p.ws + OFF_VATS)) : (reinterpret_cast<bf16_t*>(p.ws + OFF_VATP))) + ((size_t)bb * 512 + c) * T + tt;
                vd[0] = f2bf(v[0]); vd[T] = f2bf(v[1]); vd[2 * T] = f2bf(v[2]); vd[3 * T] = f2bf(v[3]);
              } else if (nt == 20) {
                if (wc < 2) {
                  *reinterpret_cast<f32x4*>(p.out + (GRP ? O_KBS : O_KBP) + orow * 64 + ct) = v;
                  st4((GRP ? (reinterpret_cast<bf16_t*>(p.ws + OFF_KBS)) : (reinterpret_cast<bf16_t*>(p.ws + OFF_KBP))) + ((size_t)bb * T + tt) * 64 + ct, pack4v(v));
                } else {
                  const int c = ct - 64;
                  *reinterpret_cast<f32x4*>(p.out + (GRP ? O_VBS : O_VBP) + orow * 64 + c) = v;
                  bf16_t* vd = (GRP ? (reinterpret_cast<bf16_t*>(p.ws + OFF_VBTS)) : (reinterpret_cast<bf16_t*>(p.ws + OFF_VBTP))) + ((size_t)bb * 64 + c) * T + tt;
                  vd[0] = f2bf(v[0]); vd[T] = f2bf(v[1]); vd[2 * T] = f2bf(v[2]); vd[3 * T] = f2bf(v[3]);
                }
              } else {
                if (wc < 2) {
                  *reinterpret_cast<f32x4*>(p.out + (GRP ? O_KIS : O_KIP) + orow * 64 + ct) = v;
                  st4((GRP ? (reinterpret_cast<bf16_t*>(p.ws + OFF_KIS)) : (reinterpret_cast<bf16_t*>(p.ws + OFF_KIP))) + ((size_t)bb * T + tt) * 64 + ct, pack4v(v));
                } else if (ct < 72) {
                  *reinterpret_cast<f32x4*>((reinterpret_cast<float*>(p.ws + OFF_WI)) + (size_t)row * 8 + (ct - 64)) = v;
                }
              }
            }
          }
      }
    }
  }
  DI void operator()(const f32x4 (&acc)[2][2][4][2], const pg8::Unit& u, int wr, int wc, int fr, int fq) const {
    if (u.pm < MP / 256) run<0>(acc, u, wr, wc, fr, fq); else run<1>(acc, u, wr, wc, fr, fq);
  }
};

template <int MODE>
struct EpiTail {
  static constexpr bool PERM = false, AFTER_DRAIN = false, MIDK = (MODE == 0);
  const Params& p;
  DI void mid(f32x4 (&acc)[2][2][4][2], const pg8::Unit& u, int wr, int wc, int fr, int fq) const {
#pragma unroll
    for (int ai = 0; ai < 2; ++ai)
#pragma unroll
      for (int m = 0; m < 4; ++m) {
        int row = u.pm * 256 + 128 * ai + 64 * wr + 16 * m + fr;
        asm volatile("" : "+v"(row));
#pragma unroll
        for (int bj = 0; bj < 2; ++bj)
#pragma unroll
          for (int n = 0; n < 2; ++n) {
            const size_t idx = (size_t)row * 1024 + u.pn * 256 + 128 * bj + 32 * wc + 16 * n + 4 * fq;
            const unsigned ga = *reinterpret_cast<const unsigned*>(reinterpret_cast<const unsigned char*>(p.ws + OFF_RA) + idx);
            const unsigned gb = *reinterpret_cast<const unsigned*>(reinterpret_cast<const unsigned char*>(p.ws + OFF_RB) + idx);
#pragma unroll
            for (int j = 0; j < 4; ++j) {
              const unsigned a8 = (ga >> (8 * j)) & 255u, b8 = (gb >> (8 * j)) & 255u;
              acc[ai][bj][m][n][j] *= (float)a8 * __builtin_amdgcn_rcpf((float)(b8 > 1u ? b8 : 1u));
            }
          }
        asm volatile("" ::: "memory");
      }
  }
  DI void operator()(const f32x4 (&acc)[2][2][4][2], const pg8::Unit& u, int wr, int wc, int fr, int fq) const {
    bf16_t* MERGED = (reinterpret_cast<bf16_t*>(p.ws + OFF_GA));
#pragma unroll
    for (int ai = 0; ai < 2; ++ai)
#pragma unroll
      for (int m = 0; m < 4; ++m) {
        const int row = u.pm * 256 + 128 * ai + 64 * wr + 16 * m + fr;
#pragma unroll
        for (int bj = 0; bj < 2; ++bj)
#pragma unroll
          for (int n = 0; n < 2; ++n) {
            const size_t idx = (size_t)row * 1024 + u.pn * 256 + 128 * bj + 32 * wc + 16 * n + 4 * fq;
            const f32x4 a = acc[ai][bj][m][n];
            if (MODE == 0) {
              const unsigned g = *reinterpret_cast<const unsigned*>(reinterpret_cast<const unsigned char*>(p.ws + OFF_RB) + idx);
              const float k = 1.f / 255.f;
              st4(MERGED + idx, pack4((float)(g & 255u) * k * a[0], (float)((g >> 8) & 255u) * k * a[1], (float)((g >> 16) & 255u) * k * a[2], (float)(g >> 24) * k * a[3]));
            } else {
              f32x4 x = *reinterpret_cast<const f32x4*>(p.out + idx);
              x = x * ALPHA + a;
              *reinterpret_cast<f32x4*>(p.out + idx) = x;
            }
          }
      }
  }
};

DI void phase_proj(const Params& p, int layer, char* smem) {
  {
    const float* bin = p.b_in + (size_t)layer * D_IN;
    float* bl = reinterpret_cast<float*>(smem + 131072);
    for (int i = otid(); i < D_INP; i += NTHREADS) bl[i] = (i < 3784) ? bin[i] : (i < 3840 ? 0.f : bin[i - 56]);
    __syncthreads();
  }
  pg8::Gemm g{(reinterpret_cast<bf16_t*>(p.ws + OFF_XB)), (reinterpret_cast<bf16_t*>(p.ws + OFF_WINT)), MT, D_INP, 1024};
  pg8::StaticOrder S; S.init(MT, D_INP, osg(gridDim.x), osg(blockIdx.x));
  EpiProj E{p, layer, (const __attribute__((address_space(3))) float*)(smem + 131072)};
  pg8::gemm_phase<EpiProj, pg8::StaticOrder>((PG8_LAS unsigned char*)smem, g, S, E);
}
DI void phase_merge(const Params& p, char* smem) {
  pg8::Gemm g{(reinterpret_cast<bf16_t*>(p.ws + OFF_QAB)), (reinterpret_cast<bf16_t*>(p.ws + OFF_WPAT)), MT, 1024, 1024};
  pg8::StaticOrder S; S.init(MT, 1024, osg(gridDim.x), osg(blockIdx.x));
  EpiTail<0> E{p};
  pg8::gemm_phase<EpiTail<0>, pg8::StaticOrder>((PG8_LAS unsigned char*)smem, g, S, E);
}
DI void phase_out(const Params& p, char* smem) {
  pg8::Gemm g{(reinterpret_cast<bf16_t*>(p.ws + OFF_GA)), (reinterpret_cast<bf16_t*>(p.ws + OFF_WOUTT)), MT, 1024, 1024};
  pg8::StaticOrder S; S.init(MT, 1024, osg(gridDim.x), osg(blockIdx.x));
  EpiTail<2> E{p};
  pg8::gemm_phase<EpiTail<2>, pg8::StaticOrder>((PG8_LAS unsigned char*)smem, g, S, E);
}

template <int grp>
DI void sb_item(const Params& p, int b, int h, int t0) {
  const int tid = otid(), w = tid >> 6, lane = tid & 63, c = lane & 15, q4 = lane >> 4;
  const int T = grp ? LS : SEQ;
  const int qpos0 = grp ? PAST + t0 : t0;
  const int m0 = grp ? MP + b * DEC_SEQ + t0 : b * SEQ + t0;
  const bf16_t* Kb = (grp ? (reinterpret_cast<bf16_t*>(p.ws + OFF_KAS)) : (reinterpret_cast<bf16_t*>(p.ws + OFF_KAP))) + (size_t)b * T * 512 + h * 64;
  const bf16_t* VTb = (grp ? (reinterpret_cast<bf16_t*>(p.ws + OFF_VATS)) : (reinterpret_cast<bf16_t*>(p.ws + OFF_VATP))) + (size_t)(b * 8 + h) * 64 * T;
  const bf16_t* qp = (reinterpret_cast<bf16_t*>(p.ws + OFF_QAB)) + (size_t)(m0 + c) * 1024 + h * 64 + q4 * 8;
  const bf16x8 qf0 = ld8(qp), qf1 = ld8(qp + 32);
  const int qpos = qpos0 + c;
  float R = 0.f;
  f32x4 O[4];
#pragma unroll
  for (int dt = 0; dt < 4; ++dt) O[dt] = f32x4{0.f, 0.f, 0.f, 0.f};
  bf16x8 kfA[2][2], vfA[4], kfB[2][2], vfB[4];
  auto loadkv = [&](int kb, bf16x8 (&kf)[2][2], bf16x8 (&vf)[4]) {
    const int s0 = kb * 32;
#pragma unroll
    for (int kt = 0; kt < 2; ++kt) { const bf16_t* kp = Kb + (size_t)(s0 + 16 * kt + c) * 512 + q4 * 8; kf[kt][0] = ld8(kp); kf[kt][1] = ld8(kp + 32); }
#pragma unroll
    for (int dt = 0; dt < 4; ++dt) {
      const bf16_t* vp = VTb + (size_t)(16 * dt + c) * T + s0 + 4 * q4;
      bf16x4 lo = ld4(vp), hi = ld4(vp + 16);
      vf[dt] = __builtin_shufflevector(lo, hi, 0, 1, 2, 3, 4, 5, 6, 7);
    }
  };
  auto comp = [&](int kb, const bf16x8 (&kf)[2][2], const bf16x8 (&vf)[4]) -> bool {
    const int s0 = kb * 32;
    f32x4 z[2];
#pragma unroll
    for (int kt = 0; kt < 2; ++kt) {
      z[kt] = mfma16(kf[kt][0], qf0, f32x4{0.f, 0.f, 0.f, 0.f});
      z[kt] = mfma16(kf[kt][1], qf1, z[kt]);
    }
    float lk[2][4], ls[2][4]; bool bf[2][4];
#pragma unroll
    for (int kt = 0; kt < 2; ++kt)
#pragma unroll
      for (int r = 0; r < 4; ++r) {
        const int key = s0 + 16 * kt + 4 * q4 + r;
        const bool before = key < qpos;
        const float zz = z[kt][r] * SB_SCALE;
        const float sp = fmaxf(zz, 0.f) + __logf(1.f + __expf(-fabsf(zz)));
        bf[kt][r] = before; lk[kt][r] = before ? -sp : 0.f; ls[kt][r] = zz - sp;
      }
    const float T1 = (lk[1][0] + lk[1][1]) + (lk[1][2] + lk[1][3]);
    const float T0 = (lk[0][0] + lk[0][1]) + (lk[0][2] + lk[0][3]);
    const F2 x1 = swap16(T1), x0 = swap16(T0);
    const float p1 = x1.lo + x1.hi, p0 = x0.lo + x0.hi;
    const F2 y1 = swap32(p1), y0 = swap32(p0);
    const float H1 = ((q4 & 1) ? 0.f : x1.hi) + ((q4 & 2) ? 0.f : y1.hi);
    const float H0 = ((q4 & 1) ? 0.f : x0.hi) + ((q4 & 2) ? 0.f : y0.hi);
    const float TT1 = y1.lo + y1.hi, TT0 = y0.lo + y0.hi;
    float a[2][4];
    { float ac = R + H1;
#pragma unroll
      for (int r = 3; r >= 0; --r) { a[1][r] = bf[1][r] ? __expf(ls[1][r] + ac) : 0.f; ac += lk[1][r]; } }
    { float ac = R + TT1 + H0;
#pragma unroll
      for (int r = 3; r >= 0; --r) { a[0][r] = bf[0][r] ? __expf(ls[0][r] + ac) : 0.f; ac += lk[0][r]; } }
    R = R + TT1 + TT0;
    const float ae[8] = {a[0][0], a[0][1], a[0][2], a[0][3], a[1][0], a[1][1], a[1][2], a[1][3]};
    const bf16x8 pf = pack8(ae);
#pragma unroll
    for (int dt = 0; dt < 4; ++dt) O[dt] = mfma16(vf[dt], pf, O[dt]);
    return __ballot(R > -50.f) == 0ull;
  };
  {
    int kb = (qpos0 + 14) >> 5;
    loadkv(kb, kfA, vfA);
    while (true) {
      if (kb >= 1) loadkv(kb - 1, kfB, vfB);
      if (comp(kb, kfA, vfA) || kb == 0) break;
      --kb;
      if (kb >= 1) loadkv(kb - 1, kfA, vfA);
      if (comp(kb, kfB, vfB) || kb == 0) break;
      --kb;
    }
  }
#pragma unroll
  for (int dt = 0; dt < 4; ++dt) {
    const size_t off = (size_t)(m0 + c) * 512 + h * 64 + dt * 16 + 4 * q4;
    const size_t offq = (size_t)(m0 + c) * 1024 + h * 64 + dt * 16 + 4 * q4;
    const bf16x4 g = ld4((reinterpret_cast<bf16_t*>(p.ws + OFF_GA)) + off);
    st4((reinterpret_cast<bf16_t*>(p.ws + OFF_QAB)) + offq, pack4(O[dt][0] * bf2f(g[0]), O[dt][1] * bf2f(g[1]), O[dt][2] * bf2f(g[2]), O[dt][3] * bf2f(g[3])));
  }
}

template <int NK>
DI void topk_round(const unsigned short* Sh, int n_adm, int half, int l32, unsigned* bmrow) {
  unsigned key[NK];
#pragma unroll
  for (int i = 0; i < NK; ++i) {
    const int s = 32 * i + l32;
    const unsigned k = Sh[s];
    key[i] = (s < n_adm) ? k : 0u;
  }
  unsigned tau = 1u; int need = 0; bool done = true;
  if (n_adm > 256) {
    tau = 0u; done = false;
    for (int bit = 15; bit >= 0; --bit) {
      const unsigned cand = tau | (1u << bit);
      int cnt = 0;
#pragma unroll
      for (int i = 0; i < NK; ++i) cnt += (key[i] >= cand) ? 1 : 0;
      cnt = hsum32(cnt);
      if (!done && cnt >= 256) tau = cand;
      if (cnt == 256) done = true;
      if (__ballot(!done) == 0ull) break;
    }
  }
  unsigned w0 = 0u, w1 = 0u;
  if (__ballot(!done) == 0ull) {
#pragma unroll
    for (int i = 0; i < NK; ++i) {
      const unsigned long long msel = __ballot(key[i] >= tau);
      const unsigned wsel = half ? (unsigned)(msel >> 32) : (unsigned)msel;
      if (i < 32) { if (l32 == i) w0 = wsel; } else { if (l32 == i - 32) w1 = wsel; }
    }
  } else {
    int cgt = 0;
#pragma unroll
    for (int i = 0; i < NK; ++i) cgt += (key[i] > tau) ? 1 : 0;
    cgt = hsum32(cgt);
    need = 256 - cgt;
    int Rk = 0; const unsigned below = (1u << l32) - 1u;
#pragma unroll
    for (int i = 0; i < NK; ++i) {
      const bool eq = key[i] == tau, gt = key[i] > tau;
      const unsigned long long me = __ballot(eq);
      const unsigned hm = half ? (unsigned)(me >> 32) : (unsigned)me;
      const int rank = Rk + __popc(hm & below);
      const bool sel = done ? (key[i] >= tau) : (gt || (eq && rank < need));
      Rk += __popc(hm);
      const unsigned long long msel = __ballot(sel);
      const unsigned wsel = half ? (unsigned)(msel >> 32) : (unsigned)msel;
      if (i < 32) { if (l32 == i) w0 = wsel; } else { if (l32 == i - 32) w1 = wsel; }
    }
  }
  bmrow[l32] = w0;
  if (NK > 32) bmrow[32 + l32] = w1;
}

template <int grp>
DI void dsa_item(const Params& p, int b, int tile32, char* smem) {
  const int tid = otid(), w = tid >> 6, lane = tid & 63, c = lane & 15, q4 = lane >> 4, half = lane >> 5, l32 = lane & 31;
  unsigned* bm = reinterpret_cast<unsigned*>(smem + LDS_BM);
  const unsigned char* btab = reinterpret_cast<const unsigned char*>(smem + LDS_BTAB);
  const float* rb = reinterpret_cast<const float*>(smem + LDS_RB);
  const int T = grp ? LS : SEQ;
  const int t0 = tile32 * 32;
  const int qpos0 = grp ? PAST + t0 : t0;
  const int m0 = grp ? MP + b * DEC_SEQ + t0 : b * SEQ + t0;
  const int n_adm = grp ? LS : ((qpos0 >> 6) + 1) * 64;
  const bf16_t* KIb = (grp ? (reinterpret_cast<bf16_t*>(p.ws + OFF_KIS)) : (reinterpret_cast<bf16_t*>(p.ws + OFF_KIP))) + (size_t)b * T * 64;
  const bf16_t* KBb = (grp ? (reinterpret_cast<bf16_t*>(p.ws + OFF_KBS)) : (reinterpret_cast<bf16_t*>(p.ws + OFF_KBP))) + (size_t)b * T * 64;
  const bf16_t* VBTb = (grp ? (reinterpret_cast<bf16_t*>(p.ws + OFF_VBTS)) : (reinterpret_cast<bf16_t*>(p.ws + OFF_VBTP))) + (size_t)b * 64 * T;

  unsigned short* S16 = reinterpret_cast<unsigned short*>(smem) + w * 8192;
  {
    const int tlA = c >> 3, hA = c & 7, tlC = q4 >> 1;
    bf16x8 af[2][2]; float4 wv[2];
#pragma unroll
    for (int pr = 0; pr < 2; ++pr) {
      const bf16_t* qip = (reinterpret_cast<bf16_t*>(p.ws + OFF_QI)) + (size_t)(m0 + 4 * w + 2 * pr + tlA) * 512 + hA * 64 + q4 * 8;
      af[pr][0] = ld8(qip); af[pr][1] = ld8(qip + 32);
      wv[pr] = *reinterpret_cast<const float4*>((reinterpret_cast<float*>(p.ws + OFF_WI)) + (size_t)(m0 + 4 * w + 2 * pr + tlC) * 8 + 4 * (q4 & 1));
    }
    const int nch = n_adm >> 6;
    char* kis = smem + LDS_KI;
    const int lrow = tid >> 3, lseg = tid & 7;
    bf16x8 pre = ld8(KIb + (size_t)lrow * 64 + lseg * 8);
    *reinterpret_cast<bf16x8*>(kis + lrow * 144 + lseg * 16) = pre;
    __syncthreads();
    for (int ch = 0; ch < nch; ++ch) {
      const bool more = ch + 1 < nch;
      if (more) pre = ld8(KIb + (size_t)((ch + 1) * 64 + lrow) * 64 + lseg * 8);
      const char* cur = kis + (ch & 1) * 9216;
#pragma unroll
      for (int u = 0; u < 4; ++u) {
        const char* rp = cur + (u * 16 + c) * 144 + q4 * 16;
        const bf16x8 b0 = *reinterpret_cast<const bf16x8*>(rp), b1 = *reinterpret_cast<const bf16x8*>(rp + 64);
#pragma unroll
        for (int pr = 0; pr < 2; ++pr) {
          __builtin_amdgcn_s_setprio(1);
          f32x4 C = mfma16(af[pr][0], b0, f32x4{0.f, 0.f, 0.f, 0.f});
          C = mfma16(af[pr][1], b1, C);
          __builtin_amdgcn_s_setprio(0);
          const float part = wv[pr].x * fmaxf(C[0], 0.f) + wv[pr].y * fmaxf(C[1], 0.f) + wv[pr].z * fmaxf(C[2], 0.f) + wv[pr].w * fmaxf(C[3], 0.f);
          const F2 ps = swap16(part); const float full = ps.lo + ps.hi;
          const unsigned hu = (unsigned)__builtin_bit_cast(unsigned short, (_Float16)full);
          const unsigned hk = (hu & 0x8000u) ? (~hu & 0xFFFFu) : (hu | 0x8000u);
          if ((q4 & 1) == 0) S16[(2 * pr + tlC) * 2048 + (ch * 4 + u) * 16 + c] = (unsigned short)hk;
        }
      }
      if (more) *reinterpret_cast<bf16x8*>(kis + ((ch + 1) & 1) * 9216 + lrow * 144 + lseg * 16) = pre;
      __syncthreads();
    }
  }
  for (int rnd = 0; rnd < 2; ++rnd) {
    const unsigned short* Sh = S16 + (2 * rnd + half) * 2048;
    unsigned* bmrow = bm + (4 * w + 2 * rnd + half) * 64;
    const int nreg = n_adm >> 5;
    if (nreg <= 16) topk_round<16>(Sh, n_adm, half, l32, bmrow);
    else if (nreg <= 32) topk_round<32>(Sh, n_adm, half, l32, bmrow);
    else if (nreg <= 48) topk_round<48>(Sh, n_adm, half, l32, bmrow);
    else topk_round<64>(Sh, n_adm, half, l32, bmrow);
  }
  __syncthreads();

  {
    const int tl = c >> 3, h = c & 7;
    bf16x8 qf[2][2]; int qposc[2], qrow[2], qloc[2];
#pragma unroll
    for (int ct = 0; ct < 2; ++ct) {
      qloc[ct] = 4 * w + 2 * ct + tl; qrow[ct] = m0 + qloc[ct]; qposc[ct] = qpos0 + qloc[ct];
      const bf16_t* qp = (reinterpret_cast<bf16_t*>(p.ws + OFF_QAB)) + (size_t)qrow[ct] * 1024 + 512 + h * 64 + q4 * 8;
      qf[ct][0] = ld8(qp); qf[ct][1] = ld8(qp + 32);
    }
    f32x4 O[2][4]; float mrun[2] = {-100.f, -100.f}; f32x4 L[2] = {f32x4{0.f, 0.f, 0.f, 0.f}, f32x4{0.f, 0.f, 0.f, 0.f}};
    bf16x8 ones; for (int e = 0; e < 8; ++e) ones[e] = (short)0x3F80;
#pragma unroll
    for (int ct = 0; ct < 2; ++ct)
#pragma unroll
      for (int dt = 0; dt < 4; ++dt) O[ct][dt] = f32x4{0.f, 0.f, 0.f, 0.f};
    const int nkb = n_adm >> 5;
    constexpr float LOG2E = 1.4426950408889634f;
    const float farbias = rb[15 * 8 + h] * LOG2E;
    auto compkv = [&](auto FAR, int kb, const bf16x8 (&kf)[2][2], const bf16x8 (&vf)[4]) {
      constexpr bool far = decltype(FAR)::value;
      const int s0 = kb * 32;
#pragma unroll
      for (int ct = 0; ct < 2; ++ct) {
        __builtin_amdgcn_s_setprio(1);
        f32x4 z0 = mfma16(kf[0][0], qf[ct][0], f32x4{0.f, 0.f, 0.f, 0.f}); z0 = mfma16(kf[0][1], qf[ct][1], z0);
        f32x4 z1 = mfma16(kf[1][0], qf[ct][0], f32x4{0.f, 0.f, 0.f, 0.f}); z1 = mfma16(kf[1][1], qf[ct][1], z1);
        __builtin_amdgcn_s_setprio(0);
        const unsigned word = bm[qloc[ct] * 64 + kb] >> (4 * q4);
        const float mref = mrun[ct];
        const float fb = farbias - mref;
        float pe[8]; float bmx = -1e30f;
#pragma unroll
        for (int e = 0; e < 8; ++e) {
          const int kt = e >> 2, r = e & 3;
          float bsh = fb;
          if (!far) { const int rel = s0 + 16 * kt + 4 * q4 + r - qposc[ct]; const int bk = btab[rel + 2047]; bsh = rb[bk * 8 + h] * LOG2E - mref; }
          const float zv = (kt ? z1[r] : z0[r]) * (ATT_SCALE * LOG2E) + bsh;
          const unsigned sgn = (unsigned)__builtin_amdgcn_sbfe((int)word, 16 * kt + r, 1);
          pe[e] = __uint_as_float((__float_as_uint(zv) & sgn) | (0xF149F2CAu & ~sgn));
          bmx = fmaxf(bmx, pe[e]);
        }
        if (__ballot(bmx > 8.f) != 0ull) {
          { const F2 m16 = swap16(bmx); bmx = fmaxf(m16.lo, m16.hi); const F2 m32 = swap32(bmx); bmx = fmaxf(m32.lo, m32.hi); }
          const float d = bmx > 8.f ? bmx : 0.f;
          const float sc = __builtin_amdgcn_exp2f(-d);
          L[ct] *= sc; mrun[ct] = mref + d;
#pragma unroll
          for (int dt = 0; dt < 4; ++dt) O[ct][dt] *= sc;
#pragma unroll
          for (int e = 0; e < 8; ++e) pe[e] -= d;
        }
#pragma unroll
        for (int e = 0; e < 8; ++e) pe[e] = __builtin_amdgcn_exp2f(pe[e]);
        const bf16x8 pf = pack8(pe);
        __builtin_amdgcn_s_setprio(1);
        L[ct] = mfma16(ones, pf, L[ct]);
#pragma unroll
        for (int dt = 0; dt < 4; ++dt) O[ct][dt] = mfma16(vf[dt], pf, O[ct][dt]);
        __builtin_amdgcn_s_setprio(0);
      }
    };
    int nfar = (qpos0 - 159) >= 0 ? ((qpos0 - 159) >> 5) + 1 : 0;
    nfar = nfar < nkb ? nfar : nkb;
    char* kd = smem; char* vd = smem + 18432;
    const int srow = tid >> 3, sseg = tid & 7;
    bf16x8 preK = ld8(KBb + (size_t)srow * 64 + sseg * 8);
    bf16x8 preV = ld8(VBTb + (size_t)srow * T + sseg * 8);
    *reinterpret_cast<bf16x8*>(kd + srow * 144 + sseg * 16) = preK;
    *reinterpret_cast<bf16x8*>(vd + srow * 144 + sseg * 16) = preV;
    __syncthreads();
    const int nkb2 = n_adm >> 6;
    for (int kb2 = 0; kb2 < nkb2; ++kb2) {
      const bool more = kb2 + 1 < nkb2;
      if (more) {
        preK = ld8(KBb + (size_t)((kb2 + 1) * 64 + srow) * 64 + sseg * 8);
        preV = ld8(VBTb + (size_t)srow * T + (kb2 + 1) * 64 + sseg * 8);
      }
      const char* kc = kd + (kb2 & 1) * 9216; const char* vc = vd + (kb2 & 1) * 9216;
#pragma unroll
      for (int sub = 0; sub < 2; ++sub) {
        const int kb = 2 * kb2 + sub;
        bf16x8 kf[2][2], vf[4];
#pragma unroll
        for (int kt = 0; kt < 2; ++kt)
#pragma unroll
          for (int kk = 0; kk < 2; ++kk) kf[kt][kk] = *reinterpret_cast<const bf16x8*>(kc + (32 * sub + 16 * kt + c) * 144 + kk * 64 + q4 * 16);
#pragma unroll
        for (int dt = 0; dt < 4; ++dt) {
          const char* vp = vc + (16 * dt + c) * 144 + sub * 64 + q4 * 8;
          const bf16x4 lo = *reinterpret_cast<const bf16x4*>(vp), hi = *reinterpret_cast<const bf16x4*>(vp + 32);
          vf[dt] = __builtin_shufflevector(lo, hi, 0, 1, 2, 3, 4, 5, 6, 7);
        }
        if (kb < nfar) compkv(std::true_type{}, kb, kf, vf); else compkv(std::false_type{}, kb, kf, vf);
      }
      if (more) {
        *reinterpret_cast<bf16x8*>(kd + ((kb2 + 1) & 1) * 9216 + srow * 144 + sseg * 16) = preK;
        *reinterpret_cast<bf16x8*>(vd + ((kb2 + 1) & 1) * 9216 + srow * 144 + sseg * 16) = preV;
      }
      __syncthreads();
    }
#pragma unroll
    for (int ct = 0; ct < 2; ++ct) {
      const float lt = L[ct][0];
      const float inv = 1.f / lt;
#pragma unroll
      for (int dt = 0; dt < 4; ++dt) {
        const size_t off = (size_t)qrow[ct] * 512 + h * 64 + dt * 16 + 4 * q4;
        const size_t offq = (size_t)qrow[ct] * 1024 + 512 + h * 64 + dt * 16 + 4 * q4;
        const bf16x4 g = ld4((reinterpret_cast<bf16_t*>(p.ws + OFF_GB)) + off);
        st4((reinterpret_cast<bf16_t*>(p.ws + OFF_QAB)) + offq, pack4(O[ct][dt][0] * inv * bf2f(g[0]), O[ct][dt][1] * inv * bf2f(g[1]), O[ct][dt][2] * inv * bf2f(g[2]), O[ct][dt][3] * inv * bf2f(g[3])));
      }
    }
  }
  __syncthreads();
}

DI void phase_attn(const Params& p, int layer, char* smem) {
  const int tid = otid();
  for (int i = tid; i < 4096; i += NTHREADS) smem[LDS_BTAB + i] = (char)(reinterpret_cast<unsigned char*>(p.ws + OFF_BTAB))[i];
  if (tid < 256) reinterpret_cast<float*>(smem + LDS_RB)[tid] = p.rel_bias[tid];
  __syncthreads();
  int* slot = reinterpret_cast<int*>(smem + LDS_SLOT);
  const int w = tid >> 6;
  const int total = 16 + 2048 + 32 + 4096;
  if (tid == 0) *slot = atomicAdd(&(reinterpret_cast<int*>(p.ws + OFF_CTR))[layer], 1);
  __syncthreads();
  int item = *slot;
  while (item < total) {
    int nxt = 0;
    if (tid == 0) nxt = atomicAdd(&(reinterpret_cast<int*>(p.ws + OFF_CTR))[layer], 1);
    if (item < 16) dsa_item<1>(p, item >> 1, item & 1, smem);
    else if (item < 2064) { const int i = item - 16; dsa_item<0>(p, i >> 6, 63 - (i & 63), smem); }
    else if (item < 2096) { const int i = item - 2064; sb_item<1>(p, i >> 2, 2 * (i & 3) + (w >> 2), (w & 3) * 16); }
    else { const int i = item - 2096; const int tile = 15 - (i >> 8), bh = i & 255; sb_item<0>(p, bh >> 3, bh & 7, tile * 128 + w * 16); }
    __syncthreads();
    if (tid == 0) *slot = nxt;
    __syncthreads();
    item = *slot;
  }
}

DI void phase_ln(const Params& p, int layer, char* smem) {
  const int tid = otid(), lane = tid & 63;
  {
    const int stride = gridDim.x * NWAVES;
    const float* g = p.ln_g + layer * 1024; const float* b = p.ln_b + layer * 1024;
    for (int row = blockIdx.x * NWAVES + (tid >> 6); row < MT; row += 2 * stride) {
      const int row2 = row + stride;
      if (row2 < MT) ln_rows2(p.out + (size_t)row * 1024, p.out + (size_t)row2 * 1024, g, b, p.out + (size_t)row * 1024, (reinterpret_cast<bf16_t*>(p.ws + OFF_XB)) + (size_t)row * 1024, p.out + (size_t)row2 * 1024, (reinterpret_cast<bf16_t*>(p.ws + OFF_XB)) + (size_t)row2 * 1024, lane);
      else ln_row_wave(p.out + (size_t)row * 1024, g, b, p.out + (size_t)row * 1024, (reinterpret_cast<bf16_t*>(p.ws + OFF_XB)) + (size_t)row * 1024, lane);
    }
  }
  if (layer + 1 < DEPTH) convert_layer(p, layer + 1, smem);
}

__global__ void __launch_bounds__(512, 2) mega_kernel(Params p) {
  extern __shared__ __attribute__((aligned(16))) char smem[];
  cg::grid_group grid = cg::this_grid();
  phase_prologue(p, smem);
  grid.sync();
  unsigned* bar = reinterpret_cast<unsigned*>((reinterpret_cast<int*>(p.ws + OFF_CTR)) + 8);
  unsigned nb = 0; const unsigned G = gridDim.x;
#pragma nounroll
  for (int l = 0; l < DEPTH; ++l) {
    phase_proj(p, l, smem);
    gbar(bar, ++nb * G);
    phase_attn(p, l, smem);
    gbar(bar, ++nb * G);
    phase_merge(p, smem);
    gbar(bar, ++nb * G);
    phase_out(p, smem);
    gbar(bar, ++nb * G);
    phase_ln(p, l, smem);
    if (l + 1 < DEPTH) gbar(bar, ++nb * G);
  }
}

#if !USE_COOP
__global__ void __launch_bounds__(512, 2) phase_kernel(Params p, int phase, int layer) {
  extern __shared__ __attribute__((aligned(16))) char smem[];
  if (phase == 0) phase_prologue(p, smem);
  else if (phase == 1) phase_proj(p, layer, smem);
  else if (phase == 2) phase_attn(p, layer, smem);
  else if (phase == 3) phase_merge(p, smem);
  else if (phase == 4) { }
  else if (phase == 5) phase_out(p, smem);
  else phase_ln(p, layer, smem);
}

#endif

extern "C" void kernel_launch(void* const* d_in, const int* in_sizes, int n_in, void* d_out, int out_size, void* d_ws, size_t ws_size, hipStream_t stream) {
  static int grid_blocks = 0;
  if (grid_blocks == 0) {
    if (n_in != 17 || out_size != OUT_TOTAL) { fprintf(stderr, "kernel_launch: unexpected shapes n_in=%d out=%d\n", n_in, out_size); grid_blocks = -1; return; }
    int dev = 0, cus = 0, per_cu = 0;
    hipGetDevice(&dev);
    hipDeviceGetAttribute(&cus, hipDeviceAttributeMultiprocessorCount, dev);
    hipFuncSetAttribute((const void*)mega_kernel, hipFuncAttributeMaxDynamicSharedMemorySize, LDS_BYTES);
#if !USE_COOP
    hipFuncSetAttribute((const void*)phase_kernel, hipFuncAttributeMaxDynamicSharedMemorySize, LDS_BYTES);
#endif
    hipOccupancyMaxActiveBlocksPerMultiprocessor(&per_cu, (const void*)mega_kernel, NTHREADS, LDS_BYTES);
    if (per_cu < 1) per_cu = 1;
    if (per_cu > 1) per_cu = 1;
    grid_blocks = cus * per_cu;
    fprintf(stderr, "kernel_launch: cus=%d per_cu=%d grid=%d ws=%zu\n", cus, per_cu, grid_blocks, ws_size);
  }
  if (grid_blocks < 0) return;
  Params p{};
  p.x_prompt = (const float*)d_in[0]; p.x_sample = (const float*)d_in[1];
  p.c_sb_k = (const float*)d_in[2]; p.c_sb_v = (const float*)d_in[3]; p.c_dsa_k = (const float*)d_in[4]; p.c_dsa_v = (const float*)d_in[5]; p.c_idx_k = (const float*)d_in[6];
  p.ln_in_g = (const float*)d_in[7]; p.ln_in_b = (const float*)d_in[8]; p.w_in = (const float*)d_in[9]; p.b_in = (const float*)d_in[10];
  p.w_pa = (const float*)d_in[11]; p.w_pb = (const float*)d_in[12]; p.w_out = (const float*)d_in[13]; p.ln_g = (const float*)d_in[14]; p.ln_b = (const float*)d_in[15];
  p.rel_bias = (const float*)d_in[16];
  p.out = (float*)d_out;
  p.ws = (char*)d_ws;
  if (OFF_END > ws_size) { fprintf(stderr, "kernel_launch: workspace too small: need %zu have %zu\n", (size_t)OFF_END, ws_size); return; }
#if USE_COOP
  void* args[] = {&p};
  hipError_t e = hipLaunchCooperativeKernel((const void*)mega_kernel, dim3(grid_blocks), dim3(NTHREADS), args, LDS_BYTES, stream);
  if (e != hipSuccess) fprintf(stderr, "cooperative launch failed: %s (grid %d)\n", hipGetErrorString(e), grid_blocks);
#else
  hipLaunchKernelGGL(phase_kernel, dim3(grid_blocks), dim3(NTHREADS), LDS_BYTES, stream, p, 0, 0);
  for (int l = 0; l < DEPTH; ++l)
    for (int ph = 1; ph <= 6; ++ph) hipLaunchKernelGGL(phase_kernel, dim3(grid_blocks), dim3(NTHREADS), LDS_BYTES, stream, p, ph, l);
#endif
}
```

```cpp
#include <hip/hip_runtime.h>
#include <hip/hip_cooperative_groups.h>
#include <cstdio>
#include <type_traits>
namespace cg = cooperative_groups;

#ifndef USE_COOP
#define USE_COOP 1
#endif

#define DI __device__ __forceinline__
typedef unsigned short bf16_t;
using bf16x8 = __attribute__((ext_vector_type(8))) short;
using bf16x4 = __attribute__((ext_vector_type(4))) short;
using f32x4  = __attribute__((ext_vector_type(4))) float;

constexpr int D_MODEL = 1024, BATCH = 32, SEQ = 2048, DEPTH = 4, DEC_BATCH = 8, DEC_SEQ = 64, PAST = 1024, LS = 1088;
constexpr int MP = BATCH * SEQ;
constexpr int MS = DEC_BATCH * DEC_SEQ;
constexpr int MT = MP + MS;
constexpr int D_IN = 5832, D_INP = 5888;
constexpr float LN_EPS = 1e-5f;
constexpr float ALPHA = 1.681792830507429f;
constexpr float SB_SCALE = 0.125f, ATT_SCALE = 0.125f;
constexpr int NTHREADS = 512, NWAVES = 8;
constexpr int LDS_S = 0, LDS_BM = 131072, LDS_BTAB = 139264, LDS_RB = 143360, LDS_SLOT = 144384, LDS_KI = 144448, LDS_BYTES = 162880;

constexpr size_t O_Y = 0, O_KAP = 67633152, O_VAP = 201850880, O_KBP = 336068608, O_VBP = 352845824, O_KIP = 369623040,
                 O_KAS = 386400256, O_VAS = 387448832, O_KBS = 388497408, O_VBS = 388628480, O_KIS = 388759552;
constexpr int OUT_TOTAL = 388890624;

constexpr size_t al256(size_t x) { return (x + 255) & ~(size_t)255; }
constexpr size_t OFF_XB = 0;
constexpr size_t OFF_QAB = OFF_XB + al256((size_t)MT * 1024 * 2);
constexpr size_t OFF_GA = OFF_QAB + al256((size_t)MT * 1024 * 2);
constexpr size_t OFF_GB = OFF_GA + al256((size_t)MT * 512 * 2);
constexpr size_t OFF_QI = OFF_GB + al256((size_t)MT * 512 * 2);
constexpr size_t OFF_KAP = OFF_QI + al256((size_t)MT * 512 * 2);
constexpr size_t OFF_VATP = OFF_KAP + al256((size_t)MP * 512 * 2);
constexpr size_t OFF_KAS = OFF_VATP + al256((size_t)MP * 512 * 2);
constexpr size_t OFF_VATS = OFF_KAS + al256((size_t)8 * LS * 512 * 2);
constexpr size_t OFF_KBP = OFF_VATS + al256((size_t)8 * LS * 512 * 2);
constexpr size_t OFF_VBTP = OFF_KBP + al256((size_t)MP * 64 * 2);
constexpr size_t OFF_KIP = OFF_VBTP + al256((size_t)MP * 64 * 2);
constexpr size_t OFF_KBS = OFF_KIP + al256((size_t)MP * 64 * 2);
constexpr size_t OFF_VBTS = OFF_KBS + al256((size_t)8 * LS * 64 * 2);
constexpr size_t OFF_KIS = OFF_VBTS + al256((size_t)8 * LS * 64 * 2);
constexpr size_t OFF_WI = OFF_KIS + al256((size_t)8 * LS * 64 * 2);
constexpr size_t OFF_RA = OFF_WI + al256((size_t)MT * 8 * 4);
constexpr size_t OFF_RB = OFF_RA + al256((size_t)MT * 1024 * 2);
constexpr size_t OFF_WINT = OFF_RB + al256((size_t)MT * 1024 * 2);
constexpr size_t OFF_WPAT = OFF_WINT + al256((size_t)D_INP * 1024 * 2);
constexpr size_t OFF_WPBT = OFF_WPAT + al256((size_t)1024 * 512 * 2);
constexpr size_t OFF_WOUTT = OFF_WPBT + al256((size_t)1024 * 512 * 2);
constexpr size_t OFF_BTAB = OFF_WOUTT + al256((size_t)1024 * 1024 * 2);
constexpr size_t OFF_CTR = OFF_BTAB + 4096;
constexpr size_t OFF_END = OFF_CTR + 256;

struct Params {
  const float* x_prompt; const float* x_sample;
  const float* c_sb_k; const float* c_sb_v; const float* c_dsa_k; const float* c_dsa_v; const float* c_idx_k;
  const float* ln_in_g; const float* ln_in_b; const float* w_in; const float* b_in; const float* w_pa; const float* w_pb;
  const float* w_out; const float* ln_g; const float* ln_b; const float* rel_bias;
  float* out; char* ws;
};

DI unsigned short f2bf(float x) { unsigned u = __float_as_uint(x); u += 0x7fffu + ((u >> 16) & 1u); return (unsigned short)(u >> 16); }
DI float bf2f(short h) { return __uint_as_float(((unsigned)(unsigned short)h) << 16); }
typedef __bf16 hbf16x2 __attribute__((ext_vector_type(2)));
typedef float f32x2v __attribute__((ext_vector_type(2)));
typedef unsigned u32x2v __attribute__((ext_vector_type(2)));
typedef unsigned u32x4v __attribute__((ext_vector_type(4)));
DI unsigned pk2(float lo, float hi) { f32x2v v; v.x = lo; v.y = hi; return __builtin_bit_cast(unsigned, __builtin_convertvector(v, hbf16x2)); }
DI bf16x4 pack4(float a, float b, float c, float d) { u32x2v u; u.x = pk2(a, b); u.y = pk2(c, d); return __builtin_bit_cast(bf16x4, u); }
DI bf16x8 pack8(const float (&e)[8]) { u32x4v u; u.x = pk2(e[0], e[1]); u.y = pk2(e[2], e[3]); u.z = pk2(e[4], e[5]); u.w = pk2(e[6], e[7]); return __builtin_bit_cast(bf16x8, u); }
DI bf16x8 ld8(const bf16_t* p) { return *reinterpret_cast<const bf16x8*>(p); }
DI bf16x4 ld4(const bf16_t* p) { return *reinterpret_cast<const bf16x4*>(p); }
DI void st4(bf16_t* p, bf16x4 v) { *reinterpret_cast<bf16x4*>(p) = v; }
DI f32x4 mfma16(bf16x8 a, bf16x8 b, f32x4 c) { return __builtin_amdgcn_mfma_f32_16x16x32_bf16(a, b, c, 0, 0, 0); }
DI int otid() { int t = threadIdx.x; asm volatile("" : "+v"(t)); return t; }
DI int osg(int v) { asm volatile("" : "+s"(v)); return v; }
DI float sigmoidf_(float x) { return __builtin_amdgcn_rcpf(1.f + __expf(-x)); }
struct F2 { float lo, hi; };
DI F2 swap16(float x) { const unsigned u = __float_as_uint(x); auto r = __builtin_amdgcn_permlane16_swap(u, u, false, false); return F2{__uint_as_float(r[0]), __uint_as_float(r[1])}; }
DI F2 swap32(float x) { const unsigned u = __float_as_uint(x); auto r = __builtin_amdgcn_permlane32_swap(u, u, false, false); return F2{__uint_as_float(r[0]), __uint_as_float(r[1])}; }
DI float row_sum16(float x) {
  x += __uint_as_float(__builtin_amdgcn_update_dpp(0, __float_as_uint(x), 0xB1, 0xF, 0xF, true));
  x += __uint_as_float(__builtin_amdgcn_update_dpp(0, __float_as_uint(x), 0x4E, 0xF, 0xF, true));
  x += __uint_as_float(__builtin_amdgcn_update_dpp(0, __float_as_uint(x), 0x141, 0xF, 0xF, true));
  x += __uint_as_float(__builtin_amdgcn_update_dpp(0, __float_as_uint(x), 0x140, 0xF, 0xF, true));
  return x;
}
DI float wave_sum(float x) { x = row_sum16(x); F2 a = swap16(x); x = a.lo + a.hi; F2 b = swap32(x); return b.lo + b.hi; }
DI int hsum32(int x) {
  x += __builtin_amdgcn_update_dpp(0, x, 0xB1, 0xF, 0xF, true);
  x += __builtin_amdgcn_update_dpp(0, x, 0x4E, 0xF, 0xF, true);
  x += __builtin_amdgcn_update_dpp(0, x, 0x141, 0xF, 0xF, true);
  x += __builtin_amdgcn_update_dpp(0, x, 0x140, 0xF, 0xF, true);
  auto r = __builtin_amdgcn_permlane16_swap((unsigned)x, (unsigned)x, false, false);
  return (int)(r[0] + r[1]);
}
DI void gbar(unsigned* ctr, unsigned target) {
  asm volatile("s_waitcnt vmcnt(0)" ::: "memory");
  __syncthreads();
  if (otid() == 0) {
    __builtin_amdgcn_fence(__ATOMIC_RELEASE, "agent");
    asm volatile("s_waitcnt vmcnt(0)" ::: "memory");
    __hip_atomic_fetch_add(ctr, 1u, __ATOMIC_RELAXED, __HIP_MEMORY_SCOPE_AGENT);
    while (__hip_atomic_load(ctr, __ATOMIC_RELAXED, __HIP_MEMORY_SCOPE_AGENT) < target) __builtin_amdgcn_s_sleep(2);
    __builtin_amdgcn_fence(__ATOMIC_ACQUIRE, "agent");
    asm volatile("s_waitcnt vmcnt(0)" ::: "memory");
  }
  __syncthreads();
}

DI void ln_row_wave(const float* src, const float* g, const float* b, float* d32, bf16_t* db, int lane) {
  float4 v[4]; float s = 0.f;
#pragma unroll
  for (int i = 0; i < 4; ++i) { v[i] = reinterpret_cast<const float4*>(src)[lane + 64 * i]; s += v[i].x + v[i].y + v[i].z + v[i].w; }
  s = wave_sum(s);
  const float mu = s * (1.f / 1024.f);
  float q = 0.f;
#pragma unroll
  for (int i = 0; i < 4; ++i) { float a = v[i].x - mu, bb = v[i].y - mu, c = v[i].z - mu, d = v[i].w - mu; q += a * a + bb * bb + c * c + d * d; }
  q = wave_sum(q);
  const float rstd = rsqrtf(q * (1.f / 1024.f) + LN_EPS);
#pragma unroll
  for (int i = 0; i < 4; ++i) {
    float4 gg = reinterpret_cast<const float4*>(g)[lane + 64 * i], bb = reinterpret_cast<const float4*>(b)[lane + 64 * i];
    float4 o;
    o.x = (v[i].x - mu) * rstd * gg.x + bb.x; o.y = (v[i].y - mu) * rstd * gg.y + bb.y;
    o.z = (v[i].z - mu) * rstd * gg.z + bb.z; o.w = (v[i].w - mu) * rstd * gg.w + bb.w;
    reinterpret_cast<float4*>(d32)[lane + 64 * i] = o;
    st4(db + 4 * (lane + 64 * i), pack4(o.x, o.y, o.z, o.w));
  }
}

DI void ln_rows2(const float* s0, const float* s1, const float* g, const float* b, float* d0, bf16_t* db0, float* d1, bf16_t* db1, int lane) {
  float4 v0[4], v1[4]; float a0 = 0.f, a1 = 0.f;
#pragma unroll
  for (int i = 0; i < 4; ++i) { v0[i] = reinterpret_cast<const float4*>(s0)[lane + 64 * i]; v1[i] = reinterpret_cast<const float4*>(s1)[lane + 64 * i]; }
#pragma unroll
  for (int i = 0; i < 4; ++i) { a0 += v0[i].x + v0[i].y + v0[i].z + v0[i].w; a1 += v1[i].x + v1[i].y + v1[i].z + v1[i].w; }
  a0 = wave_sum(a0); a1 = wave_sum(a1);
  const float mu0 = a0 * (1.f / 1024.f), mu1 = a1 * (1.f / 1024.f);
  float q0 = 0.f, q1 = 0.f;
#pragma unroll
  for (int i = 0; i < 4; ++i) {
    { float a = v0[i].x - mu0, bb = v0[i].y - mu0, c = v0[i].z - mu0, d = v0[i].w - mu0; q0 += a * a + bb * bb + c * c + d * d; }
    { float a = v1[i].x - mu1, bb = v1[i].y - mu1, c = v1[i].z - mu1, d = v1[i].w - mu1; q1 += a * a + bb * bb + c * c + d * d; }
  }
  q0 = wave_sum(q0); q1 = wave_sum(q1);
  const float r0 = rsqrtf(q0 * (1.f / 1024.f) + LN_EPS), r1 = rsqrtf(q1 * (1.f / 1024.f) + LN_EPS);
#pragma unroll
  for (int i = 0; i < 4; ++i) {
    const float4 gg = reinterpret_cast<const float4*>(g)[lane + 64 * i], bb = reinterpret_cast<const float4*>(b)[lane + 64 * i];
    float4 o;
    o.x = (v0[i].x - mu0) * r0 * gg.x + bb.x; o.y = (v0[i].y - mu0) * r0 * gg.y + bb.y; o.z = (v0[i].z - mu0) * r0 * gg.z + bb.z; o.w = (v0[i].w - mu0) * r0 * gg.w + bb.w;
    reinterpret_cast<float4*>(d0)[lane + 64 * i] = o; st4(db0 + 4 * (lane + 64 * i), pack4(o.x, o.y, o.z, o.w));
    o.x = (v1[i].x - mu1) * r1 * gg.x + bb.x; o.y = (v1[i].y - mu1) * r1 * gg.y + bb.y; o.z = (v1[i].z - mu1) * r1 * gg.z + bb.z; o.w = (v1[i].w - mu1) * r1 * gg.w + bb.w;
    reinterpret_cast<float4*>(d1)[lane + 64 * i] = o; st4(db1 + 4 * (lane + 64 * i), pack4(o.x, o.y, o.z, o.w));
  }
}

DI void tconv_tile(const float* src, int ldsrc, int K, bf16_t* dst, int n0, int k0, bool winmap, float* tile, int dk = 0) {
  const int tid = otid();
#pragma unroll
  for (int rr = 0; rr < 8; ++rr) {
    const int kl = rr * 8 + (tid >> 6), nl = tid & 63, np = n0 + nl;
    int n = np; bool ok = true;
    if (winmap) { if (np >= 3840) n = np - 56; else if (np >= 3784) ok = false; }
    tile[kl * 65 + nl] = ok ? src[(size_t)(k0 + kl) * ldsrc + n] : 0.f;
  }
  __syncthreads();
#pragma unroll
  for (int rr = 0; rr < 8; ++rr) {
    const int nl = rr * 8 + (tid >> 6), kl = tid & 63;
    dst[(size_t)(n0 + nl) * K + dk + k0 + kl] = f2bf(tile[kl * 65 + nl]);
  }
  __syncthreads();
}

DI void convert_layer(const Params& p, int l, char* smem) {
  float* tile = reinterpret_cast<float*>(smem);
  const int G = osg(gridDim.x);
  for (int it = blockIdx.x; it < 1984; it += G) {
    if (it < 1472) { int nt = it >> 4, kt = it & 15; tconv_tile(p.w_in + (size_t)l * 1024 * D_IN, D_IN, 1024, (reinterpret_cast<bf16_t*>(p.ws + OFF_WINT)), nt * 64, kt * 64, true, tile); }
    else if (it < 1600) { int i = it - 1472; int nt = i >> 3, kt = i & 7; tconv_tile(p.w_pa + (size_t)l * 512 * 1024, 1024, 1024, (reinterpret_cast<bf16_t*>(p.ws + OFF_WPAT)), nt * 64, kt * 64, false, tile); }
    else if (it < 1728) { int i = it - 1600; int nt = i >> 3, kt = i & 7; tconv_tile(p.w_pb + (size_t)l * 512 * 1024, 1024, 1024, (reinterpret_cast<bf16_t*>(p.ws + OFF_WPAT)), nt * 64, kt * 64, false, tile, 512); }
    else { int i = it - 1728; int nt = i >> 4, kt = i & 15; tconv_tile(p.w_out + (size_t)l * 1024 * 1024, 1024, 1024, (reinterpret_cast<bf16_t*>(p.ws + OFF_WOUTT)), nt * 64, kt * 64, false, tile); }
  }
  const int gtid = blockIdx.x * NTHREADS + otid(), gn = G * NTHREADS;
#pragma unroll 4
  for (int idx = gtid; idx < 8 * 1024 * 512; idx += gn) {
    int b = idx >> 19, rem = idx & ((1 << 19) - 1);
    (reinterpret_cast<bf16_t*>(p.ws + OFF_KAS))[(size_t)b * LS * 512 + rem] = f2bf(p.c_sb_k[(size_t)l * 8 * 1024 * 512 + idx]);
  }
#pragma unroll 4
  for (int idx = gtid; idx < 8 * 512 * 1024; idx += gn) {
    int b = idx >> 19, hd = (idx >> 10) & 511, t = idx & 1023;
    (reinterpret_cast<bf16_t*>(p.ws + OFF_VATS))[((size_t)b * 512 + hd) * LS + t] = f2bf(p.c_sb_v[(((size_t)l * 8 + b) * 1024 + t) * 512 + hd]);
  }
  for (int idx = gtid; idx < 8 * 1024 * 64; idx += gn) {
    int b = idx >> 16, rem = idx & 65535;
    (reinterpret_cast<bf16_t*>(p.ws + OFF_KBS))[(size_t)b * LS * 64 + rem] = f2bf(p.c_dsa_k[(size_t)l * 8 * 65536 + idx]);
    (reinterpret_cast<bf16_t*>(p.ws + OFF_KIS))[(size_t)b * LS * 64 + rem] = f2bf(p.c_idx_k[(size_t)l * 8 * 65536 + idx]);
    int d = (idx >> 10) & 63, t = idx & 1023;
    (reinterpret_cast<bf16_t*>(p.ws + OFF_VBTS))[((size_t)b * 64 + d) * LS + t] = f2bf(p.c_dsa_v[(((size_t)l * 8 + b) * 1024 + t) * 64 + d]);
  }
}

DI void phase_prologue(const Params& p, char* smem) {
  const int tid = otid(), lane = tid & 63;
  if (blockIdx.x == 0 && tid < 16) (reinterpret_cast<int*>(p.ws + OFF_CTR))[tid] = 0;
  for (int i = blockIdx.x * NTHREADS + tid; i < 4096; i += gridDim.x * NTHREADS) {
    int rel = i - 2047; int n = rel < 0 ? -rel : rel;
    float nf = (float)(n > 1 ? n : 1);
    int large = 8 + (int)(logf(nf / 8.f) / 2.7725887f * 8.f);
    large = large < 15 ? large : 15;
    int bk = (rel > 0 ? 16 : 0) + (n < 8 ? n : large);
    (reinterpret_cast<unsigned char*>(p.ws + OFF_BTAB))[i] = (unsigned char)bk;
  }
  {
    const int stride = gridDim.x * NWAVES;
    for (int row = blockIdx.x * NWAVES + (tid >> 6); row < MT; row += 2 * stride) {
      const int row2 = row + stride;
      const float* src = row < MP ? p.x_prompt + (size_t)row * 1024 : p.x_sample + (size_t)(row - MP) * 1024;
      if (row2 < MT) {
        const float* src2 = row2 < MP ? p.x_prompt + (size_t)row2 * 1024 : p.x_sample + (size_t)(row2 - MP) * 1024;
        ln_rows2(src, src2, p.ln_in_g, p.ln_in_b, p.out + (size_t)row * 1024, (reinterpret_cast<bf16_t*>(p.ws + OFF_XB)) + (size_t)row * 1024, p.out + (size_t)row2 * 1024, (reinterpret_cast<bf16_t*>(p.ws + OFF_XB)) + (size_t)row2 * 1024, lane);
      } else ln_row_wave(src, p.ln_in_g, p.ln_in_b, p.out + (size_t)row * 1024, (reinterpret_cast<bf16_t*>(p.ws + OFF_XB)) + (size_t)row * 1024, lane);
    }
  }
  convert_layer(p, 0, smem);
}


namespace pg8 {
#define PG8_LAS __attribute__((address_space(3)))
constexpr int BM = 256, BK = 64, HALF = 128, HTB = HALF * BK * 2, STAGE_BYTES = 8 * HTB, NXCD = 8, WGM = 8;
DI int lds_byte(int r, int c) { const int st = (r >> 4) * 2 + (c >> 5), rr = r & 15, cc = c & 31, ob = rr * 64 + cc * 2; return st * 1024 + (ob ^ (((ob >> 9) & 1) << 5)); }
DI void stage_rc(int b, int& R, int& C) { const int st = b / 1024, sb = b % 1024, swz = sb ^ (((sb >> 9) & 1) << 5); R = (st >> 1) * 16 + swz / 64; C = (st & 1) * 32 + (swz % 64) / 2; }
DI int perm32(int rho) { const int n = rho >> 4, i = rho & 15; return 8 * (i >> 2) + 4 * n + (i & 3); }
struct Unit { int pm, pn; };
struct Gemm { const bf16_t* A; const bf16_t* Bt; int M, N, K; };
struct StaticOrder {
    int nM, nN, nwg, G, c;
    DI void init(int M, int N, int G_, int c_) { nM = M / BM; nN = N / BM; nwg = nM * nN; G = G_; c = c_; }
    DI bool next(int i, Unit& u) const {
        const long L = (long)i * G + c; if (L >= nwg) return false;
        int wgid = (int)L; { const int q = nwg / NXCD, r = nwg % NXCD, xcd = wgid % NXCD, off = wgid / NXCD; wgid = (xcd < r ? xcd * (q + 1) : r * (q + 1) + (xcd - r) * q) + off; }
        const int nig = WGM * nN, gid = wgid / nig, fm = gid * WGM, gsz = (nM - fm) < WGM ? (nM - fm) : WGM;
        u.pm = fm + ((wgid % nig) % gsz); u.pn = (wgid % nig) / gsz; return true;
    }
    DI void a_ready(const Unit&) const {}
    DI void done(const Unit&) const {}
};
template <class Epi, class Sched>
__device__ __forceinline__ void gemm_phase(PG8_LAS unsigned char* lds, const Gemm g, const Sched& S, const Epi& E) {
    const int tid = otid(), wid = __builtin_amdgcn_readfirstlane(tid >> 6), lane = tid & 63, wr = wid >> 2, wc = wid & 3, fr = lane & 15, fq = lane >> 4;
    const int K = g.K, nt = K / BK;
    unsigned voffA[2], voffB[2];
#pragma unroll
    for (int i = 0; i < 2; ++i) { int R, C; stage_rc(tid * 16 + i * 8192, R, C); const int Rb = Epi::PERM ? ((R & ~31) + perm32(R & 31)) : R;
        voffA[i] = (unsigned)(R * K + C) * 2u; voffB[i] = (unsigned)(Rb * K + C) * 2u; }
    const size_t kstep = (size_t)(BK * 2);
    const size_t hstep = (size_t)HALF * K * 2;
    const size_t tstep = 2 * hstep;
    const unsigned ldsw = (unsigned)wid * 1024u;
    const int aoff = lds_byte(wr * 64 + fr, fq * 8), boff = lds_byte(wc * 32 + fr, fq * 8);
#define PG8_SA(b, h) (((b) * 2 + (h)) * HTB)
#define PG8_SB(b, h) ((4 + (b) * 2 + (h)) * HTB)
#define PG8_STAGE(bufoff, gbase, voff) do { _Pragma("unroll") for (int _i = 0; _i < 2; ++_i) \
        __builtin_amdgcn_global_load_lds((const unsigned*)((const char*)(gbase) + (voff)[_i]), (PG8_LAS unsigned*)(lds + (bufoff) + ldsw + _i * 8192), 16, 0, 0); } while (0)
#define PG8_LDA(dst, b, h) do { _Pragma("unroll") for (int m = 0; m < 4; ++m) _Pragma("unroll") for (int k = 0; k < 2; ++k) dst[m][k] = *(const PG8_LAS bf16x8*)(lds + PG8_SA(b, h) + aoff + m * 2048 + k * 1024); } while (0)
#define PG8_LDB(dst, b, h) do { _Pragma("unroll") for (int n = 0; n < 2; ++n) _Pragma("unroll") for (int k = 0; k < 2; ++k) dst[n][k] = *(const PG8_LAS bf16x8*)(lds + PG8_SB(b, h) + boff + n * 2048 + k * 1024); } while (0)
#define PG8_MMA(ai, bj, At, Bt) do { __builtin_amdgcn_s_setprio(1); _Pragma("unroll") for (int m = 0; m < 4; ++m) _Pragma("unroll") for (int n = 0; n < 2; ++n) _Pragma("unroll") for (int k = 0; k < 2; ++k) \
        acc[ai][bj][m][n] = __builtin_amdgcn_mfma_f32_16x16x32_bf16(Bt[n][k], At[m][k], acc[ai][bj][m][n], 0, 0, 0); __builtin_amdgcn_s_setprio(0); } while (0)
#define PG8_WAIT_V(n) asm volatile("s_waitcnt vmcnt(" #n ")" ::: "memory")
#define PG8_WAIT_L(n) asm volatile("s_waitcnt lgkmcnt(" #n ")" ::: "memory")
#define PG8_BAR __builtin_amdgcn_s_barrier()
#define PG8_SCHED __builtin_amdgcn_sched_barrier(0)
    Unit cur, nxt; int ui = 0;
    if (!S.next(0, cur)) return;
    f32x4 acc[2][2][4][2];
#pragma unroll
    for (int a = 0; a < 2; ++a)
#pragma unroll
        for (int b = 0; b < 2; ++b)
#pragma unroll
            for (int m = 0; m < 4; ++m)
#pragma unroll
                for (int n = 0; n < 2; ++n) acc[a][b][m][n] = (f32x4){0.f, 0.f, 0.f, 0.f};
    bf16x8 At[4][2], B0[2][2], B1[2][2];
    const char* cA = (const char*)g.A + (size_t)cur.pm * tstep; const char* cB = (const char*)g.Bt + (size_t)cur.pn * tstep;
    S.a_ready(cur);
    PG8_STAGE(PG8_SB(0, 0), cB, voffB); PG8_STAGE(PG8_SA(0, 0), cA, voffA); PG8_STAGE(PG8_SB(0, 1), cB + hstep, voffB); PG8_STAGE(PG8_SA(0, 1), cA + hstep, voffA);
    if (wr == 1) PG8_BAR;
    PG8_WAIT_V(4); PG8_BAR;
    PG8_STAGE(PG8_SB(1, 0), cB + kstep, voffB); PG8_STAGE(PG8_SA(1, 0), cA + kstep, voffA); PG8_STAGE(PG8_SB(1, 1), cB + hstep + kstep, voffB);
    PG8_WAIT_V(6); PG8_BAR;
    for (;;) {
        const bool has_next = S.next(ui + 1, nxt);
        const char* nA = has_next ? (const char*)g.A + (size_t)nxt.pm * tstep : cA; const char* nB = has_next ? (const char*)g.Bt + (size_t)nxt.pn * tstep : cB;
        for (int t = 0; t < nt; t += 2) {
            const bool last = (t == nt - 2);
            const char* a1 = cA + (size_t)(t + 1) * kstep;
            const char* a2 = last ? nA : cA + (size_t)(t + 2) * kstep; const char* b2 = last ? nB : cB + (size_t)(t + 2) * kstep;
            const char* a3 = a2 + kstep; const char* b3 = b2 + kstep;
            if (last && has_next) S.a_ready(nxt);
            if constexpr (Epi::MIDK) { if (t == nt / 2) E.mid(acc, cur, wr, wc, fr, fq); }
            PG8_LDB(B0, 0, 0); PG8_SCHED; PG8_LDA(At, 0, 0); PG8_STAGE(PG8_SA(1, 1), a1 + hstep, voffA);
            PG8_WAIT_L(8); PG8_BAR; PG8_WAIT_L(0); PG8_MMA(0, 0, At, B0); PG8_BAR; PG8_SCHED;
            PG8_LDB(B1, 0, 1); PG8_STAGE(PG8_SB(0, 0), b2, voffB);
            PG8_BAR; PG8_WAIT_L(0); PG8_MMA(0, 1, At, B1); PG8_BAR;
            PG8_LDA(At, 0, 1); PG8_STAGE(PG8_SA(0, 0), a2, voffA);
            PG8_BAR; PG8_WAIT_L(0); PG8_MMA(1, 0, At, B0); PG8_BAR; PG8_SCHED;
            PG8_STAGE(PG8_SB(0, 1), b2 + hstep, voffB);
            PG8_WAIT_V(6); PG8_BAR; PG8_MMA(1, 1, At, B1); PG8_BAR;
            PG8_LDB(B0, 1, 0); PG8_SCHED; PG8_LDA(At, 1, 0); PG8_STAGE(PG8_SA(0, 1), a2 + hstep, voffA);
            PG8_WAIT_L(8); PG8_BAR; PG8_WAIT_L(0); PG8_MMA(0, 0, At, B0); PG8_BAR; PG8_SCHED;
            PG8_LDB(B1, 1, 1); PG8_STAGE(PG8_SB(1, 0), b3, voffB);
            PG8_BAR; PG8_WAIT_L(0); PG8_MMA(0, 1, At, B1); PG8_BAR;
            PG8_LDA(At, 1, 1); PG8_STAGE(PG8_SA(1, 0), a3, voffA);
            PG8_BAR; PG8_WAIT_L(0); PG8_MMA(1, 0, At, B0); PG8_BAR; PG8_SCHED;
            PG8_STAGE(PG8_SB(1, 1), b3 + hstep, voffB);
            PG8_WAIT_V(6); PG8_BAR; PG8_MMA(1, 1, At, B1); PG8_BAR;
        }
        if constexpr (!Epi::AFTER_DRAIN) { E(acc, cur, wr, wc, fr, fq); S.done(cur); }
        if (!has_next) break;
#pragma unroll
        for (int a = 0; a < 2; ++a)
#pragma unroll
            for (int b = 0; b < 2; ++b)
#pragma unroll
                for (int m = 0; m < 4; ++m)
#pragma unroll
                    for (int n = 0; n < 2; ++n) acc[a][b][m][n] = (f32x4){0.f, 0.f, 0.f, 0.f};
        cur = nxt; cA = nA; cB = nB; ++ui;
    }
    PG8_WAIT_V(0);
    if (wr == 0) PG8_BAR;
    PG8_BAR;
    if constexpr (Epi::AFTER_DRAIN) { E.fused(acc, cur, wr, wc, fr, fq, lds, wid, lane); S.done(cur); }
#undef PG8_SA
#undef PG8_SB
#undef PG8_STAGE
#undef PG8_LDA
#undef PG8_LDB
#undef PG8_MMA
#undef PG8_WAIT_V
#undef PG8_WAIT_L
#undef PG8_BAR
#undef PG8_SCHED
}
}

DI bf16x4 pack4v(const f32x4 v) { return pack4(v[0], v[1], v[2], v[3]); }

struct EpiProj {
  static constexpr bool PERM = true, AFTER_DRAIN = false, MIDK = false;
  const Params& p; int layer; const __attribute__((address_space(3))) float* biasl;
  template <int GRP>
  DI void run(const f32x4 (&acc)[2][2][4][2], const pg8::Unit& u, int wr, int wc, int fr, int fq) const {
    constexpr int T = GRP ? LS : SEQ;
    char* ws = p.ws;
#pragma unroll
    for (int bj = 0; bj < 2; ++bj) {
      const int nt = 2 * u.pn + bj;
      const __attribute__((address_space(3))) f32x4* bp = reinterpret_cast<const __attribute__((address_space(3))) f32x4*>(biasl + nt * 128 + 32 * wc + 8 * fq);
      const bool simple = (nt < 4) || (nt >= 12 && nt < 20) || (nt >= 21 && nt < 29) || (nt >= 30);
      if (simple) {
        size_t off; int ld, c0, act;
        if (nt < 4) { off = OFF_QAB; ld = 1024; c0 = nt * 128; act = 0; }
        else if (nt < 16) { off = OFF_GA; ld = 512; c0 = (nt - 12) * 128; act = 1; }
        else if (nt < 20) { off = OFF_QAB; ld = 1024; c0 = 512 + (nt - 16) * 128; act = 0; }
        else if (nt < 25) { off = OFF_GB; ld = 512; c0 = (nt - 21) * 128; act = 1; }
        else if (nt < 29) { off = OFF_QI; ld = 512; c0 = (nt - 25) * 128; act = 0; }
        else if (nt < 38) { off = OFF_RA; ld = 1024; c0 = (nt - 30) * 128; act = 2; }
        else { off = OFF_RB; ld = 1024; c0 = (nt - 38) * 128; act = 2; }
        bf16_t* dst = reinterpret_cast<bf16_t*>(ws + off) + c0 + 32 * wc + 8 * fq;
#pragma unroll
        for (int ai = 0; ai < 2; ++ai)
#pragma unroll
          for (int m = 0; m < 4; ++m) {
            int row = u.pm * 256 + 128 * ai + 64 * wr + 16 * m + fr;
            asm volatile("" : "+v"(row));
            if (act == 2) {
              u32x2v g8;
#pragma unroll
              for (int n = 0; n < 2; ++n) {
                const f32x4 v = acc[ai][bj][m][n] + bp[n];
                unsigned q = 0u;
#pragma unroll
                for (int j = 0; j < 4; ++j) q |= ((unsigned)(sigmoidf_(v[j]) * 255.f + 0.5f)) << (8 * j);
                if (n == 0) g8.x = q; else g8.y = q;
              }
              *reinterpret_cast<u32x2v*>(reinterpret_cast<unsigned char*>(ws + off) + (size_t)row * 1024 + c0 + 32 * wc + 8 * fq) = g8;
              continue;
            }
            u32x4v pk;
#pragma unroll
            for (int n = 0; n < 2; ++n) {
              f32x4 v = acc[ai][bj][m][n] + bp[n];
              if (act != 0) {
#pragma unroll
                for (int j = 0; j < 4; ++j) { const float sg = sigmoidf_(v[j]); v[j] = (act == 1) ? v[j] * sg : sg; }
              }
              if (n == 0) { pk.x = pk2(v[0], v[1]); pk.y = pk2(v[2], v[3]); } else { pk.z = pk2(v[0], v[1]); pk.w = pk2(v[2], v[3]); }
            }
            *reinterpret_cast<u32x4v*>(dst + (size_t)row * ld) = pk;
          }
      } else {
#pragma unroll
        for (int ai = 0; ai < 2; ++ai)
#pragma unroll
          for (int m = 0; m < 4; ++m) {
            int row = u.pm * 256 + 128 * ai + 64 * wr + 16 * m + fr;
            asm volatile("" : "+v"(row));
            int bb, tt;
            if (!GRP) { bb = row >> 11; tt = row & 2047; } else { const int ms = row - MP; bb = ms >> 6; tt = PAST + (ms & 63); }
            const size_t orow = GRP ? (size_t)layer * MS + (row - MP) : (size_t)layer * MP + row;
#pragma unroll
            for (int n = 0; n < 2; ++n) {
              int ct = 32 * wc + 8 * fq + 4 * n;
              asm volatile("" : "+v"(ct));
              const f32x4 v = acc[ai][bj][m][n] + bp[n];
              if (nt < 8) {
                const int c = (nt - 4) * 128 + ct;
                *reinterpret_cast<f32x4*>(p.out + (GRP ? O_KAS : O_KAP) + orow * 512 + c) = v;
                bf16_t* kd = GRP ? (reinterpret_cast<bf16_t*>(p.ws + OFF_KAS)) + ((size_t)bb * LS + tt) * 512 + c : (reinterpret_cast<bf16_t*>(p.ws + OFF_KAP)) + (size_t)row * 512 + c;
                st4(kd, pack4v(v));
              } else if (nt < 12) {
                const int c = (nt - 8) * 128 + ct;
                *reinterpret_cast<f32x4*>(p.out + (GRP ? O_VAS : O_VAP) + orow * 512 + c) = v;
                bf16_t* vd = (GRP ? (reinterpret_cast<bf16_t*>(p.ws + OFF_VATS)) : (reinterpret_cast<bf16_t*>(p.ws + OFF_VATP))) + ((size_t)bb * 512 + c) * T + tt;
                vd[0] = f2bf(v[0]); vd[T] = f2bf(v[1]); vd[2 * T] = f2bf(v[2]); vd[3 * T] = f2bf(v[3]);
              } else if (nt == 20) {
                if (wc < 2) {
                  *reinterpret_cast<f32x4*>(p.out + (GRP ? O_KBS : O_KBP) + orow * 64 + ct) = v;
                  st4((GRP ? (reinterpret_cast<bf16_t*>(p.ws + OFF_KBS)) : (reinterpret_cast<bf16_t*>(p.ws + OFF_KBP))) + ((size_t)bb * T + tt) * 64 + ct, pack4v(v));
                } else {
                  const int c = ct - 64;
                  *reinterpret_cast<f32x4*>(p.out + (GRP ? O_VBS : O_VBP) + orow * 64 + c) = v;
                  bf16_t* vd = (GRP ? (reinterpret_cast<bf16_t*>(p.ws + OFF_VBTS)) : (reinterpret_cast<bf16_t*>(p.ws + OFF_VBTP))) + ((size_t)bb * 64 + c) * T + tt;
                  vd[0] = f2bf(v[0]); vd[T] = f2bf(v[1]); vd[2 * T] = f2bf(v[2]); vd[3 * T] = f2bf(v[3]);
                }
              } else {
                if (wc < 2) {
                  *reinterpret_cast<f32x4*>(p.out + (GRP ? O_KIS : O_KIP) + orow * 64 + ct) = v;
                  st4((GRP ? (reinterpret_cast<bf16_t*>(p.ws + OFF_KIS)) : (reinterpret_cast<bf16_t*>(p.ws + OFF_KIP))) + ((size_t)bb * T + tt) * 64 + ct, pack4v(v));
                } else if (ct < 72) {
                  *reinterpret_cast<f32x4*>((reinterpret_cast<float*>(p.ws + OFF_WI)) + (size_t)row * 8 + (ct - 64)) = v;
                }
              }
            }
          }
      }
    }
  }
  DI void operator()(const f32x4 (&acc)[2][2][4][2], const pg8::Unit& u, int wr, int wc, int fr, int fq) const {
    if (u.pm < MP / 256) run<0>(acc, u, wr, wc, fr, fq); else run<1>(acc, u, wr, wc, fr, fq);
  }
};

template <int MODE>
struct EpiTail {
  static constexpr bool PERM = false, AFTER_DRAIN = false, MIDK = (MODE == 0);
  const Params& p;
  DI void mid(f32x4 (&acc)[2][2][4][2], const pg8::Unit& u, int wr, int wc, int fr, int fq) const {
#pragma unroll
    for (int ai = 0; ai < 2; ++ai)
#pragma unroll
      for (int m = 0; m < 4; ++m) {
        int row = u.pm * 256 + 128 * ai + 64 * wr + 16 * m + fr;
        asm volatile("" : "+v"(row));
#pragma unroll
        for (int bj = 0; bj < 2; ++bj)
#pragma unroll
          for (int n = 0; n < 2; ++n) {
            const size_t idx = (size_t)row * 1024 + u.pn * 256 + 128 * bj + 32 * wc + 16 * n + 4 * fq;
            const unsigned ga = *reinterpret_cast<const unsigned*>(reinterpret_cast<const unsigned char*>(p.ws + OFF_RA) + idx);
            const unsigned gb = *reinterpret_cast<const unsigned*>(reinterpret_cast<const unsigned char*>(p.ws + OFF_RB) + idx);
#pragma unroll
            for (int j = 0; j < 4; ++j) {
              const unsigned a8 = (ga >> (8 * j)) & 255u, b8 = (gb >> (8 * j)) & 255u;
              acc[ai][bj][m][n][j] *= (float)a8 * __builtin_amdgcn_rcpf((float)(b8 > 1u ? b8 : 1u));
            }
          }
        asm volatile("" ::: "memory");
      }
  }
  DI void operator()(const f32x4 (&acc)[2][2][4][2], const pg8::Unit& u, int wr, int wc, int fr, int fq) const {
    bf16_t* MERGED = (reinterpret_cast<bf16_t*>(p.ws + OFF_GA));
#pragma unroll
    for (int ai = 0; ai < 2; ++ai)
#pragma unroll
      for (int m = 0; m < 4; ++m) {
        const int row = u.pm * 256 + 128 * ai + 64 * wr + 16 * m + fr;
#pragma unroll
        for (int bj = 0; bj < 2; ++bj)
#pragma unroll
          for (int n = 0; n < 2; ++n) {
            const size_t idx = (size_t)row * 1024 + u.pn * 256 + 128 * bj + 32 * wc + 16 * n + 4 * fq;
            const f32x4 a = acc[ai][bj][m][n];
            if (MODE == 0) {
              const unsigned g = *reinterpret_cast<const unsigned*>(reinterpret_cast<const unsigned char*>(p.ws + OFF_RB) + idx);
              const float k = 1.f / 255.f;
              st4(MERGED + idx, pack4((float)(g & 255u) * k * a[0], (float)((g >> 8) & 255u) * k * a[1], (float)((g >> 16) & 255u) * k * a[2], (float)(g >> 24) * k * a[3]));
            } else {
              f32x4 x = *reinterpret_cast<const f32x4*>(p.out + idx);
              x = x * ALPHA + a;
              *reinterpret_cast<f32x4*>(p.out + idx) = x;
            }
          }
      }
  }
};

DI void phase_proj(const Params& p, int layer, char* smem) {
  {
    const float* bin = p.b_in + (size_t)layer * D_IN;
    float* bl = reinterpret_cast<float*>(smem + 131072);
    for (int i = otid(); i < D_INP; i += NTHREADS) bl[i] = (i < 3784) ? bin[i] : (i < 3840 ? 0.f : bin[i - 56]);
    __syncthreads();
  }
  pg8::Gemm g{(reinterpret_cast<bf16_t*>(p.ws + OFF_XB)), (reinterpret_cast<bf16_t*>(p.ws + OFF_WINT)), MT, D_INP, 1024};
  pg8::StaticOrder S; S.init(MT, D_INP, osg(gridDim.x), osg(blockIdx.x));
  EpiProj E{p, layer, (const __attribute__((address_space(3))) float*)(smem + 131072)};
  pg8::gemm_phase<EpiProj, pg8::StaticOrder>((PG8_LAS unsigned char*)smem, g, S, E);
}
DI void phase_merge(const Params& p, char* smem) {
  pg8::Gemm g{(reinterpret_cast<bf16_t*>(p.ws + OFF_QAB)), (reinterpret_cast<bf16_t*>(p.ws + OFF_WPAT)), MT, 1024, 1024};
  pg8::StaticOrder S; S.init(MT, 1024, osg(gridDim.x), osg(blockIdx.x));
  EpiTail<0> E{p};
  pg8::gemm_phase<EpiTail<0>, pg8::StaticOrder>((PG8_LAS unsigned char*)smem, g, S, E);
}
DI void phase_out(const Params& p, char* smem) {
  pg8::Gemm g{(reinterpret_cast<bf16_t*>(p.ws + OFF_GA)), (reinterpret_cast<bf16_t*>(p.ws + OFF_WOUTT)), MT, 1024, 1024};
  pg8::StaticOrder S; S.init(MT, 1024, osg(gridDim.x), osg(blockIdx.x));
  EpiTail<2> E{p};
  pg8::gemm_phase<EpiTail<2>, pg8::StaticOrder>((PG8_LAS unsigned char*)smem, g, S, E);
}

template <int grp>
DI void sb_item(const Params& p, int b, int h, int t0) {
  const int tid = otid(), w = tid >> 6, lane = tid & 63, c = lane & 15, q4 = lane >> 4;
  const int T = grp ? LS : SEQ;
  const int qpos0 = grp ? PAST + t0 : t0;
  const int m0 = grp ? MP + b * DEC_SEQ + t0 : b * SEQ + t0;
  const bf16_t* Kb = (grp ? (reinterpret_cast<bf16_t*>(p.ws + OFF_KAS)) : (reinterpret_cast<bf16_t*>(p.ws + OFF_KAP))) + (size_t)b * T * 512 + h * 64;
  const bf16_t* VTb = (grp ? (reinterpret_cast<bf16_t*>(p.ws + OFF_VATS)) : (reinterpret_cast<bf16_t*>(p.ws + OFF_VATP))) + (size_t)(b * 8 + h) * 64 * T;
  const bf16_t* qp = (reinterpret_cast<bf16_t*>(p.ws + OFF_QAB)) + (size_t)(m0 + c) * 1024 + h * 64 + q4 * 8;
  const bf16x8 qf0 = ld8(qp), qf1 = ld8(qp + 32);
  const int qpos = qpos0 + c;
  float R = 0.f;
  f32x4 O[4];
#pragma unroll
  for (int dt = 0; dt < 4; ++dt) O[dt] = f32x4{0.f, 0.f, 0.f, 0.f};
  bf16x8 kfA[2][2], vfA[4], kfB[2][2], vfB[4];
  auto loadkv = [&](int kb, bf16x8 (&kf)[2][2], bf16x8 (&vf)[4]) {
    const int s0 = kb * 32;
#pragma unroll
    for (int kt = 0; kt < 2; ++kt) { const bf16_t* kp = Kb + (size_t)(s0 + 16 * kt + c) * 512 + q4 * 8; kf[kt][0] = ld8(kp); kf[kt][1] = ld8(kp + 32); }
#pragma unroll
    for (int dt = 0; dt < 4; ++dt) {
      const bf16_t* vp = VTb + (size_t)(16 * dt + c) * T + s0 + 4 * q4;
      bf16x4 lo = ld4(vp), hi = ld4(vp + 16);
      vf[dt] = __builtin_shufflevector(lo, hi, 0, 1, 2, 3, 4, 5, 6, 7);
    }
  };
  auto comp = [&](int kb, const bf16x8 (&kf)[2][2], const bf16x8 (&vf)[4]) -> bool {
    const int s0 = kb * 32;
    f32x4 z[2];
#pragma unroll
    for (int kt = 0; kt < 2; ++kt) {
      z[kt] = mfma16(kf[kt][0], qf0, f32x4{0.f, 0.f, 0.f, 0.f});
      z[kt] = mfma16(kf[kt][1], qf1, z[kt]);
    }
    float lk[2][4], ls[2][4]; bool bf[2][4];
#pragma unroll
    for (int kt = 0; kt < 2; ++kt)
#pragma unroll
      for (int r = 0; r < 4; ++r) {
        const int key = s0 + 16 * kt + 4 * q4 + r;
        const bool before = key < qpos;
        const float zz = z[kt][r] * SB_SCALE;
        const float sp = fmaxf(zz, 0.f) + __logf(1.f + __expf(-fabsf(zz)));
        bf[kt][r] = before; lk[kt][r] = before ? -sp : 0.f; ls[kt][r] = zz - sp;
      }
    const float T1 = (lk[1][0] + lk[1][1]) + (lk[1][2] + lk[1][3]);
    const float T0 = (lk[0][0] + lk[0][1]) + (lk[0][2] + lk[0][3]);
    const F2 x1 = swap16(T1), x0 = swap16(T0);
    const float p1 = x1.lo + x1.hi, p0 = x0.lo + x0.hi;
    const F2 y1 = swap32(p1), y0 = swap32(p0);
    const float H1 = ((q4 & 1) ? 0.f : x1.hi) + ((q4 & 2) ? 0.f : y1.hi);
    const float H0 = ((q4 & 1) ? 0.f : x0.hi) + ((q4 & 2) ? 0.f : y0.hi);
    const float TT1 = y1.lo + y1.hi, TT0 = y0.lo + y0.hi;
    float a[2][4];
    { float ac = R + H1;
#pragma unroll
      for (int r = 3; r >= 0; --r) { a[1][r] = bf[1][r] ? __expf(ls[1][r] + ac) : 0.f; ac += lk[1][r]; } }
    { float ac = R + TT1 + H0;
#pragma unroll
      for (int r = 3; r >= 0; --r) { a[0][r] = bf[0][r] ? __expf(ls[0][r] + ac) : 0.f; ac += lk[0][r]; } }
    R = R + TT1 + TT0;
    const float ae[8] = {a[0][0], a[0][1], a[0][2], a[0][3], a[1][0], a[1][1], a[1][2], a[1][3]};
    const bf16x8 pf = pack8(ae);
#pragma unroll
    for (int dt = 0; dt < 4; ++dt) O[dt] = mfma16(vf[dt], pf, O[dt]);
    return __ballot(R > -50.f) == 0ull;
  };
  {
    int kb = (qpos0 + 14) >> 5;
    loadkv(kb, kfA, vfA);
    while (true) {
      if (kb >= 1) loadkv(kb - 1, kfB, vfB);
      if (comp(kb, kfA, vfA) || kb == 0) break;
      --kb;
      if (kb >= 1) loadkv(kb - 1, kfA, vfA);
      if (comp(kb, kfB, vfB) || kb == 0) break;
      --kb;
    }
  }
#pragma unroll
  for (int dt = 0; dt < 4; ++dt) {
    const size_t off = (size_t)(m0 + c) * 512 + h * 64 + dt * 16 + 4 * q4;
    const size_t offq = (size_t)(m0 + c) * 1024 + h * 64 + dt * 16 + 4 * q4;
    const bf16x4 g = ld4((reinterpret_cast<bf16_t*>(p.ws + OFF_GA)) + off);
    st4((reinterpret_cast<bf16_t*>(p.ws + OFF_QAB)) + offq, pack4(O[dt][0] * bf2f(g[0]), O[dt][1] * bf2f(g[1]), O[dt][2] * bf2f(g[2]), O[dt][3] * bf2f(g[3])));
  }
}

typedef unsigned short us2v __attribute__((ext_vector_type(2)));
template <int NK>
DI void topk_round(const unsigned short* Sh, int n_adm, int half, int l32, unsigned* bmrow) {
  constexpr int NP = NK / 2;
  us2v kp[NP];
#pragma unroll
  for (int i = 0; i < NP; ++i) {
    const int s0 = 64 * i + l32, s1 = s0 + 32;
    const unsigned short k0 = Sh[s0], k1 = Sh[s1];
    kp[i].x = (s0 < n_adm) ? k0 : (unsigned short)0;
    kp[i].y = (s1 < n_adm) ? k1 : (unsigned short)0;
  }
  unsigned tau = 1u; int need = 0; bool done = true;
  if (n_adm > 256) {
    tau = 0u; done = false;
    for (int bit = 15; bit >= 0; --bit) {
      const unsigned cand = tau | (1u << bit);
      const unsigned cv = cand | (cand << 16), one = 0x00010001u;
      unsigned acc = 0u;
#pragma unroll
      for (int i = 0; i < NP; ++i) {
        unsigned d, m;
        asm("v_pk_sub_u16 %0, %1, %2 clamp" : "=v"(d) : "v"(cv), "v"(__builtin_bit_cast(unsigned, kp[i])));
        asm("v_pk_min_u16 %0, %1, %2" : "=v"(m) : "v"(d), "v"(one));
        acc += m;
      }
      int cnt = NK - (int)((acc & 0xFFFFu) + (acc >> 16));
      cnt = hsum32(cnt);
      if (!done && cnt >= 256) tau = cand;
      if (cnt == 256) done = true;
      if (__ballot(!done) == 0ull) break;
    }
  }
  unsigned w0 = 0u, w1 = 0u;
  if (__ballot(!done) == 0ull) {
#pragma unroll
    for (int i = 0; i < NK; ++i) {
      const unsigned key = (i & 1) ? (unsigned)kp[i >> 1].y : (unsigned)kp[i >> 1].x;
      const unsigned long long msel = __ballot(key >= tau);
      const unsigned wsel = half ? (unsigned)(msel >> 32) : (unsigned)msel;
      if (i < 32) { if (l32 == i) w0 = wsel; } else { if (l32 == i - 32) w1 = wsel; }
    }
  } else {
    int cgt = 0;
#pragma unroll
    for (int i = 0; i < NK; ++i) { const unsigned key = (i & 1) ? (unsigned)kp[i >> 1].y : (unsigned)kp[i >> 1].x; cgt += (key > tau) ? 1 : 0; }
    cgt = hsum32(cgt);
    need = 256 - cgt;
    int Rk = 0; const unsigned below = (1u << l32) - 1u;
#pragma unroll
    for (int i = 0; i < NK; ++i) {
      const unsigned key = (i & 1) ? (unsigned)kp[i >> 1].y : (unsigned)kp[i >> 1].x;
      const bool eq = key == tau, gt = key > tau;
      const unsigned long long me = __ballot(eq);
      const unsigned hm = half ? (unsigned)(me >> 32) : (unsigned)me;
      const int rank = Rk + __popc(hm & below);
      const bool sel = done ? (key >= tau) : (gt || (eq && rank < need));
      Rk += __popc(hm);
      const unsigned long long msel = __ballot(sel);
      const unsigned wsel = half ? (unsigned)(msel >> 32) : (unsigned)msel;
      if (i < 32) { if (l32 == i) w0 = wsel; } else { if (l32 == i - 32) w1 = wsel; }
    }
  }
  bmrow[l32] = w0;
  if (NK > 32) bmrow[32 + l32] = w1;
}

template <int grp>
DI void dsa_item(const Params& p, int b, int tile32, char* smem) {
  const int tid = otid(), w = tid >> 6, lane = tid & 63, c = lane & 15, q4 = lane >> 4, half = lane >> 5, l32 = lane & 31;
  unsigned* bm = reinterpret_cast<unsigned*>(smem + LDS_BM);
  const unsigned char* btab = reinterpret_cast<const unsigned char*>(smem + LDS_BTAB);
  const float* rb = reinterpret_cast<const float*>(smem + LDS_RB);
  const int T = grp ? LS : SEQ;
  const int t0 = tile32 * 32;
  const int qpos0 = grp ? PAST + t0 : t0;
  const int m0 = grp ? MP + b * DEC_SEQ + t0 : b * SEQ + t0;
  const int n_adm = grp ? LS : ((qpos0 >> 6) + 1) * 64;
  const bf16_t* KIb = (grp ? (reinterpret_cast<bf16_t*>(p.ws + OFF_KIS)) : (reinterpret_cast<bf16_t*>(p.ws + OFF_KIP))) + (size_t)b * T * 64;
  const bf16_t* KBb = (grp ? (reinterpret_cast<bf16_t*>(p.ws + OFF_KBS)) : (reinterpret_cast<bf16_t*>(p.ws + OFF_KBP))) + (size_t)b * T * 64;
  const bf16_t* VBTb = (grp ? (reinterpret_cast<bf16_t*>(p.ws + OFF_VBTS)) : (reinterpret_cast<bf16_t*>(p.ws + OFF_VBTP))) + (size_t)b * 64 * T;

  unsigned short* S16 = reinterpret_cast<unsigned short*>(smem) + w * 8192;
  {
    const int tlA = c >> 3, hA = c & 7, tlC = q4 >> 1;
    bf16x8 af[2][2]; float4 wv[2];
#pragma unroll
    for (int pr = 0; pr < 2; ++pr) {
      const bf16_t* qip = (reinterpret_cast<bf16_t*>(p.ws + OFF_QI)) + (size_t)(m0 + 4 * w + 2 * pr + tlA) * 512 + hA * 64 + q4 * 8;
      af[pr][0] = ld8(qip); af[pr][1] = ld8(qip + 32);
      wv[pr] = *reinterpret_cast<const float4*>((reinterpret_cast<float*>(p.ws + OFF_WI)) + (size_t)(m0 + 4 * w + 2 * pr + tlC) * 8 + 4 * (q4 & 1));
    }
    const int nch = n_adm >> 6;
    char* kis = smem + LDS_KI;
    const int lrow = tid >> 3, lseg = tid & 7;
    bf16x8 pre = ld8(KIb + (size_t)lrow * 64 + lseg * 8);
    *reinterpret_cast<bf16x8*>(kis + lrow * 144 + lseg * 16) = pre;
    __syncthreads();
    for (int ch = 0; ch < nch; ++ch) {
      const bool more = ch + 1 < nch;
      if (more) pre = ld8(KIb + (size_t)((ch + 1) * 64 + lrow) * 64 + lseg * 8);
      const char* cur = kis + (ch & 1) * 9216;
#pragma unroll
      for (int u = 0; u < 4; ++u) {
        const char* rp = cur + (u * 16 + c) * 144 + q4 * 16;
        const bf16x8 b0 = *reinterpret_cast<const bf16x8*>(rp), b1 = *reinterpret_cast<const bf16x8*>(rp + 64);
#pragma unroll
        for (int pr = 0; pr < 2; ++pr) {
          __builtin_amdgcn_s_setprio(1);
          f32x4 C = mfma16(af[pr][0], b0, f32x4{0.f, 0.f, 0.f, 0.f});
          C = mfma16(af[pr][1], b1, C);
          __builtin_amdgcn_s_setprio(0);
          const float part = wv[pr].x * fmaxf(C[0], 0.f) + wv[pr].y * fmaxf(C[1], 0.f) + wv[pr].z * fmaxf(C[2], 0.f) + wv[pr].w * fmaxf(C[3], 0.f);
          const F2 ps = swap16(part); const float full = ps.lo + ps.hi;
          const unsigned hu = (unsigned)__builtin_bit_cast(unsigned short, (_Float16)full);
          const unsigned hk = (hu & 0x8000u) ? (~hu & 0xFFFFu) : (hu | 0x8000u);
          if ((q4 & 1) == 0) S16[(2 * pr + tlC) * 2048 + (ch * 4 + u) * 16 + c] = (unsigned short)hk;
        }
      }
      if (more) *reinterpret_cast<bf16x8*>(kis + ((ch + 1) & 1) * 9216 + lrow * 144 + lseg * 16) = pre;
      __syncthreads();
    }
  }
  for (int rnd = 0; rnd < 2; ++rnd) {
    const unsigned short* Sh = S16 + (2 * rnd + half) * 2048;
    unsigned* bmrow = bm + (4 * w + 2 * rnd + half) * 64;
    const int nreg = n_adm >> 5;
    if (nreg <= 16) topk_round<16>(Sh, n_adm, half, l32, bmrow);
    else if (nreg <= 32) topk_round<32>(Sh, n_adm, half, l32, bmrow);
    else if (nreg <= 48) topk_round<48>(Sh, n_adm, half, l32, bmrow);
    else topk_round<64>(Sh, n_adm, half, l32, bmrow);
  }
  __syncthreads();

  {
    const int tl = c >> 3, h = c & 7;
    bf16x8 qf[2][2]; int qposc[2], qrow[2], qloc[2];
#pragma unroll
    for (int ct = 0; ct < 2; ++ct) {
      qloc[ct] = 4 * w + 2 * ct + tl; qrow[ct] = m0 + qloc[ct]; qposc[ct] = qpos0 + qloc[ct];
      const bf16_t* qp = (reinterpret_cast<bf16_t*>(p.ws + OFF_QAB)) + (size_t)qrow[ct] * 1024 + 512 + h * 64 + q4 * 8;
      qf[ct][0] = ld8(qp); qf[ct][1] = ld8(qp + 32);
    }
    f32x4 O[2][4]; float mrun[2] = {-1e20f, -1e20f}; f32x4 L[2] = {f32x4{0.f, 0.f, 0.f, 0.f}, f32x4{0.f, 0.f, 0.f, 0.f}};
    bf16x8 ones; for (int e = 0; e < 8; ++e) ones[e] = (short)0x3F80;
#pragma unroll
    for (int ct = 0; ct < 2; ++ct)
#pragma unroll
      for (int dt = 0; dt < 4; ++dt) O[ct][dt] = f32x4{0.f, 0.f, 0.f, 0.f};
    const int nkb = n_adm >> 5;
    constexpr float LOG2E = 1.4426950408889634f;
    const float farbias = rb[15 * 8 + h] * LOG2E;
    auto compkv = [&](auto FAR, int kb, const bf16x8 (&kf)[2][2], const bf16x8 (&vf)[4]) {
      constexpr bool far = decltype(FAR)::value;
      const int s0 = kb * 32;
#pragma unroll
      for (int ct = 0; ct < 2; ++ct) {
        __builtin_amdgcn_s_setprio(1);
        f32x4 z0 = mfma16(kf[0][0], qf[ct][0], f32x4{0.f, 0.f, 0.f, 0.f}); z0 = mfma16(kf[0][1], qf[ct][1], z0);
        f32x4 z1 = mfma16(kf[1][0], qf[ct][0], f32x4{0.f, 0.f, 0.f, 0.f}); z1 = mfma16(kf[1][1], qf[ct][1], z1);
        __builtin_amdgcn_s_setprio(0);
        const unsigned word = bm[qloc[ct] * 64 + kb] >> (4 * q4);
        float zz[8]; float bmx = -1e30f;
#pragma unroll
        for (int e = 0; e < 8; ++e) {
          const int kt = e >> 2, r = e & 3;
          float bias = farbias;
          if (!far) { const int rel = s0 + 16 * kt + 4 * q4 + r - qposc[ct]; const int bk = btab[rel + 2047]; bias = rb[bk * 8 + h] * LOG2E; }
          const float zv = (kt ? z1[r] : z0[r]) * (ATT_SCALE * LOG2E) + bias;
          const unsigned sgn = (unsigned)__builtin_amdgcn_sbfe((int)word, 16 * kt + r, 1);
          zz[e] = __uint_as_float((__float_as_uint(zv) & sgn) | (0xF149F2CAu & ~sgn));
          bmx = fmaxf(bmx, zz[e]);
        }
        if (__ballot(bmx > mrun[ct] + 8.f) != 0ull) {
          { const F2 m16 = swap16(bmx); bmx = fmaxf(m16.lo, m16.hi); const F2 m32 = swap32(bmx); bmx = fmaxf(m32.lo, m32.hi); }
          const bool need = bmx > mrun[ct] + 8.f;
          const float mnew = need ? bmx : mrun[ct];
          const float sc = __builtin_amdgcn_exp2f(mrun[ct] - mnew);
          L[ct] *= sc; mrun[ct] = mnew;
#pragma unroll
          for (int dt = 0; dt < 4; ++dt) O[ct][dt] *= sc;
        }
        const float mref = mrun[ct];
        float pe[8];
#pragma unroll
        for (int e = 0; e < 8; ++e) pe[e] = __builtin_amdgcn_exp2f(zz[e] - mref);
        const bf16x8 pf = pack8(pe);
        __builtin_amdgcn_s_setprio(1);
        L[ct] = mfma16(ones, pf, L[ct]);
#pragma unroll
        for (int dt = 0; dt < 4; ++dt) O[ct][dt] = mfma16(vf[dt], pf, O[ct][dt]);
        __builtin_amdgcn_s_setprio(0);
      }
    };
    int nfar = (qpos0 - 159) >= 0 ? ((qpos0 - 159) >> 5) + 1 : 0;
    nfar = nfar < nkb ? nfar : nkb;
    char* kd = smem; char* vd = smem + 18432;
    const int srow = tid >> 3, sseg = tid & 7;
    bf16x8 preK = ld8(KBb + (size_t)srow * 64 + sseg * 8);
    bf16x8 preV = ld8(VBTb + (size_t)srow * T + sseg * 8);
    *reinterpret_cast<bf16x8*>(kd + srow * 144 + sseg * 16) = preK;
    *reinterpret_cast<bf16x8*>(vd + srow * 144 + sseg * 16) = preV;
    __syncthreads();
    const int nkb2 = n_adm >> 6;
    for (int kb2 = 0; kb2 < nkb2; ++kb2) {
      const bool more = kb2 + 1 < nkb2;
      if (more) {
        preK = ld8(KBb + (size_t)((kb2 + 1) * 64 + srow) * 64 + sseg * 8);
        preV = ld8(VBTb + (size_t)srow * T + (kb2 + 1) * 64 + sseg * 8);
      }
      const char* kc = kd + (kb2 & 1) * 9216; const char* vc = vd + (kb2 & 1) * 9216;
#pragma unroll
      for (int sub = 0; sub < 2; ++sub) {
        const int kb = 2 * kb2 + sub;
        bf16x8 kf[2][2], vf[4];
#pragma unroll
        for (int kt = 0; kt < 2; ++kt)
#pragma unroll
          for (int kk = 0; kk < 2; ++kk) kf[kt][kk] = *reinterpret_cast<const bf16x8*>(kc + (32 * sub + 16 * kt + c) * 144 + kk * 64 + q4 * 16);
#pragma unroll
        for (int dt = 0; dt < 4; ++dt) {
          const char* vp = vc + (16 * dt + c) * 144 + sub * 64 + q4 * 8;
          const bf16x4 lo = *reinterpret_cast<const bf16x4*>(vp), hi = *reinterpret_cast<const bf16x4*>(vp + 32);
          vf[dt] = __builtin_shufflevector(lo, hi, 0, 1, 2, 3, 4, 5, 6, 7);
        }
        if (kb < nfar) compkv(std::true_type{}, kb, kf, vf); else compkv(std::false_type{}, kb, kf, vf);
      }
      if (more) {
        *reinterpret_cast<bf16x8*>(kd + ((kb2 + 1) & 1) * 9216 + srow * 144 + sseg * 16) = preK;
        *reinterpret_cast<bf16x8*>(vd + ((kb2 + 1) & 1) * 9216 + srow * 144 + sseg * 16) = preV;
      }
      __syncthreads();
    }
#pragma unroll
    for (int ct = 0; ct < 2; ++ct) {
      const float lt = L[ct][0];
      const float inv = 1.f / lt;
#pragma unroll
      for (int dt = 0; dt < 4; ++dt) {
        const size_t off = (size_t)qrow[ct] * 512 + h * 64 + dt * 16 + 4 * q4;
        const size_t offq = (size_t)qrow[ct] * 1024 + 512 + h * 64 + dt * 16 + 4 * q4;
        const bf16x4 g = ld4((reinterpret_cast<bf16_t*>(p.ws + OFF_GB)) + off);
        st4((reinterpret_cast<bf16_t*>(p.ws + OFF_QAB)) + offq, pack4(O[ct][dt][0] * inv * bf2f(g[0]), O[ct][dt][1] * inv * bf2f(g[1]), O[ct][dt][2] * inv * bf2f(g[2]), O[ct][dt][3] * inv * bf2f(g[3])));
      }
    }
  }
  __syncthreads();
}

DI void phase_attn(const Params& p, int layer, char* smem) {
  const int tid = otid();
  for (int i = tid; i < 4096; i += NTHREADS) smem[LDS_BTAB + i] = (char)(reinterpret_cast<unsigned char*>(p.ws + OFF_BTAB))[i];
  if (tid < 256) reinterpret_cast<float*>(smem + LDS_RB)[tid] = p.rel_bias[tid];
  __syncthreads();
  int* slot = reinterpret_cast<int*>(smem + LDS_SLOT);
  const int w = tid >> 6;
  const int total = 16 + 2048 + 32 + 4096;
  if (tid == 0) *slot = atomicAdd(&(reinterpret_cast<int*>(p.ws + OFF_CTR))[layer], 1);
  __syncthreads();
  int item = *slot;
  while (item < total) {
    int nxt = 0;
    if (tid == 0) nxt = atomicAdd(&(reinterpret_cast<int*>(p.ws + OFF_CTR))[layer], 1);
    if (item < 16) dsa_item<1>(p, item >> 1, item & 1, smem);
    else if (item < 2064) { const int i = item - 16; dsa_item<0>(p, i >> 6, 63 - (i & 63), smem); }
    else if (item < 2096) { const int i = item - 2064; sb_item<1>(p, i >> 2, 2 * (i & 3) + (w >> 2), (w & 3) * 16); }
    else { const int i = item - 2096; const int tile = 15 - (i >> 8), bh = i & 255; sb_item<0>(p, bh >> 3, bh & 7, tile * 128 + w * 16); }
    __syncthreads();
    if (tid == 0) *slot = nxt;
    __syncthreads();
    item = *slot;
  }
}

DI void phase_ln(const Params& p, int layer, char* smem) {
  const int tid = otid(), lane = tid & 63;
  {
    const int stride = gridDim.x * NWAVES;
    const float* g = p.ln_g + layer * 1024; const float* b = p.ln_b + layer * 1024;
    for (int row = blockIdx.x * NWAVES + (tid >> 6); row < MT; row += 2 * stride) {
      const int row2 = row + stride;
      if (row2 < MT) ln_rows2(p.out + (size_t)row * 1024, p.out + (size_t)row2 * 1024, g, b, p.out + (size_t)row * 1024, (reinterpret_cast<bf16_t*>(p.ws + OFF_XB)) + (size_t)row * 1024, p.out + (size_t)row2 * 1024, (reinterpret_cast<bf16_t*>(p.ws + OFF_XB)) + (size_t)row2 * 1024, lane);
      else ln_row_wave(p.out + (size_t)row * 1024, g, b, p.out + (size_t)row * 1024, (reinterpret_cast<bf16_t*>(p.ws + OFF_XB)) + (size_t)row * 1024, lane);
    }
  }
  if (layer + 1 < DEPTH) convert_layer(p, layer + 1, smem);
}

__global__ void __launch_bounds__(512, 2) mega_kernel(Params p) {
  extern __shared__ __attribute__((aligned(16))) char smem[];
  cg::grid_group grid = cg::this_grid();
  phase_prologue(p, smem);
  grid.sync();
  unsigned* bar = reinterpret_cast<unsigned*>((reinterpret_cast<int*>(p.ws + OFF_CTR)) + 8);
  unsigned nb = 0; const unsigned G = gridDim.x;
#pragma nounroll
  for (int l = 0; l < DEPTH; ++l) {
    phase_proj(p, l, smem);
    gbar(bar, ++nb * G);
    phase_attn(p, l, smem);
    gbar(bar, ++nb * G);
    phase_merge(p, smem);
    gbar(bar, ++nb * G);
    phase_out(p, smem);
    gbar(bar, ++nb * G);
    phase_ln(p, l, smem);
    if (l + 1 < DEPTH) gbar(bar, ++nb * G);
  }
}

#if !USE_COOP
__global__ void __launch_bounds__(512, 2) phase_kernel(Params p, int phase, int layer) {
  extern __shared__ __attribute__((aligned(16))) char smem[];
  if (phase == 0) phase_prologue(p, smem);
  else if (phase == 1) phase_proj(p, layer, smem);
  else if (phase == 2) phase_attn(p, layer, smem);
  else if (phase == 3) phase_merge(p, smem);
  else if (phase == 4) { }
  else if (phase == 5) phase_out(p, smem);
  else phase_ln(p, layer, smem);
}

#endif

extern "C" void kernel_launch(void* const* d_in, const int* in_sizes, int n_in, void* d_out, int out_size, void* d_ws, size_t ws_size, hipStream_t stream) {
  static int grid_blocks = 0;
  if (grid_blocks == 0) {
    if (n_in != 17 || out_size != OUT_TOTAL) { fprintf(stderr, "kernel_launch: unexpected shapes n_in=%d out=%d\n", n_in, out_size); grid_blocks = -1; return; }
    int dev = 0, cus = 0, per_cu = 0;
    hipGetDevice(&dev);
    hipDeviceGetAttribute(&cus, hipDeviceAttributeMultiprocessorCount, dev);
    hipFuncSetAttribute((const void*)mega_kernel, hipFuncAttributeMaxDynamicSharedMemorySize, LDS_BYTES);
#if !USE_COOP
    hipFuncSetAttribute((const void*)phase_kernel, hipFuncAttributeMaxDynamicSharedMemorySize, LDS_BYTES);
#endif
    hipOccupancyMaxActiveBlocksPerMultiprocessor(&per_cu, (const void*)mega_kernel, NTHREADS, LDS_BYTES);
    if (per_cu < 1) per_cu = 1;
    if (per_cu > 1) per_cu = 1;
    grid_blocks = cus * per_cu;
    fprintf(stderr, "kernel_launch: cus=%d per_cu=%d grid=%d ws=%zu\n", cus, per_cu, grid_blocks, ws_size);
  }
  if (grid_blocks < 0) return;
  Params p{};
  p.x_prompt = (const float*)d_in[0]; p.x_sample = (const float*)d_in[1];
  p.c_sb_k = (const float*)d_in[2]; p.c_sb_v = (const float*)d_in[3]; p.c_dsa_k = (const float*)d_in[4]; p.c_dsa_v = (const float*)d_in[5]; p.c_idx_k = (const float*)d_in[6];
  p.ln_in_g = (const float*)d_in[7]; p.ln_in_b = (const float*)d_in[8]; p.w_in = (const float*)d_in[9]; p.b_in = (const float*)d_in[10];
  p.w_pa = (const float*)d_in[11]; p.w_pb = (const float*)d_in[12]; p.w_out = (const float*)d_in[13]; p.ln_g = (const float*)d_in[14]; p.ln_b = (const float*)d_in[15];
  p.rel_bias = (const float*)d_in[16];
  p.out = (float*)d_out;
  p.ws = (char*)d_ws;
  if (OFF_END > ws_size) { fprintf(stderr, "kernel_launch: workspace too small: need %zu have %zu\n", (size_t)OFF_END, ws_size); return; }
#if USE_COOP
  void* args[] = {&p};
  hipError_t e = hipLaunchCooperativeKernel((const void*)mega_kernel, dim3(grid_blocks), dim3(NTHREADS), args, LDS_BYTES, stream);
  if (e != hipSuccess) fprintf(stderr, "cooperative launch failed: %s (grid %d)\n", hipGetErrorString(e), grid_blocks);
#else
  hipLaunchKernelGGL(phase_kernel, dim3(grid_blocks), dim3(NTHREADS), LDS_BYTES, stream, p, 0, 0);
  for (int l = 0; l < DEPTH; ++l)
    for (int ph = 1; ph <= 6; ++ph) hipLaunchKernelGGL(phase_kernel, dim3(grid_blocks), dim3(NTHREADS), LDS_BYTES, stream, p, ph, l);
#endif
}
```

```cpp
#include <hip/hip_runtime.h>
#include <hip/hip_cooperative_groups.h>
#include <cstdio>
#include <type_traits>
namespace cg = cooperative_groups;

#ifndef USE_COOP
#define USE_COOP 1
#endif

#define DI __device__ __forceinline__
typedef unsigned short bf16_t;
using bf16x8 = __attribute__((ext_vector_type(8))) short;
using bf16x4 = __attribute__((ext_vector_type(4))) short;
using f32x4  = __attribute__((ext_vector_type(4))) float;

constexpr int D_MODEL = 1024, BATCH = 32, SEQ = 2048, DEPTH = 4, DEC_BATCH = 8, DEC_SEQ = 64, PAST = 1024, LS = 1088;
constexpr int MP = BATCH * SEQ;
constexpr int MS = DEC_BATCH * DEC_SEQ;
constexpr int MT = MP + MS;
constexpr int D_IN = 5832, D_INP = 5888;
constexpr float LN_EPS = 1e-5f;
constexpr float ALPHA = 1.681792830507429f;
constexpr float SB_SCALE = 0.125f, ATT_SCALE = 0.125f;
constexpr int NTHREADS = 512, NWAVES = 8;
constexpr int LDS_S = 0, LDS_BM = 131072, LDS_BTAB = 139264, LDS_RB = 143360, LDS_SLOT = 144384, LDS_KI = 144448, LDS_BYTES = 162880;

constexpr size_t O_Y = 0, O_KAP = 67633152, O_VAP = 201850880, O_KBP = 336068608, O_VBP = 352845824, O_KIP = 369623040,
                 O_KAS = 386400256, O_VAS = 387448832, O_KBS = 388497408, O_VBS = 388628480, O_KIS = 388759552;
constexpr int OUT_TOTAL = 388890624;

constexpr size_t al256(size_t x) { return (x + 255) & ~(size_t)255; }
constexpr size_t OFF_XB = 0;
constexpr size_t OFF_QAB = OFF_XB + al256((size_t)MT * 1024 * 2);
constexpr size_t OFF_GA = OFF_QAB + al256((size_t)MT * 1024 * 2);
constexpr size_t OFF_GB = OFF_GA + al256((size_t)MT * 512 * 2);
constexpr size_t OFF_QI = OFF_GB + al256((size_t)MT * 512 * 2);
constexpr size_t OFF_KAP = OFF_QI + al256((size_t)MT * 512 * 2);
constexpr size_t OFF_VATP = OFF_KAP + al256((size_t)MP * 512 * 2);
constexpr size_t OFF_KAS = OFF_VATP + al256((size_t)MP * 512 * 2);
constexpr size_t OFF_VATS = OFF_KAS + al256((size_t)8 * LS * 512 * 2);
constexpr size_t OFF_KBP = OFF_VATS + al256((size_t)8 * LS * 512 * 2);
constexpr size_t OFF_VBTP = OFF_KBP + al256((size_t)MP * 64 * 2);
constexpr size_t OFF_KIP = OFF_VBTP + al256((size_t)MP * 64 * 2);
constexpr size_t OFF_KBS = OFF_KIP + al256((size_t)MP * 64 * 2);
constexpr size_t OFF_VBTS = OFF_KBS + al256((size_t)8 * LS * 64 * 2);
constexpr size_t OFF_KIS = OFF_VBTS + al256((size_t)8 * LS * 64 * 2);
constexpr size_t OFF_WI = OFF_KIS + al256((size_t)8 * LS * 64 * 2);
constexpr size_t OFF_RA = OFF_WI + al256((size_t)MT * 8 * 4);
constexpr size_t OFF_RB = OFF_RA + al256((size_t)MT * 1024 * 2);
constexpr size_t OFF_WINT = OFF_RB + al256((size_t)MT * 1024 * 2);
constexpr size_t OFF_WPAT = OFF_WINT + al256((size_t)D_INP * 1024 * 2);
constexpr size_t OFF_WPBT = OFF_WPAT + al256((size_t)1024 * 512 * 2);
constexpr size_t OFF_WOUTT = OFF_WPBT + al256((size_t)1024 * 512 * 2);
constexpr size_t OFF_BTAB = OFF_WOUTT + al256((size_t)1024 * 1024 * 2);
constexpr size_t OFF_CTR = OFF_BTAB + 4096;
constexpr size_t OFF_END = OFF_CTR + 256;

struct Params {
  const float* x_prompt; const float* x_sample;
  const float* c_sb_k; const float* c_sb_v; const float* c_dsa_k; const float* c_dsa_v; const float* c_idx_k;
  const float* ln_in_g; const float* ln_in_b; const float* w_in; const float* b_in; const float* w_pa; const float* w_pb;
  const float* w_out; const float* ln_g; const float* ln_b; const float* rel_bias;
  float* out; char* ws;
};

DI unsigned short f2bf(float x) { unsigned u = __float_as_uint(x); u += 0x7fffu + ((u >> 16) & 1u); return (unsigned short)(u >> 16); }
DI float bf2f(short h) { return __uint_as_float(((unsigned)(unsigned short)h) << 16); }
typedef __bf16 hbf16x2 __attribute__((ext_vector_type(2)));
typedef float f32x2v __attribute__((ext_vector_type(2)));
typedef unsigned u32x2v __attribute__((ext_vector_type(2)));
typedef unsigned u32x4v __attribute__((ext_vector_type(4)));
DI unsigned pk2(float lo, float hi) { f32x2v v; v.x = lo; v.y = hi; return __builtin_bit_cast(unsigned, __builtin_convertvector(v, hbf16x2)); }
DI bf16x4 pack4(float a, float b, float c, float d) { u32x2v u; u.x = pk2(a, b); u.y = pk2(c, d); return __builtin_bit_cast(bf16x4, u); }
DI bf16x8 pack8(const float (&e)[8]) { u32x4v u; u.x = pk2(e[0], e[1]); u.y = pk2(e[2], e[3]); u.z = pk2(e[4], e[5]); u.w = pk2(e[6], e[7]); return __builtin_bit_cast(bf16x8, u); }
DI bf16x8 ld8(const bf16_t* p) { return *reinterpret_cast<const bf16x8*>(p); }
DI bf16x4 ld4(const bf16_t* p) { return *reinterpret_cast<const bf16x4*>(p); }
DI void st4(bf16_t* p, bf16x4 v) { *reinterpret_cast<bf16x4*>(p) = v; }
DI f32x4 mfma16(bf16x8 a, bf16x8 b, f32x4 c) { return __builtin_amdgcn_mfma_f32_16x16x32_bf16(a, b, c, 0, 0, 0); }
DI int otid() { int t = threadIdx.x; asm volatile("" : "+v"(t)); return t; }
DI int osg(int v) { asm volatile("" : "+s"(v)); return v; }
DI float sigmoidf_(float x) { return __builtin_amdgcn_rcpf(1.f + __expf(-x)); }
struct F2 { float lo, hi; };
DI F2 swap16(float x) { const unsigned u = __float_as_uint(x); auto r = __builtin_amdgcn_permlane16_swap(u, u, false, false); return F2{__uint_as_float(r[0]), __uint_as_float(r[1])}; }
DI F2 swap32(float x) { const unsigned u = __float_as_uint(x); auto r = __builtin_amdgcn_permlane32_swap(u, u, false, false); return F2{__uint_as_float(r[0]), __uint_as_float(r[1])}; }
DI float row_sum16(float x) {
  x += __uint_as_float(__builtin_amdgcn_update_dpp(0, __float_as_uint(x), 0xB1, 0xF, 0xF, true));
  x += __uint_as_float(__builtin_amdgcn_update_dpp(0, __float_as_uint(x), 0x4E, 0xF, 0xF, true));
  x += __uint_as_float(__builtin_amdgcn_update_dpp(0, __float_as_uint(x), 0x141, 0xF, 0xF, true));
  x += __uint_as_float(__builtin_amdgcn_update_dpp(0, __float_as_uint(x), 0x140, 0xF, 0xF, true));
  return x;
}
DI float wave_sum(float x) { x = row_sum16(x); F2 a = swap16(x); x = a.lo + a.hi; F2 b = swap32(x); return b.lo + b.hi; }
DI int hsum32(int x) {
  x += __builtin_amdgcn_update_dpp(0, x, 0xB1, 0xF, 0xF, true);
  x += __builtin_amdgcn_update_dpp(0, x, 0x4E, 0xF, 0xF, true);
  x += __builtin_amdgcn_update_dpp(0, x, 0x141, 0xF, 0xF, true);
  x += __builtin_amdgcn_update_dpp(0, x, 0x140, 0xF, 0xF, true);
  auto r = __builtin_amdgcn_permlane16_swap((unsigned)x, (unsigned)x, false, false);
  return (int)(r[0] + r[1]);
}
DI void gbar(unsigned* ctr, unsigned target) {
  asm volatile("s_waitcnt vmcnt(0)" ::: "memory");
  __syncthreads();
  if (otid() == 0) {
    __builtin_amdgcn_fence(__ATOMIC_RELEASE, "agent");
    asm volatile("s_waitcnt vmcnt(0)" ::: "memory");
    __hip_atomic_fetch_add(ctr, 1u, __ATOMIC_RELAXED, __HIP_MEMORY_SCOPE_AGENT);
    while (__hip_atomic_load(ctr, __ATOMIC_RELAXED, __HIP_MEMORY_SCOPE_AGENT) < target) __builtin_amdgcn_s_sleep(2);
    __builtin_amdgcn_fence(__ATOMIC_ACQUIRE, "agent");
    asm volatile("s_waitcnt vmcnt(0)" ::: "memory");
  }
  __syncthreads();
}

DI void ln_row_wave(const float* src, const float* g, const float* b, float* d32, bf16_t* db, int lane) {
  float4 v[4]; float s = 0.f;
#pragma unroll
  for (int i = 0; i < 4; ++i) { v[i] = reinterpret_cast<const float4*>(src)[lane + 64 * i]; s += v[i].x + v[i].y + v[i].z + v[i].w; }
  s = wave_sum(s);
  const float mu = s * (1.f / 1024.f);
  float q = 0.f;
#pragma unroll
  for (int i = 0; i < 4; ++i) { float a = v[i].x - mu, bb = v[i].y - mu, c = v[i].z - mu, d = v[i].w - mu; q += a * a + bb * bb + c * c + d * d; }
  q = wave_sum(q);
  const float rstd = rsqrtf(q * (1.f / 1024.f) + LN_EPS);
#pragma unroll
  for (int i = 0; i < 4; ++i) {
    float4 gg = reinterpret_cast<const float4*>(g)[lane + 64 * i], bb = reinterpret_cast<const float4*>(b)[lane + 64 * i];
    float4 o;
    o.x = (v[i].x - mu) * rstd * gg.x + bb.x; o.y = (v[i].y - mu) * rstd * gg.y + bb.y;
    o.z = (v[i].z - mu) * rstd * gg.z + bb.z; o.w = (v[i].w - mu) * rstd * gg.w + bb.w;
    reinterpret_cast<float4*>(d32)[lane + 64 * i] = o;
    st4(db + 4 * (lane + 64 * i), pack4(o.x, o.y, o.z, o.w));
  }
}

DI void ln_rows2(const float* s0, const float* s1, const float* g, const float* b, float* d0, bf16_t* db0, float* d1, bf16_t* db1, int lane) {
  float4 v0[4], v1[4]; float a0 = 0.f, a1 = 0.f;
#pragma unroll
  for (int i = 0; i < 4; ++i) { v0[i] = reinterpret_cast<const float4*>(s0)[lane + 64 * i]; v1[i] = reinterpret_cast<const float4*>(s1)[lane + 64 * i]; }
#pragma unroll
  for (int i = 0; i < 4; ++i) { a0 += v0[i].x + v0[i].y + v0[i].z + v0[i].w; a1 += v1[i].x + v1[i].y + v1[i].z + v1[i].w; }
  a0 = wave_sum(a0); a1 = wave_sum(a1);
  const float mu0 = a0 * (1.f / 1024.f), mu1 = a1 * (1.f / 1024.f);
  float q0 = 0.f, q1 = 0.f;
#pragma unroll
  for (int i = 0; i < 4; ++i) {
    { float a = v0[i].x - mu0, bb = v0[i].y - mu0, c = v0[i].z - mu0, d = v0[i].w - mu0; q0 += a * a + bb * bb + c * c + d * d; }
    { float a = v1[i].x - mu1, bb = v1[i].y - mu1, c = v1[i].z - mu1, d = v1[i].w - mu1; q1 += a * a + bb * bb + c * c + d * d; }
  }
  q0 = wave_sum(q0); q1 = wave_sum(q1);
  const float r0 = rsqrtf(q0 * (1.f / 1024.f) + LN_EPS), r1 = rsqrtf(q1 * (1.f / 1024.f) + LN_EPS);
#pragma unroll
  for (int i = 0; i < 4; ++i) {
    const float4 gg = reinterpret_cast<const float4*>(g)[lane + 64 * i], bb = reinterpret_cast<const float4*>(b)[lane + 64 * i];
    float4 o;
    o.x = (v0[i].x - mu0) * r0 * gg.x + bb.x; o.y = (v0[i].y - mu0) * r0 * gg.y + bb.y; o.z = (v0[i].z - mu0) * r0 * gg.z + bb.z; o.w = (v0[i].w - mu0) * r0 * gg.w + bb.w;
    reinterpret_cast<float4*>(d0)[lane + 64 * i] = o; st4(db0 + 4 * (lane + 64 * i), pack4(o.x, o.y, o.z, o.w));
    o.x = (v1[i].x - mu1) * r1 * gg.x + bb.x; o.y = (v1[i].y - mu1) * r1 * gg.y + bb.y; o.z = (v1[i].z - mu1) * r1 * gg.z + bb.z; o.w = (v1[i].w - mu1) * r1 * gg.w + bb.w;
    reinterpret_cast<float4*>(d1)[lane + 64 * i] = o; st4(db1 + 4 * (lane + 64 * i), pack4(o.x, o.y, o.z, o.w));
  }
}

DI void tconv_tile(const float* src, int ldsrc, int K, bf16_t* dst, int n0, int k0, bool winmap, float* tile, int dk = 0) {
  const int tid = otid();
#pragma unroll
  for (int rr = 0; rr < 8; ++rr) {
    const int kl = rr * 8 + (tid >> 6), nl = tid & 63, np = n0 + nl;
    int n = np; bool ok = true;
    if (winmap) { if (np >= 3840) n = np - 56; else if (np >= 3784) ok = false; }
    tile[kl * 65 + nl] = ok ? src[(size_t)(k0 + kl) * ldsrc + n] : 0.f;
  }
  __syncthreads();
#pragma unroll
  for (int rr = 0; rr < 8; ++rr) {
    const int nl = rr * 8 + (tid >> 6), kl = tid & 63;
    dst[(size_t)(n0 + nl) * K + dk + k0 + kl] = f2bf(tile[kl * 65 + nl]);
  }
  __syncthreads();
}

DI void convert_layer(const Params& p, int l, char* smem) {
  float* tile = reinterpret_cast<float*>(smem);
  const int G = osg(gridDim.x);
  for (int it = blockIdx.x; it < 1984; it += G) {
    if (it < 1472) { int nt = it >> 4, kt = it & 15; tconv_tile(p.w_in + (size_t)l * 1024 * D_IN, D_IN, 1024, (reinterpret_cast<bf16_t*>(p.ws + OFF_WINT)), nt * 64, kt * 64, true, tile); }
    else if (it < 1600) { int i = it - 1472; int nt = i >> 3, kt = i & 7; tconv_tile(p.w_pa + (size_t)l * 512 * 1024, 1024, 1024, (reinterpret_cast<bf16_t*>(p.ws + OFF_WPAT)), nt * 64, kt * 64, false, tile); }
    else if (it < 1728) { int i = it - 1600; int nt = i >> 3, kt = i & 7; tconv_tile(p.w_pb + (size_t)l * 512 * 1024, 1024, 1024, (reinterpret_cast<bf16_t*>(p.ws + OFF_WPAT)), nt * 64, kt * 64, false, tile, 512); }
    else { int i = it - 1728; int nt = i >> 4, kt = i & 15; tconv_tile(p.w_out + (size_t)l * 1024 * 1024, 1024, 1024, (reinterpret_cast<bf16_t*>(p.ws + OFF_WOUTT)), nt * 64, kt * 64, false, tile); }
  }
  const int gtid = blockIdx.x * NTHREADS + otid(), gn = G * NTHREADS;
#pragma unroll 4
  for (int idx = gtid; idx < 8 * 1024 * 512; idx += gn) {
    int b = idx >> 19, rem = idx & ((1 << 19) - 1);
    (reinterpret_cast<bf16_t*>(p.ws + OFF_KAS))[(size_t)b * LS * 512 + rem] = f2bf(p.c_sb_k[(size_t)l * 8 * 1024 * 512 + idx]);
  }
#pragma unroll 4
  for (int idx = gtid; idx < 8 * 512 * 1024; idx += gn) {
    int b = idx >> 19, hd = (idx >> 10) & 511, t = idx & 1023;
    (reinterpret_cast<bf16_t*>(p.ws + OFF_VATS))[((size_t)b * 512 + hd) * LS + t] = f2bf(p.c_sb_v[(((size_t)l * 8 + b) * 1024 + t) * 512 + hd]);
  }
  for (int idx = gtid; idx < 8 * 1024 * 64; idx += gn) {
    int b = idx >> 16, rem = idx & 65535;
    (reinterpret_cast<bf16_t*>(p.ws + OFF_KBS))[(size_t)b * LS * 64 + rem] = f2bf(p.c_dsa_k[(size_t)l * 8 * 65536 + idx]);
    (reinterpret_cast<bf16_t*>(p.ws + OFF_KIS))[(size_t)b * LS * 64 + rem] = f2bf(p.c_idx_k[(size_t)l * 8 * 65536 + idx]);
    int d = (idx >> 10) & 63, t = idx & 1023;
    (reinterpret_cast<bf16_t*>(p.ws + OFF_VBTS))[((size_t)b * 64 + d) * LS + t] = f2bf(p.c_dsa_v[(((size_t)l * 8 + b) * 1024 + t) * 64 + d]);
  }
}

DI void phase_prologue(const Params& p, char* smem) {
  const int tid = otid(), lane = tid & 63;
  if (blockIdx.x == 0 && tid < 16) (reinterpret_cast<int*>(p.ws + OFF_CTR))[tid] = 0;
  for (int i = blockIdx.x * NTHREADS + tid; i < 4096; i += gridDim.x * NTHREADS) {
    int rel = i - 2047; int n = rel < 0 ? -rel : rel;
    float nf = (float)(n > 1 ? n : 1);
    int large = 8 + (int)(logf(nf / 8.f) / 2.7725887f * 8.f);
    large = large < 15 ? large : 15;
    int bk = (rel > 0 ? 16 : 0) + (n < 8 ? n : large);
    (reinterpret_cast<unsigned char*>(p.ws + OFF_BTAB))[i] = (unsigned char)bk;
  }
  {
    const int stride = gridDim.x * NWAVES;
    for (int row = blockIdx.x * NWAVES + (tid >> 6); row < MT; row += 2 * stride) {
      const int row2 = row + stride;
      const float* src = row < MP ? p.x_prompt + (size_t)row * 1024 : p.x_sample + (size_t)(row - MP) * 1024;
      if (row2 < MT) {
        const float* src2 = row2 < MP ? p.x_prompt + (size_t)row2 * 1024 : p.x_sample + (size_t)(row2 - MP) * 1024;
        ln_rows2(src, src2, p.ln_in_g, p.ln_in_b, p.out + (size_t)row * 1024, (reinterpret_cast<bf16_t*>(p.ws + OFF_XB)) + (size_t)row * 1024, p.out + (size_t)row2 * 1024, (reinterpret_cast<bf16_t*>(p.ws + OFF_XB)) + (size_t)row2 * 1024, lane);
      } else ln_row_wave(src, p.ln_in_g, p.ln_in_b, p.out + (size_t)row * 1024, (reinterpret_cast<bf16_t*>(p.ws + OFF_XB)) + (size_t)row * 1024, lane);
    }
  }
  convert_layer(p, 0, smem);
}


namespace pg8 {
#define PG8_LAS __attribute__((address_space(3)))
constexpr int BM = 256, BK = 64, HALF = 128, HTB = HALF * BK * 2, STAGE_BYTES = 8 * HTB, NXCD = 8, WGM = 8;
DI int lds_byte(int r, int c) { const int st = (r >> 4) * 2 + (c >> 5), rr = r & 15, cc = c & 31, ob = rr * 64 + cc * 2; return st * 1024 + (ob ^ (((ob >> 9) & 1) << 5)); }
DI void stage_rc(int b, int& R, int& C) { const int st = b / 1024, sb = b % 1024, swz = sb ^ (((sb >> 9) & 1) << 5); R = (st >> 1) * 16 + swz / 64; C = (st & 1) * 32 + (swz % 64) / 2; }
DI int perm32(int rho) { const int n = rho >> 4, i = rho & 15; return 8 * (i >> 2) + 4 * n + (i & 3); }
struct Unit { int pm, pn; };
struct Gemm { const bf16_t* A; const bf16_t* Bt; int M, N, K; };
struct StaticOrder {
    int nM, nN, nwg, G, c;
    DI void init(int M, int N, int G_, int c_) { nM = M / BM; nN = N / BM; nwg = nM * nN; G = G_; c = c_; }
    DI bool next(int i, Unit& u) const {
        const long L = (long)i * G + c; if (L >= nwg) return false;
        int wgid = (int)L; { const int q = nwg / NXCD, r = nwg % NXCD, xcd = wgid % NXCD, off = wgid / NXCD; wgid = (xcd < r ? xcd * (q + 1) : r * (q + 1) + (xcd - r) * q) + off; }
        const int nig = WGM * nN, gid = wgid / nig, fm = gid * WGM, gsz = (nM - fm) < WGM ? (nM - fm) : WGM;
        u.pm = fm + ((wgid % nig) % gsz); u.pn = (wgid % nig) / gsz; return true;
    }
    DI void a_ready(const Unit&) const {}
    DI void done(const Unit&) const {}
};
template <class Epi, class Sched>
__device__ __forceinline__ void gemm_phase(PG8_LAS unsigned char* lds, const Gemm g, const Sched& S, const Epi& E) {
    const int tid = otid(), wid = __builtin_amdgcn_readfirstlane(tid >> 6), lane = tid & 63, wr = wid >> 2, wc = wid & 3, fr = lane & 15, fq = lane >> 4;
    const int K = g.K, nt = K / BK;
    unsigned voffA[2], voffB[2];
#pragma unroll
    for (int i = 0; i < 2; ++i) { int R, C; stage_rc(tid * 16 + i * 8192, R, C); const int Rb = Epi::PERM ? ((R & ~31) + perm32(R & 31)) : R;
        voffA[i] = (unsigned)(R * K + C) * 2u; voffB[i] = (unsigned)(Rb * K + C) * 2u; }
    const size_t kstep = (size_t)(BK * 2);
    const size_t hstep = (size_t)HALF * K * 2;
    const size_t tstep = 2 * hstep;
    const unsigned ldsw = (unsigned)wid * 1024u;
    const int aoff = lds_byte(wr * 64 + fr, fq * 8), boff = lds_byte(wc * 32 + fr, fq * 8);
#define PG8_SA(b, h) (((b) * 2 + (h)) * HTB)
#define PG8_SB(b, h) ((4 + (b) * 2 + (h)) * HTB)
#define PG8_STAGE(bufoff, gbase, voff) do { _Pragma("unroll") for (int _i = 0; _i < 2; ++_i) \
        __builtin_amdgcn_global_load_lds((const unsigned*)((const char*)(gbase) + (voff)[_i]), (PG8_LAS unsigned*)(lds + (bufoff) + ldsw + _i * 8192), 16, 0, 0); } while (0)
#define PG8_LDA(dst, b, h) do { _Pragma("unroll") for (int m = 0; m < 4; ++m) _Pragma("unroll") for (int k = 0; k < 2; ++k) dst[m][k] = *(const PG8_LAS bf16x8*)(lds + PG8_SA(b, h) + aoff + m * 2048 + k * 1024); } while (0)
#define PG8_LDB(dst, b, h) do { _Pragma("unroll") for (int n = 0; n < 2; ++n) _Pragma("unroll") for (int k = 0; k < 2; ++k) dst[n][k] = *(const PG8_LAS bf16x8*)(lds + PG8_SB(b, h) + boff + n * 2048 + k * 1024); } while (0)
#define PG8_MMA(ai, bj, At, Bt) do { __builtin_amdgcn_s_setprio(1); _Pragma("unroll") for (int m = 0; m < 4; ++m) _Pragma("unroll") for (int n = 0; n < 2; ++n) _Pragma("unroll") for (int k = 0; k < 2; ++k) \
        acc[ai][bj][m][n] = __builtin_amdgcn_mfma_f32_16x16x32_bf16(Bt[n][k], At[m][k], acc[ai][bj][m][n], 0, 0, 0); __builtin_amdgcn_s_setprio(0); } while (0)
#define PG8_WAIT_V(n) asm volatile("s_waitcnt vmcnt(" #n ")" ::: "memory")
#define PG8_WAIT_L(n) asm volatile("s_waitcnt lgkmcnt(" #n ")" ::: "memory")
#define PG8_BAR __builtin_amdgcn_s_barrier()
#define PG8_SCHED __builtin_amdgcn_sched_barrier(0)
    Unit cur, nxt; int ui = 0;
    if (!S.next(0, cur)) return;
    f32x4 acc[2][2][4][2];
#pragma unroll
    for (int a = 0; a < 2; ++a)
#pragma unroll
        for (int b = 0; b < 2; ++b)
#pragma unroll
            for (int m = 0; m < 4; ++m)
#pragma unroll
                for (int n = 0; n < 2; ++n) acc[a][b][m][n] = (f32x4){0.f, 0.f, 0.f, 0.f};
    bf16x8 At[4][2], B0[2][2], B1[2][2];
    const char* cA = (const char*)g.A + (size_t)cur.pm * tstep; const char* cB = (const char*)g.Bt + (size_t)cur.pn * tstep;
    S.a_ready(cur);
    PG8_STAGE(PG8_SB(0, 0), cB, voffB); PG8_STAGE(PG8_SA(0, 0), cA, voffA); PG8_STAGE(PG8_SB(0, 1), cB + hstep, voffB); PG8_STAGE(PG8_SA(0, 1), cA + hstep, voffA);
    if (wr == 1) PG8_BAR;
    PG8_WAIT_V(4); PG8_BAR;
    PG8_STAGE(PG8_SB(1, 0), cB + kstep, voffB); PG8_STAGE(PG8_SA(1, 0), cA + kstep, voffA); PG8_STAGE(PG8_SB(1, 1), cB + hstep + kstep, voffB);
    PG8_WAIT_V(6); PG8_BAR;
    for (;;) {
        const bool has_next = S.next(ui + 1, nxt);
        const char* nA = has_next ? (const char*)g.A + (size_t)nxt.pm * tstep : cA; const char* nB = has_next ? (const char*)g.Bt + (size_t)nxt.pn * tstep : cB;
        for (int t = 0; t < nt; t += 2) {
            const bool last = (t == nt - 2);
            const char* a1 = cA + (size_t)(t + 1) * kstep;
            const char* a2 = last ? nA : cA + (size_t)(t + 2) * kstep; const char* b2 = last ? nB : cB + (size_t)(t + 2) * kstep;
            const char* a3 = a2 + kstep; const char* b3 = b2 + kstep;
            if (last && has_next) S.a_ready(nxt);
            if constexpr (Epi::MIDK) { if (t == nt / 2) E.mid(acc, cur, wr, wc, fr, fq); }
            PG8_LDB(B0, 0, 0); PG8_SCHED; PG8_LDA(At, 0, 0); PG8_STAGE(PG8_SA(1, 1), a1 + hstep, voffA);
            PG8_WAIT_L(8); PG8_BAR; PG8_WAIT_L(0); PG8_MMA(0, 0, At, B0); PG8_BAR; PG8_SCHED;
            PG8_LDB(B1, 0, 1); PG8_STAGE(PG8_SB(0, 0), b2, voffB);
            PG8_BAR; PG8_WAIT_L(0); PG8_MMA(0, 1, At, B1); PG8_BAR;
            PG8_LDA(At, 0, 1); PG8_STAGE(PG8_SA(0, 0), a2, voffA);
            PG8_BAR; PG8_WAIT_L(0); PG8_MMA(1, 0, At, B0); PG8_BAR; PG8_SCHED;
            PG8_STAGE(PG8_SB(0, 1), b2 + hstep, voffB);
            PG8_WAIT_V(6); PG8_BAR; PG8_MMA(1, 1, At, B1); PG8_BAR;
            PG8_LDB(B0, 1, 0); PG8_SCHED; PG8_LDA(At, 1, 0); PG8_STAGE(PG8_SA(0, 1), a2 + hstep, voffA);
            PG8_WAIT_L(8); PG8_BAR; PG8_WAIT_L(0); PG8_MMA(0, 0, At, B0); PG8_BAR; PG8_SCHED;
            PG8_LDB(B1, 1, 1); PG8_STAGE(PG8_SB(1, 0), b3, voffB);
            PG8_BAR; PG8_WAIT_L(0); PG8_MMA(0, 1, At, B1); PG8_BAR;
            PG8_LDA(At, 1, 1); PG8_STAGE(PG8_SA(1, 0), a3, voffA);
            PG8_BAR; PG8_WAIT_L(0); PG8_MMA(1, 0, At, B0); PG8_BAR; PG8_SCHED;
            PG8_STAGE(PG8_SB(1, 1), b3 + hstep, voffB);
            PG8_WAIT_V(6); PG8_BAR; PG8_MMA(1, 1, At, B1); PG8_BAR;
        }
        if constexpr (!Epi::AFTER_DRAIN) { E(acc, cur, wr, wc, fr, fq); S.done(cur); }
        if (!has_next) break;
#pragma unroll
        for (int a = 0; a < 2; ++a)
#pragma unroll
            for (int b = 0; b < 2; ++b)
#pragma unroll
                for (int m = 0; m < 4; ++m)
#pragma unroll
                    for (int n = 0; n < 2; ++n) acc[a][b][m][n] = (f32x4){0.f, 0.f, 0.f, 0.f};
        cur = nxt; cA = nA; cB = nB; ++ui;
    }
    PG8_WAIT_V(0);
    if (wr == 0) PG8_BAR;
    PG8_BAR;
    if constexpr (Epi::AFTER_DRAIN) { E.fused(acc, cur, wr, wc, fr, fq, lds, wid, lane); S.done(cur); }
#undef PG8_SA
#undef PG8_SB
#undef PG8_STAGE
#undef PG8_LDA
#undef PG8_LDB
#undef PG8_MMA
#undef PG8_WAIT_V
#undef PG8_WAIT_L
#undef PG8_BAR
#undef PG8_SCHED
}
}

DI bf16x4 pack4v(const f32x4 v) { return pack4(v[0], v[1], v[2], v[3]); }

struct EpiProj {
  static constexpr bool PERM = true, AFTER_DRAIN = false, MIDK = false;
  const Params& p; int layer; const __attribute__((address_space(3))) float* biasl;
  template <int GRP>
  DI void run(const f32x4 (&acc)[2][2][4][2], const pg8::Unit& u, int wr, int wc, int fr, int fq) const {
    constexpr int T = GRP ? LS : SEQ;
    char* ws = p.ws;
#pragma unroll
    for (int bj = 0; bj < 2; ++bj) {
      const int nt = 2 * u.pn + bj;
      const __attribute__((address_space(3))) f32x4* bp = reinterpret_cast<const __attribute__((address_space(3))) f32x4*>(biasl + nt * 128 + 32 * wc + 8 * fq);
      const bool simple = (nt < 4) || (nt >= 12 && nt < 20) || (nt >= 21 && nt < 29) || (nt >= 30);
      if (simple) {
        size_t off; int ld, c0, act;
        if (nt < 4) { off = OFF_QAB; ld = 1024; c0 = nt * 128; act = 0; }
        else if (nt < 16) { off = OFF_GA; ld = 512; c0 = (nt - 12) * 128; act = 1; }
        else if (nt < 20) { off = OFF_QAB; ld = 1024; c0 = 512 + (nt - 16) * 128; act = 0; }
        else if (nt < 25) { off = OFF_GB; ld = 512; c0 = (nt - 21) * 128; act = 1; }
        else if (nt < 29) { off = OFF_QI; ld = 512; c0 = (nt - 25) * 128; act = 0; }
        else if (nt < 38) { off = OFF_RA; ld = 1024; c0 = (nt - 30) * 128; act = 2; }
        else { off = OFF_RB; ld = 1024; c0 = (nt - 38) * 128; act = 2; }
        bf16_t* dst = reinterpret_cast<bf16_t*>(ws + off) + c0 + 32 * wc + 8 * fq;
#pragma unroll
        for (int ai = 0; ai < 2; ++ai)
#pragma unroll
          for (int m = 0; m < 4; ++m) {
            int row = u.pm * 256 + 128 * ai + 64 * wr + 16 * m + fr;
            asm volatile("" : "+v"(row));
            if (act == 2) {
              u32x2v g8;
#pragma unroll
              for (int n = 0; n < 2; ++n) {
                const f32x4 v = acc[ai][bj][m][n] + bp[n];
                unsigned q = 0u;
#pragma unroll
                for (int j = 0; j < 4; ++j) q |= ((unsigned)(sigmoidf_(v[j]) * 255.f + 0.5f)) << (8 * j);
                if (n == 0) g8.x = q; else g8.y = q;
              }
              *reinterpret_cast<u32x2v*>(reinterpret_cast<unsigned char*>(ws + off) + (size_t)row * 1024 + c0 + 32 * wc + 8 * fq) = g8;
              continue;
            }
            u32x4v pk;
#pragma unroll
            for (int n = 0; n < 2; ++n) {
              f32x4 v = acc[ai][bj][m][n] + bp[n];
              if (act != 0) {
#pragma unroll
                for (int j = 0; j < 4; ++j) { const float sg = sigmoidf_(v[j]); v[j] = (act == 1) ? v[j] * sg : sg; }
              }
              if (n == 0) { pk.x = pk2(v[0], v[1]); pk.y = pk2(v[2], v[3]); } else { pk.z = pk2(v[0], v[1]); pk.w = pk2(v[2], v[3]); }
            }
            *reinterpret_cast<u32x4v*>(dst + (size_t)row * ld) = pk;
          }
      } else {
#pragma unroll
        for (int ai = 0; ai < 2; ++ai)
#pragma unroll
          for (int m = 0; m < 4; ++m) {
            int row = u.pm * 256 + 128 * ai + 64 * wr + 16 * m + fr;
            asm volatile("" : "+v"(row));
            int bb, tt;
            if (!GRP) { bb = row >> 11; tt = row & 2047; } else { const int ms = row - MP; bb = ms >> 6; tt = PAST + (ms & 63); }
            const size_t orow = GRP ? (size_t)layer * MS + (row - MP) : (size_t)layer * MP + row;
#pragma unroll
            for (int n = 0; n < 2; ++n) {
              int ct = 32 * wc + 8 * fq + 4 * n;
              asm volatile("" : "+v"(ct));
              const f32x4 v = acc[ai][bj][m][n] + bp[n];
              if (nt < 8) {
                const int c = (nt - 4) * 128 + ct;
                *reinterpret_cast<f32x4*>(p.out + (GRP ? O_KAS : O_KAP) + orow * 512 + c) = v;
                bf16_t* kd = GRP ? (reinterpret_cast<bf16_t*>(p.ws + OFF_KAS)) + ((size_t)bb * LS + tt) * 512 + c : (reinterpret_cast<bf16_t*>(p.ws + OFF_KAP)) + (size_t)row * 512 + c;
                st4(kd, pack4v(v));
              } else if (nt < 12) {
                const int c = (nt - 8) * 128 + ct;
                *reinterpret_cast<f32x4*>(p.out + (GRP ? O_VAS : O_VAP) + orow * 512 + c) = v;
                bf16_t* vd = (GRP ? (reinterpret_cast<bf16_t*>(p.ws + OFF_VATS)) : (reinterpret_cast<bf16_t*>(p.ws + OFF_VATP))) + ((size_t)bb * 512 + c) * T + tt;
                vd[0] = f2bf(v[0]); vd[T] = f2bf(v[1]); vd[2 * T] = f2bf(v[2]); vd[3 * T] = f2bf(v[3]);
              } else if (nt == 20) {
                if (wc < 2) {
                  *reinterpret_cast<f32x4*>(p.out + (GRP ? O_KBS : O_KBP) + orow * 64 + ct) = v;
                  st4((GRP ? (reinterpret_cast<bf16_t*>(p.ws + OFF_KBS)) : (reinterpret_cast<bf16_t*>(p.ws + OFF_KBP))) + ((size_t)bb * T + tt) * 64 + ct, pack4v(v));
                } else {
                  const int c = ct - 64;
                  *reinterpret_cast<f32x4*>(p.out + (GRP ? O_VBS : O_VBP) + orow * 64 + c) = v;
                  bf16_t* vd = (GRP ? (reinterpret_cast<bf16_t*>(p.ws + OFF_VBTS)) : (reinterpret_cast<bf16_t*>(p.ws + OFF_VBTP))) + ((size_t)bb * 64 + c) * T + tt;
                  vd[0] = f2bf(v[0]); vd[T] = f2bf(v[1]); vd[2 * T] = f2bf(v[2]); vd[3 * T] = f2bf(v[3]);
                }
              } else {
                if (wc < 2) {
                  *reinterpret_cast<f32x4*>(p.out + (GRP ? O_KIS : O_KIP) + orow * 64 + ct) = v;
                  st4((GRP ? (reinterpret_cast<bf16_t*>(p.ws + OFF_KIS)) : (reinterpret_cast<bf16_t*>(p.ws + OFF_KIP))) + ((size_t)bb * T + tt) * 64 + ct, pack4v(v));
                } else if (ct < 72) {
                  *reinterpret_cast<f32x4*>((reinterpret_cast<float*>(p.ws + OFF_WI)) + (size_t)row * 8 + (ct - 64)) = v;
                }
              }
            }
          }
      }
    }
  }
  DI void operator()(const f32x4 (&acc)[2][2][4][2], const pg8::Unit& u, int wr, int wc, int fr, int fq) const {
    if (u.pm < MP / 256) run<0>(acc, u, wr, wc, fr, fq); else run<1>(acc, u, wr, wc, fr, fq);
  }
};

template <int MODE>
struct EpiTail {
  static constexpr bool PERM = false, AFTER_DRAIN = false, MIDK = (MODE == 0);
  const Params& p;
  DI void mid(f32x4 (&acc)[2][2][4][2], const pg8::Unit& u, int wr, int wc, int fr, int fq) const {
#pragma unroll
    for (int ai = 0; ai < 2; ++ai)
#pragma unroll
      for (int m = 0; m < 4; ++m) {
        int row = u.pm * 256 + 128 * ai + 64 * wr + 16 * m + fr;
        asm volatile("" : "+v"(row));
#pragma unroll
        for (int bj = 0; bj < 2; ++bj)
#pragma unroll
          for (int n = 0; n < 2; ++n) {
            const size_t idx = (size_t)row * 1024 + u.pn * 256 + 128 * bj + 32 * wc + 16 * n + 4 * fq;
            const unsigned ga = *reinterpret_cast<const unsigned*>(reinterpret_cast<const unsigned char*>(p.ws + OFF_RA) + idx);
            const unsigned gb = *reinterpret_cast<const unsigned*>(reinterpret_cast<const unsigned char*>(p.ws + OFF_RB) + idx);
#pragma unroll
            for (int j = 0; j < 4; ++j) {
              const unsigned a8 = (ga >> (8 * j)) & 255u, b8 = (gb >> (8 * j)) & 255u;
              acc[ai][bj][m][n][j] *= (float)a8 * __builtin_amdgcn_rcpf((float)(b8 > 1u ? b8 : 1u));
            }
          }
        asm volatile("" ::: "memory");
      }
  }
  DI void operator()(const f32x4 (&acc)[2][2][4][2], const pg8::Unit& u, int wr, int wc, int fr, int fq) const {
    bf16_t* MERGED = (reinterpret_cast<bf16_t*>(p.ws + OFF_GA));
#pragma unroll
    for (int ai = 0; ai < 2; ++ai)
#pragma unroll
      for (int m = 0; m < 4; ++m) {
        const int row = u.pm * 256 + 128 * ai + 64 * wr + 16 * m + fr;
#pragma unroll
        for (int bj = 0; bj < 2; ++bj)
#pragma unroll
          for (int n = 0; n < 2; ++n) {
            const size_t idx = (size_t)row * 1024 + u.pn * 256 + 128 * bj + 32 * wc + 16 * n + 4 * fq;
            const f32x4 a = acc[ai][bj][m][n];
            if (MODE == 0) {
              const unsigned g = *reinterpret_cast<const unsigned*>(reinterpret_cast<const unsigned char*>(p.ws + OFF_RB) + idx);
              const float k = 1.f / 255.f;
              st4(MERGED + idx, pack4((float)(g & 255u) * k * a[0], (float)((g >> 8) & 255u) * k * a[1], (float)((g >> 16) & 255u) * k * a[2], (float)(g >> 24) * k * a[3]));
            } else {
              f32x4 x = *reinterpret_cast<const f32x4*>(p.out + idx);
              x = x * ALPHA + a;
              *reinterpret_cast<f32x4*>(p.out + idx) = x;
            }
          }
      }
  }
};

DI void phase_proj(const Params& p, int layer, char* smem) {
  {
    const float* bin = p.b_in + (size_t)layer * D_IN;
    float* bl = reinterpret_cast<float*>(smem + 131072);
    for (int i = otid(); i < D_INP; i += NTHREADS) bl[i] = (i < 3784) ? bin[i] : (i < 3840 ? 0.f : bin[i - 56]);
    __syncthreads();
  }
  pg8::Gemm g{(reinterpret_cast<bf16_t*>(p.ws + OFF_XB)), (reinterpret_cast<bf16_t*>(p.ws + OFF_WINT)), MT, D_INP, 1024};
  pg8::StaticOrder S; S.init(MT, D_INP, osg(gridDim.x), osg(blockIdx.x));
  EpiProj E{p, layer, (const __attribute__((address_space(3))) float*)(smem + 131072)};
  pg8::gemm_phase<EpiProj, pg8::StaticOrder>((PG8_LAS unsigned char*)smem, g, S, E);
}
DI void phase_merge(const Params& p, char* smem) {
  pg8::Gemm g{(reinterpret_cast<bf16_t*>(p.ws + OFF_QAB)), (reinterpret_cast<bf16_t*>(p.ws + OFF_WPAT)), MT, 1024, 1024};
  pg8::StaticOrder S; S.init(MT, 1024, osg(gridDim.x), osg(blockIdx.x));
  EpiTail<0> E{p};
  pg8::gemm_phase<EpiTail<0>, pg8::StaticOrder>((PG8_LAS unsigned char*)smem, g, S, E);
}
DI void phase_out(const Params& p, char* smem) {
  pg8::Gemm g{(reinterpret_cast<bf16_t*>(p.ws + OFF_GA)), (reinterpret_cast<bf16_t*>(p.ws + OFF_WOUTT)), MT, 1024, 1024};
  pg8::StaticOrder S; S.init(MT, 1024, osg(gridDim.x), osg(blockIdx.x));
  EpiTail<2> E{p};
  pg8::gemm_phase<EpiTail<2>, pg8::StaticOrder>((PG8_LAS unsigned char*)smem, g, S, E);
}

template <int grp>
DI void sb_item(const Params& p, int b, int h, int t0) {
  const int tid = otid(), w = tid >> 6, lane = tid & 63, c = lane & 15, q4 = lane >> 4;
  const int T = grp ? LS : SEQ;
  const int qpos0 = grp ? PAST + t0 : t0;
  const int m0 = grp ? MP + b * DEC_SEQ + t0 : b * SEQ + t0;
  const bf16_t* Kb = (grp ? (reinterpret_cast<bf16_t*>(p.ws + OFF_KAS)) : (reinterpret_cast<bf16_t*>(p.ws + OFF_KAP))) + (size_t)b * T * 512 + h * 64;
  const bf16_t* VTb = (grp ? (reinterpret_cast<bf16_t*>(p.ws + OFF_VATS)) : (reinterpret_cast<bf16_t*>(p.ws + OFF_VATP))) + (size_t)(b * 8 + h) * 64 * T;
  const bf16_t* qp = (reinterpret_cast<bf16_t*>(p.ws + OFF_QAB)) + (size_t)(m0 + c) * 1024 + h * 64 + q4 * 8;
  const bf16x8 qf0 = ld8(qp), qf1 = ld8(qp + 32);
  const int qpos = qpos0 + c;
  float R = 0.f;
  f32x4 O[4];
#pragma unroll
  for (int dt = 0; dt < 4; ++dt) O[dt] = f32x4{0.f, 0.f, 0.f, 0.f};
  bf16x8 kfA[2][2], vfA[4], kfB[2][2], vfB[4];
  auto loadkv = [&](int kb, bf16x8 (&kf)[2][2], bf16x8 (&vf)[4]) {
    const int s0 = kb * 32;
#pragma unroll
    for (int kt = 0; kt < 2; ++kt) { const bf16_t* kp = Kb + (size_t)(s0 + 16 * kt + c) * 512 + q4 * 8; kf[kt][0] = ld8(kp); kf[kt][1] = ld8(kp + 32); }
#pragma unroll
    for (int dt = 0; dt < 4; ++dt) {
      const bf16_t* vp = VTb + (size_t)(16 * dt + c) * T + s0 + 4 * q4;
      bf16x4 lo = ld4(vp), hi = ld4(vp + 16);
      vf[dt] = __builtin_shufflevector(lo, hi, 0, 1, 2, 3, 4, 5, 6, 7);
    }
  };
  auto comp = [&](int kb, const bf16x8 (&kf)[2][2], const bf16x8 (&vf)[4]) -> bool {
    const int s0 = kb * 32;
    f32x4 z[2];
#pragma unroll
    for (int kt = 0; kt < 2; ++kt) {
      z[kt] = mfma16(kf[kt][0], qf0, f32x4{0.f, 0.f, 0.f, 0.f});
      z[kt] = mfma16(kf[kt][1], qf1, z[kt]);
    }
    float lk[2][4], ls[2][4]; bool bf[2][4];
#pragma unroll
    for (int kt = 0; kt < 2; ++kt)
#pragma unroll
      for (int r = 0; r < 4; ++r) {
        const int key = s0 + 16 * kt + 4 * q4 + r;
        const bool before = key < qpos;
        const float zz = z[kt][r] * SB_SCALE;
        const float sp = fmaxf(zz, 0.f) + __logf(1.f + __expf(-fabsf(zz)));
        bf[kt][r] = before; lk[kt][r] = before ? -sp : 0.f; ls[kt][r] = zz - sp;
      }
    const float T1 = (lk[1][0] + lk[1][1]) + (lk[1][2] + lk[1][3]);
    const float T0 = (lk[0][0] + lk[0][1]) + (lk[0][2] + lk[0][3]);
    const F2 x1 = swap16(T1), x0 = swap16(T0);
    const float p1 = x1.lo + x1.hi, p0 = x0.lo + x0.hi;
    const F2 y1 = swap32(p1), y0 = swap32(p0);
    const float H1 = ((q4 & 1) ? 0.f : x1.hi) + ((q4 & 2) ? 0.f : y1.hi);
    const float H0 = ((q4 & 1) ? 0.f : x0.hi) + ((q4 & 2) ? 0.f : y0.hi);
    const float TT1 = y1.lo + y1.hi, TT0 = y0.lo + y0.hi;
    float a[2][4];
    { float ac = R + H1;
#pragma unroll
      for (int r = 3; r >= 0; --r) { a[1][r] = bf[1][r] ? __expf(ls[1][r] + ac) : 0.f; ac += lk[1][r]; } }
    { float ac = R + TT1 + H0;
#pragma unroll
      for (int r = 3; r >= 0; --r) { a[0][r] = bf[0][r] ? __expf(ls[0][r] + ac) : 0.f; ac += lk[0][r]; } }
    R = R + TT1 + TT0;
    const float ae[8] = {a[0][0], a[0][1], a[0][2], a[0][3], a[1][0], a[1][1], a[1][2], a[1][3]};
    const bf16x8 pf = pack8(ae);
#pragma unroll
    for (int dt = 0; dt < 4; ++dt) O[dt] = mfma16(vf[dt], pf, O[dt]);
    return __ballot(R > -50.f) == 0ull;
  };
  {
    int kb = (qpos0 + 14) >> 5;
    loadkv(kb, kfA, vfA);
    while (true) {
      if (kb >= 1) loadkv(kb - 1, kfB, vfB);
      if (comp(kb, kfA, vfA) || kb == 0) break;
      --kb;
      if (kb >= 1) loadkv(kb - 1, kfA, vfA);
      if (comp(kb, kfB, vfB) || kb == 0) break;
      --kb;
    }
  }
#pragma unroll
  for (int dt = 0; dt < 4; ++dt) {
    const size_t off = (size_t)(m0 + c) * 512 + h * 64 + dt * 16 + 4 * q4;
    const size_t offq = (size_t)(m0 + c) * 1024 + h * 64 + dt * 16 + 4 * q4;
    const bf16x4 g = ld4((reinterpret_cast<bf16_t*>(p.ws + OFF_GA)) + off);
    st4((reinterpret_cast<bf16_t*>(p.ws + OFF_QAB)) + offq, pack4(O[dt][0] * bf2f(g[0]), O[dt][1] * bf2f(g[1]), O[dt][2] * bf2f(g[2]), O[dt][3] * bf2f(g[3])));
  }
}

typedef unsigned short us2v __attribute__((ext_vector_type(2)));
template <int NK>
DI void topk_round(const unsigned short* Sh, int n_adm, int half, int l32, unsigned* bmrow) {
  constexpr int NP = NK / 2;
  us2v kp[NP];
#pragma unroll
  for (int i = 0; i < NP; ++i) {
    const int s0 = 64 * i + l32, s1 = s0 + 32;
    const unsigned short k0 = Sh[s0], k1 = Sh[s1];
    kp[i].x = (s0 < n_adm) ? k0 : (unsigned short)0;
    kp[i].y = (s1 < n_adm) ? k1 : (unsigned short)0;
  }
  unsigned tau = 1u; int need = 0; bool done = true;
  if (n_adm > 256) {
    tau = 0u; done = false;
    for (int bit = 15; bit >= 0; --bit) {
      const unsigned cand = tau | (1u << bit);
      const unsigned cv = cand | (cand << 16), one = 0x00010001u;
      unsigned acc = 0u;
#pragma unroll
      for (int i = 0; i < NP; ++i) {
        unsigned d, m;
        asm("v_pk_sub_u16 %0, %1, %2 clamp" : "=v"(d) : "v"(cv), "v"(__builtin_bit_cast(unsigned, kp[i])));
        asm("v_pk_min_u16 %0, %1, %2" : "=v"(m) : "v"(d), "v"(one));
        acc += m;
      }
      int cnt = NK - (int)((acc & 0xFFFFu) + (acc >> 16));
      cnt = hsum32(cnt);
      if (!done && cnt >= 256) tau = cand;
      if (cnt == 256) done = true;
      if (__ballot(!done) == 0ull) break;
    }
  }
  unsigned w0 = 0u, w1 = 0u;
  if (__ballot(!done) == 0ull) {
#pragma unroll
    for (int i = 0; i < NK; ++i) {
      const unsigned key = (i & 1) ? (unsigned)kp[i >> 1].y : (unsigned)kp[i >> 1].x;
      const unsigned long long msel = __ballot(key >= tau);
      const unsigned wsel = half ? (unsigned)(msel >> 32) : (unsigned)msel;
      if (i < 32) { if (l32 == i) w0 = wsel; } else { if (l32 == i - 32) w1 = wsel; }
    }
  } else {
    int cgt = 0;
#pragma unroll
    for (int i = 0; i < NK; ++i) { const unsigned key = (i & 1) ? (unsigned)kp[i >> 1].y : (unsigned)kp[i >> 1].x; cgt += (key > tau) ? 1 : 0; }
    cgt = hsum32(cgt);
    need = 256 - cgt;
    int Rk = 0; const unsigned below = (1u << l32) - 1u;
#pragma unroll
    for (int i = 0; i < NK; ++i) {
      const unsigned key = (i & 1) ? (unsigned)kp[i >> 1].y : (unsigned)kp[i >> 1].x;
      const bool eq = key == tau, gt = key > tau;
      const unsigned long long me = __ballot(eq);
      const unsigned hm = half ? (unsigned)(me >> 32) : (unsigned)me;
      const int rank = Rk + __popc(hm & below);
      const bool sel = done ? (key >= tau) : (gt || (eq && rank < need));
      Rk += __popc(hm);
      const unsigned long long msel = __ballot(sel);
      const unsigned wsel = half ? (unsigned)(msel >> 32) : (unsigned)msel;
      if (i < 32) { if (l32 == i) w0 = wsel; } else { if (l32 == i - 32) w1 = wsel; }
    }
  }
  bmrow[l32] = w0;
  if (NK > 32) bmrow[32 + l32] = w1;
}

template <int grp>
DI void dsa_item(const Params& p, int b, int tile32, char* smem) {
  const int tid = otid(), w = tid >> 6, lane = tid & 63, c = lane & 15, q4 = lane >> 4, half = lane >> 5, l32 = lane & 31;
  unsigned* bm = reinterpret_cast<unsigned*>(smem + LDS_BM);
  const unsigned char* btab = reinterpret_cast<const unsigned char*>(smem + LDS_BTAB);
  const float* rb = reinterpret_cast<const float*>(smem + LDS_RB);
  const int T = grp ? LS : SEQ;
  const int t0 = tile32 * 32;
  const int qpos0 = grp ? PAST + t0 : t0;
  const int m0 = grp ? MP + b * DEC_SEQ + t0 : b * SEQ + t0;
  const int n_adm = grp ? LS : ((qpos0 >> 6) + 1) * 64;
  const bf16_t* KIb = (grp ? (reinterpret_cast<bf16_t*>(p.ws + OFF_KIS)) : (reinterpret_cast<bf16_t*>(p.ws + OFF_KIP))) + (size_t)b * T * 64;
  const bf16_t* KBb = (grp ? (reinterpret_cast<bf16_t*>(p.ws + OFF_KBS)) : (reinterpret_cast<bf16_t*>(p.ws + OFF_KBP))) + (size_t)b * T * 64;
  const bf16_t* VBTb = (grp ? (reinterpret_cast<bf16_t*>(p.ws + OFF_VBTS)) : (reinterpret_cast<bf16_t*>(p.ws + OFF_VBTP))) + (size_t)b * 64 * T;

  unsigned short* S16 = reinterpret_cast<unsigned short*>(smem) + w * 8192;
  {
    const int tlA = c >> 3, hA = c & 7, tlC = q4 >> 1;
    bf16x8 af[2][2]; float4 wv[2];
#pragma unroll
    for (int pr = 0; pr < 2; ++pr) {
      const bf16_t* qip = (reinterpret_cast<bf16_t*>(p.ws + OFF_QI)) + (size_t)(m0 + 4 * w + 2 * pr + tlA) * 512 + hA * 64 + q4 * 8;
      af[pr][0] = ld8(qip); af[pr][1] = ld8(qip + 32);
      wv[pr] = *reinterpret_cast<const float4*>((reinterpret_cast<float*>(p.ws + OFF_WI)) + (size_t)(m0 + 4 * w + 2 * pr + tlC) * 8 + 4 * (q4 & 1));
    }
    const int nch = n_adm >> 6;
    char* kis = smem + LDS_KI;
    const int lrow = tid >> 3, lseg = tid & 7;
    bf16x8 pre = ld8(KIb + (size_t)lrow * 64 + lseg * 8);
    *reinterpret_cast<bf16x8*>(kis + lrow * 144 + lseg * 16) = pre;
    __syncthreads();
    for (int ch = 0; ch < nch; ++ch) {
      const bool more = ch + 1 < nch;
      if (more) pre = ld8(KIb + (size_t)((ch + 1) * 64 + lrow) * 64 + lseg * 8);
      const char* cur = kis + (ch & 1) * 9216;
#pragma unroll
      for (int u = 0; u < 4; ++u) {
        const char* rp = cur + (u * 16 + c) * 144 + q4 * 16;
        const bf16x8 b0 = *reinterpret_cast<const bf16x8*>(rp), b1 = *reinterpret_cast<const bf16x8*>(rp + 64);
#pragma unroll
        for (int pr = 0; pr < 2; ++pr) {
          __builtin_amdgcn_s_setprio(1);
          f32x4 C = mfma16(af[pr][0], b0, f32x4{0.f, 0.f, 0.f, 0.f});
          C = mfma16(af[pr][1], b1, C);
          __builtin_amdgcn_s_setprio(0);
          const float part = wv[pr].x * fmaxf(C[0], 0.f) + wv[pr].y * fmaxf(C[1], 0.f) + wv[pr].z * fmaxf(C[2], 0.f) + wv[pr].w * fmaxf(C[3], 0.f);
          const F2 ps = swap16(part); const float full = ps.lo + ps.hi;
          const unsigned hu = (unsigned)__builtin_bit_cast(unsigned short, (_Float16)full);
          const unsigned hk = hu ^ ((unsigned)__builtin_amdgcn_sbfe((int)hu, 15, 1) | 0x8000u);
          if ((q4 & 1) == 0) S16[(2 * pr + tlC) * 2048 + (ch * 4 + u) * 16 + c] = (unsigned short)hk;
        }
      }
      if (more) *reinterpret_cast<bf16x8*>(kis + ((ch + 1) & 1) * 9216 + lrow * 144 + lseg * 16) = pre;
      __syncthreads();
    }
  }
  for (int rnd = 0; rnd < 2; ++rnd) {
    const unsigned short* Sh = S16 + (2 * rnd + half) * 2048;
    unsigned* bmrow = bm + (4 * w + 2 * rnd + half) * 64;
    const int nreg = n_adm >> 5;
    if (nreg <= 16) topk_round<16>(Sh, n_adm, half, l32, bmrow);
    else if (nreg <= 32) topk_round<32>(Sh, n_adm, half, l32, bmrow);
    else if (nreg <= 48) topk_round<48>(Sh, n_adm, half, l32, bmrow);
    else topk_round<64>(Sh, n_adm, half, l32, bmrow);
  }
  __syncthreads();

  {
    const int tl = c >> 3, h = c & 7;
    bf16x8 qf[2][2]; int qposc[2], qrow[2], qloc[2];
#pragma unroll
    for (int ct = 0; ct < 2; ++ct) {
      qloc[ct] = 4 * w + 2 * ct + tl; qrow[ct] = m0 + qloc[ct]; qposc[ct] = qpos0 + qloc[ct];
      const bf16_t* qp = (reinterpret_cast<bf16_t*>(p.ws + OFF_QAB)) + (size_t)qrow[ct] * 1024 + 512 + h * 64 + q4 * 8;
      qf[ct][0] = ld8(qp); qf[ct][1] = ld8(qp + 32);
    }
    f32x4 O[2][4]; float mrun[2] = {-1e20f, -1e20f}; f32x4 L[2] = {f32x4{0.f, 0.f, 0.f, 0.f}, f32x4{0.f, 0.f, 0.f, 0.f}};
    bf16x8 ones; for (int e = 0; e < 8; ++e) ones[e] = (short)0x3F80;
#pragma unroll
    for (int ct = 0; ct < 2; ++ct)
#pragma unroll
      for (int dt = 0; dt < 4; ++dt) O[ct][dt] = f32x4{0.f, 0.f, 0.f, 0.f};
    const int nkb = n_adm >> 5;
    constexpr float LOG2E = 1.4426950408889634f;
    const float farbias = rb[15 * 8 + h] * LOG2E;
    auto compkv = [&](auto FAR, int kb, const bf16x8 (&kf)[2][2], const bf16x8 (&vf)[4]) {
      constexpr bool far = decltype(FAR)::value;
      const int s0 = kb * 32;
#pragma unroll
      for (int ct = 0; ct < 2; ++ct) {
        __builtin_amdgcn_s_setprio(1);
        f32x4 z0 = mfma16(kf[0][0], qf[ct][0], f32x4{0.f, 0.f, 0.f, 0.f}); z0 = mfma16(kf[0][1], qf[ct][1], z0);
        f32x4 z1 = mfma16(kf[1][0], qf[ct][0], f32x4{0.f, 0.f, 0.f, 0.f}); z1 = mfma16(kf[1][1], qf[ct][1], z1);
        __builtin_amdgcn_s_setprio(0);
        const unsigned word = bm[qloc[ct] * 64 + kb] >> (4 * q4);
        float zz[8]; float bmx = -1e30f;
#pragma unroll
        for (int e = 0; e < 8; ++e) {
          const int kt = e >> 2, r = e & 3;
          float bias = farbias;
          if (!far) { const int rel = s0 + 16 * kt + 4 * q4 + r - qposc[ct]; const int bk = btab[rel + 2047]; bias = rb[bk * 8 + h] * LOG2E; }
          const float zv = (kt ? z1[r] : z0[r]) * (ATT_SCALE * LOG2E) + bias;
          const unsigned sgn = (unsigned)__builtin_amdgcn_sbfe((int)word, 16 * kt + r, 1);
          zz[e] = __uint_as_float((__float_as_uint(zv) & sgn) | (0xF149F2CAu & ~sgn));
          bmx = fmaxf(bmx, zz[e]);
        }
        if (__ballot(bmx > mrun[ct] + 8.f) != 0ull) {
          { const F2 m16 = swap16(bmx); bmx = fmaxf(m16.lo, m16.hi); const F2 m32 = swap32(bmx); bmx = fmaxf(m32.lo, m32.hi); }
          const bool need = bmx > mrun[ct] + 8.f;
          const float mnew = need ? bmx : mrun[ct];
          const float sc = __builtin_amdgcn_exp2f(mrun[ct] - mnew);
          L[ct] *= sc; mrun[ct] = mnew;
#pragma unroll
          for (int dt = 0; dt < 4; ++dt) O[ct][dt] *= sc;
        }
        const float mref = mrun[ct];
        float pe[8];
#pragma unroll
        for (int e = 0; e < 8; ++e) pe[e] = __builtin_amdgcn_exp2f(zz[e] - mref);
        const bf16x8 pf = pack8(pe);
        __builtin_amdgcn_s_setprio(1);
        L[ct] = mfma16(ones, pf, L[ct]);
#pragma unroll
        for (int dt = 0; dt < 4; ++dt) O[ct][dt] = mfma16(vf[dt], pf, O[ct][dt]);
        __builtin_amdgcn_s_setprio(0);
      }
    };
    int nfar = (qpos0 - 159) >= 0 ? ((qpos0 - 159) >> 5) + 1 : 0;
    nfar = nfar < nkb ? nfar : nkb;
    char* kd = smem; char* vd = smem + 18432;
    const int srow = tid >> 3, sseg = tid & 7;
    bf16x8 preK = ld8(KBb + (size_t)srow * 64 + sseg * 8);
    bf16x8 preV = ld8(VBTb + (size_t)srow * T + sseg * 8);
    *reinterpret_cast<bf16x8*>(kd + srow * 144 + sseg * 16) = preK;
    *reinterpret_cast<bf16x8*>(vd + srow * 144 + sseg * 16) = preV;
    __syncthreads();
    const int nkb2 = n_adm >> 6;
    for (int kb2 = 0; kb2 < nkb2; ++kb2) {
      const bool more = kb2 + 1 < nkb2;
      if (more) {
        preK = ld8(KBb + (size_t)((kb2 + 1) * 64 + srow) * 64 + sseg * 8);
        preV = ld8(VBTb + (size_t)srow * T + (kb2 + 1) * 64 + sseg * 8);
      }
      const char* kc = kd + (kb2 & 1) * 9216; const char* vc = vd + (kb2 & 1) * 9216;
#pragma unroll
      for (int sub = 0; sub < 2; ++sub) {
        const int kb = 2 * kb2 + sub;
        bf16x8 kf[2][2], vf[4];
#pragma unroll
        for (int kt = 0; kt < 2; ++kt)
#pragma unroll
          for (int kk = 0; kk < 2; ++kk) kf[kt][kk] = *reinterpret_cast<const bf16x8*>(kc + (32 * sub + 16 * kt + c) * 144 + kk * 64 + q4 * 16);
#pragma unroll
        for (int dt = 0; dt < 4; ++dt) {
          const char* vp = vc + (16 * dt + c) * 144 + sub * 64 + q4 * 8;
          const bf16x4 lo = *reinterpret_cast<const bf16x4*>(vp), hi = *reinterpret_cast<const bf16x4*>(vp + 32);
          vf[dt] = __builtin_shufflevector(lo, hi, 0, 1, 2, 3, 4, 5, 6, 7);
        }
        if (kb < nfar) compkv(std::true_type{}, kb, kf, vf); else compkv(std::false_type{}, kb, kf, vf);
      }
      if (more) {
        *reinterpret_cast<bf16x8*>(kd + ((kb2 + 1) & 1) * 9216 + srow * 144 + sseg * 16) = preK;
        *reinterpret_cast<bf16x8*>(vd + ((kb2 + 1) & 1) * 9216 + srow * 144 + sseg * 16) = preV;
      }
      __syncthreads();
    }
#pragma unroll
    for (int ct = 0; ct < 2; ++ct) {
      const float lt = L[ct][0];
      const float inv = 1.f / lt;
#pragma unroll
      for (int dt = 0; dt < 4; ++dt) {
        const size_t off = (size_t)qrow[ct] * 512 + h * 64 + dt * 16 + 4 * q4;
        const size_t offq = (size_t)qrow[ct] * 1024 + 512 + h * 64 + dt * 16 + 4 * q4;
        const bf16x4 g = ld4((reinterpret_cast<bf16_t*>(p.ws + OFF_GB)) + off);
        st4((reinterpret_cast<bf16_t*>(p.ws + OFF_QAB)) + offq, pack4(O[ct][dt][0] * inv * bf2f(g[0]), O[ct][dt][1] * inv * bf2f(g[1]), O[ct][dt][2] * inv * bf2f(g[2]), O[ct][dt][3] * inv * bf2f(g[3])));
      }
    }
  }
  __syncthreads();
}

DI void phase_attn(const Params& p, int layer, char* smem) {
  const int tid = otid();
  for (int i = tid; i < 4096; i += NTHREADS) smem[LDS_BTAB + i] = (char)(reinterpret_cast<unsigned char*>(p.ws + OFF_BTAB))[i];
  if (tid < 256) reinterpret_cast<float*>(smem + LDS_RB)[tid] = p.rel_bias[tid];
  __syncthreads();
  int* slot = reinterpret_cast<int*>(smem + LDS_SLOT);
  const int w = tid >> 6;
  const int total = 16 + 2048 + 32 + 4096;
  if (tid == 0) *slot = atomicAdd(&(reinterpret_cast<int*>(p.ws + OFF_CTR))[layer], 1);
  __syncthreads();
  int item = *slot;
  while (item < total) {
    int nxt = 0;
    if (tid == 0) nxt = atomicAdd(&(reinterpret_cast<int*>(p.ws + OFF_CTR))[layer], 1);
    if (item < 16) dsa_item<1>(p, item >> 1, item & 1, smem);
    else if (item < 2064) { const int i = item - 16; dsa_item<0>(p, i >> 6, 63 - (i & 63), smem); }
    else if (item < 2096) { const int i = item - 2064; sb_item<1>(p, i >> 2, 2 * (i & 3) + (w >> 2), (w & 3) * 16); }
    else { const int i = item - 2096; const int tile = 15 - (i >> 8), bh = i & 255; sb_item<0>(p, bh >> 3, bh & 7, tile * 128 + w * 16); }
    __syncthreads();
    if (tid == 0) *slot = nxt;
    __syncthreads();
    item = *slot;
  }
}

DI void phase_ln(const Params& p, int layer, char* smem) {
  const int tid = otid(), lane = tid & 63;
  {
    const int stride = gridDim.x * NWAVES;
    const float* g = p.ln_g + layer * 1024; const float* b = p.ln_b + layer * 1024;
    for (int row = blockIdx.x * NWAVES + (tid >> 6); row < MT; row += 2 * stride) {
      const int row2 = row + stride;
      if (row2 < MT) ln_rows2(p.out + (size_t)row * 1024, p.out + (size_t)row2 * 1024, g, b, p.out + (size_t)row * 1024, (reinterpret_cast<bf16_t*>(p.ws + OFF_XB)) + (size_t)row * 1024, p.out + (size_t)row2 * 1024, (reinterpret_cast<bf16_t*>(p.ws + OFF_XB)) + (size_t)row2 * 1024, lane);
      else ln_row_wave(p.out + (size_t)row * 1024, g, b, p.out + (size_t)row * 1024, (reinterpret_cast<bf16_t*>(p.ws + OFF_XB)) + (size_t)row * 1024, lane);
    }
  }
  if (layer + 1 < DEPTH) convert_layer(p, layer + 1, smem);
}

__global__ void __launch_bounds__(512, 2) mega_kernel(Params p) {
  extern __shared__ __attribute__((aligned(16))) char smem[];
  cg::grid_group grid = cg::this_grid();
  phase_prologue(p, smem);
  grid.sync();
  unsigned* bar = reinterpret_cast<unsigned*>((reinterpret_cast<int*>(p.ws + OFF_CTR)) + 8);
  unsigned nb = 0; const unsigned G = gridDim.x;
#pragma nounroll
  for (int l = 0; l < DEPTH; ++l) {
    phase_proj(p, l, smem);
    gbar(bar, ++nb * G);
    phase_attn(p, l, smem);
    gbar(bar, ++nb * G);
    phase_merge(p, smem);
    gbar(bar, ++nb * G);
    phase_out(p, smem);
    gbar(bar, ++nb * G);
    phase_ln(p, l, smem);
    if (l + 1 < DEPTH) gbar(bar, ++nb * G);
  }
}

#if !USE_COOP
__global__ void __launch_bounds__(512, 2) phase_kernel(Params p, int phase, int layer) {
  extern __shared__ __attribute__((aligned(16))) char smem[];
  if (phase == 0) phase_prologue(p, smem);
  else if (phase == 1) phase_proj(p, layer, smem);
  else if (phase == 2) phase_attn(p, layer, smem);
  else if (phase == 3) phase_merge(p, smem);
  else if (phase == 4) { }
  else if (phase == 5) phase_out(p, smem);
  else phase_ln(p, layer, smem);
}

#endif

extern "C" void kernel_launch(void* const* d_in, const int* in_sizes, int n_in, void* d_out, int out_size, void* d_ws, size_t ws_size, hipStream_t stream) {
  static int grid_blocks = 0;
  if (grid_blocks == 0) {
    if (n_in != 17 || out_size != OUT_TOTAL) { fprintf(stderr, "kernel_launch: unexpected shapes n_in=%d out=%d\n", n_in, out_size); grid_blocks = -1; return; }
    int dev = 0, cus = 0, per_cu = 0;
    hipGetDevice(&dev);
    hipDeviceGetAttribute(&cus, hipDeviceAttributeMultiprocessorCount, dev);
    hipFuncSetAttribute((const void*)mega_kernel, hipFuncAttributeMaxDynamicSharedMemorySize, LDS_BYTES);
#if !USE_COOP
    hipFuncSetAttribute((const void*)phase_kernel, hipFuncAttributeMaxDynamicSharedMemorySize, LDS_BYTES);
#endif
    hipOccupancyMaxActiveBlocksPerMultiprocessor(&per_cu, (const void*)mega_kernel, NTHREADS, LDS_BYTES);
    if (per_cu < 1) per_cu = 1;
    if (per_cu > 1) per_cu = 1;
    grid_blocks = cus * per_cu;
    fprintf(stderr, "kernel_launch: cus=%d per_cu=%d grid=%d ws=%zu\n", cus, per_cu, grid_blocks, ws_size);
  }
  if (grid_blocks < 0) return;
  Params p{};
  p.x_prompt = (const float*)d_in[0]; p.x_sample = (const float*)d_in[1];
  p.c_sb_k = (const float*)d_in[2]; p.c_sb_v = (const float*)d_in[3]; p.c_dsa_k = (const float*)d_in[4]; p.c_dsa_v = (const float*)d_in[5]; p.c_idx_k = (const float*)d_in[6];
  p.ln_in_g = (const float*)d_in[7]; p.ln_in_b = (const float*)d_in[8]; p.w_in = (const float*)d_in[9]; p.b_in = (const float*)d_in[10];
  p.w_pa = (const float*)d_in[11]; p.w_pb = (const float*)d_in[12]; p.w_out = (const float*)d_in[13]; p.ln_g = (const float*)d_in[14]; p.ln_b = (const float*)d_in[15];
  p.rel_bias = (const float*)d_in[16];
  p.out = (float*)d_out;
  p.ws = (char*)d_ws;
  if (OFF_END > ws_size) { fprintf(stderr, "kernel_launch: workspace too small: need %zu have %zu\n", (size_t)OFF_END, ws_size); return; }
#if USE_COOP
  void* args[] = {&p};
  hipError_t e = hipLaunchCooperativeKernel((const void*)mega_kernel, dim3(grid_blocks), dim3(NTHREADS), args, LDS_BYTES, stream);
  if (e != hipSuccess) fprintf(stderr, "cooperative launch failed: %s (grid %d)\n", hipGetErrorString(e), grid_blocks);
#else
  hipLaunchKernelGGL(phase_kernel, dim3(grid_blocks), dim3(NTHREADS), LDS_BYTES, stream, p, 0, 0);
  for (int l = 0; l < DEPTH; ++l)
    for (int ph = 1; ph <= 6; ++ph) hipLaunchKernelGGL(phase_kernel, dim3(grid_blocks), dim3(NTHREADS), LDS_BYTES, stream, p, ph, l);
#endif
}
```

```cpp
#include <hip/hip_runtime.h>
#include <hip/hip_cooperative_groups.h>
#include <cstdio>
#include <type_traits>
namespace cg = cooperative_groups;

#ifndef USE_COOP
#define USE_COOP 1
#endif

#define DI __device__ __forceinline__
typedef unsigned short bf16_t;
using bf16x8 = __attribute__((ext_vector_type(8))) short;
using bf16x4 = __attribute__((ext_vector_type(4))) short;
using f32x4  = __attribute__((ext_vector_type(4))) float;

constexpr int D_MODEL = 1024, BATCH = 32, SEQ = 2048, DEPTH = 4, DEC_BATCH = 8, DEC_SEQ = 64, PAST = 1024, LS = 1088;
constexpr int MP = BATCH * SEQ;
constexpr int MS = DEC_BATCH * DEC_SEQ;
constexpr int MT = MP + MS;
constexpr int D_IN = 5832, D_INP = 5888;
constexpr float LN_EPS = 1e-5f;
constexpr float ALPHA = 1.681792830507429f;
constexpr float SB_SCALE = 0.125f, ATT_SCALE = 0.125f;
constexpr int NTHREADS = 512, NWAVES = 8;
constexpr int LDS_S = 0, LDS_BM = 131072, LDS_BTAB = 139264, LDS_RB = 143360, LDS_SLOT = 144384, LDS_KI = 144448, LDS_BYTES = 162880;

constexpr size_t O_Y = 0, O_KAP = 67633152, O_VAP = 201850880, O_KBP = 336068608, O_VBP = 352845824, O_KIP = 369623040,
                 O_KAS = 386400256, O_VAS = 387448832, O_KBS = 388497408, O_VBS = 388628480, O_KIS = 388759552;
constexpr int OUT_TOTAL = 388890624;

constexpr size_t al256(size_t x) { return (x + 255) & ~(size_t)255; }
constexpr size_t OFF_XB = 0;
constexpr size_t OFF_QAB = OFF_XB + al256((size_t)MT * 1024 * 2);
constexpr size_t OFF_GA = OFF_QAB + al256((size_t)MT * 1024 * 2);
constexpr size_t OFF_GB = OFF_GA + al256((size_t)MT * 512 * 2);
constexpr size_t OFF_QI = OFF_GB + al256((size_t)MT * 512 * 2);
constexpr size_t OFF_KAP = OFF_QI + al256((size_t)MT * 512 * 2);
constexpr size_t OFF_VATP = OFF_KAP + al256((size_t)MP * 512 * 2);
constexpr size_t OFF_KAS = OFF_VATP + al256((size_t)MP * 512 * 2);
constexpr size_t OFF_VATS = OFF_KAS + al256((size_t)8 * LS * 512 * 2);
constexpr size_t OFF_KBP = OFF_VATS + al256((size_t)8 * LS * 512 * 2);
constexpr size_t OFF_VBTP = OFF_KBP + al256((size_t)MP * 64 * 2);
constexpr size_t OFF_KIP = OFF_VBTP + al256((size_t)MP * 64 * 2);
constexpr size_t OFF_KBS = OFF_KIP + al256((size_t)MP * 64 * 2);
constexpr size_t OFF_VBTS = OFF_KBS + al256((size_t)8 * LS * 64 * 2);
constexpr size_t OFF_KIS = OFF_VBTS + al256((size_t)8 * LS * 64 * 2);
constexpr size_t OFF_WI = OFF_KIS + al256((size_t)8 * LS * 64 * 2);
constexpr size_t OFF_RA = OFF_WI + al256((size_t)MT * 8 * 4);
constexpr size_t OFF_RB = OFF_RA + al256((size_t)MT * 1024 * 2);
constexpr size_t OFF_WINT = OFF_RB + al256((size_t)MT * 1024 * 2);
constexpr size_t OFF_WPAT = OFF_WINT + al256((size_t)D_INP * 1024 * 2);
constexpr size_t OFF_WPBT = OFF_WPAT + al256((size_t)1024 * 512 * 2);
constexpr size_t OFF_WOUTT = OFF_WPBT + al256((size_t)1024 * 512 * 2);
constexpr size_t OFF_BTAB = OFF_WOUTT + al256((size_t)1024 * 1024 * 2);
constexpr size_t OFF_CTR = OFF_BTAB + 4096;
constexpr size_t OFF_END = OFF_CTR + 256;

struct Params {
  const float* x_prompt; const float* x_sample;
  const float* c_sb_k; const float* c_sb_v; const float* c_dsa_k; const float* c_dsa_v; const float* c_idx_k;
  const float* ln_in_g; const float* ln_in_b; const float* w_in; const float* b_in; const float* w_pa; const float* w_pb;
  const float* w_out; const float* ln_g; const float* ln_b; const float* rel_bias;
  float* out; char* ws;
};

DI unsigned short f2bf(float x) { unsigned u = __float_as_uint(x); u += 0x7fffu + ((u >> 16) & 1u); return (unsigned short)(u >> 16); }
DI float bf2f(short h) { return __uint_as_float(((unsigned)(unsigned short)h) << 16); }
typedef __bf16 hbf16x2 __attribute__((ext_vector_type(2)));
typedef float f32x2v __attribute__((ext_vector_type(2)));
typedef unsigned u32x2v __attribute__((ext_vector_type(2)));
typedef unsigned u32x4v __attribute__((ext_vector_type(4)));
DI unsigned pk2(float lo, float hi) { f32x2v v; v.x = lo; v.y = hi; return __builtin_bit_cast(unsigned, __builtin_convertvector(v, hbf16x2)); }
DI bf16x4 pack4(float a, float b, float c, float d) { u32x2v u; u.x = pk2(a, b); u.y = pk2(c, d); return __builtin_bit_cast(bf16x4, u); }
DI bf16x8 pack8(const float (&e)[8]) { u32x4v u; u.x = pk2(e[0], e[1]); u.y = pk2(e[2], e[3]); u.z = pk2(e[4], e[5]); u.w = pk2(e[6], e[7]); return __builtin_bit_cast(bf16x8, u); }
DI bf16x8 ld8(const bf16_t* p) { return *reinterpret_cast<const bf16x8*>(p); }
DI bf16x4 ld4(const bf16_t* p) { return *reinterpret_cast<const bf16x4*>(p); }
DI void st4(bf16_t* p, bf16x4 v) { *reinterpret_cast<bf16x4*>(p) = v; }
DI f32x4 mfma16(bf16x8 a, bf16x8 b, f32x4 c) { return __builtin_amdgcn_mfma_f32_16x16x32_bf16(a, b, c, 0, 0, 0); }
DI int otid() { int t = threadIdx.x; asm volatile("" : "+v"(t)); return t; }
DI int osg(int v) { asm volatile("" : "+s"(v)); return v; }
DI float sigmoidf_(float x) { return __builtin_amdgcn_rcpf(1.f + __expf(-x)); }
struct F2 { float lo, hi; };
DI F2 swap16(float x) { const unsigned u = __float_as_uint(x); auto r = __builtin_amdgcn_permlane16_swap(u, u, false, false); return F2{__uint_as_float(r[0]), __uint_as_float(r[1])}; }
DI F2 swap32(float x) { const unsigned u = __float_as_uint(x); auto r = __builtin_amdgcn_permlane32_swap(u, u, false, false); return F2{__uint_as_float(r[0]), __uint_as_float(r[1])}; }
DI float row_sum16(float x) {
  x += __uint_as_float(__builtin_amdgcn_update_dpp(0, __float_as_uint(x), 0xB1, 0xF, 0xF, true));
  x += __uint_as_float(__builtin_amdgcn_update_dpp(0, __float_as_uint(x), 0x4E, 0xF, 0xF, true));
  x += __uint_as_float(__builtin_amdgcn_update_dpp(0, __float_as_uint(x), 0x141, 0xF, 0xF, true));
  x += __uint_as_float(__builtin_amdgcn_update_dpp(0, __float_as_uint(x), 0x140, 0xF, 0xF, true));
  return x;
}
DI float wave_sum(float x) { x = row_sum16(x); F2 a = swap16(x); x = a.lo + a.hi; F2 b = swap32(x); return b.lo + b.hi; }
DI int hsum32(int x) {
  x += __builtin_amdgcn_update_dpp(0, x, 0xB1, 0xF, 0xF, true);
  x += __builtin_amdgcn_update_dpp(0, x, 0x4E, 0xF, 0xF, true);
  x += __builtin_amdgcn_update_dpp(0, x, 0x141, 0xF, 0xF, true);
  x += __builtin_amdgcn_update_dpp(0, x, 0x140, 0xF, 0xF, true);
  auto r = __builtin_amdgcn_permlane16_swap((unsigned)x, (unsigned)x, false, false);
  return (int)(r[0] + r[1]);
}
DI void gbar(unsigned* ctr, unsigned target) {
  asm volatile("s_waitcnt vmcnt(0)" ::: "memory");
  __syncthreads();
  if (otid() == 0) {
    __builtin_amdgcn_fence(__ATOMIC_RELEASE, "agent");
    asm volatile("s_waitcnt vmcnt(0)" ::: "memory");
    __hip_atomic_fetch_add(ctr, 1u, __ATOMIC_RELAXED, __HIP_MEMORY_SCOPE_AGENT);
    while (__hip_atomic_load(ctr, __ATOMIC_RELAXED, __HIP_MEMORY_SCOPE_AGENT) < target) __builtin_amdgcn_s_sleep(2);
    __builtin_amdgcn_fence(__ATOMIC_ACQUIRE, "agent");
    asm volatile("s_waitcnt vmcnt(0)" ::: "memory");
  }
  __syncthreads();
}

DI void ln_row_wave(const float* src, const float* g, const float* b, float* d32, bf16_t* db, int lane) {
  float4 v[4]; float s = 0.f;
#pragma unroll
  for (int i = 0; i < 4; ++i) { v[i] = reinterpret_cast<const float4*>(src)[lane + 64 * i]; s += v[i].x + v[i].y + v[i].z + v[i].w; }
  s = wave_sum(s);
  const float mu = s * (1.f / 1024.f);
  float q = 0.f;
#pragma unroll
  for (int i = 0; i < 4; ++i) { float a = v[i].x - mu, bb = v[i].y - mu, c = v[i].z - mu, d = v[i].w - mu; q += a * a + bb * bb + c * c + d * d; }
  q = wave_sum(q);
  const float rstd = rsqrtf(q * (1.f / 1024.f) + LN_EPS);
#pragma unroll
  for (int i = 0; i < 4; ++i) {
    float4 gg = reinterpret_cast<const float4*>(g)[lane + 64 * i], bb = reinterpret_cast<const float4*>(b)[lane + 64 * i];
    float4 o;
    o.x = (v[i].x - mu) * rstd * gg.x + bb.x; o.y = (v[i].y - mu) * rstd * gg.y + bb.y;
    o.z = (v[i].z - mu) * rstd * gg.z + bb.z; o.w = (v[i].w - mu) * rstd * gg.w + bb.w;
    reinterpret_cast<float4*>(d32)[lane + 64 * i] = o;
    st4(db + 4 * (lane + 64 * i), pack4(o.x, o.y, o.z, o.w));
  }
}

DI void ln_rows2(const float* s0, const float* s1, const float* g, const float* b, float* d0, bf16_t* db0, float* d1, bf16_t* db1, int lane) {
  float4 v0[4], v1[4]; float a0 = 0.f, a1 = 0.f;
#pragma unroll
  for (int i = 0; i < 4; ++i) { v0[i] = reinterpret_cast<const float4*>(s0)[lane + 64 * i]; v1[i] = reinterpret_cast<const float4*>(s1)[lane + 64 * i]; }
#pragma unroll
  for (int i = 0; i < 4; ++i) { a0 += v0[i].x + v0[i].y + v0[i].z + v0[i].w; a1 += v1[i].x + v1[i].y + v1[i].z + v1[i].w; }
  a0 = wave_sum(a0); a1 = wave_sum(a1);
  const float mu0 = a0 * (1.f / 1024.f), mu1 = a1 * (1.f / 1024.f);
  float q0 = 0.f, q1 = 0.f;
#pragma unroll
  for (int i = 0; i < 4; ++i) {
    { float a = v0[i].x - mu0, bb = v0[i].y - mu0, c = v0[i].z - mu0, d = v0[i].w - mu0; q0 += a * a + bb * bb + c * c + d * d; }
    { float a = v1[i].x - mu1, bb = v1[i].y - mu1, c = v1[i].z - mu1, d = v1[i].w - mu1; q1 += a * a + bb * bb + c * c + d * d; }
  }
  q0 = wave_sum(q0); q1 = wave_sum(q1);
  const float r0 = rsqrtf(q0 * (1.f / 1024.f) + LN_EPS), r1 = rsqrtf(q1 * (1.f / 1024.f) + LN_EPS);
#pragma unroll
  for (int i = 0; i < 4; ++i) {
    const float4 gg = reinterpret_cast<const float4*>(g)[lane + 64 * i], bb = reinterpret_cast<const float4*>(b)[lane + 64 * i];
    float4 o;
    o.x = (v0[i].x - mu0) * r0 * gg.x + bb.x; o.y = (v0[i].y - mu0) * r0 * gg.y + bb.y; o.z = (v0[i].z - mu0) * r0 * gg.z + bb.z; o.w = (v0[i].w - mu0) * r0 * gg.w + bb.w;
    reinterpret_cast<float4*>(d0)[lane + 64 * i] = o; st4(db0 + 4 * (lane + 64 * i), pack4(o.x, o.y, o.z, o.w));
    o.x = (v1[i].x - mu1) * r1 * gg.x + bb.x; o.y = (v1[i].y - mu1) * r1 * gg.y + bb.y; o.z = (v1[i].z - mu1) * r1 * gg.z + bb.z; o.w = (v1[i].w - mu1) * r1 * gg.w + bb.w;
    reinterpret_cast<float4*>(d1)[lane + 64 * i] = o; st4(db1 + 4 * (lane + 64 * i), pack4(o.x, o.y, o.z, o.w));
  }
}

DI void tconv_tile(const float* src, int ldsrc, int K, bf16_t* dst, int n0, int k0, bool winmap, float* tile, int dk = 0) {
  const int tid = otid();
#pragma unroll
  for (int rr = 0; rr < 8; ++rr) {
    const int kl = rr * 8 + (tid >> 6), nl = tid & 63, np = n0 + nl;
    int n = np; bool ok = true;
    if (winmap) { if (np >= 3840) n = np - 56; else if (np >= 3784) ok = false; }
    tile[kl * 65 + nl] = ok ? src[(size_t)(k0 + kl) * ldsrc + n] : 0.f;
  }
  __syncthreads();
#pragma unroll
  for (int rr = 0; rr < 8; ++rr) {
    const int nl = rr * 8 + (tid >> 6), kl = tid & 63;
    dst[(size_t)(n0 + nl) * K + dk + k0 + kl] = f2bf(tile[kl * 65 + nl]);
  }
  __syncthreads();
}

DI void convert_layer(const Params& p, int l, char* smem) {
  float* tile = reinterpret_cast<float*>(smem);
  const int G = osg(gridDim.x);
  for (int it = blockIdx.x; it < 1984; it += G) {
    if (it < 1472) { int nt = it >> 4, kt = it & 15; tconv_tile(p.w_in + (size_t)l * 1024 * D_IN, D_IN, 1024, (reinterpret_cast<bf16_t*>(p.ws + OFF_WINT)), nt * 64, kt * 64, true, tile); }
    else if (it < 1600) { int i = it - 1472; int nt = i >> 3, kt = i & 7; tconv_tile(p.w_pa + (size_t)l * 512 * 1024, 1024, 1024, (reinterpret_cast<bf16_t*>(p.ws + OFF_WPAT)), nt * 64, kt * 64, false, tile); }
    else if (it < 1728) { int i = it - 1600; int nt = i >> 3, kt = i & 7; tconv_tile(p.w_pb + (size_t)l * 512 * 1024, 1024, 1024, (reinterpret_cast<bf16_t*>(p.ws + OFF_WPAT)), nt * 64, kt * 64, false, tile, 512); }
    else { int i = it - 1728; int nt = i >> 4, kt = i & 15; tconv_tile(p.w_out + (size_t)l * 1024 * 1024, 1024, 1024, (reinterpret_cast<bf16_t*>(p.ws + OFF_WOUTT)), nt * 64, kt * 64, false, tile); }
  }
  const int gtid = blockIdx.x * NTHREADS + otid(), gn = G * NTHREADS;
#pragma unroll 4
  for (int idx = gtid; idx < 8 * 1024 * 512; idx += gn) {
    int b = idx >> 19, rem = idx & ((1 << 19) - 1);
    (reinterpret_cast<bf16_t*>(p.ws + OFF_KAS))[(size_t)b * LS * 512 + rem] = f2bf(p.c_sb_k[(size_t)l * 8 * 1024 * 512 + idx]);
  }
#pragma unroll 4
  for (int idx = gtid; idx < 8 * 512 * 1024; idx += gn) {
    int b = idx >> 19, hd = (idx >> 10) & 511, t = idx & 1023;
    (reinterpret_cast<bf16_t*>(p.ws + OFF_VATS))[((size_t)b * 512 + hd) * LS + t] = f2bf(p.c_sb_v[(((size_t)l * 8 + b) * 1024 + t) * 512 + hd]);
  }
  for (int idx = gtid; idx < 8 * 1024 * 64; idx += gn) {
    int b = idx >> 16, rem = idx & 65535;
    (reinterpret_cast<bf16_t*>(p.ws + OFF_KBS))[(size_t)b * LS * 64 + rem] = f2bf(p.c_dsa_k[(size_t)l * 8 * 65536 + idx]);
    (reinterpret_cast<bf16_t*>(p.ws + OFF_KIS))[(size_t)b * LS * 64 + rem] = f2bf(p.c_idx_k[(size_t)l * 8 * 65536 + idx]);
    int d = (idx >> 10) & 63, t = idx & 1023;
    (reinterpret_cast<bf16_t*>(p.ws + OFF_VBTS))[((size_t)b * 64 + d) * LS + t] = f2bf(p.c_dsa_v[(((size_t)l * 8 + b) * 1024 + t) * 64 + d]);
  }
}

DI void phase_prologue(const Params& p, char* smem) {
  const int tid = otid(), lane = tid & 63;
  if (blockIdx.x == 0 && tid < 16) (reinterpret_cast<int*>(p.ws + OFF_CTR))[tid] = 0;
  for (int i = blockIdx.x * NTHREADS + tid; i < 4096; i += gridDim.x * NTHREADS) {
    int rel = i - 2047; int n = rel < 0 ? -rel : rel;
    float nf = (float)(n > 1 ? n : 1);
    int large = 8 + (int)(logf(nf / 8.f) / 2.7725887f * 8.f);
    large = large < 15 ? large : 15;
    int bk = (rel > 0 ? 16 : 0) + (n < 8 ? n : large);
    (reinterpret_cast<unsigned char*>(p.ws + OFF_BTAB))[i] = (unsigned char)bk;
  }
  {
    const int stride = gridDim.x * NWAVES;
    for (int row = blockIdx.x * NWAVES + (tid >> 6); row < MT; row += 2 * stride) {
      const int row2 = row + stride;
      const float* src = row < MP ? p.x_prompt + (size_t)row * 1024 : p.x_sample + (size_t)(row - MP) * 1024;
      if (row2 < MT) {
        const float* src2 = row2 < MP ? p.x_prompt + (size_t)row2 * 1024 : p.x_sample + (size_t)(row2 - MP) * 1024;
        ln_rows2(src, src2, p.ln_in_g, p.ln_in_b, p.out + (size_t)row * 1024, (reinterpret_cast<bf16_t*>(p.ws + OFF_XB)) + (size_t)row * 1024, p.out + (size_t)row2 * 1024, (reinterpret_cast<bf16_t*>(p.ws + OFF_XB)) + (size_t)row2 * 1024, lane);
      } else ln_row_wave(src, p.ln_in_g, p.ln_in_b, p.out + (size_t)row * 1024, (reinterpret_cast<bf16_t*>(p.ws + OFF_XB)) + (size_t)row * 1024, lane);
    }
  }
  convert_layer(p, 0, smem);
}


namespace pg8 {
#define PG8_LAS __attribute__((address_space(3)))
constexpr int BM = 256, BK = 64, HALF = 128, HTB = HALF * BK * 2, STAGE_BYTES = 8 * HTB, NXCD = 8, WGM = 8;
DI int lds_byte(int r, int c) { const int st = (r >> 4) * 2 + (c >> 5), rr = r & 15, cc = c & 31, ob = rr * 64 + cc * 2; return st * 1024 + (ob ^ (((ob >> 9) & 1) << 5)); }
DI void stage_rc(int b, int& R, int& C) { const int st = b / 1024, sb = b % 1024, swz = sb ^ (((sb >> 9) & 1) << 5); R = (st >> 1) * 16 + swz / 64; C = (st & 1) * 32 + (swz % 64) / 2; }
DI int perm32(int rho) { const int n = rho >> 4, i = rho & 15; return 8 * (i >> 2) + 4 * n + (i & 3); }
struct Unit { int pm, pn; };
struct Gemm { const bf16_t* A; const bf16_t* Bt; int M, N, K; };
struct StaticOrder {
    int nM, nN, nwg, G, c;
    DI void init(int M, int N, int G_, int c_) { nM = M / BM; nN = N / BM; nwg = nM * nN; G = G_; c = c_; }
    DI bool next(int i, Unit& u) const {
        const long L = (long)i * G + c; if (L >= nwg) return false;
        int wgid = (int)L; { const int q = nwg / NXCD, r = nwg % NXCD, xcd = wgid % NXCD, off = wgid / NXCD; wgid = (xcd < r ? xcd * (q + 1) : r * (q + 1) + (xcd - r) * q) + off; }
        const int nig = WGM * nN, gid = wgid / nig, fm = gid * WGM, gsz = (nM - fm) < WGM ? (nM - fm) : WGM;
        u.pm = fm + ((wgid % nig) % gsz); u.pn = (wgid % nig) / gsz; return true;
    }
    DI void a_ready(const Unit&) const {}
    DI void done(const Unit&) const {}
};
template <class Epi, class Sched>
__device__ __forceinline__ void gemm_phase(PG8_LAS unsigned char* lds, const Gemm g, const Sched& S, const Epi& E) {
    const int tid = otid(), wid = __builtin_amdgcn_readfirstlane(tid >> 6), lane = tid & 63, wr = wid >> 2, wc = wid & 3, fr = lane & 15, fq = lane >> 4;
    const int K = g.K, nt = K / BK;
    unsigned voffA[2], voffB[2];
#pragma unroll
    for (int i = 0; i < 2; ++i) { int R, C; stage_rc(tid * 16 + i * 8192, R, C); const int Rb = Epi::PERM ? ((R & ~31) + perm32(R & 31)) : R;
        voffA[i] = (unsigned)(R * K + C) * 2u; voffB[i] = (unsigned)(Rb * K + C) * 2u; }
    const size_t kstep = (size_t)(BK * 2);
    const size_t hstep = (size_t)HALF * K * 2;
    const size_t tstep = 2 * hstep;
    const unsigned ldsw = (unsigned)wid * 1024u;
    const int aoff = lds_byte(wr * 64 + fr, fq * 8), boff = lds_byte(wc * 32 + fr, fq * 8);
#define PG8_SA(b, h) (((b) * 2 + (h)) * HTB)
#define PG8_SB(b, h) ((4 + (b) * 2 + (h)) * HTB)
#define PG8_STAGE(bufoff, gbase, voff) do { _Pragma("unroll") for (int _i = 0; _i < 2; ++_i) \
        __builtin_amdgcn_global_load_lds((const unsigned*)((const char*)(gbase) + (voff)[_i]), (PG8_LAS unsigned*)(lds + (bufoff) + ldsw + _i * 8192), 16, 0, 0); } while (0)
#define PG8_LDA(dst, b, h) do { _Pragma("unroll") for (int m = 0; m < 4; ++m) _Pragma("unroll") for (int k = 0; k < 2; ++k) dst[m][k] = *(const PG8_LAS bf16x8*)(lds + PG8_SA(b, h) + aoff + m * 2048 + k * 1024); } while (0)
#define PG8_LDB(dst, b, h) do { _Pragma("unroll") for (int n = 0; n < 2; ++n) _Pragma("unroll") for (int k = 0; k < 2; ++k) dst[n][k] = *(const PG8_LAS bf16x8*)(lds + PG8_SB(b, h) + boff + n * 2048 + k * 1024); } while (0)
#define PG8_MMA(ai, bj, At, Bt) do { __builtin_amdgcn_s_setprio(1); _Pragma("unroll") for (int m = 0; m < 4; ++m) _Pragma("unroll") for (int n = 0; n < 2; ++n) _Pragma("unroll") for (int k = 0; k < 2; ++k) \
        acc[ai][bj][m][n] = __builtin_amdgcn_mfma_f32_16x16x32_bf16(Bt[n][k], At[m][k], acc[ai][bj][m][n], 0, 0, 0); __builtin_amdgcn_s_setprio(0); } while (0)
#define PG8_WAIT_V(n) asm volatile("s_waitcnt vmcnt(" #n ")" ::: "memory")
#define PG8_WAIT_L(n) asm volatile("s_waitcnt lgkmcnt(" #n ")" ::: "memory")
#define PG8_BAR __builtin_amdgcn_s_barrier()
#define PG8_SCHED __builtin_amdgcn_sched_barrier(0)
    Unit cur, nxt; int ui = 0;
    if (!S.next(0, cur)) return;
    f32x4 acc[2][2][4][2];
#pragma unroll
    for (int a = 0; a < 2; ++a)
#pragma unroll
        for (int b = 0; b < 2; ++b)
#pragma unroll
            for (int m = 0; m < 4; ++m)
#pragma unroll
                for (int n = 0; n < 2; ++n) acc[a][b][m][n] = (f32x4){0.f, 0.f, 0.f, 0.f};
    bf16x8 At[4][2], B0[2][2], B1[2][2];
    const char* cA = (const char*)g.A + (size_t)cur.pm * tstep; const char* cB = (const char*)g.Bt + (size_t)cur.pn * tstep;
    S.a_ready(cur);
    PG8_STAGE(PG8_SB(0, 0), cB, voffB); PG8_STAGE(PG8_SA(0, 0), cA, voffA); PG8_STAGE(PG8_SB(0, 1), cB + hstep, voffB); PG8_STAGE(PG8_SA(0, 1), cA + hstep, voffA);
    if (wr == 1) PG8_BAR;
    PG8_WAIT_V(4); PG8_BAR;
    PG8_STAGE(PG8_SB(1, 0), cB + kstep, voffB); PG8_STAGE(PG8_SA(1, 0), cA + kstep, voffA); PG8_STAGE(PG8_SB(1, 1), cB + hstep + kstep, voffB);
    PG8_WAIT_V(6); PG8_BAR;
    for (;;) {
        const bool has_next = S.next(ui + 1, nxt);
        const char* nA = has_next ? (const char*)g.A + (size_t)nxt.pm * tstep : cA; const char* nB = has_next ? (const char*)g.Bt + (size_t)nxt.pn * tstep : cB;
        for (int t = 0; t < nt; t += 2) {
            const bool last = (t == nt - 2);
            const char* a1 = cA + (size_t)(t + 1) * kstep;
            const char* a2 = last ? nA : cA + (size_t)(t + 2) * kstep; const char* b2 = last ? nB : cB + (size_t)(t + 2) * kstep;
            const char* a3 = a2 + kstep; const char* b3 = b2 + kstep;
            if (last && has_next) S.a_ready(nxt);
            if constexpr (Epi::MIDK) { if (t == nt / 2) E.mid(acc, cur, wr, wc, fr, fq); }
            PG8_LDB(B0, 0, 0); PG8_SCHED; PG8_LDA(At, 0, 0); PG8_STAGE(PG8_SA(1, 1), a1 + hstep, voffA);
            PG8_WAIT_L(8); PG8_BAR; PG8_WAIT_L(0); PG8_MMA(0, 0, At, B0); PG8_BAR; PG8_SCHED;
            PG8_LDB(B1, 0, 1); PG8_STAGE(PG8_SB(0, 0), b2, voffB);
            PG8_BAR; PG8_WAIT_L(0); PG8_MMA(0, 1, At, B1); PG8_BAR;
            PG8_LDA(At, 0, 1); PG8_STAGE(PG8_SA(0, 0), a2, voffA);
            PG8_BAR; PG8_WAIT_L(0); PG8_MMA(1, 0, At, B0); PG8_BAR; PG8_SCHED;
            PG8_STAGE(PG8_SB(0, 1), b2 + hstep, voffB);
            PG8_WAIT_V(6); PG8_BAR; PG8_MMA(1, 1, At, B1); PG8_BAR;
            PG8_LDB(B0, 1, 0); PG8_SCHED; PG8_LDA(At, 1, 0); PG8_STAGE(PG8_SA(0, 1), a2 + hstep, voffA);
            PG8_WAIT_L(8); PG8_BAR; PG8_WAIT_L(0); PG8_MMA(0, 0, At, B0); PG8_BAR; PG8_SCHED;
            PG8_LDB(B1, 1, 1); PG8_STAGE(PG8_SB(1, 0), b3, voffB);
            PG8_BAR; PG8_WAIT_L(0); PG8_MMA(0, 1, At, B1); PG8_BAR;
            PG8_LDA(At, 1, 1); PG8_STAGE(PG8_SA(1, 0), a3, voffA);
            PG8_BAR; PG8_WAIT_L(0); PG8_MMA(1, 0, At, B0); PG8_BAR; PG8_SCHED;
            PG8_STAGE(PG8_SB(1, 1), b3 + hstep, voffB);
            PG8_WAIT_V(6); PG8_BAR; PG8_MMA(1, 1, At, B1); PG8_BAR;
        }
        if constexpr (!Epi::AFTER_DRAIN) { E(acc, cur, wr, wc, fr, fq); S.done(cur); }
        if (!has_next) break;
#pragma unroll
        for (int a = 0; a < 2; ++a)
#pragma unroll
            for (int b = 0; b < 2; ++b)
#pragma unroll
                for (int m = 0; m < 4; ++m)
#pragma unroll
                    for (int n = 0; n < 2; ++n) acc[a][b][m][n] = (f32x4){0.f, 0.f, 0.f, 0.f};
        cur = nxt; cA = nA; cB = nB; ++ui;
    }
    PG8_WAIT_V(0);
    if (wr == 0) PG8_BAR;
    PG8_BAR;
    if constexpr (Epi::AFTER_DRAIN) { E.fused(acc, cur, wr, wc, fr, fq, lds, wid, lane); S.done(cur); }
#undef PG8_SA
#undef PG8_SB
#undef PG8_STAGE
#undef PG8_LDA
#undef PG8_LDB
#undef PG8_MMA
#undef PG8_WAIT_V
#undef PG8_WAIT_L
#undef PG8_BAR
#undef PG8_SCHED
}
}

DI bf16x4 pack4v(const f32x4 v) { return pack4(v[0], v[1], v[2], v[3]); }

struct EpiProj {
  static constexpr bool PERM = true, AFTER_DRAIN = false, MIDK = false;
  const Params& p; int layer; const __attribute__((address_space(3))) float* biasl;
  template <int GRP>
  DI void run(const f32x4 (&acc)[2][2][4][2], const pg8::Unit& u, int wr, int wc, int fr, int fq) const {
    constexpr int T = GRP ? LS : SEQ;
    char* ws = p.ws;
#pragma unroll
    for (int bj = 0; bj < 2; ++bj) {
      const int nt = 2 * u.pn + bj;
      const __attribute__((address_space(3))) f32x4* bp = reinterpret_cast<const __attribute__((address_space(3))) f32x4*>(biasl + nt * 128 + 32 * wc + 8 * fq);
      const bool simple = (nt < 4) || (nt >= 12 && nt < 20) || (nt >= 21 && nt < 29) || (nt >= 30);
      if (simple) {
        size_t off; int ld, c0, act;
        if (nt < 4) { off = OFF_QAB; ld = 1024; c0 = nt * 128; act = 0; }
        else if (nt < 16) { off = OFF_GA; ld = 512; c0 = (nt - 12) * 128; act = 1; }
        else if (nt < 20) { off = OFF_QAB; ld = 1024; c0 = 512 + (nt - 16) * 128; act = 0; }
        else if (nt < 25) { off = OFF_GB; ld = 512; c0 = (nt - 21) * 128; act = 1; }
        else if (nt < 29) { off = OFF_QI; ld = 512; c0 = (nt - 25) * 128; act = 0; }
        else if (nt < 38) { off = OFF_RA; ld = 1024; c0 = (nt - 30) * 128; act = 2; }
        else { off = OFF_RB; ld = 1024; c0 = (nt - 38) * 128; act = 2; }
        bf16_t* dst = reinterpret_cast<bf16_t*>(ws + off) + c0 + 32 * wc + 8 * fq;
#pragma unroll
        for (int ai = 0; ai < 2; ++ai)
#pragma unroll
          for (int m = 0; m < 4; ++m) {
            int row = u.pm * 256 + 128 * ai + 64 * wr + 16 * m + fr;
            asm volatile("" : "+v"(row));
            if (act == 2) {
              u32x2v g8;
#pragma unroll
              for (int n = 0; n < 2; ++n) {
                const f32x4 v = acc[ai][bj][m][n] + bp[n];
                unsigned q = 0u;
#pragma unroll
                for (int j = 0; j < 4; ++j) q |= ((unsigned)(sigmoidf_(v[j]) * 255.f + 0.5f)) << (8 * j);
                if (n == 0) g8.x = q; else g8.y = q;
              }
              *reinterpret_cast<u32x2v*>(reinterpret_cast<unsigned char*>(ws + off) + (size_t)row * 1024 + c0 + 32 * wc + 8 * fq) = g8;
              continue;
            }
            u32x4v pk;
#pragma unroll
            for (int n = 0; n < 2; ++n) {
              f32x4 v = acc[ai][bj][m][n] + bp[n];
              if (act != 0) {
#pragma unroll
                for (int j = 0; j < 4; ++j) { const float sg = sigmoidf_(v[j]); v[j] = (act == 1) ? v[j] * sg : sg; }
              }
              if (n == 0) { pk.x = pk2(v[0], v[1]); pk.y = pk2(v[2], v[3]); } else { pk.z = pk2(v[0], v[1]); pk.w = pk2(v[2], v[3]); }
            }
            *reinterpret_cast<u32x4v*>(dst + (size_t)row * ld) = pk;
          }
      } else {
#pragma unroll
        for (int ai = 0; ai < 2; ++ai)
#pragma unroll
          for (int m = 0; m < 4; ++m) {
            int row = u.pm * 256 + 128 * ai + 64 * wr + 16 * m + fr;
            asm volatile("" : "+v"(row));
            int bb, tt;
            if (!GRP) { bb = row >> 11; tt = row & 2047; } else { const int ms = row - MP; bb = ms >> 6; tt = PAST + (ms & 63); }
            const size_t orow = GRP ? (size_t)layer * MS + (row - MP) : (size_t)layer * MP + row;
#pragma unroll
            for (int n = 0; n < 2; ++n) {
              int ct = 32 * wc + 8 * fq + 4 * n;
              asm volatile("" : "+v"(ct));
              const f32x4 v = acc[ai][bj][m][n] + bp[n];
              if (nt < 8) {
                const int c = (nt - 4) * 128 + ct;
                *reinterpret_cast<f32x4*>(p.out + (GRP ? O_KAS : O_KAP) + orow * 512 + c) = v;
                bf16_t* kd = GRP ? (reinterpret_cast<bf16_t*>(p.ws + OFF_KAS)) + ((size_t)bb * LS + tt) * 512 + c : (reinterpret_cast<bf16_t*>(p.ws + OFF_KAP)) + (size_t)row * 512 + c;
                st4(kd, pack4v(v));
              } else if (nt < 12) {
                const int c = (nt - 8) * 128 + ct;
                *reinterpret_cast<f32x4*>(p.out + (GRP ? O_VAS : O_VAP) + orow * 512 + c) = v;
                bf16_t* vd = (GRP ? (reinterpret_cast<bf16_t*>(p.ws + OFF_VATS)) : (reinterpret_cast<bf16_t*>(p.ws + OFF_VATP))) + ((size_t)bb * 512 + c) * T + tt;
                vd[0] = f2bf(v[0]); vd[T] = f2bf(v[1]); vd[2 * T] = f2bf(v[2]); vd[3 * T] = f2bf(v[3]);
              } else if (nt == 20) {
                if (wc < 2) {
                  *reinterpret_cast<f32x4*>(p.out + (GRP ? O_KBS : O_KBP) + orow * 64 + ct) = v;
                  st4((GRP ? (reinterpret_cast<bf16_t*>(p.ws + OFF_KBS)) : (reinterpret_cast<bf16_t*>(p.ws + OFF_KBP))) + ((size_t)bb * T + tt) * 64 + ct, pack4v(v));
                } else {
                  const int c = ct - 64;
                  *reinterpret_cast<f32x4*>(p.out + (GRP ? O_VBS : O_VBP) + orow * 64 + c) = v;
                  bf16_t* vd = (GRP ? (reinterpret_cast<bf16_t*>(p.ws + OFF_VBTS)) : (reinterpret_cast<bf16_t*>(p.ws + OFF_VBTP))) + ((size_t)bb * 64 + c) * T + tt;
                  vd[0] = f2bf(v[0]); vd[T] = f2bf(v[1]); vd[2 * T] = f2bf(v[2]); vd[3 * T] = f2bf(v[3]);
                }
              } else {
                if (wc < 2) {
                  *reinterpret_cast<f32x4*>(p.out + (GRP ? O_KIS : O_KIP) + orow * 64 + ct) = v;
                  st4((GRP ? (reinterpret_cast<bf16_t*>(p.ws + OFF_KIS)) : (reinterpret_cast<bf16_t*>(p.ws + OFF_KIP))) + ((size_t)bb * T + tt) * 64 + ct, pack4v(v));
                } else if (ct < 72) {
                  *reinterpret_cast<f32x4*>((reinterpret_cast<float*>(p.ws + OFF_WI)) + (size_t)row * 8 + (ct - 64)) = v;
                }
              }
            }
          }
      }
    }
  }
  DI void operator()(const f32x4 (&acc)[2][2][4][2], const pg8::Unit& u, int wr, int wc, int fr, int fq) const {
    if (u.pm < MP / 256) run<0>(acc, u, wr, wc, fr, fq); else run<1>(acc, u, wr, wc, fr, fq);
  }
};

template <int MODE>
struct EpiTail {
  static constexpr bool PERM = false, AFTER_DRAIN = false, MIDK = (MODE == 0);
  const Params& p;
  DI void mid(f32x4 (&acc)[2][2][4][2], const pg8::Unit& u, int wr, int wc, int fr, int fq) const {
#pragma unroll
    for (int ai = 0; ai < 2; ++ai)
#pragma unroll
      for (int m = 0; m < 4; ++m) {
        int row = u.pm * 256 + 128 * ai + 64 * wr + 16 * m + fr;
        asm volatile("" : "+v"(row));
#pragma unroll
        for (int bj = 0; bj < 2; ++bj)
#pragma unroll
          for (int n = 0; n < 2; ++n) {
            const size_t idx = (size_t)row * 1024 + u.pn * 256 + 128 * bj + 32 * wc + 16 * n + 4 * fq;
            const unsigned ga = *reinterpret_cast<const unsigned*>(reinterpret_cast<const unsigned char*>(p.ws + OFF_RA) + idx);
            const unsigned gb = *reinterpret_cast<const unsigned*>(reinterpret_cast<const unsigned char*>(p.ws + OFF_RB) + idx);
#pragma unroll
            for (int j = 0; j < 4; ++j) {
              const unsigned a8 = (ga >> (8 * j)) & 255u, b8 = (gb >> (8 * j)) & 255u;
              acc[ai][bj][m][n][j] *= (float)a8 * __builtin_amdgcn_rcpf((float)(b8 > 1u ? b8 : 1u));
            }
          }
        asm volatile("" ::: "memory");
      }
  }
  DI void operator()(const f32x4 (&acc)[2][2][4][2], const pg8::Unit& u, int wr, int wc, int fr, int fq) const {
    bf16_t* MERGED = (reinterpret_cast<bf16_t*>(p.ws + OFF_GA));
#pragma unroll
    for (int ai = 0; ai < 2; ++ai)
#pragma unroll
      for (int m = 0; m < 4; ++m) {
        const int row = u.pm * 256 + 128 * ai + 64 * wr + 16 * m + fr;
#pragma unroll
        for (int bj = 0; bj < 2; ++bj)
#pragma unroll
          for (int n = 0; n < 2; ++n) {
            const size_t idx = (size_t)row * 1024 + u.pn * 256 + 128 * bj + 32 * wc + 16 * n + 4 * fq;
            const f32x4 a = acc[ai][bj][m][n];
            if (MODE == 0) {
              const unsigned g = *reinterpret_cast<const unsigned*>(reinterpret_cast<const unsigned char*>(p.ws + OFF_RB) + idx);
              const float k = 1.f / 255.f;
              st4(MERGED + idx, pack4((float)(g & 255u) * k * a[0], (float)((g >> 8) & 255u) * k * a[1], (float)((g >> 16) & 255u) * k * a[2], (float)(g >> 24) * k * a[3]));
            } else {
              f32x4 x = *reinterpret_cast<const f32x4*>(p.out + idx);
              x = x * ALPHA + a;
              *reinterpret_cast<f32x4*>(p.out + idx) = x;
            }
          }
      }
  }
};

DI void phase_proj(const Params& p, int layer, char* smem) {
  {
    const float* bin = p.b_in + (size_t)layer * D_IN;
    float* bl = reinterpret_cast<float*>(smem + 131072);
    for (int i = otid(); i < D_INP; i += NTHREADS) bl[i] = (i < 3784) ? bin[i] : (i < 3840 ? 0.f : bin[i - 56]);
    __syncthreads();
  }
  pg8::Gemm g{(reinterpret_cast<bf16_t*>(p.ws + OFF_XB)), (reinterpret_cast<bf16_t*>(p.ws + OFF_WINT)), MT, D_INP, 1024};
  pg8::StaticOrder S; S.init(MT, D_INP, osg(gridDim.x), osg(blockIdx.x));
  EpiProj E{p, layer, (const __attribute__((address_space(3))) float*)(smem + 131072)};
  pg8::gemm_phase<EpiProj, pg8::StaticOrder>((PG8_LAS unsigned char*)smem, g, S, E);
}
DI void phase_merge(const Params& p, char* smem) {
  pg8::Gemm g{(reinterpret_cast<bf16_t*>(p.ws + OFF_QAB)), (reinterpret_cast<bf16_t*>(p.ws + OFF_WPAT)), MT, 1024, 1024};
  pg8::StaticOrder S; S.init(MT, 1024, osg(gridDim.x), osg(blockIdx.x));
  EpiTail<0> E{p};
  pg8::gemm_phase<EpiTail<0>, pg8::StaticOrder>((PG8_LAS unsigned char*)smem, g, S, E);
}
DI void phase_out(const Params& p, char* smem) {
  pg8::Gemm g{(reinterpret_cast<bf16_t*>(p.ws + OFF_GA)), (reinterpret_cast<bf16_t*>(p.ws + OFF_WOUTT)), MT, 1024, 1024};
  pg8::StaticOrder S; S.init(MT, 1024, osg(gridDim.x), osg(blockIdx.x));
  EpiTail<2> E{p};
  pg8::gemm_phase<EpiTail<2>, pg8::StaticOrder>((PG8_LAS unsigned char*)smem, g, S, E);
}

template <int grp>
DI void sb_item(const Params& p, int b, int h, int t0) {
  const int tid = otid(), w = tid >> 6, lane = tid & 63, c = lane & 15, q4 = lane >> 4;
  const int T = grp ? LS : SEQ;
  const int qpos0 = grp ? PAST + t0 : t0;
  const int m0 = grp ? MP + b * DEC_SEQ + t0 : b * SEQ + t0;
  const bf16_t* Kb = (grp ? (reinterpret_cast<bf16_t*>(p.ws + OFF_KAS)) : (reinterpret_cast<bf16_t*>(p.ws + OFF_KAP))) + (size_t)b * T * 512 + h * 64;
  const bf16_t* VTb = (grp ? (reinterpret_cast<bf16_t*>(p.ws + OFF_VATS)) : (reinterpret_cast<bf16_t*>(p.ws + OFF_VATP))) + (size_t)(b * 8 + h) * 64 * T;
  const bf16_t* qp = (reinterpret_cast<bf16_t*>(p.ws + OFF_QAB)) + (size_t)(m0 + c) * 1024 + h * 64 + q4 * 8;
  const bf16x8 qf0 = ld8(qp), qf1 = ld8(qp + 32);
  const int qpos = qpos0 + c;
  float R = 0.f;
  f32x4 O[4];
#pragma unroll
  for (int dt = 0; dt < 4; ++dt) O[dt] = f32x4{0.f, 0.f, 0.f, 0.f};
  bf16x8 kfA[2][2], vfA[4], kfB[2][2], vfB[4];
  auto loadkv = [&](int kb, bf16x8 (&kf)[2][2], bf16x8 (&vf)[4]) {
    const int s0 = kb * 32;
#pragma unroll
    for (int kt = 0; kt < 2; ++kt) { const bf16_t* kp = Kb + (size_t)(s0 + 16 * kt + c) * 512 + q4 * 8; kf[kt][0] = ld8(kp); kf[kt][1] = ld8(kp + 32); }
#pragma unroll
    for (int dt = 0; dt < 4; ++dt) {
      const bf16_t* vp = VTb + (size_t)(16 * dt + c) * T + s0 + 4 * q4;
      bf16x4 lo = ld4(vp), hi = ld4(vp + 16);
      vf[dt] = __builtin_shufflevector(lo, hi, 0, 1, 2, 3, 4, 5, 6, 7);
    }
  };
  auto comp = [&](int kb, const bf16x8 (&kf)[2][2], const bf16x8 (&vf)[4]) -> bool {
    const int s0 = kb * 32;
    f32x4 z[2];
#pragma unroll
    for (int kt = 0; kt < 2; ++kt) {
      z[kt] = mfma16(kf[kt][0], qf0, f32x4{0.f, 0.f, 0.f, 0.f});
      z[kt] = mfma16(kf[kt][1], qf1, z[kt]);
    }
    float lk[2][4], ls[2][4]; bool bf[2][4];
#pragma unroll
    for (int kt = 0; kt < 2; ++kt)
#pragma unroll
      for (int r = 0; r < 4; ++r) {
        const int key = s0 + 16 * kt + 4 * q4 + r;
        const bool before = key < qpos;
        const float zz = z[kt][r] * SB_SCALE;
        const float sp = fmaxf(zz, 0.f) + __logf(1.f + __expf(-fabsf(zz)));
        bf[kt][r] = before; lk[kt][r] = before ? -sp : 0.f; ls[kt][r] = zz - sp;
      }
    const float T1 = (lk[1][0] + lk[1][1]) + (lk[1][2] + lk[1][3]);
    const float T0 = (lk[0][0] + lk[0][1]) + (lk[0][2] + lk[0][3]);
    const F2 x1 = swap16(T1), x0 = swap16(T0);
    const float p1 = x1.lo + x1.hi, p0 = x0.lo + x0.hi;
    const F2 y1 = swap32(p1), y0 = swap32(p0);
    const float H1 = ((q4 & 1) ? 0.f : x1.hi) + ((q4 & 2) ? 0.f : y1.hi);
    const float H0 = ((q4 & 1) ? 0.f : x0.hi) + ((q4 & 2) ? 0.f : y0.hi);
    const float TT1 = y1.lo + y1.hi, TT0 = y0.lo + y0.hi;
    float a[2][4];
    { float ac = R + H1;
#pragma unroll
      for (int r = 3; r >= 0; --r) { a[1][r] = bf[1][r] ? __expf(ls[1][r] + ac) : 0.f; ac += lk[1][r]; } }
    { float ac = R + TT1 + H0;
#pragma unroll
      for (int r = 3; r >= 0; --r) { a[0][r] = bf[0][r] ? __expf(ls[0][r] + ac) : 0.f; ac += lk[0][r]; } }
    R = R + TT1 + TT0;
    const float ae[8] = {a[0][0], a[0][1], a[0][2], a[0][3], a[1][0], a[1][1], a[1][2], a[1][3]};
    const bf16x8 pf = pack8(ae);
#pragma unroll
    for (int dt = 0; dt < 4; ++dt) O[dt] = mfma16(vf[dt], pf, O[dt]);
    return __ballot(R > -50.f) == 0ull;
  };
  {
    int kb = (qpos0 + 14) >> 5;
    loadkv(kb, kfA, vfA);
    while (true) {
      if (kb >= 1) loadkv(kb - 1, kfB, vfB);
      if (comp(kb, kfA, vfA) || kb == 0) break;
      --kb;
      if (kb >= 1) loadkv(kb - 1, kfA, vfA);
      if (comp(kb, kfB, vfB) || kb == 0) break;
      --kb;
    }
  }
#pragma unroll
  for (int dt = 0; dt < 4; ++dt) {
    const size_t off = (size_t)(m0 + c) * 512 + h * 64 + dt * 16 + 4 * q4;
    const size_t offq = (size_t)(m0 + c) * 1024 + h * 64 + dt * 16 + 4 * q4;
    const bf16x4 g = ld4((reinterpret_cast<bf16_t*>(p.ws + OFF_GA)) + off);
    st4((reinterpret_cast<bf16_t*>(p.ws + OFF_QAB)) + offq, pack4(O[dt][0] * bf2f(g[0]), O[dt][1] * bf2f(g[1]), O[dt][2] * bf2f(g[2]), O[dt][3] * bf2f(g[3])));
  }
}

typedef unsigned short us2v __attribute__((ext_vector_type(2)));
template <int NK>
DI void topk_round(const unsigned short* Sh, int n_adm, int half, int l32, unsigned* bmrow) {
  constexpr int NP = NK / 2;
  us2v kp[NP];
#pragma unroll
  for (int i = 0; i < NP; ++i) {
    const int s0 = 64 * i + l32, s1 = s0 + 32;
    const unsigned short k0 = Sh[s0], k1 = Sh[s1];
    kp[i].x = (s0 < n_adm) ? k0 : (unsigned short)0;
    kp[i].y = (s1 < n_adm) ? k1 : (unsigned short)0;
  }
  unsigned tau = 1u; int need = 0; bool done = true;
  if (n_adm > 256) {
    tau = 0u; done = false;
    for (int bit = 15; bit >= 0; --bit) {
      const unsigned cand = tau | (1u << bit);
      const unsigned cv = cand | (cand << 16), one = 0x00010001u;
      unsigned acc = 0u;
#pragma unroll
      for (int i = 0; i < NP; ++i) {
        unsigned d, m;
        asm("v_pk_sub_u16 %0, %1, %2 clamp" : "=v"(d) : "v"(cv), "v"(__builtin_bit_cast(unsigned, kp[i])));
        asm("v_pk_min_u16 %0, %1, %2" : "=v"(m) : "v"(d), "v"(one));
        acc += m;
      }
      int cnt = NK - (int)((acc & 0xFFFFu) + (acc >> 16));
      cnt = hsum32(cnt);
      if (!done && cnt >= 256) tau = cand;
      if (cnt == 256) done = true;
      if (__ballot(!done) == 0ull) break;
    }
  }
  unsigned w0 = 0u, w1 = 0u;
  if (__ballot(!done) == 0ull) {
#pragma unroll
    for (int i = 0; i < NK; ++i) {
      const unsigned key = (i & 1) ? (unsigned)kp[i >> 1].y : (unsigned)kp[i >> 1].x;
      const unsigned long long msel = __ballot(key >= tau);
      const unsigned wsel = half ? (unsigned)(msel >> 32) : (unsigned)msel;
      if (i < 32) { if (l32 == i) w0 = wsel; } else { if (l32 == i - 32) w1 = wsel; }
    }
  } else {
    int cgt = 0;
#pragma unroll
    for (int i = 0; i < NK; ++i) { const unsigned key = (i & 1) ? (unsigned)kp[i >> 1].y : (unsigned)kp[i >> 1].x; cgt += (key > tau) ? 1 : 0; }
    cgt = hsum32(cgt);
    need = 256 - cgt;
    int Rk = 0; const unsigned below = (1u << l32) - 1u;
#pragma unroll
    for (int i = 0; i < NK; ++i) {
      const unsigned key = (i & 1) ? (unsigned)kp[i >> 1].y : (unsigned)kp[i >> 1].x;
      const bool eq = key == tau, gt = key > tau;
      const unsigned long long me = __ballot(eq);
      const unsigned hm = half ? (unsigned)(me >> 32) : (unsigned)me;
      const int rank = Rk + __popc(hm & below);
      const bool sel = done ? (key >= tau) : (gt || (eq && rank < need));
      Rk += __popc(hm);
      const unsigned long long msel = __ballot(sel);
      const unsigned wsel = half ? (unsigned)(msel >> 32) : (unsigned)msel;
      if (i < 32) { if (l32 == i) w0 = wsel; } else { if (l32 == i - 32) w1 = wsel; }
    }
  }
  bmrow[l32] = w0;
  if (NK > 32) bmrow[32 + l32] = w1;
}

template <int grp>
DI void dsa_item(const Params& p, int b, int tile32, char* smem) {
  const int tid = otid(), w = tid >> 6, lane = tid & 63, c = lane & 15, q4 = lane >> 4, half = lane >> 5, l32 = lane & 31;
  unsigned* bm = reinterpret_cast<unsigned*>(smem + LDS_BM);
  const unsigned char* btab = reinterpret_cast<const unsigned char*>(smem + LDS_BTAB);
  const float* rb = reinterpret_cast<const float*>(smem + LDS_RB);
  const int T = grp ? LS : SEQ;
  const int t0 = tile32 * 32;
  const int qpos0 = grp ? PAST + t0 : t0;
  const int m0 = grp ? MP + b * DEC_SEQ + t0 : b * SEQ + t0;
  const int n_adm = grp ? LS : ((qpos0 >> 6) + 1) * 64;
  const bf16_t* KIb = (grp ? (reinterpret_cast<bf16_t*>(p.ws + OFF_KIS)) : (reinterpret_cast<bf16_t*>(p.ws + OFF_KIP))) + (size_t)b * T * 64;
  const bf16_t* KBb = (grp ? (reinterpret_cast<bf16_t*>(p.ws + OFF_KBS)) : (reinterpret_cast<bf16_t*>(p.ws + OFF_KBP))) + (size_t)b * T * 64;
  const bf16_t* VBTb = (grp ? (reinterpret_cast<bf16_t*>(p.ws + OFF_VBTS)) : (reinterpret_cast<bf16_t*>(p.ws + OFF_VBTP))) + (size_t)b * 64 * T;

  unsigned short* S16 = reinterpret_cast<unsigned short*>(smem) + w * 8192;
  {
    const int tlA = c >> 3, hA = c & 7, tlC = q4 >> 1;
    bf16x8 af[2][2]; float4 wv[2];
#pragma unroll
    for (int pr = 0; pr < 2; ++pr) {
      const bf16_t* qip = (reinterpret_cast<bf16_t*>(p.ws + OFF_QI)) + (size_t)(m0 + 4 * w + 2 * pr + tlA) * 512 + hA * 64 + q4 * 8;
      af[pr][0] = ld8(qip); af[pr][1] = ld8(qip + 32);
      wv[pr] = *reinterpret_cast<const float4*>((reinterpret_cast<float*>(p.ws + OFF_WI)) + (size_t)(m0 + 4 * w + 2 * pr + tlC) * 8 + 4 * (q4 & 1));
    }
    const int nch = n_adm >> 6;
    char* kis = smem + LDS_KI;
    const int lrow = tid >> 3, lseg = tid & 7;
    bf16x8 pre = ld8(KIb + (size_t)lrow * 64 + lseg * 8);
    *reinterpret_cast<bf16x8*>(kis + lrow * 144 + lseg * 16) = pre;
    __syncthreads();
    for (int ch = 0; ch < nch; ++ch) {
      const bool more = ch + 1 < nch;
      if (more) pre = ld8(KIb + (size_t)((ch + 1) * 64 + lrow) * 64 + lseg * 8);
      const char* cur = kis + (ch & 1) * 9216;
#pragma unroll
      for (int u = 0; u < 4; ++u) {
        const char* rp = cur + (u * 16 + c) * 144 + q4 * 16;
        const bf16x8 b0 = *reinterpret_cast<const bf16x8*>(rp), b1 = *reinterpret_cast<const bf16x8*>(rp + 64);
#pragma unroll
        for (int pr = 0; pr < 2; ++pr) {
            f32x4 C = mfma16(af[pr][0], b0, f32x4{0.f, 0.f, 0.f, 0.f});
          C = mfma16(af[pr][1], b1, C);
            const float part = wv[pr].x * fmaxf(C[0], 0.f) + wv[pr].y * fmaxf(C[1], 0.f) + wv[pr].z * fmaxf(C[2], 0.f) + wv[pr].w * fmaxf(C[3], 0.f);
          const F2 ps = swap16(part); const float full = ps.lo + ps.hi;
          const unsigned hu = (unsigned)__builtin_bit_cast(unsigned short, (_Float16)full);
          const unsigned hk = hu ^ ((unsigned)__builtin_amdgcn_sbfe((int)hu, 15, 1) | 0x8000u);
          if ((q4 & 1) == 0) S16[(2 * pr + tlC) * 2048 + (ch * 4 + u) * 16 + c] = (unsigned short)hk;
        }
      }
      if (more) *reinterpret_cast<bf16x8*>(kis + ((ch + 1) & 1) * 9216 + lrow * 144 + lseg * 16) = pre;
      __syncthreads();
    }
  }
  for (int rnd = 0; rnd < 2; ++rnd) {
    const unsigned short* Sh = S16 + (2 * rnd + half) * 2048;
    unsigned* bmrow = bm + (4 * w + 2 * rnd + half) * 64;
    const int nreg = n_adm >> 5;
    if (nreg <= 16) topk_round<16>(Sh, n_adm, half, l32, bmrow);
    else if (nreg <= 32) topk_round<32>(Sh, n_adm, half, l32, bmrow);
    else if (nreg <= 48) topk_round<48>(Sh, n_adm, half, l32, bmrow);
    else topk_round<64>(Sh, n_adm, half, l32, bmrow);
  }
  __syncthreads();

  {
    const int tl = c >> 3, h = c & 7;
    bf16x8 qf[2][2]; int qposc[2], qrow[2], qloc[2];
#pragma unroll
    for (int ct = 0; ct < 2; ++ct) {
      qloc[ct] = 4 * w + 2 * ct + tl; qrow[ct] = m0 + qloc[ct]; qposc[ct] = qpos0 + qloc[ct];
      const bf16_t* qp = (reinterpret_cast<bf16_t*>(p.ws + OFF_QAB)) + (size_t)qrow[ct] * 1024 + 512 + h * 64 + q4 * 8;
      qf[ct][0] = ld8(qp); qf[ct][1] = ld8(qp + 32);
    }
    f32x4 O[2][4]; float mrun[2] = {-1e20f, -1e20f}; f32x4 L[2] = {f32x4{0.f, 0.f, 0.f, 0.f}, f32x4{0.f, 0.f, 0.f, 0.f}};
    bf16x8 ones; for (int e = 0; e < 8; ++e) ones[e] = (short)0x3F80;
#pragma unroll
    for (int ct = 0; ct < 2; ++ct)
#pragma unroll
      for (int dt = 0; dt < 4; ++dt) O[ct][dt] = f32x4{0.f, 0.f, 0.f, 0.f};
    const int nkb = n_adm >> 5;
    constexpr float LOG2E = 1.4426950408889634f;
    const float farbias = rb[15 * 8 + h] * LOG2E;
    auto compkv = [&](auto FAR, int kb, const bf16x8 (&kf)[2][2], const bf16x8 (&vf)[4]) {
      constexpr bool far = decltype(FAR)::value;
      const int s0 = kb * 32;
#pragma unroll
      for (int ct = 0; ct < 2; ++ct) {
        f32x4 z0 = mfma16(kf[0][0], qf[ct][0], f32x4{0.f, 0.f, 0.f, 0.f}); z0 = mfma16(kf[0][1], qf[ct][1], z0);
        f32x4 z1 = mfma16(kf[1][0], qf[ct][0], f32x4{0.f, 0.f, 0.f, 0.f}); z1 = mfma16(kf[1][1], qf[ct][1], z1);
        const unsigned word = bm[qloc[ct] * 64 + kb] >> (4 * q4);
        float zz[8]; float bmx = -1e30f;
#pragma unroll
        for (int e = 0; e < 8; ++e) {
          const int kt = e >> 2, r = e & 3;
          float bias = farbias;
          if (!far) { const int rel = s0 + 16 * kt + 4 * q4 + r - qposc[ct]; const int bk = btab[rel + 2047]; bias = rb[bk * 8 + h] * LOG2E; }
          const float zv = (kt ? z1[r] : z0[r]) * (ATT_SCALE * LOG2E) + bias;
          const unsigned sgn = (unsigned)__builtin_amdgcn_sbfe((int)word, 16 * kt + r, 1);
          zz[e] = __uint_as_float((__float_as_uint(zv) & sgn) | (0xF149F2CAu & ~sgn));
          bmx = fmaxf(bmx, zz[e]);
        }
        if (__ballot(bmx > mrun[ct] + 8.f) != 0ull) {
          { const F2 m16 = swap16(bmx); bmx = fmaxf(m16.lo, m16.hi); const F2 m32 = swap32(bmx); bmx = fmaxf(m32.lo, m32.hi); }
          const bool need = bmx > mrun[ct] + 8.f;
          const float mnew = need ? bmx : mrun[ct];
          const float sc = __builtin_amdgcn_exp2f(mrun[ct] - mnew);
          L[ct] *= sc; mrun[ct] = mnew;
#pragma unroll
          for (int dt = 0; dt < 4; ++dt) O[ct][dt] *= sc;
        }
        const float mref = mrun[ct];
        float pe[8];
#pragma unroll
        for (int e = 0; e < 8; ++e) pe[e] = __builtin_amdgcn_exp2f(zz[e] - mref);
        const bf16x8 pf = pack8(pe);
        L[ct] = mfma16(ones, pf, L[ct]);
#pragma unroll
        for (int dt = 0; dt < 4; ++dt) O[ct][dt] = mfma16(vf[dt], pf, O[ct][dt]);
      }
    };
    int nfar = (qpos0 - 159) >= 0 ? ((qpos0 - 159) >> 5) + 1 : 0;
    nfar = nfar < nkb ? nfar : nkb;
    char* kd = smem; char* vd = smem + 18432;
    const int srow = tid >> 3, sseg = tid & 7;
    bf16x8 preK = ld8(KBb + (size_t)srow * 64 + sseg * 8);
    bf16x8 preV = ld8(VBTb + (size_t)srow * T + sseg * 8);
    *reinterpret_cast<bf16x8*>(kd + srow * 144 + sseg * 16) = preK;
    *reinterpret_cast<bf16x8*>(vd + srow * 144 + sseg * 16) = preV;
    __syncthreads();
    const int nkb2 = n_adm >> 6;
    for (int kb2 = 0; kb2 < nkb2; ++kb2) {
      const bool more = kb2 + 1 < nkb2;
      if (more) {
        preK = ld8(KBb + (size_t)((kb2 + 1) * 64 + srow) * 64 + sseg * 8);
        preV = ld8(VBTb + (size_t)srow * T + (kb2 + 1) * 64 + sseg * 8);
      }
      const char* kc = kd + (kb2 & 1) * 9216; const char* vc = vd + (kb2 & 1) * 9216;
#pragma unroll
      for (int sub = 0; sub < 2; ++sub) {
        const int kb = 2 * kb2 + sub;
        bf16x8 kf[2][2], vf[4];
#pragma unroll
        for (int kt = 0; kt < 2; ++kt)
#pragma unroll
          for (int kk = 0; kk < 2; ++kk) kf[kt][kk] = *reinterpret_cast<const bf16x8*>(kc + (32 * sub + 16 * kt + c) * 144 + kk * 64 + q4 * 16);
#pragma unroll
        for (int dt = 0; dt < 4; ++dt) {
          const char* vp = vc + (16 * dt + c) * 144 + sub * 64 + q4 * 8;
          const bf16x4 lo = *reinterpret_cast<const bf16x4*>(vp), hi = *reinterpret_cast<const bf16x4*>(vp + 32);
          vf[dt] = __builtin_shufflevector(lo, hi, 0, 1, 2, 3, 4, 5, 6, 7);
        }
        if (kb < nfar) compkv(std::true_type{}, kb, kf, vf); else compkv(std::false_type{}, kb, kf, vf);
      }
      if (more) {
        *reinterpret_cast<bf16x8*>(kd + ((kb2 + 1) & 1) * 9216 + srow * 144 + sseg * 16) = preK;
        *reinterpret_cast<bf16x8*>(vd + ((kb2 + 1) & 1) * 9216 + srow * 144 + sseg * 16) = preV;
      }
      __syncthreads();
    }
#pragma unroll
    for (int ct = 0; ct < 2; ++ct) {
      const float lt = L[ct][0];
      const float inv = 1.f / lt;
#pragma unroll
      for (int dt = 0; dt < 4; ++dt) {
        const size_t off = (size_t)qrow[ct] * 512 + h * 64 + dt * 16 + 4 * q4;
        const size_t offq = (size_t)qrow[ct] * 1024 + 512 + h * 64 + dt * 16 + 4 * q4;
        const bf16x4 g = ld4((reinterpret_cast<bf16_t*>(p.ws + OFF_GB)) + off);
        st4((reinterpret_cast<bf16_t*>(p.ws + OFF_QAB)) + offq, pack4(O[ct][dt][0] * inv * bf2f(g[0]), O[ct][dt][1] * inv * bf2f(g[1]), O[ct][dt][2] * inv * bf2f(g[2]), O[ct][dt][3] * inv * bf2f(g[3])));
      }
    }
  }
  __syncthreads();
}

DI void phase_attn(const Params& p, int layer, char* smem) {
  const int tid = otid();
  for (int i = tid; i < 4096; i += NTHREADS) smem[LDS_BTAB + i] = (char)(reinterpret_cast<unsigned char*>(p.ws + OFF_BTAB))[i];
  if (tid < 256) reinterpret_cast<float*>(smem + LDS_RB)[tid] = p.rel_bias[tid];
  __syncthreads();
  int* slot = reinterpret_cast<int*>(smem + LDS_SLOT);
  const int w = tid >> 6;
  if (__builtin_amdgcn_readfirstlane(tid) >= 256) __builtin_amdgcn_s_setprio(1);
  const int total = 16 + 2048 + 32 + 4096;
  if (tid == 0) *slot = atomicAdd(&(reinterpret_cast<int*>(p.ws + OFF_CTR))[layer], 1);
  __syncthreads();
  int item = *slot;
  while (item < total) {
    int nxt = 0;
    if (tid == 0) nxt = atomicAdd(&(reinterpret_cast<int*>(p.ws + OFF_CTR))[layer], 1);
    if (item < 16) dsa_item<1>(p, item >> 1, item & 1, smem);
    else if (item < 2064) { const int i = item - 16; dsa_item<0>(p, i >> 6, 63 - (i & 63), smem); }
    else if (item < 2096) { const int i = item - 2064; sb_item<1>(p, i >> 2, 2 * (i & 3) + (w >> 2), (w & 3) * 16); }
    else { const int i = item - 2096; const int tile = 15 - (i >> 8), bh = i & 255; sb_item<0>(p, bh >> 3, bh & 7, tile * 128 + w * 16); }
    __syncthreads();
    if (tid == 0) *slot = nxt;
    __syncthreads();
    item = *slot;
  }
  __builtin_amdgcn_s_setprio(0);
}

DI void phase_ln(const Params& p, int layer, char* smem) {
  const int tid = otid(), lane = tid & 63;
  {
    const int stride = gridDim.x * NWAVES;
    const float* g = p.ln_g + layer * 1024; const float* b = p.ln_b + layer * 1024;
    for (int row = blockIdx.x * NWAVES + (tid >> 6); row < MT; row += 2 * stride) {
      const int row2 = row + stride;
      if (row2 < MT) ln_rows2(p.out + (size_t)row * 1024, p.out + (size_t)row2 * 1024, g, b, p.out + (size_t)row * 1024, (reinterpret_cast<bf16_t*>(p.ws + OFF_XB)) + (size_t)row * 1024, p.out + (size_t)row2 * 1024, (reinterpret_cast<bf16_t*>(p.ws + OFF_XB)) + (size_t)row2 * 1024, lane);
      else ln_row_wave(p.out + (size_t)row * 1024, g, b, p.out + (size_t)row * 1024, (reinterpret_cast<bf16_t*>(p.ws + OFF_XB)) + (size_t)row * 1024, lane);
    }
  }
  if (layer + 1 < DEPTH) convert_layer(p, layer + 1, smem);
}

__global__ void __launch_bounds__(512, 2) mega_kernel(Params p) {
  extern __shared__ __attribute__((aligned(16))) char smem[];
  cg::grid_group grid = cg::this_grid();
  phase_prologue(p, smem);
  grid.sync();
  unsigned* bar = reinterpret_cast<unsigned*>((reinterpret_cast<int*>(p.ws + OFF_CTR)) + 8);
  unsigned nb = 0; const unsigned G = gridDim.x;
#pragma nounroll
  for (int l = 0; l < DEPTH; ++l) {
    phase_proj(p, l, smem);
    gbar(bar, ++nb * G);
    phase_attn(p, l, smem);
    gbar(bar, ++nb * G);
    phase_merge(p, smem);
    gbar(bar, ++nb * G);
    phase_out(p, smem);
    gbar(bar, ++nb * G);
    phase_ln(p, l, smem);
    if (l + 1 < DEPTH) gbar(bar, ++nb * G);
  }
}

#if !USE_COOP
__global__ void __launch_bounds__(512, 2) phase_kernel(Params p, int phase, int layer) {
  extern __shared__ __attribute__((aligned(16))) char smem[];
  if (phase == 0) phase_prologue(p, smem);
  else if (phase == 1) phase_proj(p, layer, smem);
  else if (phase == 2) phase_attn(p, layer, smem);
  else if (phase == 3) phase_merge(p, smem);
  else if (phase == 4) { }
  else if (phase == 5) phase_out(p, smem);
  else phase_ln(p, layer, smem);
}

#endif

extern "C" void kernel_launch(void* const* d_in, const int* in_sizes, int n_in, void* d_out, int out_size, void* d_ws, size_t ws_size, hipStream_t stream) {
  static int grid_blocks = 0;
  if (grid_blocks == 0) {
    if (n_in != 17 || out_size != OUT_TOTAL) { fprintf(stderr, "kernel_launch: unexpected shapes n_in=%d out=%d\n", n_in, out_size); grid_blocks = -1; return; }
    int dev = 0, cus = 0, per_cu = 0;
    hipGetDevice(&dev);
    hipDeviceGetAttribute(&cus, hipDeviceAttributeMultiprocessorCount, dev);
    hipFuncSetAttribute((const void*)mega_kernel, hipFuncAttributeMaxDynamicSharedMemorySize, LDS_BYTES);
#if !USE_COOP
    hipFuncSetAttribute((const void*)phase_kernel, hipFuncAttributeMaxDynamicSharedMemorySize, LDS_BYTES);
#endif
    hipOccupancyMaxActiveBlocksPerMultiprocessor(&per_cu, (const void*)mega_kernel, NTHREADS, LDS_BYTES);
    if (per_cu < 1) per_cu = 1;
    if (per_cu > 1) per_cu = 1;
    grid_blocks = cus * per_cu;
    fprintf(stderr, "kernel_launch: cus=%d per_cu=%d grid=%d ws=%zu\n", cus, per_cu, grid_blocks, ws_size);
  }
  if (grid_blocks < 0) return;
  Params p{};
  p.x_prompt = (const float*)d_in[0]; p.x_sample = (const float*)d_in[1];
  p.c_sb_k = (const float*)d_in[2]; p.c_sb_v = (const float*)d_in[3]; p.c_dsa_k = (const float*)d_in[4]; p.c_dsa_v = (const float*)d_in[5]; p.c_idx_k = (const float*)d_in[6];
  p.ln_in_g = (const float*)d_in[7]; p.ln_in_b = (const float*)d_in[8]; p.w_in = (const float*)d_in[9]; p.b_in = (const float*)d_in[10];
  p.w_pa = (const float*)d_in[11]; p.w_pb = (const float*)d_in[12]; p.w_out = (const float*)d_in[13]; p.ln_g = (const float*)d_in[14]; p.ln_b = (const float*)d_in[15];
  p.rel_bias = (const float*)d_in[16];
  p.out = (float*)d_out;
  p.ws = (char*)d_ws;
  if (OFF_END > ws_size) { fprintf(stderr, "kernel_launch: workspace too small: need %zu have %zu\n", (size_t)OFF_END, ws_size); return; }
#if USE_COOP
  void* args[] = {&p};
  hipError_t e = hipLaunchCooperativeKernel((const void*)mega_kernel, dim3(grid_blocks), dim3(NTHREADS), args, LDS_BYTES, stream);
  if (e != hipSuccess) fprintf(stderr, "cooperative launch failed: %s (grid %d)\n", hipGetErrorString(e), grid_blocks);
#else
  hipLaunchKernelGGL(phase_kernel, dim3(grid_blocks), dim3(NTHREADS), LDS_BYTES, stream, p, 0, 0);
  for (int l = 0; l < DEPTH; ++l)
    for (int ph = 1; ph <= 6; ++ph) hipLaunchKernelGGL(phase_kernel, dim3(grid_blocks), dim3(NTHREADS), LDS_BYTES, stream, p, ph, l);
#endif
}
```

```cpp
#include <hip/hip_runtime.h>
#include <hip/hip_cooperative_groups.h>
#include <cstdio>
#include <type_traits>
namespace cg = cooperative_groups;

#ifndef USE_COOP
#define USE_COOP 1
#endif

#define DI __device__ __forceinline__
typedef unsigned short bf16_t;
using bf16x8 = __attribute__((ext_vector_type(8))) short;
using bf16x4 = __attribute__((ext_vector_type(4))) short;
using f32x4  = __attribute__((ext_vector_type(4))) float;

constexpr int D_MODEL = 1024, BATCH = 32, SEQ = 2048, DEPTH = 4, DEC_BATCH = 8, DEC_SEQ = 64, PAST = 1024, LS = 1088;
constexpr int MP = BATCH * SEQ;
constexpr int MS = DEC_BATCH * DEC_SEQ;
constexpr int MT = MP + MS;
constexpr int D_IN = 5832, D_INP = 5888;
constexpr float LN_EPS = 1e-5f;
constexpr float ALPHA = 1.681792830507429f;
constexpr float SB_SCALE = 0.125f, ATT_SCALE = 0.125f;
constexpr int NTHREADS = 512, NWAVES = 8;
constexpr int LDS_S = 0, LDS_BM = 131072, LDS_BTAB = 139264, LDS_RB = 143360, LDS_SLOT = 144384, LDS_KI = 144448, LDS_BYTES = 162880;

constexpr size_t O_Y = 0, O_KAP = 67633152, O_VAP = 201850880, O_KBP = 336068608, O_VBP = 352845824, O_KIP = 369623040,
                 O_KAS = 386400256, O_VAS = 387448832, O_KBS = 388497408, O_VBS = 388628480, O_KIS = 388759552;
constexpr int OUT_TOTAL = 388890624;

constexpr size_t al256(size_t x) { return (x + 255) & ~(size_t)255; }
constexpr size_t OFF_XB = 0;
constexpr size_t OFF_QAB = OFF_XB + al256((size_t)MT * 1024 * 2);
constexpr size_t OFF_GA = OFF_QAB + al256((size_t)MT * 1024 * 2);
constexpr size_t OFF_GB = OFF_GA + al256((size_t)MT * 512 * 2);
constexpr size_t OFF_QI = OFF_GB + al256((size_t)MT * 512 * 2);
constexpr size_t OFF_KAP = OFF_QI + al256((size_t)MT * 512 * 2);
constexpr size_t OFF_VATP = OFF_KAP + al256((size_t)MP * 512 * 2);
constexpr size_t OFF_KAS = OFF_VATP + al256((size_t)MP * 512 * 2);
constexpr size_t OFF_VATS = OFF_KAS + al256((size_t)8 * LS * 512 * 2);
constexpr size_t OFF_KBP = OFF_VATS + al256((size_t)8 * LS * 512 * 2);
constexpr size_t OFF_VBTP = OFF_KBP + al256((size_t)MP * 64 * 2);
constexpr size_t OFF_KIP = OFF_VBTP + al256((size_t)MP * 64 * 2);
constexpr size_t OFF_KBS = OFF_KIP + al256((size_t)MP * 64 * 2);
constexpr size_t OFF_VBTS = OFF_KBS + al256((size_t)8 * LS * 64 * 2);
constexpr size_t OFF_KIS = OFF_VBTS + al256((size_t)8 * LS * 64 * 2);
constexpr size_t OFF_WI = OFF_KIS + al256((size_t)8 * LS * 64 * 2);
constexpr size_t OFF_RA = OFF_WI + al256((size_t)MT * 8 * 4);
constexpr size_t OFF_RB = OFF_RA + al256((size_t)MT * 1024 * 2);
constexpr size_t OFF_WINT = OFF_RB + al256((size_t)MT * 1024 * 2);
constexpr size_t OFF_WPAT = OFF_WINT + al256((size_t)D_INP * 1024 * 2);
constexpr size_t OFF_WPBT = OFF_WPAT + al256((size_t)1024 * 512 * 2);
constexpr size_t OFF_WOUTT = OFF_WPBT + al256((size_t)1024 * 512 * 2);
constexpr size_t OFF_BTAB = OFF_WOUTT + al256((size_t)1024 * 1024 * 2);
constexpr size_t OFF_CTR = OFF_BTAB + 4096;
constexpr size_t OFF_END = OFF_CTR + 256;

struct Params {
  const float* x_prompt; const float* x_sample;
  const float* c_sb_k; const float* c_sb_v; const float* c_dsa_k; const float* c_dsa_v; const float* c_idx_k;
  const float* ln_in_g; const float* ln_in_b; const float* w_in; const float* b_in; const float* w_pa; const float* w_pb;
  const float* w_out; const float* ln_g; const float* ln_b; const float* rel_bias;
  float* out; char* ws;
};

DI unsigned short f2bf(float x) { unsigned u = __float_as_uint(x); u += 0x7fffu + ((u >> 16) & 1u); return (unsigned short)(u >> 16); }
DI float bf2f(short h) { return __uint_as_float(((unsigned)(unsigned short)h) << 16); }
typedef __bf16 hbf16x2 __attribute__((ext_vector_type(2)));
typedef float f32x2v __attribute__((ext_vector_type(2)));
typedef unsigned u32x2v __attribute__((ext_vector_type(2)));
typedef unsigned u32x4v __attribute__((ext_vector_type(4)));
DI unsigned pk2(float lo, float hi) { f32x2v v; v.x = lo; v.y = hi; return __builtin_bit_cast(unsigned, __builtin_convertvector(v, hbf16x2)); }
DI bf16x4 pack4(float a, float b, float c, float d) { u32x2v u; u.x = pk2(a, b); u.y = pk2(c, d); return __builtin_bit_cast(bf16x4, u); }
DI bf16x8 pack8(const float (&e)[8]) { u32x4v u; u.x = pk2(e[0], e[1]); u.y = pk2(e[2], e[3]); u.z = pk2(e[4], e[5]); u.w = pk2(e[6], e[7]); return __builtin_bit_cast(bf16x8, u); }
DI bf16x8 ld8(const bf16_t* p) { return *reinterpret_cast<const bf16x8*>(p); }
DI bf16x4 ld4(const bf16_t* p) { return *reinterpret_cast<const bf16x4*>(p); }
DI void st4(bf16_t* p, bf16x4 v) { *reinterpret_cast<bf16x4*>(p) = v; }
DI f32x4 mfma16(bf16x8 a, bf16x8 b, f32x4 c) { return __builtin_amdgcn_mfma_f32_16x16x32_bf16(a, b, c, 0, 0, 0); }
DI int otid() { int t = threadIdx.x; asm volatile("" : "+v"(t)); return t; }
DI int osg(int v) { asm volatile("" : "+s"(v)); return v; }
DI float sigmoidf_(float x) { return __builtin_amdgcn_rcpf(1.f + __expf(-x)); }
struct F2 { float lo, hi; };
DI F2 swap16(float x) { const unsigned u = __float_as_uint(x); auto r = __builtin_amdgcn_permlane16_swap(u, u, false, false); return F2{__uint_as_float(r[0]), __uint_as_float(r[1])}; }
DI F2 swap32(float x) { const unsigned u = __float_as_uint(x); auto r = __builtin_amdgcn_permlane32_swap(u, u, false, false); return F2{__uint_as_float(r[0]), __uint_as_float(r[1])}; }
DI float row_sum16(float x) {
  x += __uint_as_float(__builtin_amdgcn_update_dpp(0, __float_as_uint(x), 0xB1, 0xF, 0xF, true));
  x += __uint_as_float(__builtin_amdgcn_update_dpp(0, __float_as_uint(x), 0x4E, 0xF, 0xF, true));
  x += __uint_as_float(__builtin_amdgcn_update_dpp(0, __float_as_uint(x), 0x141, 0xF, 0xF, true));
  x += __uint_as_float(__builtin_amdgcn_update_dpp(0, __float_as_uint(x), 0x140, 0xF, 0xF, true));
  return x;
}
DI float wave_sum(float x) { x = row_sum16(x); F2 a = swap16(x); x = a.lo + a.hi; F2 b = swap32(x); return b.lo + b.hi; }
DI int hsum32(int x) {
  x += __builtin_amdgcn_update_dpp(0, x, 0xB1, 0xF, 0xF, true);
  x += __builtin_amdgcn_update_dpp(0, x, 0x4E, 0xF, 0xF, true);
  x += __builtin_amdgcn_update_dpp(0, x, 0x141, 0xF, 0xF, true);
  x += __builtin_amdgcn_update_dpp(0, x, 0x140, 0xF, 0xF, true);
  auto r = __builtin_amdgcn_permlane16_swap((unsigned)x, (unsigned)x, false, false);
  return (int)(r[0] + r[1]);
}
DI void gbar(unsigned* ctr, unsigned target) {
  asm volatile("s_waitcnt vmcnt(0)" ::: "memory");
  __syncthreads();
  if (otid() == 0) {
    __builtin_amdgcn_fence(__ATOMIC_RELEASE, "agent");
    asm volatile("s_waitcnt vmcnt(0)" ::: "memory");
    __hip_atomic_fetch_add(ctr, 1u, __ATOMIC_RELAXED, __HIP_MEMORY_SCOPE_AGENT);
    while (__hip_atomic_load(ctr, __ATOMIC_RELAXED, __HIP_MEMORY_SCOPE_AGENT) < target) __builtin_amdgcn_s_sleep(2);
    __builtin_amdgcn_fence(__ATOMIC_ACQUIRE, "agent");
    asm volatile("s_waitcnt vmcnt(0)" ::: "memory");
  }
  __syncthreads();
}

DI void ln_row_wave(const float* src, const float* g, const float* b, float* d32, bf16_t* db, int lane) {
  float4 v[4]; float s = 0.f;
#pragma unroll
  for (int i = 0; i < 4; ++i) { v[i] = reinterpret_cast<const float4*>(src)[lane + 64 * i]; s += v[i].x + v[i].y + v[i].z + v[i].w; }
  s = wave_sum(s);
  const float mu = s * (1.f / 1024.f);
  float q = 0.f;
#pragma unroll
  for (int i = 0; i < 4; ++i) { float a = v[i].x - mu, bb = v[i].y - mu, c = v[i].z - mu, d = v[i].w - mu; q += a * a + bb * bb + c * c + d * d; }
  q = wave_sum(q);
  const float rstd = rsqrtf(q * (1.f / 1024.f) + LN_EPS);
#pragma unroll
  for (int i = 0; i < 4; ++i) {
    float4 gg = reinterpret_cast<const float4*>(g)[lane + 64 * i], bb = reinterpret_cast<const float4*>(b)[lane + 64 * i];
    float4 o;
    o.x = (v[i].x - mu) * rstd * gg.x + bb.x; o.y = (v[i].y - mu) * rstd * gg.y + bb.y;
    o.z = (v[i].z - mu) * rstd * gg.z + bb.z; o.w = (v[i].w - mu) * rstd * gg.w + bb.w;
    reinterpret_cast<float4*>(d32)[lane + 64 * i] = o;
    st4(db + 4 * (lane + 64 * i), pack4(o.x, o.y, o.z, o.w));
  }
}

DI void ln_rows2(const float* s0, const float* s1, const float* g, const float* b, float* d0, bf16_t* db0, float* d1, bf16_t* db1, int lane) {
  float4 v0[4], v1[4]; float a0 = 0.f, a1 = 0.f;
#pragma unroll
  for (int i = 0; i < 4; ++i) { v0[i] = reinterpret_cast<const float4*>(s0)[lane + 64 * i]; v1[i] = reinterpret_cast<const float4*>(s1)[lane + 64 * i]; }
#pragma unroll
  for (int i = 0; i < 4; ++i) { a0 += v0[i].x + v0[i].y + v0[i].z + v0[i].w; a1 += v1[i].x + v1[i].y + v1[i].z + v1[i].w; }
  a0 = wave_sum(a0); a1 = wave_sum(a1);
  const float mu0 = a0 * (1.f / 1024.f), mu1 = a1 * (1.f / 1024.f);
  float q0 = 0.f, q1 = 0.f;
#pragma unroll
  for (int i = 0; i < 4; ++i) {
    { float a = v0[i].x - mu0, bb = v0[i].y - mu0, c = v0[i].z - mu0, d = v0[i].w - mu0; q0 += a * a + bb * bb + c * c + d * d; }
    { float a = v1[i].x - mu1, bb = v1[i].y - mu1, c = v1[i].z - mu1, d = v1[i].w - mu1; q1 += a * a + bb * bb + c * c + d * d; }
  }
  q0 = wave_sum(q0); q1 = wave_sum(q1);
  const float r0 = rsqrtf(q0 * (1.f / 1024.f) + LN_EPS), r1 = rsqrtf(q1 * (1.f / 1024.f) + LN_EPS);
#pragma unroll
  for (int i = 0; i < 4; ++i) {
    const float4 gg = reinterpret_cast<const float4*>(g)[lane + 64 * i], bb = reinterpret_cast<const float4*>(b)[lane + 64 * i];
    float4 o;
    o.x = (v0[i].x - mu0) * r0 * gg.x + bb.x; o.y = (v0[i].y - mu0) * r0 * gg.y + bb.y; o.z = (v0[i].z - mu0) * r0 * gg.z + bb.z; o.w = (v0[i].w - mu0) * r0 * gg.w + bb.w;
    reinterpret_cast<float4*>(d0)[lane + 64 * i] = o; st4(db0 + 4 * (lane + 64 * i), pack4(o.x, o.y, o.z, o.w));
    o.x = (v1[i].x - mu1) * r1 * gg.x + bb.x; o.y = (v1[i].y - mu1) * r1 * gg.y + bb.y; o.z = (v1[i].z - mu1) * r1 * gg.z + bb.z; o.w = (v1[i].w - mu1) * r1 * gg.w + bb.w;
    reinterpret_cast<float4*>(d1)[lane + 64 * i] = o; st4(db1 + 4 * (lane + 64 * i), pack4(o.x, o.y, o.z, o.w));
  }
}

DI void tconv_tile(const float* src, int ldsrc, int K, bf16_t* dst, int n0, int k0, bool winmap, float* tile, int dk = 0) {
  const int tid = otid();
#pragma unroll
  for (int rr = 0; rr < 8; ++rr) {
    const int kl = rr * 8 + (tid >> 6), nl = tid & 63, np = n0 + nl;
    int n = np; bool ok = true;
    if (winmap) { if (np >= 3840) n = np - 56; else if (np >= 3784) ok = false; }
    tile[kl * 65 + nl] = ok ? src[(size_t)(k0 + kl) * ldsrc + n] : 0.f;
  }
  __syncthreads();
#pragma unroll
  for (int rr = 0; rr < 8; ++rr) {
    const int nl = rr * 8 + (tid >> 6), kl = tid & 63;
    dst[(size_t)(n0 + nl) * K + dk + k0 + kl] = f2bf(tile[kl * 65 + nl]);
  }
  __syncthreads();
}

DI void convert_layer(const Params& p, int l, char* smem) {
  float* tile = reinterpret_cast<float*>(smem);
  const int G = osg(gridDim.x);
  for (int it = blockIdx.x; it < 1984; it += G) {
    if (it < 1472) { int nt = it >> 4, kt = it & 15; tconv_tile(p.w_in + (size_t)l * 1024 * D_IN, D_IN, 1024, (reinterpret_cast<bf16_t*>(p.ws + OFF_WINT)), nt * 64, kt * 64, true, tile); }
    else if (it < 1600) { int i = it - 1472; int nt = i >> 3, kt = i & 7; tconv_tile(p.w_pa + (size_t)l * 512 * 1024, 1024, 1024, (reinterpret_cast<bf16_t*>(p.ws + OFF_WPAT)), nt * 64, kt * 64, false, tile); }
    else if (it < 1728) { int i = it - 1600; int nt = i >> 3, kt = i & 7; tconv_tile(p.w_pb + (size_t)l * 512 * 1024, 1024, 1024, (reinterpret_cast<bf16_t*>(p.ws + OFF_WPAT)), nt * 64, kt * 64, false, tile, 512); }
    else { int i = it - 1728; int nt = i >> 4, kt = i & 15; tconv_tile(p.w_out + (size_t)l * 1024 * 1024, 1024, 1024, (reinterpret_cast<bf16_t*>(p.ws + OFF_WOUTT)), nt * 64, kt * 64, false, tile); }
  }
  const int gtid = blockIdx.x * NTHREADS + otid(), gn = G * NTHREADS;
#pragma unroll 4
  for (int idx = gtid; idx < 8 * 1024 * 512; idx += gn) {
    int b = idx >> 19, rem = idx & ((1 << 19) - 1);
    (reinterpret_cast<bf16_t*>(p.ws + OFF_KAS))[(size_t)b * LS * 512 + rem] = f2bf(p.c_sb_k[(size_t)l * 8 * 1024 * 512 + idx]);
  }
#pragma unroll 4
  for (int idx = gtid; idx < 8 * 512 * 1024; idx += gn) {
    int b = idx >> 19, hd = (idx >> 10) & 511, t = idx & 1023;
    (reinterpret_cast<bf16_t*>(p.ws + OFF_VATS))[((size_t)b * 512 + hd) * LS + t] = f2bf(p.c_sb_v[(((size_t)l * 8 + b) * 1024 + t) * 512 + hd]);
  }
  for (int idx = gtid; idx < 8 * 1024 * 64; idx += gn) {
    int b = idx >> 16, rem = idx & 65535;
    (reinterpret_cast<bf16_t*>(p.ws + OFF_KBS))[(size_t)b * LS * 64 + rem] = f2bf(p.c_dsa_k[(size_t)l * 8 * 65536 + idx]);
    (reinterpret_cast<bf16_t*>(p.ws + OFF_KIS))[(size_t)b * LS * 64 + rem] = f2bf(p.c_idx_k[(size_t)l * 8 * 65536 + idx]);
    int d = (idx >> 10) & 63, t = idx & 1023;
    (reinterpret_cast<bf16_t*>(p.ws + OFF_VBTS))[((size_t)b * 64 + d) * LS + t] = f2bf(p.c_dsa_v[(((size_t)l * 8 + b) * 1024 + t) * 64 + d]);
  }
}

DI void phase_prologue(const Params& p, char* smem) {
  const int tid = otid(), lane = tid & 63;
  if (blockIdx.x == 0 && tid < 16) (reinterpret_cast<int*>(p.ws + OFF_CTR))[tid] = 0;
  for (int i = blockIdx.x * NTHREADS + tid; i < 4096; i += gridDim.x * NTHREADS) {
    int rel = i - 2047; int n = rel < 0 ? -rel : rel;
    float nf = (float)(n > 1 ? n : 1);
    int large = 8 + (int)(logf(nf / 8.f) / 2.7725887f * 8.f);
    large = large < 15 ? large : 15;
    int bk = (rel > 0 ? 16 : 0) + (n < 8 ? n : large);
    (reinterpret_cast<unsigned char*>(p.ws + OFF_BTAB))[i] = (unsigned char)bk;
  }
  {
    const int stride = gridDim.x * NWAVES;
    for (int row = blockIdx.x * NWAVES + (tid >> 6); row < MT; row += 2 * stride) {
      const int row2 = row + stride;
      const float* src = row < MP ? p.x_prompt + (size_t)row * 1024 : p.x_sample + (size_t)(row - MP) * 1024;
      if (row2 < MT) {
        const float* src2 = row2 < MP ? p.x_prompt + (size_t)row2 * 1024 : p.x_sample + (size_t)(row2 - MP) * 1024;
        ln_rows2(src, src2, p.ln_in_g, p.ln_in_b, p.out + (size_t)row * 1024, (reinterpret_cast<bf16_t*>(p.ws + OFF_XB)) + (size_t)row * 1024, p.out + (size_t)row2 * 1024, (reinterpret_cast<bf16_t*>(p.ws + OFF_XB)) + (size_t)row2 * 1024, lane);
      } else ln_row_wave(src, p.ln_in_g, p.ln_in_b, p.out + (size_t)row * 1024, (reinterpret_cast<bf16_t*>(p.ws + OFF_XB)) + (size_t)row * 1024, lane);
    }
  }
  convert_layer(p, 0, smem);
}


namespace pg8 {
#define PG8_LAS __attribute__((address_space(3)))
constexpr int BM = 256, BK = 64, HALF = 128, HTB = HALF * BK * 2, STAGE_BYTES = 8 * HTB, NXCD = 8, WGM = 8;
DI int lds_byte(int r, int c) { const int st = (r >> 4) * 2 + (c >> 5), rr = r & 15, cc = c & 31, ob = rr * 64 + cc * 2; return st * 1024 + (ob ^ (((ob >> 9) & 1) << 5)); }
DI void stage_rc(int b, int& R, int& C) { const int st = b / 1024, sb = b % 1024, swz = sb ^ (((sb >> 9) & 1) << 5); R = (st >> 1) * 16 + swz / 64; C = (st & 1) * 32 + (swz % 64) / 2; }
DI int perm32(int rho) { const int n = rho >> 4, i = rho & 15; return 8 * (i >> 2) + 4 * n + (i & 3); }
struct Unit { int pm, pn; };
struct Gemm { const bf16_t* A; const bf16_t* Bt; int M, N, K; };
struct StaticOrder {
    int nM, nN, nwg, G, c;
    DI void init(int M, int N, int G_, int c_) { nM = M / BM; nN = N / BM; nwg = nM * nN; G = G_; c = c_; }
    DI bool next(int i, Unit& u) const {
        const long L = (long)i * G + c; if (L >= nwg) return false;
        int wgid = (int)L; { const int q = nwg / NXCD, r = nwg % NXCD, xcd = wgid % NXCD, off = wgid / NXCD; wgid = (xcd < r ? xcd * (q + 1) : r * (q + 1) + (xcd - r) * q) + off; }
        const int nig = WGM * nN, gid = wgid / nig, fm = gid * WGM, gsz = (nM - fm) < WGM ? (nM - fm) : WGM;
        u.pm = fm + ((wgid % nig) % gsz); u.pn = (wgid % nig) / gsz; return true;
    }
    DI void a_ready(const Unit&) const {}
    DI void done(const Unit&) const {}
};
template <class Epi, class Sched>
__device__ __forceinline__ void gemm_phase(PG8_LAS unsigned char* lds, const Gemm g, const Sched& S, const Epi& E) {
    const int tid = otid(), wid = __builtin_amdgcn_readfirstlane(tid >> 6), lane = tid & 63, wr = wid >> 2, wc = wid & 3, fr = lane & 15, fq = lane >> 4;
    const int K = g.K, nt = K / BK;
    unsigned voffA[2], voffB[2];
#pragma unroll
    for (int i = 0; i < 2; ++i) { int R, C; stage_rc(tid * 16 + i * 8192, R, C); const int Rb = Epi::PERM ? ((R & ~31) + perm32(R & 31)) : R;
        voffA[i] = (unsigned)(R * K + C) * 2u; voffB[i] = (unsigned)(Rb * K + C) * 2u; }
    const size_t kstep = (size_t)(BK * 2);
    const size_t hstep = (size_t)HALF * K * 2;
    const size_t tstep = 2 * hstep;
    const unsigned ldsw = (unsigned)wid * 1024u;
    const int aoff = lds_byte(wr * 64 + fr, fq * 8), boff = lds_byte(wc * 32 + fr, fq * 8);
#define PG8_SA(b, h) (((b) * 2 + (h)) * HTB)
#define PG8_SB(b, h) ((4 + (b) * 2 + (h)) * HTB)
#define PG8_STAGE(bufoff, gbase, voff) do { _Pragma("unroll") for (int _i = 0; _i < 2; ++_i) \
        __builtin_amdgcn_global_load_lds((const unsigned*)((const char*)(gbase) + (voff)[_i]), (PG8_LAS unsigned*)(lds + (bufoff) + ldsw + _i * 8192), 16, 0, 0); } while (0)
#define PG8_LDA(dst, b, h) do { _Pragma("unroll") for (int m = 0; m < 4; ++m) _Pragma("unroll") for (int k = 0; k < 2; ++k) dst[m][k] = *(const PG8_LAS bf16x8*)(lds + PG8_SA(b, h) + aoff + m * 2048 + k * 1024); } while (0)
#define PG8_LDB(dst, b, h) do { _Pragma("unroll") for (int n = 0; n < 2; ++n) _Pragma("unroll") for (int k = 0; k < 2; ++k) dst[n][k] = *(const PG8_LAS bf16x8*)(lds + PG8_SB(b, h) + boff + n * 2048 + k * 1024); } while (0)
#define PG8_MMA(ai, bj, At, Bt) do { __builtin_amdgcn_s_setprio(1); _Pragma("unroll") for (int m = 0; m < 4; ++m) _Pragma("unroll") for (int n = 0; n < 2; ++n) _Pragma("unroll") for (int k = 0; k < 2; ++k) \
        acc[ai][bj][m][n] = __builtin_amdgcn_mfma_f32_16x16x32_bf16(Bt[n][k], At[m][k], acc[ai][bj][m][n], 0, 0, 0); __builtin_amdgcn_s_setprio(0); } while (0)
#define PG8_WAIT_V(n) asm volatile("s_waitcnt vmcnt(" #n ")" ::: "memory")
#define PG8_WAIT_L(n) asm volatile("s_waitcnt lgkmcnt(" #n ")" ::: "memory")
#define PG8_BAR __builtin_amdgcn_s_barrier()
#define PG8_SCHED __builtin_amdgcn_sched_barrier(0)
    Unit cur, nxt; int ui = 0;
    if (!S.next(0, cur)) return;
    f32x4 acc[2][2][4][2];
#pragma unroll
    for (int a = 0; a < 2; ++a)
#pragma unroll
        for (int b = 0; b < 2; ++b)
#pragma unroll
            for (int m = 0; m < 4; ++m)
#pragma unroll
                for (int n = 0; n < 2; ++n) acc[a][b][m][n] = (f32x4){0.f, 0.f, 0.f, 0.f};
    bf16x8 At[4][2], B0[2][2], B1[2][2];
    const char* cA = (const char*)g.A + (size_t)cur.pm * tstep; const char* cB = (const char*)g.Bt + (size_t)cur.pn * tstep;
    S.a_ready(cur);
    PG8_STAGE(PG8_SB(0, 0), cB, voffB); PG8_STAGE(PG8_SA(0, 0), cA, voffA); PG8_STAGE(PG8_SB(0, 1), cB + hstep, voffB); PG8_STAGE(PG8_SA(0, 1), cA + hstep, voffA);
    if (wr == 1) PG8_BAR;
    PG8_WAIT_V(4); PG8_BAR;
    PG8_STAGE(PG8_SB(1, 0), cB + kstep, voffB); PG8_STAGE(PG8_SA(1, 0), cA + kstep, voffA); PG8_STAGE(PG8_SB(1, 1), cB + hstep + kstep, voffB);
    PG8_WAIT_V(6); PG8_BAR;
    for (;;) {
        const bool has_next = S.next(ui + 1, nxt);
        const char* nA = has_next ? (const char*)g.A + (size_t)nxt.pm * tstep : cA; const char* nB = has_next ? (const char*)g.Bt + (size_t)nxt.pn * tstep : cB;
        for (int t = 0; t < nt; t += 2) {
            const bool last = (t == nt - 2);
            const char* a1 = cA + (size_t)(t + 1) * kstep;
            const char* a2 = last ? nA : cA + (size_t)(t + 2) * kstep; const char* b2 = last ? nB : cB + (size_t)(t + 2) * kstep;
            const char* a3 = a2 + kstep; const char* b3 = b2 + kstep;
            if (last && has_next) S.a_ready(nxt);
            if constexpr (Epi::MIDK) { if (t == nt / 2) E.mid(acc, cur, wr, wc, fr, fq); }
            PG8_LDB(B0, 0, 0); PG8_SCHED; PG8_LDA(At, 0, 0); PG8_STAGE(PG8_SA(1, 1), a1 + hstep, voffA);
            PG8_WAIT_L(8); PG8_BAR; PG8_WAIT_L(0); PG8_MMA(0, 0, At, B0); PG8_BAR; PG8_SCHED;
            PG8_LDB(B1, 0, 1); PG8_STAGE(PG8_SB(0, 0), b2, voffB);
            PG8_BAR; PG8_WAIT_L(0); PG8_MMA(0, 1, At, B1); PG8_BAR;
            PG8_LDA(At, 0, 1); PG8_STAGE(PG8_SA(0, 0), a2, voffA);
            PG8_BAR; PG8_WAIT_L(0); PG8_MMA(1, 0, At, B0); PG8_BAR; PG8_SCHED;
            PG8_STAGE(PG8_SB(0, 1), b2 + hstep, voffB);
            PG8_WAIT_V(6); PG8_BAR; PG8_MMA(1, 1, At, B1); PG8_BAR;
            PG8_LDB(B0, 1, 0); PG8_SCHED; PG8_LDA(At, 1, 0); PG8_STAGE(PG8_SA(0, 1), a2 + hstep, voffA);
            PG8_WAIT_L(8); PG8_BAR; PG8_WAIT_L(0); PG8_MMA(0, 0, At, B0); PG8_BAR; PG8_SCHED;
            PG8_LDB(B1, 1, 1); PG8_STAGE(PG8_SB(1, 0), b3, voffB);
            PG8_BAR; PG8_WAIT_L(0); PG8_MMA(0, 1, At, B1); PG8_BAR;
            PG8_LDA(At, 1, 1); PG8_STAGE(PG8_SA(1, 0), a3, voffA);
            PG8_BAR; PG8_WAIT_L(0); PG8_MMA(1, 0, At, B0); PG8_BAR; PG8_SCHED;
            PG8_STAGE(PG8_SB(1, 1), b3 + hstep, voffB);
            PG8_WAIT_V(6); PG8_BAR; PG8_MMA(1, 1, At, B1); PG8_BAR;
        }
        if constexpr (!Epi::AFTER_DRAIN) { E(acc, cur, wr, wc, fr, fq); S.done(cur); }
        if (!has_next) break;
#pragma unroll
        for (int a = 0; a < 2; ++a)
#pragma unroll
            for (int b = 0; b < 2; ++b)
#pragma unroll
                for (int m = 0; m < 4; ++m)
#pragma unroll
                    for (int n = 0; n < 2; ++n) acc[a][b][m][n] = (f32x4){0.f, 0.f, 0.f, 0.f};
        cur = nxt; cA = nA; cB = nB; ++ui;
    }
    PG8_WAIT_V(0);
    if (wr == 0) PG8_BAR;
    PG8_BAR;
    if constexpr (Epi::AFTER_DRAIN) { E.fused(acc, cur, wr, wc, fr, fq, lds, wid, lane); S.done(cur); }
#undef PG8_SA
#undef PG8_SB
#undef PG8_STAGE
#undef PG8_LDA
#undef PG8_LDB
#undef PG8_MMA
#undef PG8_WAIT_V
#undef PG8_WAIT_L
#undef PG8_BAR
#undef PG8_SCHED
}
}

DI bf16x4 pack4v(const f32x4 v) { return pack4(v[0], v[1], v[2], v[3]); }

struct EpiProj {
  static constexpr bool PERM = true, AFTER_DRAIN = false, MIDK = false;
  const Params& p; int layer; const __attribute__((address_space(3))) float* biasl;
  template <int GRP>
  DI void run(const f32x4 (&acc)[2][2][4][2], const pg8::Unit& u, int wr, int wc, int fr, int fq) const {
    constexpr int T = GRP ? LS : SEQ;
    char* ws = p.ws;
#pragma unroll
    for (int bj = 0; bj < 2; ++bj) {
      const int nt = 2 * u.pn + bj;
      const __attribute__((address_space(3))) f32x4* bp = reinterpret_cast<const __attribute__((address_space(3))) f32x4*>(biasl + nt * 128 + 32 * wc + 8 * fq);
      const bool simple = (nt < 4) || (nt >= 12 && nt < 20) || (nt >= 21 && nt < 29) || (nt >= 30);
      if (simple) {
        size_t off; int ld, c0, act;
        if (nt < 4) { off = OFF_QAB; ld = 1024; c0 = nt * 128; act = 0; }
        else if (nt < 16) { off = OFF_GA; ld = 512; c0 = (nt - 12) * 128; act = 1; }
        else if (nt < 20) { off = OFF_QAB; ld = 1024; c0 = 512 + (nt - 16) * 128; act = 0; }
        else if (nt < 25) { off = OFF_GB; ld = 512; c0 = (nt - 21) * 128; act = 1; }
        else if (nt < 29) { off = OFF_QI; ld = 512; c0 = (nt - 25) * 128; act = 0; }
        else if (nt < 38) { off = OFF_RA; ld = 1024; c0 = (nt - 30) * 128; act = 2; }
        else { off = OFF_RB; ld = 1024; c0 = (nt - 38) * 128; act = 2; }
        bf16_t* dst = reinterpret_cast<bf16_t*>(ws + off) + c0 + 32 * wc + 8 * fq;
#pragma unroll
        for (int ai = 0; ai < 2; ++ai)
#pragma unroll
          for (int m = 0; m < 4; ++m) {
            int row = u.pm * 256 + 128 * ai + 64 * wr + 16 * m + fr;
            asm volatile("" : "+v"(row));
            if (act == 2) {
              u32x2v g8;
#pragma unroll
              for (int n = 0; n < 2; ++n) {
                const f32x4 v = acc[ai][bj][m][n] + bp[n];
                unsigned q = 0u;
#pragma unroll
                for (int j = 0; j < 4; ++j) q |= ((unsigned)(sigmoidf_(v[j]) * 255.f + 0.5f)) << (8 * j);
                if (n == 0) g8.x = q; else g8.y = q;
              }
              *reinterpret_cast<u32x2v*>(reinterpret_cast<unsigned char*>(ws + off) + (size_t)row * 1024 + c0 + 32 * wc + 8 * fq) = g8;
              continue;
            }
            u32x4v pk;
#pragma unroll
            for (int n = 0; n < 2; ++n) {
              f32x4 v = acc[ai][bj][m][n] + bp[n];
              if (act != 0) {
#pragma unroll
                for (int j = 0; j < 4; ++j) { const float sg = sigmoidf_(v[j]); v[j] = (act == 1) ? v[j] * sg : sg; }
              }
              if (n == 0) { pk.x = pk2(v[0], v[1]); pk.y = pk2(v[2], v[3]); } else { pk.z = pk2(v[0], v[1]); pk.w = pk2(v[2], v[3]); }
            }
            *reinterpret_cast<u32x4v*>(dst + (size_t)row * ld) = pk;
          }
      } else {
#pragma unroll
        for (int ai = 0; ai < 2; ++ai)
#pragma unroll
          for (int m = 0; m < 4; ++m) {
            int row = u.pm * 256 + 128 * ai + 64 * wr + 16 * m + fr;
            asm volatile("" : "+v"(row));
            int bb, tt;
            if (!GRP) { bb = row >> 11; tt = row & 2047; } else { const int ms = row - MP; bb = ms >> 6; tt = PAST + (ms & 63); }
            const size_t orow = GRP ? (size_t)layer * MS + (row - MP) : (size_t)layer * MP + row;
#pragma unroll
            for (int n = 0; n < 2; ++n) {
              int ct = 32 * wc + 8 * fq + 4 * n;
              asm volatile("" : "+v"(ct));
              const f32x4 v = acc[ai][bj][m][n] + bp[n];
              if (nt < 8) {
                const int c = (nt - 4) * 128 + ct;
                *reinterpret_cast<f32x4*>(p.out + (GRP ? O_KAS : O_KAP) + orow * 512 + c) = v;
                bf16_t* kd = GRP ? (reinterpret_cast<bf16_t*>(p.ws + OFF_KAS)) + ((size_t)bb * LS + tt) * 512 + c : (reinterpret_cast<bf16_t*>(p.ws + OFF_KAP)) + (size_t)row * 512 + c;
                st4(kd, pack4v(v));
              } else if (nt < 12) {
                const int c = (nt - 8) * 128 + ct;
                *reinterpret_cast<f32x4*>(p.out + (GRP ? O_VAS : O_VAP) + orow * 512 + c) = v;
                bf16_t* vd = (GRP ? (reinterpret_cast<bf16_t*>(p.ws + OFF_VATS)) : (reinterpret_cast<bf16_t*>(p.ws + OFF_VATP))) + ((size_t)bb * 512 + c) * T + tt;
                vd[0] = f2bf(v[0]); vd[T] = f2bf(v[1]); vd[2 * T] = f2bf(v[2]); vd[3 * T] = f2bf(v[3]);
              } else if (nt == 20) {
                if (wc < 2) {
                  *reinterpret_cast<f32x4*>(p.out + (GRP ? O_KBS : O_KBP) + orow * 64 + ct) = v;
                  st4((GRP ? (reinterpret_cast<bf16_t*>(p.ws + OFF_KBS)) : (reinterpret_cast<bf16_t*>(p.ws + OFF_KBP))) + ((size_t)bb * T + tt) * 64 + ct, pack4v(v));
                } else {
                  const int c = ct - 64;
                  *reinterpret_cast<f32x4*>(p.out + (GRP ? O_VBS : O_VBP) + orow * 64 + c) = v;
                  bf16_t* vd = (GRP ? (reinterpret_cast<bf16_t*>(p.ws + OFF_VBTS)) : (reinterpret_cast<bf16_t*>(p.ws + OFF_VBTP))) + ((size_t)bb * 64 + c) * T + tt;
                  vd[0] = f2bf(v[0]); vd[T] = f2bf(v[1]); vd[2 * T] = f2bf(v[2]); vd[3 * T] = f2bf(v[3]);
                }
              } else {
                if (wc < 2) {
                  *reinterpret_cast<f32x4*>(p.out + (GRP ? O_KIS : O_KIP) + orow * 64 + ct) = v;
                  st4((GRP ? (reinterpret_cast<bf16_t*>(p.ws + OFF_KIS)) : (reinterpret_cast<bf16_t*>(p.ws + OFF_KIP))) + ((size_t)bb * T + tt) * 64 + ct, pack4v(v));
                } else if (ct < 72) {
                  *reinterpret_cast<f32x4*>((reinterpret_cast<float*>(p.ws + OFF_WI)) + (size_t)row * 8 + (ct - 64)) = v;
                }
              }
            }
          }
      }
    }
  }
  DI void operator()(const f32x4 (&acc)[2][2][4][2], const pg8::Unit& u, int wr, int wc, int fr, int fq) const {
    if (u.pm < MP / 256) run<0>(acc, u, wr, wc, fr, fq); else run<1>(acc, u, wr, wc, fr, fq);
  }
};

template <int MODE>
struct EpiTail {
  static constexpr bool PERM = false, AFTER_DRAIN = false, MIDK = (MODE == 0);
  const Params& p;
  DI void mid(f32x4 (&acc)[2][2][4][2], const pg8::Unit& u, int wr, int wc, int fr, int fq) const {
#pragma unroll
    for (int ai = 0; ai < 2; ++ai)
#pragma unroll
      for (int m = 0; m < 4; ++m) {
        int row = u.pm * 256 + 128 * ai + 64 * wr + 16 * m + fr;
        asm volatile("" : "+v"(row));
#pragma unroll
        for (int bj = 0; bj < 2; ++bj)
#pragma unroll
          for (int n = 0; n < 2; ++n) {
            const size_t idx = (size_t)row * 1024 + u.pn * 256 + 128 * bj + 32 * wc + 16 * n + 4 * fq;
            const unsigned ga = *reinterpret_cast<const unsigned*>(reinterpret_cast<const unsigned char*>(p.ws + OFF_RA) + idx);
            const unsigned gb = *reinterpret_cast<const unsigned*>(reinterpret_cast<const unsigned char*>(p.ws + OFF_RB) + idx);
#pragma unroll
            for (int j = 0; j < 4; ++j) {
              const unsigned a8 = (ga >> (8 * j)) & 255u, b8 = (gb >> (8 * j)) & 255u;
              acc[ai][bj][m][n][j] *= (float)a8 * __builtin_amdgcn_rcpf((float)(b8 > 1u ? b8 : 1u));
            }
          }
        asm volatile("" ::: "memory");
      }
  }
  DI void operator()(const f32x4 (&acc)[2][2][4][2], const pg8::Unit& u, int wr, int wc, int fr, int fq) const {
    bf16_t* MERGED = (reinterpret_cast<bf16_t*>(p.ws + OFF_GA));
#pragma unroll
    for (int ai = 0; ai < 2; ++ai)
#pragma unroll
      for (int m = 0; m < 4; ++m) {
        const int row = u.pm * 256 + 128 * ai + 64 * wr + 16 * m + fr;
#pragma unroll
        for (int bj = 0; bj < 2; ++bj)
#pragma unroll
          for (int n = 0; n < 2; ++n) {
            const size_t idx = (size_t)row * 1024 + u.pn * 256 + 128 * bj + 32 * wc + 16 * n + 4 * fq;
            const f32x4 a = acc[ai][bj][m][n];
            if (MODE == 0) {
              const unsigned g = *reinterpret_cast<const unsigned*>(reinterpret_cast<const unsigned char*>(p.ws + OFF_RB) + idx);
              const float k = 1.f / 255.f;
              st4(MERGED + idx, pack4((float)(g & 255u) * k * a[0], (float)((g >> 8) & 255u) * k * a[1], (float)((g >> 16) & 255u) * k * a[2], (float)(g >> 24) * k * a[3]));
            } else {
              f32x4 x = *reinterpret_cast<const f32x4*>(p.out + idx);
              x = x * ALPHA + a;
              *reinterpret_cast<f32x4*>(p.out + idx) = x;
            }
          }
      }
  }
};

DI void phase_proj(const Params& p, int layer, char* smem) {
  {
    const float* bin = p.b_in + (size_t)layer * D_IN;
    float* bl = reinterpret_cast<float*>(smem + 131072);
    for (int i = otid(); i < D_INP; i += NTHREADS) bl[i] = (i < 3784) ? bin[i] : (i < 3840 ? 0.f : bin[i - 56]);
    __syncthreads();
  }
  pg8::Gemm g{(reinterpret_cast<bf16_t*>(p.ws + OFF_XB)), (reinterpret_cast<bf16_t*>(p.ws + OFF_WINT)), MT, D_INP, 1024};
  pg8::StaticOrder S; S.init(MT, D_INP, osg(gridDim.x), osg(blockIdx.x));
  EpiProj E{p, layer, (const __attribute__((address_space(3))) float*)(smem + 131072)};
  pg8::gemm_phase<EpiProj, pg8::StaticOrder>((PG8_LAS unsigned char*)smem, g, S, E);
}
DI void phase_merge(const Params& p, char* smem) {
  pg8::Gemm g{(reinterpret_cast<bf16_t*>(p.ws + OFF_QAB)), (reinterpret_cast<bf16_t*>(p.ws + OFF_WPAT)), MT, 1024, 1024};
  pg8::StaticOrder S; S.init(MT, 1024, osg(gridDim.x), osg(blockIdx.x));
  EpiTail<0> E{p};
  pg8::gemm_phase<EpiTail<0>, pg8::StaticOrder>((PG8_LAS unsigned char*)smem, g, S, E);
}
DI void phase_out(const Params& p, char* smem) {
  pg8::Gemm g{(reinterpret_cast<bf16_t*>(p.ws + OFF_GA)), (reinterpret_cast<bf16_t*>(p.ws + OFF_WOUTT)), MT, 1024, 1024};
  pg8::StaticOrder S; S.init(MT, 1024, osg(gridDim.x), osg(blockIdx.x));
  EpiTail<2> E{p};
  pg8::gemm_phase<EpiTail<2>, pg8::StaticOrder>((PG8_LAS unsigned char*)smem, g, S, E);
}

template <int grp>
DI void sb_item(const Params& p, int b, int h, int t0) {
  const int tid = otid(), w = tid >> 6, lane = tid & 63, c = lane & 15, q4 = lane >> 4;
  const int T = grp ? LS : SEQ;
  const int qpos0 = grp ? PAST + t0 : t0;
  const int m0 = grp ? MP + b * DEC_SEQ + t0 : b * SEQ + t0;
  const bf16_t* Kb = (grp ? (reinterpret_cast<bf16_t*>(p.ws + OFF_KAS)) : (reinterpret_cast<bf16_t*>(p.ws + OFF_KAP))) + (size_t)b * T * 512 + h * 64;
  const bf16_t* VTb = (grp ? (reinterpret_cast<bf16_t*>(p.ws + OFF_VATS)) : (reinterpret_cast<bf16_t*>(p.ws + OFF_VATP))) + (size_t)(b * 8 + h) * 64 * T;
  const bf16_t* qp = (reinterpret_cast<bf16_t*>(p.ws + OFF_QAB)) + (size_t)(m0 + c) * 1024 + h * 64 + q4 * 8;
  const bf16x8 qf0 = ld8(qp), qf1 = ld8(qp + 32);
  const int qpos = qpos0 + c;
  float R = 0.f;
  f32x4 O[4];
#pragma unroll
  for (int dt = 0; dt < 4; ++dt) O[dt] = f32x4{0.f, 0.f, 0.f, 0.f};
  bf16x8 kfA[2][2], vfA[4], kfB[2][2], vfB[4];
  auto loadkv = [&](int kb, bf16x8 (&kf)[2][2], bf16x8 (&vf)[4]) {
    const int s0 = kb * 32;
#pragma unroll
    for (int kt = 0; kt < 2; ++kt) { const bf16_t* kp = Kb + (size_t)(s0 + 16 * kt + c) * 512 + q4 * 8; kf[kt][0] = ld8(kp); kf[kt][1] = ld8(kp + 32); }
#pragma unroll
    for (int dt = 0; dt < 4; ++dt) {
      const bf16_t* vp = VTb + (size_t)(16 * dt + c) * T + s0 + 4 * q4;
      bf16x4 lo = ld4(vp), hi = ld4(vp + 16);
      vf[dt] = __builtin_shufflevector(lo, hi, 0, 1, 2, 3, 4, 5, 6, 7);
    }
  };
  auto comp = [&](int kb, const bf16x8 (&kf)[2][2], const bf16x8 (&vf)[4]) -> bool {
    const int s0 = kb * 32;
    f32x4 z[2];
#pragma unroll
    for (int kt = 0; kt < 2; ++kt) {
      z[kt] = mfma16(kf[kt][0], qf0, f32x4{0.f, 0.f, 0.f, 0.f});
      z[kt] = mfma16(kf[kt][1], qf1, z[kt]);
    }
    float lk[2][4], ls[2][4]; bool bf[2][4];
#pragma unroll
    for (int kt = 0; kt < 2; ++kt)
#pragma unroll
      for (int r = 0; r < 4; ++r) {
        const int key = s0 + 16 * kt + 4 * q4 + r;
        const bool before = key < qpos;
        const float zz = z[kt][r] * SB_SCALE;
        const float sp = fmaxf(zz, 0.f) + __logf(1.f + __expf(-fabsf(zz)));
        bf[kt][r] = before; lk[kt][r] = before ? -sp : 0.f; ls[kt][r] = zz - sp;
      }
    const float T1 = (lk[1][0] + lk[1][1]) + (lk[1][2] + lk[1][3]);
    const float T0 = (lk[0][0] + lk[0][1]) + (lk[0][2] + lk[0][3]);
    const F2 x1 = swap16(T1), x0 = swap16(T0);
    const float p1 = x1.lo + x1.hi, p0 = x0.lo + x0.hi;
    const F2 y1 = swap32(p1), y0 = swap32(p0);
    const float H1 = ((q4 & 1) ? 0.f : x1.hi) + ((q4 & 2) ? 0.f : y1.hi);
    const float H0 = ((q4 & 1) ? 0.f : x0.hi) + ((q4 & 2) ? 0.f : y0.hi);
    const float TT1 = y1.lo + y1.hi, TT0 = y0.lo + y0.hi;
    float a[2][4];
    { float ac = R + H1;
#pragma unroll
      for (int r = 3; r >= 0; --r) { a[1][r] = bf[1][r] ? __expf(ls[1][r] + ac) : 0.f; ac += lk[1][r]; } }
    { float ac = R + TT1 + H0;
#pragma unroll
      for (int r = 3; r >= 0; --r) { a[0][r] = bf[0][r] ? __expf(ls[0][r] + ac) : 0.f; ac += lk[0][r]; } }
    R = R + TT1 + TT0;
    const float ae[8] = {a[0][0], a[0][1], a[0][2], a[0][3], a[1][0], a[1][1], a[1][2], a[1][3]};
    const bf16x8 pf = pack8(ae);
#pragma unroll
    for (int dt = 0; dt < 4; ++dt) O[dt] = mfma16(vf[dt], pf, O[dt]);
    return __ballot(R > -30.f) == 0ull;
  };
  {
    int kb = (qpos0 + 14) >> 5;
    loadkv(kb, kfA, vfA);
    while (true) {
      if (kb >= 1) loadkv(kb - 1, kfB, vfB);
      if (comp(kb, kfA, vfA) || kb == 0) break;
      --kb;
      if (kb >= 1) loadkv(kb - 1, kfA, vfA);
      if (comp(kb, kfB, vfB) || kb == 0) break;
      --kb;
    }
  }
#pragma unroll
  for (int dt = 0; dt < 4; ++dt) {
    const size_t off = (size_t)(m0 + c) * 512 + h * 64 + dt * 16 + 4 * q4;
    const size_t offq = (size_t)(m0 + c) * 1024 + h * 64 + dt * 16 + 4 * q4;
    const bf16x4 g = ld4((reinterpret_cast<bf16_t*>(p.ws + OFF_GA)) + off);
    st4((reinterpret_cast<bf16_t*>(p.ws + OFF_QAB)) + offq, pack4(O[dt][0] * bf2f(g[0]), O[dt][1] * bf2f(g[1]), O[dt][2] * bf2f(g[2]), O[dt][3] * bf2f(g[3])));
  }
}

typedef unsigned short us2v __attribute__((ext_vector_type(2)));
template <int NK>
DI void topk_round(const unsigned short* Sh, int n_adm, int half, int l32, unsigned* bmrow) {
  constexpr int NP = NK / 2;
  us2v kp[NP];
#pragma unroll
  for (int i = 0; i < NP; ++i) {
    const int s0 = 64 * i + l32, s1 = s0 + 32;
    const unsigned short k0 = Sh[s0], k1 = Sh[s1];
    kp[i].x = (s0 < n_adm) ? k0 : (unsigned short)0;
    kp[i].y = (s1 < n_adm) ? k1 : (unsigned short)0;
  }
  unsigned tau = 1u; int need = 0; bool done = true;
  if (n_adm > 256) {
    tau = 0u; done = false;
    for (int bit = 15; bit >= 0; --bit) {
      const unsigned cand = tau | (1u << bit);
      const unsigned cv = cand | (cand << 16), one = 0x00010001u;
      unsigned acc = 0u;
#pragma unroll
      for (int i = 0; i < NP; ++i) {
        unsigned d, m;
        asm("v_pk_sub_u16 %0, %1, %2 clamp" : "=v"(d) : "v"(cv), "v"(__builtin_bit_cast(unsigned, kp[i])));
        asm("v_pk_min_u16 %0, %1, %2" : "=v"(m) : "v"(d), "v"(one));
        acc += m;
      }
      int cnt = NK - (int)((acc & 0xFFFFu) + (acc >> 16));
      cnt = hsum32(cnt);
      if (!done && cnt >= 256) tau = cand;
      if (cnt == 256) done = true;
      if (__ballot(!done) == 0ull) break;
    }
  }
  unsigned w0 = 0u, w1 = 0u;
  if (__ballot(!done) == 0ull) {
#pragma unroll
    for (int i = 0; i < NK; ++i) {
      const unsigned key = (i & 1) ? (unsigned)kp[i >> 1].y : (unsigned)kp[i >> 1].x;
      const unsigned long long msel = __ballot(key >= tau);
      const unsigned wsel = half ? (unsigned)(msel >> 32) : (unsigned)msel;
      if (i < 32) { if (l32 == i) w0 = wsel; } else { if (l32 == i - 32) w1 = wsel; }
    }
  } else {
    int cgt = 0;
#pragma unroll
    for (int i = 0; i < NK; ++i) { const unsigned key = (i & 1) ? (unsigned)kp[i >> 1].y : (unsigned)kp[i >> 1].x; cgt += (key > tau) ? 1 : 0; }
    cgt = hsum32(cgt);
    need = 256 - cgt;
    int Rk = 0; const unsigned below = (1u << l32) - 1u;
#pragma unroll
    for (int i = 0; i < NK; ++i) {
      const unsigned key = (i & 1) ? (unsigned)kp[i >> 1].y : (unsigned)kp[i >> 1].x;
      const bool eq = key == tau, gt = key > tau;
      const unsigned long long me = __ballot(eq);
      const unsigned hm = half ? (unsigned)(me >> 32) : (unsigned)me;
      const int rank = Rk + __popc(hm & below);
      const bool sel = done ? (key >= tau) : (gt || (eq && rank < need));
      Rk += __popc(hm);
      const unsigned long long msel = __ballot(sel);
      const unsigned wsel = half ? (unsigned)(msel >> 32) : (unsigned)msel;
      if (i < 32) { if (l32 == i) w0 = wsel; } else { if (l32 == i - 32) w1 = wsel; }
    }
  }
  bmrow[l32] = w0;
  if (NK > 32) bmrow[32 + l32] = w1;
}

template <int grp>
DI void dsa_item(const Params& p, int b, int tile32, char* smem) {
  const int tid = otid(), w = tid >> 6, lane = tid & 63, c = lane & 15, q4 = lane >> 4, half = lane >> 5, l32 = lane & 31;
  unsigned* bm = reinterpret_cast<unsigned*>(smem + LDS_BM);
  const unsigned char* btab = reinterpret_cast<const unsigned char*>(smem + LDS_BTAB);
  const float* rb = reinterpret_cast<const float*>(smem + LDS_RB);
  const int T = grp ? LS : SEQ;
  const int t0 = tile32 * 32;
  const int qpos0 = grp ? PAST + t0 : t0;
  const int m0 = grp ? MP + b * DEC_SEQ + t0 : b * SEQ + t0;
  const int n_adm = grp ? LS : ((qpos0 >> 6) + 1) * 64;
  const bf16_t* KIb = (grp ? (reinterpret_cast<bf16_t*>(p.ws + OFF_KIS)) : (reinterpret_cast<bf16_t*>(p.ws + OFF_KIP))) + (size_t)b * T * 64;
  const bf16_t* KBb = (grp ? (reinterpret_cast<bf16_t*>(p.ws + OFF_KBS)) : (reinterpret_cast<bf16_t*>(p.ws + OFF_KBP))) + (size_t)b * T * 64;
  const bf16_t* VBTb = (grp ? (reinterpret_cast<bf16_t*>(p.ws + OFF_VBTS)) : (reinterpret_cast<bf16_t*>(p.ws + OFF_VBTP))) + (size_t)b * 64 * T;

  unsigned short* S16 = reinterpret_cast<unsigned short*>(smem) + w * 8192;
  {
    const int tlA = c >> 3, hA = c & 7, tlC = q4 >> 1;
    bf16x8 af[2][2]; float4 wv[2];
#pragma unroll
    for (int pr = 0; pr < 2; ++pr) {
      const bf16_t* qip = (reinterpret_cast<bf16_t*>(p.ws + OFF_QI)) + (size_t)(m0 + 4 * w + 2 * pr + tlA) * 512 + hA * 64 + q4 * 8;
      af[pr][0] = ld8(qip); af[pr][1] = ld8(qip + 32);
      wv[pr] = *reinterpret_cast<const float4*>((reinterpret_cast<float*>(p.ws + OFF_WI)) + (size_t)(m0 + 4 * w + 2 * pr + tlC) * 8 + 4 * (q4 & 1));
    }
    const int nch = n_adm >> 6;
    char* kis = smem + LDS_KI;
    const int lrow = tid >> 3, lseg = tid & 7;
    bf16x8 pre = ld8(KIb + (size_t)lrow * 64 + lseg * 8);
    *reinterpret_cast<bf16x8*>(kis + lrow * 144 + lseg * 16) = pre;
    __syncthreads();
    for (int ch = 0; ch < nch; ++ch) {
      const bool more = ch + 1 < nch;
      if (more) pre = ld8(KIb + (size_t)((ch + 1) * 64 + lrow) * 64 + lseg * 8);
      const char* cur = kis + (ch & 1) * 9216;
#pragma unroll
      for (int u = 0; u < 4; ++u) {
        const char* rp = cur + (u * 16 + c) * 144 + q4 * 16;
        const bf16x8 b0 = *reinterpret_cast<const bf16x8*>(rp), b1 = *reinterpret_cast<const bf16x8*>(rp + 64);
#pragma unroll
        for (int pr = 0; pr < 2; ++pr) {
            f32x4 C = mfma16(af[pr][0], b0, f32x4{0.f, 0.f, 0.f, 0.f});
          C = mfma16(af[pr][1], b1, C);
            const float part = wv[pr].x * fmaxf(C[0], 0.f) + wv[pr].y * fmaxf(C[1], 0.f) + wv[pr].z * fmaxf(C[2], 0.f) + wv[pr].w * fmaxf(C[3], 0.f);
          const F2 ps = swap16(part); const float full = ps.lo + ps.hi;
          const unsigned hu = (unsigned)__builtin_bit_cast(unsigned short, (_Float16)full);
          const unsigned hk = hu ^ ((unsigned)__builtin_amdgcn_sbfe((int)hu, 15, 1) | 0x8000u);
          if ((q4 & 1) == 0) S16[(2 * pr + tlC) * 2048 + (ch * 4 + u) * 16 + c] = (unsigned short)hk;
        }
      }
      if (more) *reinterpret_cast<bf16x8*>(kis + ((ch + 1) & 1) * 9216 + lrow * 144 + lseg * 16) = pre;
      __syncthreads();
    }
  }
  for (int rnd = 0; rnd < 2; ++rnd) {
    const unsigned short* Sh = S16 + (2 * rnd + half) * 2048;
    unsigned* bmrow = bm + (4 * w + 2 * rnd + half) * 64;
    const int nreg = n_adm >> 5;
    if (nreg <= 16) topk_round<16>(Sh, n_adm, half, l32, bmrow);
    else if (nreg <= 32) topk_round<32>(Sh, n_adm, half, l32, bmrow);
    else if (nreg <= 48) topk_round<48>(Sh, n_adm, half, l32, bmrow);
    else topk_round<64>(Sh, n_adm, half, l32, bmrow);
  }
  __syncthreads();

  {
    const int tl = c >> 3, h = c & 7;
    bf16x8 qf[2][2]; int qposc[2], qrow[2], qloc[2];
#pragma unroll
    for (int ct = 0; ct < 2; ++ct) {
      qloc[ct] = 4 * w + 2 * ct + tl; qrow[ct] = m0 + qloc[ct]; qposc[ct] = qpos0 + qloc[ct];
      const bf16_t* qp = (reinterpret_cast<bf16_t*>(p.ws + OFF_QAB)) + (size_t)qrow[ct] * 1024 + 512 + h * 64 + q4 * 8;
      qf[ct][0] = ld8(qp); qf[ct][1] = ld8(qp + 32);
    }
    f32x4 O[2][4]; float mrun[2] = {-1e20f, -1e20f}; f32x4 L[2] = {f32x4{0.f, 0.f, 0.f, 0.f}, f32x4{0.f, 0.f, 0.f, 0.f}};
    bf16x8 ones; for (int e = 0; e < 8; ++e) ones[e] = (short)0x3F80;
#pragma unroll
    for (int ct = 0; ct < 2; ++ct)
#pragma unroll
      for (int dt = 0; dt < 4; ++dt) O[ct][dt] = f32x4{0.f, 0.f, 0.f, 0.f};
    const int nkb = n_adm >> 5;
    constexpr float LOG2E = 1.4426950408889634f;
    const float farbias = rb[15 * 8 + h] * LOG2E;
    auto compkv = [&](auto FAR, int kb, const bf16x8 (&kf)[2][2], const bf16x8 (&vf)[4]) {
      constexpr bool far = decltype(FAR)::value;
      const int s0 = kb * 32;
#pragma unroll
      for (int ct = 0; ct < 2; ++ct) {
        f32x4 z0 = mfma16(kf[0][0], qf[ct][0], f32x4{0.f, 0.f, 0.f, 0.f}); z0 = mfma16(kf[0][1], qf[ct][1], z0);
        f32x4 z1 = mfma16(kf[1][0], qf[ct][0], f32x4{0.f, 0.f, 0.f, 0.f}); z1 = mfma16(kf[1][1], qf[ct][1], z1);
        const unsigned word = bm[qloc[ct] * 64 + kb] >> (4 * q4);
        float zz[8]; float bmx = -1e30f;
#pragma unroll
        for (int e = 0; e < 8; ++e) {
          const int kt = e >> 2, r = e & 3;
          float bias = farbias;
          if (!far) { const int rel = s0 + 16 * kt + 4 * q4 + r - qposc[ct]; const int bk = btab[rel + 2047]; bias = rb[bk * 8 + h] * LOG2E; }
          const float zv = (kt ? z1[r] : z0[r]) * (ATT_SCALE * LOG2E) + bias;
          const unsigned sgn = (unsigned)__builtin_amdgcn_sbfe((int)word, 16 * kt + r, 1);
          zz[e] = __uint_as_float((__float_as_uint(zv) & sgn) | (0xF149F2CAu & ~sgn));
          bmx = fmaxf(bmx, zz[e]);
        }
        if (__ballot(bmx > mrun[ct] + 8.f) != 0ull) {
          { const F2 m16 = swap16(bmx); bmx = fmaxf(m16.lo, m16.hi); const F2 m32 = swap32(bmx); bmx = fmaxf(m32.lo, m32.hi); }
          const bool need = bmx > mrun[ct] + 8.f;
          const float mnew = need ? bmx : mrun[ct];
          const float sc = __builtin_amdgcn_exp2f(mrun[ct] - mnew);
          L[ct] *= sc; mrun[ct] = mnew;
#pragma unroll
          for (int dt = 0; dt < 4; ++dt) O[ct][dt] *= sc;
        }
        const float mref = mrun[ct];
        float pe[8];
#pragma unroll
        for (int e = 0; e < 8; ++e) pe[e] = __builtin_amdgcn_exp2f(zz[e] - mref);
        const bf16x8 pf = pack8(pe);
        L[ct] = mfma16(ones, pf, L[ct]);
#pragma unroll
        for (int dt = 0; dt < 4; ++dt) O[ct][dt] = mfma16(vf[dt], pf, O[ct][dt]);
      }
    };
    int nfar = (qpos0 - 159) >= 0 ? ((qpos0 - 159) >> 5) + 1 : 0;
    nfar = nfar < nkb ? nfar : nkb;
    char* kd = smem; char* vd = smem + 18432;
    const int srow = tid >> 3, sseg = tid & 7;
    bf16x8 preK = ld8(KBb + (size_t)srow * 64 + sseg * 8);
    bf16x8 preV = ld8(VBTb + (size_t)srow * T + sseg * 8);
    *reinterpret_cast<bf16x8*>(kd + srow * 144 + sseg * 16) = preK;
    *reinterpret_cast<bf16x8*>(vd + srow * 144 + sseg * 16) = preV;
    __syncthreads();
    const int nkb2 = n_adm >> 6;
    for (int kb2 = 0; kb2 < nkb2; ++kb2) {
      const bool more = kb2 + 1 < nkb2;
      if (more) {
        preK = ld8(KBb + (size_t)((kb2 + 1) * 64 + srow) * 64 + sseg * 8);
        preV = ld8(VBTb + (size_t)srow * T + (kb2 + 1) * 64 + sseg * 8);
      }
      const char* kc = kd + (kb2 & 1) * 9216; const char* vc = vd + (kb2 & 1) * 9216;
#pragma unroll
      for (int sub = 0; sub < 2; ++sub) {
        const int kb = 2 * kb2 + sub;
        bf16x8 kf[2][2], vf[4];
#pragma unroll
        for (int kt = 0; kt < 2; ++kt)
#pragma unroll
          for (int kk = 0; kk < 2; ++kk) kf[kt][kk] = *reinterpret_cast<const bf16x8*>(kc + (32 * sub + 16 * kt + c) * 144 + kk * 64 + q4 * 16);
#pragma unroll
        for (int dt = 0; dt < 4; ++dt) {
          const char* vp = vc + (16 * dt + c) * 144 + sub * 64 + q4 * 8;
          const bf16x4 lo = *reinterpret_cast<const bf16x4*>(vp), hi = *reinterpret_cast<const bf16x4*>(vp + 32);
          vf[dt] = __builtin_shufflevector(lo, hi, 0, 1, 2, 3, 4, 5, 6, 7);
        }
        if (kb < nfar) compkv(std::true_type{}, kb, kf, vf); else compkv(std::false_type{}, kb, kf, vf);
      }
      if (more) {
        *reinterpret_cast<bf16x8*>(kd + ((kb2 + 1) & 1) * 9216 + srow * 144 + sseg * 16) = preK;
        *reinterpret_cast<bf16x8*>(vd + ((kb2 + 1) & 1) * 9216 + srow * 144 + sseg * 16) = preV;
      }
      __syncthreads();
    }
#pragma unroll
    for (int ct = 0; ct < 2; ++ct) {
      const float lt = L[ct][0];
      const float inv = 1.f / lt;
#pragma unroll
      for (int dt = 0; dt < 4; ++dt) {
        const size_t off = (size_t)qrow[ct] * 512 + h * 64 + dt * 16 + 4 * q4;
        const size_t offq = (size_t)qrow[ct] * 1024 + 512 + h * 64 + dt * 16 + 4 * q4;
        const bf16x4 g = ld4((reinterpret_cast<bf16_t*>(p.ws + OFF_GB)) + off);
        st4((reinterpret_cast<bf16_t*>(p.ws + OFF_QAB)) + offq, pack4(O[ct][dt][0] * inv * bf2f(g[0]), O[ct][dt][1] * inv * bf2f(g[1]), O[ct][dt][2] * inv * bf2f(g[2]), O[ct][dt][3] * inv * bf2f(g[3])));
      }
    }
  }
  __syncthreads();
}

DI void phase_attn(const Params& p, int layer, char* smem) {
  const int tid = otid();
  for (int i = tid; i < 4096; i += NTHREADS) smem[LDS_BTAB + i] = (char)(reinterpret_cast<unsigned char*>(p.ws + OFF_BTAB))[i];
  if (tid < 256) reinterpret_cast<float*>(smem + LDS_RB)[tid] = p.rel_bias[tid];
  __syncthreads();
  int* slot = reinterpret_cast<int*>(smem + LDS_SLOT);
  const int w = tid >> 6;
  if (__builtin_amdgcn_readfirstlane(tid) >= 256) __builtin_amdgcn_s_setprio(1);
  const int total = 16 + 2048 + 32 + 4096;
  if (tid == 0) *slot = atomicAdd(&(reinterpret_cast<int*>(p.ws + OFF_CTR))[layer], 1);
  __syncthreads();
  int item = *slot;
  while (item < total) {
    int nxt = 0;
    if (tid == 0) nxt = atomicAdd(&(reinterpret_cast<int*>(p.ws + OFF_CTR))[layer], 1);
    if (item < 16) dsa_item<1>(p, item >> 1, item & 1, smem);
    else if (item < 2064) { const int i = item - 16; dsa_item<0>(p, i >> 6, 63 - (i & 63), smem); }
    else if (item < 2096) { const int i = item - 2064; sb_item<1>(p, i >> 2, 2 * (i & 3) + (w >> 2), (w & 3) * 16); }
    else { const int i = item - 2096; const int tile = 15 - (i >> 8), bh = i & 255; sb_item<0>(p, bh >> 3, bh & 7, tile * 128 + w * 16); }
    __syncthreads();
    if (tid == 0) *slot = nxt;
    __syncthreads();
    item = *slot;
  }
  __builtin_amdgcn_s_setprio(0);
}

DI void phase_ln(const Params& p, int layer, char* smem) {
  const int tid = otid(), lane = tid & 63;
  {
    const int stride = gridDim.x * NWAVES;
    const float* g = p.ln_g + layer * 1024; const float* b = p.ln_b + layer * 1024;
    for (int row = blockIdx.x * NWAVES + (tid >> 6); row < MT; row += 2 * stride) {
      const int row2 = row + stride;
      if (row2 < MT) ln_rows2(p.out + (size_t)row * 1024, p.out + (size_t)row2 * 1024, g, b, p.out + (size_t)row * 1024, (reinterpret_cast<bf16_t*>(p.ws + OFF_XB)) + (size_t)row * 1024, p.out + (size_t)row2 * 1024, (reinterpret_cast<bf16_t*>(p.ws + OFF_XB)) + (size_t)row2 * 1024, lane);
      else ln_row_wave(p.out + (size_t)row * 1024, g, b, p.out + (size_t)row * 1024, (reinterpret_cast<bf16_t*>(p.ws + OFF_XB)) + (size_t)row * 1024, lane);
    }
  }
  if (layer + 1 < DEPTH) convert_layer(p, layer + 1, smem);
}

__global__ void __launch_bounds__(512, 2) mega_kernel(Params p) {
  extern __shared__ __attribute__((aligned(16))) char smem[];
  cg::grid_group grid = cg::this_grid();
  phase_prologue(p, smem);
  grid.sync();
  unsigned* bar = reinterpret_cast<unsigned*>((reinterpret_cast<int*>(p.ws + OFF_CTR)) + 8);
  unsigned nb = 0; const unsigned G = gridDim.x;
#pragma nounroll
  for (int l = 0; l < DEPTH; ++l) {
    phase_proj(p, l, smem);
    gbar(bar, ++nb * G);
    phase_attn(p, l, smem);
    gbar(bar, ++nb * G);
    phase_merge(p, smem);
    gbar(bar, ++nb * G);
    phase_out(p, smem);
    gbar(bar, ++nb * G);
    phase_ln(p, l, smem);
    if (l + 1 < DEPTH) gbar(bar, ++nb * G);
  }
}

#if !USE_COOP
__global__ void __launch_bounds__(512, 2) phase_kernel(Params p, int phase, int layer) {
  extern __shared__ __attribute__((aligned(16))) char smem[];
  if (phase == 0) phase_prologue(p, smem);
  else if (phase == 1) phase_proj(p, layer, smem);
  else if (phase == 2) phase_attn(p, layer, smem);
  else if (phase == 3) phase_merge(p, smem);
  else if (phase == 4) { }
  else if (phase == 5) phase_out(p, smem);
  else phase_ln(p, layer, smem);
}

#endif

extern "C" void kernel_launch(void* const* d_in, const int* in_sizes, int n_in, void* d_out, int out_size, void* d_ws, size_t ws_size, hipStream_t stream) {
  static int grid_blocks = 0;
  if (grid_blocks == 0) {
    if (n_in != 17 || out_size != OUT_TOTAL) { fprintf(stderr, "kernel_launch: unexpected shapes n_in=%d out=%d\n", n_in, out_size); grid_blocks = -1; return; }
    int dev = 0, cus = 0, per_cu = 0;
    hipGetDevice(&dev);
    hipDeviceGetAttribute(&cus, hipDeviceAttributeMultiprocessorCount, dev);
    hipFuncSetAttribute((const void*)mega_kernel, hipFuncAttributeMaxDynamicSharedMemorySize, LDS_BYTES);
#if !USE_COOP
    hipFuncSetAttribute((const void*)phase_kernel, hipFuncAttributeMaxDynamicSharedMemorySize, LDS_BYTES);
#endif
    hipOccupancyMaxActiveBlocksPerMultiprocessor(&per_cu, (const void*)mega_kernel, NTHREADS, LDS_BYTES);
    if (per_cu < 1) per_cu = 1;
    if (per_cu > 1) per_cu = 1;
    grid_blocks = cus * per_cu;
    fprintf(stderr, "kernel_launch: cus=%d per_cu=%d grid=%d ws=%zu\n", cus, per_cu, grid_blocks, ws_size);
  }
  if (grid_blocks < 0) return;
  Params p{};
  p.x_prompt = (const float*)d_in[0]; p.x_sample = (const float*)d_in[1];
  p.c_sb_k = (const float*)d_in[2]; p.c_sb_v = (const float*)d_in[3]; p.c_dsa_k = (const float*)d_in[4]; p.c_dsa_v = (const float*)d_in[5]; p.c_idx_k = (const float*)d_in[6];
  p.ln_in_g = (const float*)d_in[7]; p.ln_in_b = (const float*)d_in[8]; p.w_in = (const float*)d_in[9]; p.b_in = (const float*)d_in[10];
  p.w_pa = (const float*)d_in[11]; p.w_pb = (const float*)d_in[12]; p.w_out = (const float*)d_in[13]; p.ln_g = (const float*)d_in[14]; p.ln_b = (const float*)d_in[15];
  p.rel_bias = (const float*)d_in[16];
  p.out = (float*)d_out;
  p.ws = (char*)d_ws;
  if (OFF_END > ws_size) { fprintf(stderr, "kernel_launch: workspace too small: need %zu have %zu\n", (size_t)OFF_END, ws_size); return; }
#if USE_COOP
  void* args[] = {&p};
  hipError_t e = hipLaunchCooperativeKernel((const void*)mega_kernel, dim3(grid_blocks), dim3(NTHREADS), args, LDS_BYTES, stream);
  if (e != hipSuccess) fprintf(stderr, "cooperative launch failed: %s (grid %d)\n", hipGetErrorString(e), grid_blocks);
#else
  hipLaunchKernelGGL(phase_kernel, dim3(grid_blocks), dim3(NTHREADS), LDS_BYTES, stream, p, 0, 0);
  for (int l = 0; l < DEPTH; ++l)
    for (int ph = 1; ph <= 6; ++ph) hipLaunchKernelGGL(phase_kernel, dim3(grid_blocks), dim3(NTHREADS), LDS_BYTES, stream, p, ph, l);
#endif
}
```
